# Optimizing an MI355X kernel written in HIP

```python
import math
import jax
import jax.numpy as jnp
from jax import lax
import numpy as np

D_MODEL = 2048
BATCH = 8
SEQ = 4096
DEPTH = 4

CHUNK = 64
N_META = 16
Q_BLOCK = 128
EPS = 1e-6

N_MIXERS = 4
GROUP_WIDTH = D_MODEL // N_MIXERS
D_MIX = N_MIXERS * GROUP_WIDTH
HEAD_DIM = 64

SSD_HEADS = GROUP_WIDTH // HEAD_DIM
SSD_GROUPS = 2
SSD_STATE = 128
SSD_CONV = 4
SSD_XBC = GROUP_WIDTH + 2 * SSD_GROUPS * SSD_STATE

POOL_WINDOWS = (2, 4, 8, 16)
POOL_GROUP_DIM = GROUP_WIDTH // len(POOL_WINDOWS)

FOX_HEADS = GROUP_WIDTH // HEAD_DIM

DSA_HEADS = GROUP_WIDTH // HEAD_DIM
DSA_LATENT = 128
IDX_HEADS = 4
IDX_DIM = 64
DSA_TOPK_MAX = 256

FFN_DIM = 256 * (-(-8 * D_MODEL // (3 * 256)))
FFN_CONV = 3

IN_SIZES = (
    GROUP_WIDTH,
    SSD_XBC,
    SSD_HEADS,
    GROUP_WIDTH,
    3 * GROUP_WIDTH,
    FOX_HEADS,
    GROUP_WIDTH,
    DSA_LATENT,
    IDX_HEADS * IDX_DIM,
    IDX_DIM,
    IDX_HEADS,
)
D_IN = sum(IN_SIZES)

kernel_name = 'hybrid_stream_encoder_ssd_pool_fox_dsa'


def rms_norm(x, g):
    xf = x.astype(jnp.float32)
    y = xf * lax.rsqrt(jnp.mean(xf * xf, axis=-1, keepdims=True) + EPS)
    return (y * g.astype(jnp.float32)).astype(x.dtype)


def split_cols(u, sizes):
    offs, acc = [], 0
    for s in sizes[:-1]:
        acc += s
        offs.append(acc)
    return jnp.split(u, offs, axis=-1)


def causal_dwconv(x, w, b):
    k_w = w.shape[0]
    n = x.shape[1]
    xp = jnp.pad(x, ((0, 0), (k_w - 1, 0), (0, 0)))
    return sum((w[k] * xp[:, k:k + n] for k in range(k_w)), b)


def chunk_ids(n):
    p = jnp.arange(n)
    return jnp.where(p < N_META, 0, 1 + (p - N_META) // CHUNK)


def pad_seq(t, n_pad, left=False):
    cfg = [(0, 0)] * t.ndim
    cfg[1] = (n_pad, 0) if left else (0, n_pad)
    return jnp.pad(t, cfg)


def ssd_mixer(z, xbc, dt_raw, conv_w, conv_b, dt_bias, a_log, d_skip, norm_g):
    f32 = jnp.float32
    bsz, n, _ = z.shape
    r = SSD_HEADS // SSD_GROUPS
    xbc = jax.nn.silu(causal_dwconv(xbc, conv_w, conv_b)).astype(f32)
    xs, bm, cm = jnp.split(xbc, [GROUP_WIDTH, GROUP_WIDTH + SSD_GROUPS * SSD_STATE], axis=-1)
    dt = jax.nn.softplus(dt_raw.astype(f32) + dt_bias.astype(f32))
    a_neg = -jnp.exp(a_log.astype(f32))
    pad = (-n) % CHUNK
    xs, bm, cm, dt = (pad_seq(t, pad, left=True) for t in (xs, bm, cm, dt))
    nc = (n + pad) // CHUNK
    x = xs.reshape(bsz, nc, CHUNK, SSD_GROUPS, r, HEAD_DIM)
    bc = bm.reshape(bsz, nc, CHUNK, SSD_GROUPS, SSD_STATE)
    cc = cm.reshape(bsz, nc, CHUNK, SSD_GROUPS, SSD_STATE)
    dtc = dt.reshape(bsz, nc, CHUNK, SSD_GROUPS, r)
    xdt = x * dtc[..., None]
    a = jnp.moveaxis(dtc * a_neg.reshape(SSD_GROUPS, r), 2, -1)
    a_cs = jnp.cumsum(a, axis=-1)
    tril = jnp.tril(jnp.ones((CHUNK, CHUNK), dtype=bool))
    seg = a_cs[..., :, None] - a_cs[..., None, :]
    decay_in = jnp.exp(jnp.where(tril, seg, -jnp.inf))
    cb = jnp.einsum('bclgn,bcsgn->bcgls', cc, bc)
    m = cb[:, :, :, None] * decay_in
    y_diag = jnp.einsum('bcgrls,bcsgrp->bclgrp', m, xdt)
    decay_to_end = jnp.moveaxis(jnp.exp(a_cs[..., -1:] - a_cs), -1, 2)
    chunk_states = jnp.einsum('bclgn,bclgrp->bcgrpn', bc, xdt * decay_to_end[..., None])
    chunk_decay = jnp.exp(a_cs[..., -1])

    def step(h, inp):
        dec, st = inp
        return dec[..., None, None] * h + st, h

    h0 = jnp.zeros((bsz, SSD_GROUPS, r, HEAD_DIM, SSD_STATE), f32)
    _, h_in = lax.scan(step, h0, (jnp.moveaxis(chunk_decay, 1, 0), jnp.moveaxis(chunk_states, 1, 0)))
    h_in = jnp.moveaxis(h_in, 0, 1)
    decay_from_start = jnp.moveaxis(jnp.exp(a_cs), -1, 2)
    y_off = jnp.einsum('bclgn,bcgrpn->bclgrp', cc, h_in) * decay_from_start[..., None]
    y = y_diag + y_off + d_skip.astype(f32).reshape(SSD_GROUPS, r)[:, :, None] * x
    y = y.reshape(bsz, n + pad, GROUP_WIDTH)[:, pad:]
    gz = (y * jax.nn.silu(z.astype(f32))).reshape(bsz, n, SSD_GROUPS, GROUP_WIDTH // SSD_GROUPS)
    gz = gz * lax.rsqrt(jnp.mean(gz * gz, axis=-1, keepdims=True) + EPS)
    return (gz.reshape(bsz, n, GROUP_WIDTH) * norm_g.astype(f32)).astype(z.dtype)


def pool_mixer(u, w, scale):
    f32 = jnp.float32
    bsz, n, _ = u.shape
    uf = u.astype(f32).reshape(bsz, n, len(POOL_WINDOWS), POOL_GROUP_DIM)
    cs = jnp.cumsum(uf, axis=1)
    count = jnp.arange(1, n + 1, dtype=f32)[:, None]
    outs = []
    for gi, win in enumerate(POOL_WINDOWS):
        c = cs[:, :, gi]
        lag = jnp.pad(c, ((0, 0), (win, 0), (0, 0)))[:, :n]
        outs.append((c - lag) / jnp.minimum(count, float(win)) - uf[:, :, gi])
    pooled = jnp.stack(outs, axis=2)
    mixed = jnp.einsum('blgc,gcd->blgd', pooled, w.astype(f32)).reshape(bsz, n, GROUP_WIDTH)
    return (mixed * scale.astype(f32)).astype(u.dtype)


def fox_mixer(q, k, v, f_logit, f_bias):
    f32 = jnp.float32
    bsz, n, _ = q.shape
    n_pad = (-n) % Q_BLOCK
    lp = n + n_pad
    nb = lp // Q_BLOCK
    log_f = jax.nn.log_sigmoid(f_logit.astype(f32) + f_bias.astype(f32))
    fcum = jnp.moveaxis(pad_seq(jnp.cumsum(log_f, axis=1), n_pad), -1, 1)
    q, k, v = (pad_seq(t, n_pad).reshape(bsz, lp, FOX_HEADS, HEAD_DIM) for t in (q, k, v))
    qb = jnp.moveaxis(q.reshape(bsz, nb, Q_BLOCK, FOX_HEADS, HEAD_DIM), 1, 0)
    fb = jnp.moveaxis(fcum.reshape(bsz, FOX_HEADS, nb, Q_BLOCK), 2, 0)
    posb = jnp.arange(lp).reshape(nb, Q_BLOCK)
    key_pos = jnp.arange(lp)
    scale = HEAD_DIM ** -0.5

    def block(args):
        qi, fi, qpos = args
        s = jnp.einsum('bqhd,bkhd->bhqk', qi, k).astype(f32) * scale
        s = s + (fi[..., :, None] - fcum[..., None, :])
        s = jnp.where(key_pos[None, :] <= qpos[:, None], s, -jnp.inf)
        p = jax.nn.softmax(s, axis=-1).astype(v.dtype)
        return jnp.einsum('bhqk,bkhd->bqhd', p, v)

    out = lax.map(block, (qb, fb, posb))
    return jnp.moveaxis(out, 0, 1).reshape(bsz, lp, GROUP_WIDTH)[:, :n]


def dsa_mixer(q, c_kv, q_idx, k_idx, w_idx, kv_norm, w_uk, w_uv, topk):
    f32 = jnp.float32
    bsz, n, _ = q.shape
    n_pad = (-n) % Q_BLOCK
    lp = n + n_pad
    nb = lp // Q_BLOCK
    c = pad_seq(rms_norm(c_kv, kv_norm), n_pad)
    q = q.reshape(bsz, n, DSA_HEADS, HEAD_DIM)
    q_lat = jnp.einsum('blhd,hrd->blhr', q, w_uk) * (HEAD_DIM ** -0.5)
    qi = q_idx.reshape(bsz, n, IDX_HEADS, IDX_DIM)
    wi = w_idx * ((IDX_HEADS ** -0.5) * (IDX_DIM ** -0.5))
    ki = pad_seq(k_idx, n_pad)
    q_lat, qi, wi = (pad_seq(t, n_pad) for t in (q_lat, qi, wi))
    to_blocks = lambda t: jnp.moveaxis(t.reshape((bsz, nb, Q_BLOCK) + t.shape[2:]), 1, 0)
    cid = chunk_ids(lp)
    cidb = cid.reshape(nb, Q_BLOCK)
    bidx = jnp.arange(bsz)[:, None, None]

    def block(args):
        ql, qx, wx, qc = args
        logits = jnp.einsum('bqhd,bkd->bqhk', qx, ki).astype(f32)
        score = jnp.einsum('bqh,bqhk->bqk', wx.astype(f32), jax.nn.relu(logits))
        admissible = cid[None, :] <= qc[:, None]
        score = jnp.where(admissible[None], score, -jnp.inf)
        top_score, idx = lax.top_k(score, topk)
        valid = top_score > -jnp.inf
        c_sel = c[bidx, idx]
        s = jnp.einsum('bqhr,bqkr->bqhk', ql, c_sel).astype(f32)
        s = jnp.where(valid[:, :, None, :], s, -jnp.inf)
        p = jax.nn.softmax(s, axis=-1).astype(c_sel.dtype)
        o_lat = jnp.einsum('bqhk,bqkr->bqhr', p, c_sel)
        return jnp.einsum('bqhr,hrd->bqhd', o_lat, w_uv)

    out = lax.map(block, (to_blocks(q_lat), to_blocks(qi), to_blocks(wi), cidb))
    return jnp.moveaxis(out, 0, 1).reshape(bsz, lp, GROUP_WIDTH)[:, :n]


def hybrid_layer(x, g_mix_pre, g_mix_post, g_ffn_pre, g_ffn_post, w_in,
                 ssd_conv_w, ssd_conv_b, ssd_dt_bias, ssd_a_log, ssd_d, ssd_norm,
                 pool_w, pool_scale, fox_f_bias, dsa_kv_norm, dsa_w_uk, dsa_w_uv,
                 w_out, ffn_w_gate, ffn_w_up, ffn_conv_w, ffn_conv_b, ffn_w_down, topk):
    h = rms_norm(x, g_mix_pre)
    u = h @ w_in
    (z, xbc, dt_raw, pool_in, fox_qkv, f_logit,
     dq, dc, dqi, dki, dwi) = split_cols(u, IN_SIZES)
    y_a = ssd_mixer(z, xbc, dt_raw, ssd_conv_w, ssd_conv_b, ssd_dt_bias, ssd_a_log, ssd_d, ssd_norm)
    y_b = pool_mixer(pool_in, pool_w, pool_scale)
    fq, fk, fv = jnp.split(fox_qkv, 3, axis=-1)
    y_c = fox_mixer(fq, fk, fv, f_logit, fox_f_bias)
    y_d = dsa_mixer(dq, dc, dqi, dki, dwi, dsa_kv_norm, dsa_w_uk, dsa_w_uv, topk)
    mix = jnp.concatenate([y_a, y_b, y_c, y_d], axis=-1) @ w_out
    x = x + rms_norm(mix, g_mix_post)
    h = rms_norm(x, g_ffn_pre)
    gate = causal_dwconv(h @ ffn_w_gate, ffn_conv_w, ffn_conv_b)
    y = (jax.nn.silu(gate) * (h @ ffn_w_up)) @ ffn_w_down
    return x + rms_norm(y, g_ffn_post)


def setup_inputs(seed: int = 0) -> dict:
    key = jax.random.key(seed)
    ks = jax.random.split(key, 32)
    nrm = lambda k, shape, s: jax.random.normal(k, shape, jnp.float32) * s
    gain = lambda k, shape: 1.0 + 0.02 * jax.random.normal(k, shape, jnp.float32)
    r = SSD_HEADS // SSD_GROUPS
    dt0 = jnp.exp(jax.random.uniform(ks[10], (DEPTH, SSD_HEADS), jnp.float32, math.log(1e-3), math.log(1e-1)))
    return {
        'x': nrm(ks[0], (BATCH, SEQ, D_MODEL), 1.0),
        'meta_tokens': nrm(ks[1], (N_META, D_MODEL), 1.0),
        'norm_mix_pre': gain(ks[2], (DEPTH, D_MODEL)),
        'norm_mix_post': gain(ks[3], (DEPTH, D_MODEL)),
        'norm_ffn_pre': gain(ks[4], (DEPTH, D_MODEL)),
        'norm_ffn_post': gain(ks[5], (DEPTH, D_MODEL)),
        'w_in': nrm(ks[6], (DEPTH, D_MODEL, D_IN), D_MODEL ** -0.5),
        'ssd_conv_w': nrm(ks[7], (DEPTH, SSD_CONV, SSD_XBC), SSD_CONV ** -0.5),
        'ssd_conv_b': nrm(ks[8], (DEPTH, SSD_XBC), 0.02),
        'ssd_dt_bias': dt0 + jnp.log(-jnp.expm1(-dt0)),
        'ssd_a_log': jnp.log(jax.random.uniform(ks[11], (DEPTH, SSD_HEADS), jnp.float32, 1.0, 16.0)),
        'ssd_d': gain(ks[12], (DEPTH, SSD_HEADS)),
        'ssd_norm': gain(ks[13], (DEPTH, GROUP_WIDTH)),
        'pool_w': nrm(ks[14], (DEPTH, len(POOL_WINDOWS), POOL_GROUP_DIM, POOL_GROUP_DIM), POOL_GROUP_DIM ** -0.5),
        'pool_scale': gain(ks[15], (DEPTH, GROUP_WIDTH)),
        'fox_f_bias': jax.random.uniform(ks[16], (DEPTH, FOX_HEADS), jnp.float32, 1.0, 5.0),
        'dsa_kv_norm': gain(ks[17], (DEPTH, DSA_LATENT)),
        'dsa_w_uk': nrm(ks[18], (DEPTH, DSA_HEADS, DSA_LATENT, HEAD_DIM), DSA_LATENT ** -0.5),
        'dsa_w_uv': nrm(ks[19], (DEPTH, DSA_HEADS, DSA_LATENT, HEAD_DIM), DSA_LATENT ** -0.5),
        'w_out': nrm(ks[20], (DEPTH, D_MIX, D_MODEL), D_MIX ** -0.5),
        'ffn_w_gate': nrm(ks[21], (DEPTH, D_MODEL, FFN_DIM), D_MODEL ** -0.5),
        'ffn_w_up': nrm(ks[22], (DEPTH, D_MODEL, FFN_DIM), D_MODEL ** -0.5),
        'ffn_conv_w': nrm(ks[23], (DEPTH, FFN_CONV, FFN_DIM), FFN_CONV ** -0.5),
        'ffn_conv_b': nrm(ks[24], (DEPTH, FFN_DIM), 0.02),
        'ffn_w_down': nrm(ks[25], (DEPTH, FFN_DIM, D_MODEL), FFN_DIM ** -0.5),
    }


def reference(x, meta_tokens, norm_mix_pre, norm_mix_post, norm_ffn_pre, norm_ffn_post, w_in,
              ssd_conv_w, ssd_conv_b, ssd_dt_bias, ssd_a_log, ssd_d, ssd_norm,
              pool_w, pool_scale, fox_f_bias, dsa_kv_norm, dsa_w_uk, dsa_w_uv,
              w_out, ffn_w_gate, ffn_w_up, ffn_conv_w, ffn_conv_b, ffn_w_down):
    topk = min(DSA_TOPK_MAX, SEQ // 4)
    meta = jnp.broadcast_to(meta_tokens.astype(x.dtype)[None], (x.shape[0], N_META, D_MODEL))
    h = jnp.concatenate([meta, x], axis=1)
    for i in range(DEPTH):
        h = hybrid_layer(h, norm_mix_pre[i], norm_mix_post[i], norm_ffn_pre[i], norm_ffn_post[i], w_in[i],
                         ssd_conv_w[i], ssd_conv_b[i], ssd_dt_bias[i], ssd_a_log[i], ssd_d[i], ssd_norm[i],
                         pool_w[i], pool_scale[i], fox_f_bias[i], dsa_kv_norm[i], dsa_w_uk[i], dsa_w_uv[i],
                         w_out[i], ffn_w_gate[i], ffn_w_up[i], ffn_conv_w[i], ffn_conv_b[i], ffn_w_down[i], topk)
    return h[:, N_META:]
```

```cpp
#include <hip/hip_runtime.h>
#include <cstdio>
#include <cstdint>

constexpr int NB = 8, SEQ = 4096, NMETA = 16, L = SEQ + NMETA  , T = NB * L  , MP = 33024  , DM = 2048;
constexpr int NU = 5120, KOUT = 2560, FF = 5632, NGU = 2 * FF, DIN = 4564;
constexpr int C_Z = 0, C_XBC = 512, C_POOL = 1536, C_FQ = 2048, C_FK = 2560, C_FV = 3072, C_QLAT = 3584, C_DC = 4608, C_QI = 4736, C_KI = 4992, C_SM = 5056;
constexpr int LKP = 4224, NMW = 66  , TOPK = 256, DEPTH = 4;
constexpr float EPSF = 1e-6f;
typedef unsigned short bf16;
typedef unsigned long long u64;

__device__ __forceinline__ float bf2f(bf16 v) { return __uint_as_float(((unsigned)v) << 16); }
__device__ __forceinline__ bf16 f2bf(float f) { unsigned u = __float_as_uint(f); return (bf16)((u + 0x7fffu + ((u >> 16) & 1u)) >> 16); }
__device__ __forceinline__ unsigned pk2(float lo, float hi) { return (unsigned)f2bf(lo) | ((unsigned)f2bf(hi) << 16); }
__device__ __forceinline__ float siluf(float x) { return x / (1.f + __expf(-x)); }
__device__ __forceinline__ float softplusf(float x) { return fmaxf(x, 0.f) + log1pf(__expf(-fabsf(x))); }
__device__ __forceinline__ float logsigmoidf(float x) { return fminf(x, 0.f) - log1pf(__expf(-fabsf(x))); }
__device__ __forceinline__ float wave_sum(float v) {
#pragma unroll
    for (int o = 1; o < 64; o <<= 1) v += __shfl_xor(v, o);
    return v;
}
__device__ __forceinline__ float* xf_row(float* dout, float* metax, int t) {
    const int b = t / L, p = t - b * L;
    return p < NMETA ? metax + (size_t)(b * NMETA + p) * DM : dout + ((size_t)b * SEQ + (p - NMETA)) * DM;
}
namespace pg8 {
#define PG8_LAS __attribute__((address_space(3)))
typedef unsigned short bf16_t;
typedef short bf16x8 __attribute__((ext_vector_type(8)));
typedef float f32x4 __attribute__((ext_vector_type(4)));
typedef unsigned u32x4 __attribute__((ext_vector_type(4)));
constexpr int BM = 256, BK = 64, HALF = 128, HTB = HALF * BK * 2  , STAGE_BYTES = 8 * HTB, NXCD = 8, WGM = 8;

__host__ __device__ __forceinline__ int lds_byte(int r, int c) { const int st = (r >> 4) * 2 + (c >> 5), rr = r & 15, cc = c & 31, ob = rr * 64 + cc * 2; return st * 1024 + (ob ^ (((ob >> 9) & 1) << 5)); }
__host__ __device__ __forceinline__ void stage_rc(int b, int& R, int& C) { const int st = b / 1024, sb = b % 1024, swz = sb ^ (((sb >> 9) & 1) << 5); R = (st >> 1) * 16 + swz / 64; C = (st & 1) * 32 + (swz % 64) / 2; }
__host__ __device__ __forceinline__ int perm32(int rho) { const int n = rho >> 4, i = rho & 15; return 8 * (i >> 2) + 4 * n + (i & 3); }

struct Unit { int pm, pn; };
struct Gemm { const bf16_t* A; const bf16_t* Bt; int M, N, K; size_t a_tstep; };

struct StaticOrder {
    int nM, nN, nwg, G, c;
    __host__ __device__ void init(int M, int N, int G_, int c_) { nM = M / BM; nN = N / BM; nwg = nM * nN; G = G_; c = c_; }
    __host__ __device__ bool next(int i, Unit& u) const {
        const long L = (long)i * G + c; if (L >= nwg) return false;
        int wgid = (int)L; { const int q = nwg / NXCD, r = nwg % NXCD, xcd = wgid % NXCD, off = wgid / NXCD; wgid = (xcd < r ? xcd * (q + 1) : r * (q + 1) + (xcd - r) * q) + off; }
        const int nig = WGM * nN, gid = wgid / nig, fm = gid * WGM, gsz = (nM - fm) < WGM ? (nM - fm) : WGM;
        u.pm = fm + ((wgid % nig) % gsz); u.pn = (wgid % nig) / gsz; return true;
    }
    __device__ __forceinline__ void a_ready(const Unit&) const {}
    __device__ __forceinline__ void done(const Unit&) const {}
};


__device__ __forceinline__ unsigned cvt_pk_bf16(float lo, float hi) { unsigned r; asm volatile("v_cvt_pk_bf16_f32 %0, %1, %2" : "=v"(r) : "v"(lo), "v"(hi)); return r; }

struct EpiBf16Plain {
    static constexpr bool PERM = true, AFTER_DRAIN = false;
    bf16_t* O; int ldc; const float* rs; float* UF; int sm_col0;
    __device__ __forceinline__ void operator()(f32x4 (&acc)[2][2][4][2], const Unit& u, int wr, int wc, int fr, int fq) const {
        const int row0 = u.pm * BM + wr * 64 + fr, col0 = u.pn * BM + wc * 32 + 8 * fq;
#pragma unroll
        for (int ai = 0; ai < 2; ++ai)
#pragma unroll
            for (int m = 0; m < 4; ++m) {
                const int row = row0 + ai * HALF + m * 16; const float s = rs ? rs[row] : 1.f; bf16_t* rowp = O + (size_t)row * ldc + col0;
#pragma unroll
                for (int bj = 0; bj < 2; ++bj) { const f32x4 v0 = acc[ai][bj][m][0] * s, v1 = acc[ai][bj][m][1] * s;
                    u32x4 w; w.x = cvt_pk_bf16(v0[0], v0[1]); w.y = cvt_pk_bf16(v0[2], v0[3]); w.z = cvt_pk_bf16(v1[0], v1[1]); w.w = cvt_pk_bf16(v1[2], v1[3]);
                    *(u32x4*)(rowp + bj * HALF) = w;
                    if (UF) { const int c = col0 + bj * HALF - sm_col0; if (c >= 0 && c < 32) { float* p = UF + (size_t)row * 32 + c; *(f32x4*)p = v0; *(f32x4*)(p + 4) = v1; } } }
            }
    }
};

struct EpiGateUp {
    static constexpr bool PERM = true, AFTER_DRAIN = false;
    bf16_t* H; const float* rs; const float* cw; const float* cb; PG8_LAS float* halo;
    __device__ __forceinline__ void operator()(f32x4 (&acc)[2][2][4][2], const Unit& u, int wr, int wc, int fr, int fq) const {
        const int lane = fq * 16 + fr, chl = wc * 32 + 8 * fq, ch0 = u.pn * 128 + chl, rbase = u.pm * 254 - 2;
#pragma unroll
        for (int ai = 0; ai < 2; ++ai)
#pragma unroll
            for (int m = 0; m < 4; ++m) { const int grow = rbase + ai * 128 + wr * 64 + m * 16 + fr; const float s = grow >= 0 ? rs[grow] : 0.f;
#pragma unroll
                for (int bj = 0; bj < 2; ++bj)
#pragma unroll
                    for (int n = 0; n < 2; ++n) acc[ai][bj][m][n] = acc[ai][bj][m][n] * s; }
        if (fr >= 14) {
#pragma unroll
            for (int ai = 0; ai < 2; ++ai)
#pragma unroll
                for (int n = 0; n < 2; ++n) *(PG8_LAS f32x4*)(halo + ((2 * ai + wr) * 2 + (fr - 14)) * 128 + chl + 4 * n) = acc[ai][0][3][n];
        }
        asm volatile("s_waitcnt lgkmcnt(0)" ::: "memory"); __builtin_amdgcn_s_barrier(); asm volatile("" ::: "memory");
        f32x4 w0[2], w1[2], w2[2], bb[2];
#pragma unroll
        for (int n = 0; n < 2; ++n) { w0[n] = *(const f32x4*)(cw + ch0 + 4 * n); w1[n] = *(const f32x4*)(cw + FF + ch0 + 4 * n); w2[n] = *(const f32x4*)(cw + 2 * FF + ch0 + 4 * n); bb[n] = *(const f32x4*)(cb + ch0 + 4 * n); }
#pragma unroll
        for (int ai = 0; ai < 2; ++ai)
#pragma unroll
            for (int m = 0; m < 4; ++m) {
                const int rl = ai * 128 + wr * 64 + m * 16 + fr, grow = rbase + rl, pos = grow >= 0 ? grow % L : 0, blk = 2 * ai + wr;
                const float t1 = pos >= 1 ? 1.f : 0.f, t2 = pos >= 2 ? 1.f : 0.f;
                unsigned pk[4];
#pragma unroll
                for (int n = 0; n < 2; ++n) {
                    const f32x4 cur = acc[ai][0][m][n]; f32x4 g1, g2;
#pragma unroll
                    for (int j = 0; j < 4; ++j) {
                        const float s1 = __shfl(cur[j], (lane + 63) & 63), s2 = __shfl(cur[j], (lane + 62) & 63);
                        float p15, p14;
                        if (m > 0) { const float pv = acc[ai][0][m > 0 ? m - 1 : 0][n][j]; p15 = __shfl(pv, fq * 16 + 15); p14 = __shfl(pv, fq * 16 + 14); }
                        else if (blk > 0) { p14 = halo[((blk - 1) * 2 + 0) * 128 + chl + 4 * n + j]; p15 = halo[((blk - 1) * 2 + 1) * 128 + chl + 4 * n + j]; }
                        else { p14 = 0.f; p15 = 0.f; }
                        g1[j] = fr >= 1 ? s1 : p15; g2[j] = fr >= 2 ? s2 : (fr == 1 ? p15 : p14);
                    }
                    const f32x4 cv = bb[n] + w2[n] * cur + (w1[n] * g1) * t1 + (w0[n] * g2) * t2;
                    const f32x4 up = acc[ai][1][m][n];
                    float hv[4];
#pragma unroll
                    for (int j = 0; j < 4; ++j) hv[j] = cv[j] / (1.f + __expf(-cv[j])) * up[j];
                    pk[2 * n] = cvt_pk_bf16(hv[0], hv[1]); pk[2 * n + 1] = cvt_pk_bf16(hv[2], hv[3]);
                }
                if (rl >= 2) { u32x4 w; w.x = pk[0]; w.y = pk[1]; w.z = pk[2]; w.w = pk[3]; *(u32x4*)(H + (size_t)grow * FF + ch0) = w; }
            }
    }
};
template <class Epi, class Sched, bool ALIGN_EPI = false, bool SP2 = false>
__device__ __forceinline__ void gemm_phase(PG8_LAS unsigned char* lds, const Gemm g, const Sched& S, const Epi& E) {
    const int tid = threadIdx.x, wid = __builtin_amdgcn_readfirstlane(tid >> 6), lane = tid & 63, wr = wid >> 2, wc = wid & 3, fr = lane & 15, fq = lane >> 4;
    const int K = g.K, nt = K / BK;
    unsigned voffA[2], voffB[2];
#pragma unroll
    for (int i = 0; i < 2; ++i) { int R, C; stage_rc(tid * 16 + i * 8192, R, C); const int Rb = Epi::PERM ? ((R & ~31) + perm32(R & 31)) : R;
        voffA[i] = (unsigned)(R * K + C) * 2u; voffB[i] = (unsigned)(Rb * K + C) * 2u; }
    const size_t kstep = (size_t)(BK * 2);
    const size_t hstep = (size_t)HALF * K * 2;
    const size_t tstep = 2 * hstep;
    const unsigned ldsw = (unsigned)wid * 1024u;
    const int aoff = lds_byte(wr * 64 + fr, fq * 8), boff = lds_byte(wc * 32 + fr, fq * 8);
#define PG8_SA(b, h) (((b) * 2 + (h)) * HTB)
#define PG8_SB(b, h) ((4 + (b) * 2 + (h)) * HTB)
#define PG8_STAGE(bufoff, gbase, voff) do { _Pragma("unroll") for (int _i = 0; _i < 2; ++_i) \
        __builtin_amdgcn_global_load_lds((const unsigned*)((const char*)(gbase) + (voff)[_i]), (PG8_LAS unsigned*)(lds + (bufoff) + ldsw + _i * 8192), 16, 0, 0); } while (0)
#define PG8_LDA(dst, b, h) do { _Pragma("unroll") for (int m = 0; m < 4; ++m) _Pragma("unroll") for (int k = 0; k < 2; ++k) dst[m][k] = *(const PG8_LAS bf16x8*)(lds + PG8_SA(b, h) + aoff + m * 2048 + k * 1024); } while (0)
#define PG8_LDB(dst, b, h) do { _Pragma("unroll") for (int n = 0; n < 2; ++n) _Pragma("unroll") for (int k = 0; k < 2; ++k) dst[n][k] = *(const PG8_LAS bf16x8*)(lds + PG8_SB(b, h) + boff + n * 2048 + k * 1024); } while (0)
#define PG8_MMA(ai, bj, At, Bt) do { __builtin_amdgcn_s_setprio(1); _Pragma("unroll") for (int m = 0; m < 4; ++m) _Pragma("unroll") for (int n = 0; n < 2; ++n) _Pragma("unroll") for (int k = 0; k < 2; ++k) \
        acc[ai][bj][m][n] = __builtin_amdgcn_mfma_f32_16x16x32_bf16(Bt[n][k], At[m][k], acc[ai][bj][m][n], 0, 0, 0); __builtin_amdgcn_s_setprio(0); } while (0)
#define PG8_WAIT_V(n) asm volatile("s_waitcnt vmcnt(" #n ")" ::: "memory")
#define PG8_WAIT_L(n) asm volatile("s_waitcnt lgkmcnt(" #n ")" ::: "memory")
#define PG8_BAR __builtin_amdgcn_s_barrier()
#define PG8_SCHED __builtin_amdgcn_sched_barrier(0)
    Unit cur, nxt; int ui = 0;
    if (!S.next(0, cur)) return;
    f32x4 acc[2][2][4][2];
#pragma unroll
    for (int a = 0; a < 2; ++a)
#pragma unroll
        for (int b = 0; b < 2; ++b)
#pragma unroll
            for (int m = 0; m < 4; ++m)
#pragma unroll
                for (int n = 0; n < 2; ++n) acc[a][b][m][n] = (f32x4){0.f, 0.f, 0.f, 0.f};
    bf16x8 At[4][2], B0[2][2], B1[2][2];
    const char* cA = (const char*)g.A + (size_t)cur.pm * g.a_tstep; const char* cB = (const char*)g.Bt + (size_t)cur.pn * tstep;
    S.a_ready(cur);
    if constexpr (SP2) {
        PG8_STAGE(PG8_SB(0, 0), cB, voffB); PG8_STAGE(PG8_SB(0, 1), cB + hstep, voffB); PG8_STAGE(PG8_SA(0, 0), cA, voffA); PG8_STAGE(PG8_SA(0, 1), cA + hstep, voffA);
        if (wr == 1) PG8_BAR;
        PG8_WAIT_V(2); PG8_BAR;
        PG8_STAGE(PG8_SB(1, 0), cB + kstep, voffB); PG8_STAGE(PG8_SA(1, 0), cA + kstep, voffA); PG8_STAGE(PG8_SB(1, 1), cB + hstep + kstep, voffB);
        PG8_WAIT_V(6); PG8_BAR;
    } else {
        PG8_STAGE(PG8_SB(0, 0), cB, voffB); PG8_STAGE(PG8_SA(0, 0), cA, voffA); PG8_STAGE(PG8_SB(0, 1), cB + hstep, voffB); PG8_STAGE(PG8_SA(0, 1), cA + hstep, voffA);
        if (wr == 1) PG8_BAR;
        PG8_WAIT_V(4); PG8_BAR;
        PG8_STAGE(PG8_SB(1, 0), cB + kstep, voffB); PG8_STAGE(PG8_SA(1, 0), cA + kstep, voffA); PG8_STAGE(PG8_SB(1, 1), cB + hstep + kstep, voffB);
        PG8_WAIT_V(6); PG8_BAR;
    }
    for (;;) {
        const bool has_next = S.next(ui + 1, nxt);
        const char* nA = has_next ? (const char*)g.A + (size_t)nxt.pm * g.a_tstep : cA; const char* nB = has_next ? (const char*)g.Bt + (size_t)nxt.pn * tstep : cB;
        for (int t = 0; t < nt; t += 2) {
            const bool last = (t == nt - 2);
            const char* a1 = cA + (size_t)(t + 1) * kstep;
            const char* a2 = last ? nA : cA + (size_t)(t + 2) * kstep; const char* b2 = last ? nB : cB + (size_t)(t + 2) * kstep;
            const char* a3 = a2 + kstep; const char* b3 = b2 + kstep;
            if (last && has_next) S.a_ready(nxt);
            if constexpr (SP2) {
            PG8_LDB(B0, 0, 0); PG8_LDB(B1, 0, 1); PG8_SCHED; PG8_LDA(At, 0, 0); PG8_STAGE(PG8_SA(1, 1), a1 + hstep, voffA);
            PG8_WAIT_V(8); PG8_WAIT_L(0); PG8_BAR; PG8_MMA(0, 0, At, B0); PG8_MMA(0, 1, At, B1); PG8_BAR; PG8_SCHED;
            PG8_LDA(At, 0, 1); PG8_STAGE(PG8_SB(0, 0), b2, voffB); PG8_STAGE(PG8_SB(0, 1), b2 + hstep, voffB); PG8_STAGE(PG8_SA(0, 0), a2, voffA);
            PG8_WAIT_V(8); PG8_WAIT_L(0); PG8_BAR; PG8_MMA(1, 0, At, B0); PG8_MMA(1, 1, At, B1); PG8_BAR; PG8_SCHED;
            PG8_LDB(B0, 1, 0); PG8_LDB(B1, 1, 1); PG8_SCHED; PG8_LDA(At, 1, 0); PG8_STAGE(PG8_SA(0, 1), a2 + hstep, voffA);
            PG8_WAIT_V(8); PG8_WAIT_L(0); PG8_BAR; PG8_MMA(0, 0, At, B0); PG8_MMA(0, 1, At, B1); PG8_BAR; PG8_SCHED;
            PG8_LDA(At, 1, 1); PG8_STAGE(PG8_SB(1, 0), b3, voffB); PG8_STAGE(PG8_SB(1, 1), b3 + hstep, voffB); PG8_STAGE(PG8_SA(1, 0), a3, voffA);
            PG8_WAIT_V(8); PG8_WAIT_L(0); PG8_BAR; PG8_MMA(1, 0, At, B0); PG8_MMA(1, 1, At, B1); PG8_BAR; PG8_SCHED;
            } else {
            PG8_LDB(B0, 0, 0); PG8_SCHED; PG8_LDA(At, 0, 0); PG8_STAGE(PG8_SA(1, 1), a1 + hstep, voffA);
            PG8_WAIT_L(8); PG8_BAR; PG8_WAIT_L(0); PG8_MMA(0, 0, At, B0); PG8_BAR; PG8_SCHED;
            PG8_LDB(B1, 0, 1); PG8_STAGE(PG8_SB(0, 0), b2, voffB);
            PG8_BAR; PG8_WAIT_L(0); PG8_MMA(0, 1, At, B1); PG8_BAR;
            PG8_LDA(At, 0, 1); PG8_STAGE(PG8_SA(0, 0), a2, voffA);
            PG8_BAR; PG8_WAIT_L(0); PG8_MMA(1, 0, At, B0); PG8_BAR; PG8_SCHED;
            PG8_STAGE(PG8_SB(0, 1), b2 + hstep, voffB);
            PG8_WAIT_V(6); PG8_BAR; PG8_MMA(1, 1, At, B1); PG8_BAR;
            PG8_LDB(B0, 1, 0); PG8_SCHED; PG8_LDA(At, 1, 0); PG8_STAGE(PG8_SA(0, 1), a2 + hstep, voffA);
            PG8_WAIT_L(8); PG8_BAR; PG8_WAIT_L(0); PG8_MMA(0, 0, At, B0); PG8_BAR; PG8_SCHED;
            PG8_LDB(B1, 1, 1); PG8_STAGE(PG8_SB(1, 0), b3, voffB);
            PG8_BAR; PG8_WAIT_L(0); PG8_MMA(0, 1, At, B1); PG8_BAR;
            PG8_LDA(At, 1, 1); PG8_STAGE(PG8_SA(1, 0), a3, voffA);
            PG8_BAR; PG8_WAIT_L(0); PG8_MMA(1, 0, At, B0); PG8_BAR; PG8_SCHED;
            PG8_STAGE(PG8_SB(1, 1), b3 + hstep, voffB);
            PG8_WAIT_V(6); PG8_BAR; PG8_MMA(1, 1, At, B1); PG8_BAR;
            }
        }
        if constexpr (ALIGN_EPI) { if (wr == 0) PG8_BAR; }
        if constexpr (!Epi::AFTER_DRAIN) { E(acc, cur, wr, wc, fr, fq); S.done(cur); }
        if (!has_next) break;
#pragma unroll
        for (int a = 0; a < 2; ++a)
#pragma unroll
            for (int b = 0; b < 2; ++b)
#pragma unroll
                for (int m = 0; m < 4; ++m)
#pragma unroll
                    for (int n = 0; n < 2; ++n) acc[a][b][m][n] = (f32x4){0.f, 0.f, 0.f, 0.f};
        cur = nxt; cA = nA; cB = nB; ++ui;
        if constexpr (ALIGN_EPI) { if (wr == 1) PG8_BAR; }
    }
    PG8_WAIT_V(0);
    if constexpr (!ALIGN_EPI) { if (wr == 0) PG8_BAR; }
    PG8_BAR;
    if constexpr (Epi::AFTER_DRAIN) { E.fused(acc, cur, wr, wc, fr, fq, lds, wid, lane); S.done(cur); }
#undef PG8_SA
#undef PG8_SB
#undef PG8_STAGE
#undef PG8_LDA
#undef PG8_LDB
#undef PG8_MMA
#undef PG8_WAIT_V
#undef PG8_WAIT_L
#undef PG8_BAR
#undef PG8_SCHED
}
}

constexpr int LDS_BYTES = 147456, HALO_OFF = 133120;
struct GemmArgs { const bf16* A; const bf16* Bt; bf16* O; const float* rs; float* UF; const float* cw; const float* cb; int Mtiles, N, K, ldc, kind, pad; };
__global__ void __launch_bounds__(512, 2) k_gemm(GemmArgs a) {
    extern __shared__ __attribute__((aligned(16))) unsigned char lds[];
    PG8_LAS unsigned char* l3 = (PG8_LAS unsigned char*)lds;
    pg8::StaticOrder S; S.init(a.Mtiles * 256, a.N, (int)gridDim.x, (int)blockIdx.x);
    if (a.kind == 0) {
        pg8::Gemm g{a.A, a.Bt, a.Mtiles * 256, a.N, a.K, (size_t)256 * a.K * 2};
        pg8::EpiBf16Plain E{a.O, a.ldc, a.rs, a.UF, C_SM};
        pg8::gemm_phase<pg8::EpiBf16Plain, pg8::StaticOrder, true, true>(l3, g, S, E);
    } else {
        pg8::Gemm g{a.A - (size_t)2 * a.K, a.Bt, a.Mtiles * 256, a.N, a.K, (size_t)254 * a.K * 2};
        pg8::EpiGateUp E{a.O, a.rs, a.cw, a.cb, (PG8_LAS float*)(l3 + HALO_OFF)};
        pg8::gemm_phase<pg8::EpiGateUp, pg8::StaticOrder, true, true>(l3, g, S, E);
    }
}

__global__ void __launch_bounds__(256) k_prep_x(const float* x, const float* meta, float* dout, float* metax, bf16* XB, float* RSTD) {
    const int wave = (blockIdx.x * 256 + threadIdx.x) >> 6, lane = threadIdx.x & 63;
    if (wave >= MP + 8) return;
    const int t = wave - 8;
    bf16* xb = XB + (ptrdiff_t)t * DM;
    if (t < 0 || t >= T) {
#pragma unroll
        for (int j = 0; j < 4; ++j) *(uint4*)(xb + 8 * lane + 512 * j) = make_uint4(0, 0, 0, 0);
        if (t >= T && lane == 0) RSTD[t] = 0.f;
        return;
    }
    const int b = t / L, p = t - b * L;
    const float* src = p < NMETA ? meta + (size_t)p * DM : x + ((size_t)b * SEQ + (p - NMETA)) * DM;
    float* dst = xf_row(dout, metax, t);
    float ss = 0.f;
#pragma unroll
    for (int j = 0; j < 4; ++j) {
        const float4 a = *(const float4*)(src + 8 * lane + 512 * j), c = *(const float4*)(src + 8 * lane + 512 * j + 4);
        ss += a.x * a.x + a.y * a.y + a.z * a.z + a.w * a.w + c.x * c.x + c.y * c.y + c.z * c.z + c.w * c.w;
        *(float4*)(dst + 8 * lane + 512 * j) = a; *(float4*)(dst + 8 * lane + 512 * j + 4) = c;
        *(uint4*)(xb + 8 * lane + 512 * j) = make_uint4(pk2(a.x, a.y), pk2(a.z, a.w), pk2(c.x, c.y), pk2(c.z, c.w));
    }
    ss = wave_sum(ss);
    if (lane == 0) RSTD[t] = rsqrtf(ss * (1.f / DM) + EPSF);
}

template <class F> __device__ __forceinline__ void transpose_tile(bf16* dst, int Kd, const F& val) {
    __shared__ float tile[32][33];
    const int k0 = blockIdx.x * 32, n0 = blockIdx.y * 32, tx = threadIdx.x, ty = threadIdx.y;
#pragma unroll
    for (int i = 0; i < 4; ++i) tile[ty + 8 * i][tx] = val(k0 + ty + 8 * i, n0 + tx);
    __syncthreads();
#pragma unroll
    for (int i = 0; i < 4; ++i) dst[(size_t)(n0 + ty + 8 * i) * Kd + k0 + tx] = f2bf(tile[tx][ty + 8 * i]);
}
__global__ void __launch_bounds__(256) k_prep_win(const float* w_in, const float* g, const float* w_uk, bf16* WinT) {
    transpose_tile(WinT, DM, [=](int k, int n) -> float {
        int src = -1;
        if (n < C_XBC) src = n;
        else if (n < C_POOL) src = 512 + (n - C_XBC);
        else if (n < C_FQ) src = 1544 + (n - C_POOL);
        else if (n < C_QLAT) src = 2056 + (n - C_FQ);
        else if (n < C_DC) {
            const int h = (n - C_QLAT) >> 7, r = (n - C_QLAT) & 127; const float* wq = w_in + (size_t)k * DIN + 3600 + 64 * h; const float* wu = w_uk + ((size_t)h * 128 + r) * 64;
            float s = 0.f;
            for (int d = 0; d < 64; ++d) s += wq[d] * wu[d];
            return s * 0.125f * g[k];
        }
        else if (n < C_QI) src = 4112 + (n - C_DC);
        else if (n < C_KI) src = 4240 + (n - C_QI);
        else if (n < C_SM) src = 4496 + (n - C_KI);
        else if (n < C_SM + 8) src = 1536 + (n - C_SM);
        else if (n < C_SM + 16) src = 3592 + (n - C_SM - 8);
        else if (n < C_SM + 20) src = 4560 + (n - C_SM - 16);
        return src >= 0 ? w_in[(size_t)k * DIN + src] * g[k] : 0.f;
    });
}
__global__ void __launch_bounds__(256) k_prep_wout(const float* w_out, const float* ssd_norm, const float* pool_w, const float* pool_scale, const float* w_uv, bf16* WoutT) {
    transpose_tile(WoutT, KOUT, [=](int k, int n) -> float {
        if (k < 512) return ssd_norm[k] * w_out[(size_t)k * DM + n];
        if (k < 1024) { const int gi = (k - 512) >> 7, c = (k - 512) & 127; const float* pw = pool_w + ((size_t)gi * 128 + c) * 128; float s = 0.f;
            for (int d = 0; d < 128; ++d) s += pw[d] * pool_scale[128 * gi + d] * w_out[(size_t)(512 + 128 * gi + d) * DM + n];
            return s; }
        if (k < 1536) return w_out[(size_t)k * DM + n];
        const int h = (k - 1536) >> 7, r = (k - 1536) & 127; const float* wv = w_uv + ((size_t)h * 128 + r) * 64; float s = 0.f;
        for (int d = 0; d < 64; ++d) s += wv[d] * w_out[(size_t)(1536 + 64 * h + d) * DM + n];
        return s;
    });
}
__global__ void __launch_bounds__(256) k_prep_wgu(const float* wg, const float* wu, const float* g, bf16* WguT) {
    transpose_tile(WguT, DM, [=](int k, int n) -> float { const int pn = n >> 8, w = n & 255, ch = 128 * pn + (w & 127); return ((w >> 7) ? wu : wg)[(size_t)k * FF + ch] * g[k]; });
}
__global__ void __launch_bounds__(256) k_prep_wdn(const float* wd, bf16* WdnT) {
    transpose_tile(WdnT, FF, [=](int k, int n) -> float { return wd[(size_t)k * DM + n]; });
}

__global__ void __launch_bounds__(256) k_conv_xbc(const bf16* U, const float* cw, const float* cb, bf16* XC) {
    const int idx = blockIdx.x * 256 + threadIdx.x; if (idx >= T * 128) return;
    const int t = idx >> 7, c0 = (idx & 127) * 8, pos = t % L;
    float acc[8];
#pragma unroll
    for (int j = 0; j < 8; ++j) acc[j] = cb[c0 + j];
#pragma unroll
    for (int k = 0; k < 4; ++k) {
        if (pos - 3 + k < 0) continue;
        const uint4 v = *(const uint4*)(U + (size_t)(t - 3 + k) * NU + C_XBC + c0); const unsigned w[4] = {v.x, v.y, v.z, v.w};
#pragma unroll
        for (int j = 0; j < 8; ++j) acc[j] += cw[k * 1024 + c0 + j] * bf2f((bf16)(w[j >> 1] >> (16 * (j & 1))));
    }
    *(uint4*)(XC + (size_t)t * 1024 + c0) = make_uint4(pk2(siluf(acc[0]), siluf(acc[1])), pk2(siluf(acc[2]), siluf(acc[3])), pk2(siluf(acc[4]), siluf(acc[5])), pk2(siluf(acc[6]), siluf(acc[7])));
}
__global__ void __launch_bounds__(256) k_pool(const bf16* U, bf16* Y) {
    const int idx = blockIdx.x * 256 + threadIdx.x; if (idx >= T * 64) return;
    const int t = idx >> 6, c0 = (idx & 63) * 8, pos = t % L, gi = c0 >> 7, win = 2 << gi, n = min(pos + 1, win);
    float acc[8] = {0, 0, 0, 0, 0, 0, 0, 0}, self[8];
    for (int i = 0; i < n; ++i) {
        const uint4 v = *(const uint4*)(U + (size_t)(t - i) * NU + C_POOL + c0); const unsigned w[4] = {v.x, v.y, v.z, v.w};
#pragma unroll
        for (int j = 0; j < 8; ++j) { const float f = bf2f((bf16)(w[j >> 1] >> (16 * (j & 1)))); acc[j] += f; if (i == 0) self[j] = f; }
    }
    const float inv = 1.f / (float)n; float o[8];
#pragma unroll
    for (int j = 0; j < 8; ++j) o[j] = acc[j] * inv - self[j];
    *(uint4*)(Y + (size_t)t * KOUT + 512 + c0) = make_uint4(pk2(o[0], o[1]), pk2(o[2], o[3]), pk2(o[4], o[5]), pk2(o[6], o[7]));
}
__global__ void __launch_bounds__(256) k_cn_dt(const bf16* U, const float* UF, const float* kvn, const float* dtb, bf16* CN, float* DT) {
    const int t = (blockIdx.x * 256 + threadIdx.x) >> 6, lane = threadIdx.x & 63; if (t >= T) return;
    const unsigned v = *(const unsigned*)(U + (size_t)t * NU + C_DC + 2 * lane);
    const float a = bf2f((bf16)(v & 0xffff)), c = bf2f((bf16)(v >> 16));
    const float rs = rsqrtf(wave_sum(a * a + c * c) * (1.f / 128.f) + EPSF);
    *(unsigned*)(CN + (size_t)t * 128 + 2 * lane) = pk2(a * rs * kvn[2 * lane], c * rs * kvn[2 * lane + 1]);
    if (lane < 8) DT[(size_t)t * 8 + lane] = softplusf(UF[(size_t)t * 32 + lane] + dtb[lane]);
}
__global__ void __launch_bounds__(64) k_fcum(const float* UF, const float* fb, float* FCUM) {
    const int bh = blockIdx.x, b = bh >> 3, h = bh & 7, lane = threadIdx.x; float carry = 0.f; const float bias = fb[h];
    for (int base = 0; base < LKP; base += 64) {
        const int p = base + lane; float v = p < L ? logsigmoidf(UF[(size_t)(b * L + p) * 32 + 8 + h] + bias) : 0.f;
#pragma unroll
        for (int o = 1; o < 64; o <<= 1) { const float n = __shfl_up(v, o); if (lane >= o) v += n; }
        v += carry; FCUM[(size_t)bh * LKP + p] = v; carry = __shfl(v, 63);
    }
}

__global__ void __launch_bounds__(256) k_ssd_rec(const bf16* XC, const float* DT, const float* a_log, const float* dsk, float* YA) {
    const int bh = blockIdx.x, b = bh >> 3, hd = bh & 7, g = hd >> 2, tid = threadIdx.x, p = tid >> 2, ns = tid & 3;
    const float a_neg = -__expf(a_log[hd]), Dk = dsk[hd];
    float h[32];
#pragma unroll
    for (int i = 0; i < 32; ++i) h[i] = 0.f;
    const bf16* row = XC + (size_t)(b * L) * 1024; const float* dtp = DT + (size_t)(b * L) * 8 + hd; float* ya = YA + (size_t)(b * L) * 512 + 64 * hd + p;
    uint4 Bn[4], Cn[4]; float xn, dtn;
#pragma unroll
    for (int q = 0; q < 4; ++q) { Bn[q] = *(const uint4*)(row + 512 + 128 * g + 32 * ns + 8 * q); Cn[q] = *(const uint4*)(row + 768 + 128 * g + 32 * ns + 8 * q); }
    xn = bf2f(row[64 * hd + p]); dtn = dtp[0];
    for (int s = 0; s < L; ++s) {
        uint4 Bc[4], Cc[4];
#pragma unroll
        for (int q = 0; q < 4; ++q) { Bc[q] = Bn[q]; Cc[q] = Cn[q]; }
        const float xv = xn, dt = dtn;
        if (s + 1 < L) { const bf16* r2 = row + (size_t)(s + 1) * 1024;
#pragma unroll
            for (int q = 0; q < 4; ++q) { Bn[q] = *(const uint4*)(r2 + 512 + 128 * g + 32 * ns + 8 * q); Cn[q] = *(const uint4*)(r2 + 768 + 128 * g + 32 * ns + 8 * q); }
            xn = bf2f(r2[64 * hd + p]); dtn = dtp[(size_t)(s + 1) * 8]; }
        const float da = __expf(dt * a_neg), xd = xv * dt; float y = 0.f;
#pragma unroll
        for (int q = 0; q < 4; ++q) { const unsigned bw[4] = {Bc[q].x, Bc[q].y, Bc[q].z, Bc[q].w}, cw[4] = {Cc[q].x, Cc[q].y, Cc[q].z, Cc[q].w};
#pragma unroll
            for (int j = 0; j < 8; ++j) { const float bv = bf2f((bf16)(bw[j >> 1] >> (16 * (j & 1)))), cv = bf2f((bf16)(cw[j >> 1] >> (16 * (j & 1))));
                h[8 * q + j] = da * h[8 * q + j] + xd * bv; y += cv * h[8 * q + j]; } }
        y += __shfl_xor(y, 1); y += __shfl_xor(y, 2);
        if (ns == 0) ya[(size_t)s * 512] = y + Dk * xv;
    }
}
__global__ void __launch_bounds__(256) k_ssd_gate(const float* YA, const bf16* U, bf16* Y) {
    const int w = (blockIdx.x * 256 + threadIdx.x) >> 6, lane = threadIdx.x & 63; if (w >= T * 2) return;
    const int t = w >> 1, g = w & 1;
    const float4 ya = *(const float4*)(YA + (size_t)t * 512 + 256 * g + 4 * lane);
    const uint2 zz = *(const uint2*)(U + (size_t)t * NU + C_Z + 256 * g + 4 * lane);
    const float g0 = ya.x * siluf(bf2f((bf16)(zz.x & 0xffff))), g1 = ya.y * siluf(bf2f((bf16)(zz.x >> 16))), g2 = ya.z * siluf(bf2f((bf16)(zz.y & 0xffff))), g3 = ya.w * siluf(bf2f((bf16)(zz.y >> 16)));
    const float rs = rsqrtf(wave_sum(g0 * g0 + g1 * g1 + g2 * g2 + g3 * g3) * (1.f / 256.f) + EPSF);
    *(uint2*)(Y + (size_t)t * KOUT + 256 * g + 4 * lane) = make_uint2(pk2(g0 * rs, g1 * rs), pk2(g2 * rs, g3 * rs));
}

__global__ void __launch_bounds__(64) k_fox_naive(const bf16* U, const float* FCUM, bf16* Y) {
    const int blk = blockIdx.x, qb = blk % 65, bh = blk / 65, h = bh & 7, b = bh >> 3;
    const int q = qb * 64 + threadIdx.x; const bool valid = q < L; const int qq = valid ? q : L - 1;
    const size_t rowq = (size_t)(b * L + qq);
    float qv[64], o[64];
#pragma unroll
    for (int d = 0; d < 64; d += 2) { const unsigned v = *(const unsigned*)(U + rowq * NU + C_FQ + 64 * h + d); qv[d] = bf2f((bf16)(v & 0xffff)) * 0.125f; qv[d + 1] = bf2f((bf16)(v >> 16)) * 0.125f; o[d] = 0.f; o[d + 1] = 0.f; }
    float m = -1e30f, l = 0.f;
    const int kmax = min(qb * 64 + 63, L - 1);
    const float* fc = FCUM + (size_t)bh * LKP;
    for (int k = 0; k <= kmax; ++k) {
        const bf16* kr = U + (size_t)(b * L + k) * NU + C_FK + 64 * h; const bf16* vr = kr + (C_FV - C_FK);
        float s = 0.f;
#pragma unroll
        for (int d = 0; d < 64; d += 2) { const unsigned v = *(const unsigned*)(kr + d); s += qv[d] * bf2f((bf16)(v & 0xffff)) + qv[d + 1] * bf2f((bf16)(v >> 16)); }
        s -= fc[k];
        const bool ok = k <= qq;
        const float mn = ok ? fmaxf(m, s) : m, alpha = __expf(m - mn), pp = ok ? __expf(s - mn) : 0.f;
        l = l * alpha + pp; m = mn;
#pragma unroll
        for (int d = 0; d < 64; d += 2) { const unsigned v = *(const unsigned*)(vr + d); o[d] = o[d] * alpha + pp * bf2f((bf16)(v & 0xffff)); o[d + 1] = o[d + 1] * alpha + pp * bf2f((bf16)(v >> 16)); }
    }
    if (valid) { const float inv = 1.f / l;
#pragma unroll
        for (int d = 0; d < 64; d += 2) *(unsigned*)(Y + rowq * KOUT + 1024 + 64 * h + d) = pk2(o[d] * inv, o[d + 1] * inv); }
}

__device__ __forceinline__ unsigned fkey(float f) { const unsigned u = __float_as_uint(f); return (u & 0x80000000u) ? ~u : (u | 0x80000000u); }
__global__ void __launch_bounds__(256) k_dsa_naive(const bf16* U, const float* UF, const bf16* CN, u64* MASK, bf16* Y) {
    __shared__ unsigned sk[LKP];
    __shared__ float qi_s[256], ql_s[1024], p_s[8][256];
    __shared__ int sel[256];
    __shared__ int cnt[40];
    __shared__ int wcnt[NMW + 2], wpre[NMW + 2];
    const int t = blockIdx.x, b = t / L, p = t - b * L, tid = threadIdx.x, lane = tid & 63, wv = tid >> 6;
    const int c = p < NMETA ? 0 : 1 + (p - NMETA) / 64, nadm = c == 0 ? NMETA : NMETA + 64 * c;
    const bf16* urow = U + (size_t)t * NU;
    qi_s[tid] = bf2f(urow[C_QI + tid]);
#pragma unroll
    for (int i = 0; i < 4; ++i) ql_s[tid + 256 * i] = bf2f(urow[C_QLAT + tid + 256 * i]);
    if (tid < 40) cnt[tid] = 0;
    const float wi0 = UF[(size_t)t * 32 + 16], wi1 = UF[(size_t)t * 32 + 17], wi2 = UF[(size_t)t * 32 + 18], wi3 = UF[(size_t)t * 32 + 19];
    __syncthreads();
#pragma unroll 1
    for (int k = tid; k < LKP; k += 256) {
        unsigned key = 0u;
        if (k < nadm) {
            const bf16* kr = U + (size_t)(b * L + k) * NU + C_KI; float d0 = 0.f, d1 = 0.f, d2 = 0.f, d3 = 0.f;
#pragma unroll
            for (int d = 0; d < 64; d += 2) { const unsigned v = *(const unsigned*)(kr + d); const float k0 = bf2f((bf16)(v & 0xffff)), k1 = bf2f((bf16)(v >> 16));
                d0 += qi_s[d] * k0 + qi_s[d + 1] * k1; d1 += qi_s[64 + d] * k0 + qi_s[65 + d] * k1; d2 += qi_s[128 + d] * k0 + qi_s[129 + d] * k1; d3 += qi_s[192 + d] * k0 + qi_s[193 + d] * k1; }
            float s = wi0 * fmaxf(d0, 0.f) + wi1 * fmaxf(d1, 0.f) + wi2 * fmaxf(d2, 0.f) + wi3 * fmaxf(d3, 0.f);
            if (s == 0.f) s = 0.f;
            key = fkey(s);
        }
        sk[k] = key;
    }
    __syncthreads();
    unsigned tau = 0u; int need = 0;
    if (nadm > TOPK) {
        for (int bit = 31; bit >= 0; --bit) {
            const unsigned cand = tau | (1u << bit); int n = 0;
            for (int k = tid; k < nadm; k += 256) n += sk[k] >= cand ? 1 : 0;
#pragma unroll
            for (int o = 1; o < 64; o <<= 1) n += __shfl_xor(n, o);
            if (lane == 0) atomicAdd(&cnt[31 - bit], n);
            __syncthreads();
            if (cnt[31 - bit] >= TOPK) tau = cand;
        }
        int n = 0;
        for (int k = tid; k < nadm; k += 256) n += sk[k] > tau ? 1 : 0;
#pragma unroll
        for (int o = 1; o < 64; o <<= 1) n += __shfl_xor(n, o);
        if (lane == 0) atomicAdd(&cnt[32], n);
        __syncthreads();
        need = TOPK - cnt[32];
    }
    for (int j = 0; j < 17; ++j) { const int k = tid + 256 * j, w = 4 * j + wv; if (w >= NMW) break;
        const bool eq = (nadm > TOPK) && k < nadm && sk[k] == tau; const u64 be = __ballot(eq); if (lane == 0) wcnt[w] = __popcll(be); }
    __syncthreads();
    if (tid == 0) { int s = 0; for (int w = 0; w < NMW; ++w) { wpre[w] = s; s += wcnt[w]; } }
    __syncthreads();
    u64 selw[17];
    for (int j = 0; j < 17; ++j) { const int k = tid + 256 * j, w = 4 * j + wv; selw[j] = 0; if (w >= NMW) break;
        bool s;
        if (nadm <= TOPK) s = k < nadm;
        else { const bool in = k < nadm, gt = in && sk[k] > tau, eq = in && sk[k] == tau; const u64 be = __ballot(eq);
            const int rank = wpre[w] + __popcll(be & ((1ull << lane) - 1ull)); s = gt || (eq && rank < need); }
        const u64 bs = __ballot(s); selw[j] = bs;
        if (lane == 0) { MASK[(size_t)t * NMW + w] = bs; wcnt[w] = __popcll(bs); } }
    __syncthreads();
    if (tid == 0) { int s = 0; for (int w = 0; w < NMW; ++w) { wpre[w] = s; s += wcnt[w]; } wpre[NMW] = s; }
    __syncthreads();
    const int nsel = wpre[NMW];
    for (int j = 0; j < 17; ++j) { const int k = tid + 256 * j, w = 4 * j + wv; if (w >= NMW) break;
        if ((selw[j] >> lane) & 1ull) { const int pos = wpre[w] + __popcll(selw[j] & ((1ull << lane) - 1ull)); if (pos < 256) sel[pos] = k; } }
    __syncthreads();
    float sc8[8];
    if (tid < nsel) { const bf16* cr = CN + (size_t)(b * L + sel[tid]) * 128;
#pragma unroll
        for (int h = 0; h < 8; ++h) sc8[h] = 0.f;
        for (int r = 0; r < 128; r += 2) { const unsigned v = *(const unsigned*)(cr + r); const float c0 = bf2f((bf16)(v & 0xffff)), c1 = bf2f((bf16)(v >> 16));
#pragma unroll
            for (int h = 0; h < 8; ++h) sc8[h] += ql_s[128 * h + r] * c0 + ql_s[128 * h + r + 1] * c1; }
#pragma unroll
        for (int h = 0; h < 8; ++h) p_s[h][tid] = sc8[h]; }
    __syncthreads();
    for (int h = 2 * wv; h < 2 * wv + 2; ++h) {
        float mx = -1e30f;
        for (int i = lane; i < nsel; i += 64) mx = fmaxf(mx, p_s[h][i]);
#pragma unroll
        for (int o = 1; o < 64; o <<= 1) mx = fmaxf(mx, __shfl_xor(mx, o));
        float sm = 0.f;
        for (int i = lane; i < nsel; i += 64) { const float e = __expf(p_s[h][i] - mx); p_s[h][i] = e; sm += e; }
        sm = wave_sum(sm); const float inv = 1.f / sm;
        for (int i = lane; i < nsel; i += 64) p_s[h][i] *= inv;
    }
    __syncthreads();
    const bf16* cb = CN + (size_t)(b * L) * 128;
#pragma unroll
    for (int mm = 0; mm < 4; ++mm) { const int oi = tid + 256 * mm, h = oi >> 7, r = oi & 127; float acc = 0.f;
        for (int i = 0; i < nsel; ++i) acc += p_s[h][i] * bf2f(cb[(size_t)sel[i] * 128 + r]);
        Y[(size_t)t * KOUT + 1536 + oi] = f2bf(acc); }
}

__global__ void __launch_bounds__(256) k_resid(const bf16* MIX, const float* g, float* dout, float* metax, bf16* XB, float* RSTD) {
    const int t = (blockIdx.x * 256 + threadIdx.x) >> 6, lane = threadIdx.x & 63; if (t >= T) return;
    float mv[32]; float ss = 0.f;
#pragma unroll
    for (int j = 0; j < 4; ++j) { const uint4 v = *(const uint4*)(MIX + (size_t)t * DM + 8 * lane + 512 * j); const unsigned w[4] = {v.x, v.y, v.z, v.w};
#pragma unroll
        for (int i = 0; i < 8; ++i) { const float f = bf2f((bf16)(w[i >> 1] >> (16 * (i & 1)))); mv[8 * j + i] = f; ss += f * f; } }
    const float rs = rsqrtf(wave_sum(ss) * (1.f / DM) + EPSF);
    float* xr = xf_row(dout, metax, t); float s2 = 0.f;
#pragma unroll
    for (int j = 0; j < 4; ++j) { const int c = 8 * lane + 512 * j;
        float4 a = *(const float4*)(xr + c), b4 = *(const float4*)(xr + c + 4); const float4 ga = *(const float4*)(g + c), gb = *(const float4*)(g + c + 4);
        a.x += mv[8 * j] * rs * ga.x; a.y += mv[8 * j + 1] * rs * ga.y; a.z += mv[8 * j + 2] * rs * ga.z; a.w += mv[8 * j + 3] * rs * ga.w;
        b4.x += mv[8 * j + 4] * rs * gb.x; b4.y += mv[8 * j + 5] * rs * gb.y; b4.z += mv[8 * j + 6] * rs * gb.z; b4.w += mv[8 * j + 7] * rs * gb.w;
        s2 += a.x * a.x + a.y * a.y + a.z * a.z + a.w * a.w + b4.x * b4.x + b4.y * b4.y + b4.z * b4.z + b4.w * b4.w;
        *(float4*)(xr + c) = a; *(float4*)(xr + c + 4) = b4;
        *(uint4*)(XB + (size_t)t * DM + c) = make_uint4(pk2(a.x, a.y), pk2(a.z, a.w), pk2(b4.x, b4.y), pk2(b4.z, b4.w)); }
    s2 = wave_sum(s2);
    if (lane == 0) RSTD[t] = rsqrtf(s2 * (1.f / DM) + EPSF);
}

constexpr size_t MiB = (size_t)1 << 20;
constexpr size_t WS_CTL = 0, WS_WIN = 1 * MiB, WS_WOUT = 21 * MiB, WS_WGU = 31 * MiB, WS_WDN = 75 * MiB, WS_METAX = 97 * MiB, WS_RSTD = 98 * MiB, WS_UF = 99 * MiB,
                 WS_DT = 104 * MiB, WS_FCUM = 106 * MiB, WS_CN = 108 * MiB, WS_MASK = 117 * MiB, WS_XB = 134 * MiB, WS_Y = 264 * MiB, WS_R1 = 426 * MiB, WS_XC = WS_R1 + 323 * MiB,
                 WS_YA = 814 * MiB, WS_END = 879 * MiB;
static_assert(WS_WIN + (size_t)NU * DM * 2 <= WS_WOUT && WS_WOUT + (size_t)DM * KOUT * 2 <= WS_WGU && WS_WGU + (size_t)NGU * DM * 2 <= WS_WDN && WS_WDN + (size_t)DM * FF * 2 <= WS_METAX, "ws weights");
static_assert(WS_UF + (size_t)MP * 32 * 4 <= WS_DT && WS_DT + (size_t)T * 8 * 4 <= WS_FCUM && WS_FCUM + (size_t)64 * LKP * 4 <= WS_CN && WS_CN + (size_t)MP * 128 * 2 <= WS_MASK && WS_MASK + (size_t)T * NMW * 8 <= WS_XB, "ws small");
static_assert(WS_XB + (size_t)(MP + 8) * DM * 2 <= WS_Y && WS_Y + (size_t)MP * KOUT * 2 <= WS_R1 && WS_R1 + (size_t)MP * NU * 2 <= WS_XC && WS_XC + (size_t)MP * 1024 * 2 <= WS_YA && WS_R1 + (size_t)MP * FF * 2 <= WS_YA && WS_YA + (size_t)T * 512 * 4 <= WS_END, "ws big");

extern "C" void kernel_launch(void* const* d_in, const int* in_sizes, int n_in, void* d_out, int out_size, void* d_ws, size_t ws_size, hipStream_t stream) {
    static int ok = 0;
    if (ok == 0) {
        if (n_in != 25 || in_sizes[0] != NB * SEQ * DM || out_size != NB * SEQ * DM || ws_size < WS_END) { fprintf(stderr, "kernel_launch: unexpected shapes (n_in %d in0 %d out %d ws %zu)\n", n_in, n_in > 0 ? in_sizes[0] : -1, out_size, ws_size); ok = -1; return; }
        if (hipFuncSetAttribute((const void*)k_gemm, hipFuncAttributeMaxDynamicSharedMemorySize, LDS_BYTES) != hipSuccess) { fprintf(stderr, "kernel_launch: hipFuncSetAttribute failed\n"); ok = -1; return; }
        ok = 1;
    }
    if (ok < 0) return;
    const float* x = (const float*)d_in[0]; const float* meta = (const float*)d_in[1];
    const float* norm_mix_pre = (const float*)d_in[2]; const float* norm_mix_post = (const float*)d_in[3]; const float* norm_ffn_pre = (const float*)d_in[4]; const float* norm_ffn_post = (const float*)d_in[5];
    const float* w_in = (const float*)d_in[6]; const float* ssd_conv_w = (const float*)d_in[7]; const float* ssd_conv_b = (const float*)d_in[8]; const float* ssd_dt_bias = (const float*)d_in[9];
    const float* ssd_a_log = (const float*)d_in[10]; const float* ssd_d = (const float*)d_in[11]; const float* ssd_norm = (const float*)d_in[12]; const float* pool_w = (const float*)d_in[13];
    const float* pool_scale = (const float*)d_in[14]; const float* fox_f_bias = (const float*)d_in[15]; const float* dsa_kv_norm = (const float*)d_in[16]; const float* dsa_w_uk = (const float*)d_in[17];
    const float* dsa_w_uv = (const float*)d_in[18]; const float* w_out = (const float*)d_in[19]; const float* ffn_w_gate = (const float*)d_in[20]; const float* ffn_w_up = (const float*)d_in[21];
    const float* ffn_conv_w = (const float*)d_in[22]; const float* ffn_conv_b = (const float*)d_in[23]; const float* ffn_w_down = (const float*)d_in[24];
    unsigned char* ws = (unsigned char*)d_ws; float* dout = (float*)d_out;
    bf16* WIN = (bf16*)(ws + WS_WIN); bf16* WOUT = (bf16*)(ws + WS_WOUT); bf16* WGU = (bf16*)(ws + WS_WGU); bf16* WDN = (bf16*)(ws + WS_WDN);
    float* METAX = (float*)(ws + WS_METAX); float* RSTD = (float*)(ws + WS_RSTD); float* UF = (float*)(ws + WS_UF); float* DTB = (float*)(ws + WS_DT); float* FCUM = (float*)(ws + WS_FCUM);
    bf16* CN = (bf16*)(ws + WS_CN); u64* MASK = (u64*)(ws + WS_MASK); bf16* XB = (bf16*)(ws + WS_XB) + (size_t)8 * DM; bf16* Y = (bf16*)(ws + WS_Y);
    bf16* U = (bf16*)(ws + WS_R1); bf16* XC = (bf16*)(ws + WS_XC); bf16* H = (bf16*)(ws + WS_R1); bf16* MIX = (bf16*)(ws + WS_R1); bf16* MIX2 = (bf16*)(ws + WS_Y); float* YA = (float*)(ws + WS_YA);

    k_prep_x<<<((MP + 8) * 64 + 255) / 256, 256, 0, stream>>>(x, meta, dout, METAX, XB, RSTD);
    for (int ly = 0; ly < DEPTH; ++ly) {
        k_prep_win<<<dim3(DM / 32, NU / 32), dim3(32, 8), 0, stream>>>(w_in + (size_t)ly * DM * DIN, norm_mix_pre + (size_t)ly * DM, dsa_w_uk + (size_t)ly * 8 * 128 * 64, WIN);
        k_prep_wout<<<dim3(KOUT / 32, DM / 32), dim3(32, 8), 0, stream>>>(w_out + (size_t)ly * DM * DM, ssd_norm + (size_t)ly * 512, pool_w + (size_t)ly * 4 * 128 * 128, pool_scale + (size_t)ly * 512, dsa_w_uv + (size_t)ly * 8 * 128 * 64, WOUT);
        k_prep_wgu<<<dim3(DM / 32, NGU / 32), dim3(32, 8), 0, stream>>>(ffn_w_gate + (size_t)ly * DM * FF, ffn_w_up + (size_t)ly * DM * FF, norm_ffn_pre + (size_t)ly * DM, WGU);
        k_prep_wdn<<<dim3(FF / 32, DM / 32), dim3(32, 8), 0, stream>>>(ffn_w_down + (size_t)ly * FF * DM, WDN);
        { GemmArgs a{}; a.A = XB; a.Bt = WIN; a.O = U; a.rs = RSTD; a.UF = UF; a.Mtiles = 129; a.N = NU; a.K = DM; a.ldc = NU; a.kind = 0;
          hipLaunchKernelGGL(k_gemm, dim3(256), dim3(512), LDS_BYTES, stream, a); }
        k_conv_xbc<<<(T * 128 + 255) / 256, 256, 0, stream>>>(U, ssd_conv_w + (size_t)ly * 4 * 1024, ssd_conv_b + (size_t)ly * 1024, XC);
        k_pool<<<(T * 64 + 255) / 256, 256, 0, stream>>>(U, Y);
        k_cn_dt<<<(T * 64 + 255) / 256, 256, 0, stream>>>(U, UF, dsa_kv_norm + (size_t)ly * 128, ssd_dt_bias + (size_t)ly * 8, CN, DTB);
        k_fcum<<<64, 64, 0, stream>>>(UF, fox_f_bias + (size_t)ly * 8, FCUM);
        k_ssd_rec<<<64, 256, 0, stream>>>(XC, DTB, ssd_a_log + (size_t)ly * 8, ssd_d + (size_t)ly * 8, YA);
        k_ssd_gate<<<(T * 2 * 64 + 255) / 256, 256, 0, stream>>>(YA, U, Y);
        k_fox_naive<<<64 * 65, 64, 0, stream>>>(U, FCUM, Y);
        k_dsa_naive<<<T, 256, 0, stream>>>(U, UF, CN, MASK, Y);
        { GemmArgs a{}; a.A = Y; a.Bt = WOUT; a.O = MIX; a.Mtiles = 129; a.N = DM; a.K = KOUT; a.ldc = DM; a.kind = 0;
          hipLaunchKernelGGL(k_gemm, dim3(256), dim3(512), LDS_BYTES, stream, a); }
        k_resid<<<(T * 64 + 255) / 256, 256, 0, stream>>>(MIX, norm_mix_post + (size_t)ly * DM, dout, METAX, XB, RSTD);
        { GemmArgs a{}; a.A = XB; a.Bt = WGU; a.O = H; a.rs = RSTD; a.cw = ffn_conv_w + (size_t)ly * 3 * FF; a.cb = ffn_conv_b + (size_t)ly * FF; a.Mtiles = 130; a.N = NGU; a.K = DM; a.ldc = FF; a.kind = 1;
          hipLaunchKernelGGL(k_gemm, dim3(256), dim3(512), LDS_BYTES, stream, a); }
        { GemmArgs a{}; a.A = H; a.Bt = WDN; a.O = MIX2; a.Mtiles = 129; a.N = DM; a.K = FF; a.ldc = DM; a.kind = 0;
          hipLaunchKernelGGL(k_gemm, dim3(256), dim3(512), LDS_BYTES, stream, a); }
        k_resid<<<(T * 64 + 255) / 256, 256, 0, stream>>>(MIX2, norm_ffn_post + (size_t)ly * DM, dout, METAX, XB, RSTD);
    }
}
```

```cpp
#include <hip/hip_runtime.h>
#include <cstdio>
#include <cstdint>

constexpr int NB = 8, SEQ = 4096, NMETA = 16, L = SEQ + NMETA  , T = NB * L  , MP = 33024  , DM = 2048;
constexpr int NU = 5120, KOUT = 2560, FF = 5632, NGU = 2 * FF, DIN = 4564;
constexpr int C_Z = 0, C_XBC = 512, C_POOL = 1536, C_FQ = 2048, C_FK = 2560, C_FV = 3072, C_QLAT = 3584, C_DC = 4608, C_QI = 4736, C_KI = 4992, C_SM = 5056;
constexpr int LKP = 4224, NMW = 66  , TOPK = 256, DEPTH = 4;
constexpr float EPSF = 1e-6f;
typedef unsigned short bf16;
typedef unsigned long long u64;

__device__ __forceinline__ float bf2f(bf16 v) { return __uint_as_float(((unsigned)v) << 16); }
__device__ __forceinline__ bf16 f2bf(float f) { unsigned u = __float_as_uint(f); return (bf16)((u + 0x7fffu + ((u >> 16) & 1u)) >> 16); }
__device__ __forceinline__ unsigned pk2(float lo, float hi) { return (unsigned)f2bf(lo) | ((unsigned)f2bf(hi) << 16); }
__device__ __forceinline__ float siluf(float x) { return x / (1.f + __expf(-x)); }
__device__ __forceinline__ float softplusf(float x) { return fmaxf(x, 0.f) + log1pf(__expf(-fabsf(x))); }
__device__ __forceinline__ float logsigmoidf(float x) { return fminf(x, 0.f) - log1pf(__expf(-fabsf(x))); }
__device__ __forceinline__ float wave_sum(float v) {
#pragma unroll
    for (int o = 1; o < 64; o <<= 1) v += __shfl_xor(v, o);
    return v;
}
__device__ __forceinline__ float* xf_row(float* dout, float* metax, int t) {
    const int b = t / L, p = t - b * L;
    return p < NMETA ? metax + (size_t)(b * NMETA + p) * DM : dout + ((size_t)b * SEQ + (p - NMETA)) * DM;
}
namespace pg8 {
#define PG8_LAS __attribute__((address_space(3)))
typedef unsigned short bf16_t;
typedef short bf16x8 __attribute__((ext_vector_type(8)));
typedef float f32x4 __attribute__((ext_vector_type(4)));
typedef unsigned u32x4 __attribute__((ext_vector_type(4)));
constexpr int BM = 256, BK = 64, HALF = 128, HTB = HALF * BK * 2  , STAGE_BYTES = 8 * HTB, NXCD = 8, WGM = 8;

__host__ __device__ __forceinline__ int lds_byte(int r, int c) { const int st = (r >> 4) * 2 + (c >> 5), rr = r & 15, cc = c & 31, ob = rr * 64 + cc * 2; return st * 1024 + (ob ^ (((ob >> 9) & 1) << 5)); }
__host__ __device__ __forceinline__ void stage_rc(int b, int& R, int& C) { const int st = b / 1024, sb = b % 1024, swz = sb ^ (((sb >> 9) & 1) << 5); R = (st >> 1) * 16 + swz / 64; C = (st & 1) * 32 + (swz % 64) / 2; }
__host__ __device__ __forceinline__ int perm32(int rho) { const int n = rho >> 4, i = rho & 15; return 8 * (i >> 2) + 4 * n + (i & 3); }

struct Unit { int pm, pn; };
struct Gemm { const bf16_t* A; const bf16_t* Bt; int M, N, K; size_t a_tstep; };

struct StaticOrder {
    int nM, nN, nwg, G, c;
    __host__ __device__ void init(int M, int N, int G_, int c_) { nM = M / BM; nN = N / BM; nwg = nM * nN; G = G_; c = c_; }
    __host__ __device__ bool next(int i, Unit& u) const {
        const long L = (long)i * G + c; if (L >= nwg) return false;
        int wgid = (int)L; { const int q = nwg / NXCD, r = nwg % NXCD, xcd = wgid % NXCD, off = wgid / NXCD; wgid = (xcd < r ? xcd * (q + 1) : r * (q + 1) + (xcd - r) * q) + off; }
        const int nig = WGM * nN, gid = wgid / nig, fm = gid * WGM, gsz = (nM - fm) < WGM ? (nM - fm) : WGM;
        u.pm = fm + ((wgid % nig) % gsz); u.pn = (wgid % nig) / gsz; return true;
    }
    __device__ __forceinline__ void a_ready(const Unit&) const {}
    __device__ __forceinline__ void done(const Unit&) const {}
};


__device__ __forceinline__ unsigned cvt_pk_bf16(float lo, float hi) { unsigned r; asm volatile("v_cvt_pk_bf16_f32 %0, %1, %2" : "=v"(r) : "v"(lo), "v"(hi)); return r; }

struct EpiBf16Plain {
    static constexpr bool PERM = true, AFTER_DRAIN = false;
    bf16_t* O; int ldc; const float* rs; float* UF; int sm_col0;
    __device__ __forceinline__ void operator()(f32x4 (&acc)[2][2][4][2], const Unit& u, int wr, int wc, int fr, int fq) const {
        const int row0 = u.pm * BM + wr * 64 + fr, col0 = u.pn * BM + wc * 32 + 8 * fq;
#pragma unroll
        for (int ai = 0; ai < 2; ++ai)
#pragma unroll
            for (int m = 0; m < 4; ++m) {
                const int row = row0 + ai * HALF + m * 16; const float s = rs ? rs[row] : 1.f; bf16_t* rowp = O + (size_t)row * ldc + col0;
#pragma unroll
                for (int bj = 0; bj < 2; ++bj) { const f32x4 v0 = acc[ai][bj][m][0] * s, v1 = acc[ai][bj][m][1] * s;
                    u32x4 w; w.x = cvt_pk_bf16(v0[0], v0[1]); w.y = cvt_pk_bf16(v0[2], v0[3]); w.z = cvt_pk_bf16(v1[0], v1[1]); w.w = cvt_pk_bf16(v1[2], v1[3]);
                    *(u32x4*)(rowp + bj * HALF) = w;
                    if (UF) { const int c = col0 + bj * HALF - sm_col0; if (c >= 0 && c < 32) { float* p = UF + (size_t)row * 32 + c; *(f32x4*)p = v0; *(f32x4*)(p + 4) = v1; } } }
            }
    }
};

struct EpiGateUp {
    static constexpr bool PERM = true, AFTER_DRAIN = false;
    bf16_t* H; const float* rs; const float* cw; const float* cb; PG8_LAS float* halo;
    __device__ __forceinline__ void operator()(f32x4 (&acc)[2][2][4][2], const Unit& u, int wr, int wc, int fr, int fq) const {
        const int lane = fq * 16 + fr, chl = wc * 32 + 8 * fq, ch0 = u.pn * 128 + chl, rbase = u.pm * 254 - 2;
#pragma unroll
        for (int ai = 0; ai < 2; ++ai)
#pragma unroll
            for (int m = 0; m < 4; ++m) { const int grow = rbase + ai * 128 + wr * 64 + m * 16 + fr; const float s = grow >= 0 ? rs[grow] : 0.f;
#pragma unroll
                for (int bj = 0; bj < 2; ++bj)
#pragma unroll
                    for (int n = 0; n < 2; ++n) acc[ai][bj][m][n] = acc[ai][bj][m][n] * s; }
        if (fr >= 14) {
#pragma unroll
            for (int ai = 0; ai < 2; ++ai)
#pragma unroll
                for (int n = 0; n < 2; ++n) *(PG8_LAS f32x4*)(halo + ((2 * ai + wr) * 2 + (fr - 14)) * 128 + chl + 4 * n) = acc[ai][0][3][n];
        }
        asm volatile("s_waitcnt lgkmcnt(0)" ::: "memory"); __builtin_amdgcn_s_barrier(); asm volatile("" ::: "memory");
        f32x4 w0[2], w1[2], w2[2], bb[2];
#pragma unroll
        for (int n = 0; n < 2; ++n) { w0[n] = *(const f32x4*)(cw + ch0 + 4 * n); w1[n] = *(const f32x4*)(cw + FF + ch0 + 4 * n); w2[n] = *(const f32x4*)(cw + 2 * FF + ch0 + 4 * n); bb[n] = *(const f32x4*)(cb + ch0 + 4 * n); }
#pragma unroll
        for (int ai = 0; ai < 2; ++ai)
#pragma unroll
            for (int m = 0; m < 4; ++m) {
                const int rl = ai * 128 + wr * 64 + m * 16 + fr, grow = rbase + rl, pos = grow >= 0 ? grow % L : 0, blk = 2 * ai + wr;
                const float t1 = pos >= 1 ? 1.f : 0.f, t2 = pos >= 2 ? 1.f : 0.f;
                unsigned pk[4];
#pragma unroll
                for (int n = 0; n < 2; ++n) {
                    const f32x4 cur = acc[ai][0][m][n]; f32x4 g1, g2;
#pragma unroll
                    for (int j = 0; j < 4; ++j) {
                        const float s1 = __shfl(cur[j], (lane + 63) & 63), s2 = __shfl(cur[j], (lane + 62) & 63);
                        float p15, p14;
                        if (m > 0) { const float pv = acc[ai][0][m > 0 ? m - 1 : 0][n][j]; p15 = __shfl(pv, fq * 16 + 15); p14 = __shfl(pv, fq * 16 + 14); }
                        else if (blk > 0) { p14 = halo[((blk - 1) * 2 + 0) * 128 + chl + 4 * n + j]; p15 = halo[((blk - 1) * 2 + 1) * 128 + chl + 4 * n + j]; }
                        else { p14 = 0.f; p15 = 0.f; }
                        g1[j] = fr >= 1 ? s1 : p15; g2[j] = fr >= 2 ? s2 : (fr == 1 ? p15 : p14);
                    }
                    const f32x4 cv = bb[n] + w2[n] * cur + (w1[n] * g1) * t1 + (w0[n] * g2) * t2;
                    const f32x4 up = acc[ai][1][m][n];
                    float hv[4];
#pragma unroll
                    for (int j = 0; j < 4; ++j) hv[j] = cv[j] / (1.f + __expf(-cv[j])) * up[j];
                    pk[2 * n] = cvt_pk_bf16(hv[0], hv[1]); pk[2 * n + 1] = cvt_pk_bf16(hv[2], hv[3]);
                }
                if (rl >= 2) { u32x4 w; w.x = pk[0]; w.y = pk[1]; w.z = pk[2]; w.w = pk[3]; *(u32x4*)(H + (size_t)grow * FF + ch0) = w; }
            }
    }
};
template <class Epi, class Sched, bool ALIGN_EPI = false, bool SP2 = false>
__device__ __forceinline__ void gemm_phase(PG8_LAS unsigned char* lds, const Gemm g, const Sched& S, const Epi& E, const int tid) {
    const int wid = __builtin_amdgcn_readfirstlane(tid >> 6), lane = tid & 63, wr = wid >> 2, wc = wid & 3, fr = lane & 15, fq = lane >> 4;
    const int K = g.K, nt = K / BK;
    unsigned voffA[2], voffB[2];
#pragma unroll
    for (int i = 0; i < 2; ++i) { int R, C; stage_rc(tid * 16 + i * 8192, R, C); const int Rb = Epi::PERM ? ((R & ~31) + perm32(R & 31)) : R;
        voffA[i] = (unsigned)(R * K + C) * 2u; voffB[i] = (unsigned)(Rb * K + C) * 2u; }
    const size_t kstep = (size_t)(BK * 2);
    const size_t hstep = (size_t)HALF * K * 2;
    const size_t tstep = 2 * hstep;
    const unsigned ldsw = (unsigned)wid * 1024u;
    const int aoff = lds_byte(wr * 64 + fr, fq * 8), boff = lds_byte(wc * 32 + fr, fq * 8);
#define PG8_SA(b, h) (((b) * 2 + (h)) * HTB)
#define PG8_SB(b, h) ((4 + (b) * 2 + (h)) * HTB)
#define PG8_STAGE(bufoff, gbase, voff) do { _Pragma("unroll") for (int _i = 0; _i < 2; ++_i) \
        __builtin_amdgcn_global_load_lds((const unsigned*)((const char*)(gbase) + (voff)[_i]), (PG8_LAS unsigned*)(lds + (bufoff) + ldsw + _i * 8192), 16, 0, 0); } while (0)
#define PG8_LDA(dst, b, h) do { _Pragma("unroll") for (int m = 0; m < 4; ++m) _Pragma("unroll") for (int k = 0; k < 2; ++k) dst[m][k] = *(const PG8_LAS bf16x8*)(lds + PG8_SA(b, h) + aoff + m * 2048 + k * 1024); } while (0)
#define PG8_LDB(dst, b, h) do { _Pragma("unroll") for (int n = 0; n < 2; ++n) _Pragma("unroll") for (int k = 0; k < 2; ++k) dst[n][k] = *(const PG8_LAS bf16x8*)(lds + PG8_SB(b, h) + boff + n * 2048 + k * 1024); } while (0)
#define PG8_MMA(ai, bj, At, Bt) do { __builtin_amdgcn_s_setprio(1); _Pragma("unroll") for (int m = 0; m < 4; ++m) _Pragma("unroll") for (int n = 0; n < 2; ++n) _Pragma("unroll") for (int k = 0; k < 2; ++k) \
        acc[ai][bj][m][n] = __builtin_amdgcn_mfma_f32_16x16x32_bf16(Bt[n][k], At[m][k], acc[ai][bj][m][n], 0, 0, 0); __builtin_amdgcn_s_setprio(0); } while (0)
#define PG8_WAIT_V(n) asm volatile("s_waitcnt vmcnt(" #n ")" ::: "memory")
#define PG8_WAIT_L(n) asm volatile("s_waitcnt lgkmcnt(" #n ")" ::: "memory")
#define PG8_BAR __builtin_amdgcn_s_barrier()
#define PG8_SCHED __builtin_amdgcn_sched_barrier(0)
    Unit cur, nxt; int ui = 0;
    if (!S.next(0, cur)) return;
    f32x4 acc[2][2][4][2];
#pragma unroll
    for (int a = 0; a < 2; ++a)
#pragma unroll
        for (int b = 0; b < 2; ++b)
#pragma unroll
            for (int m = 0; m < 4; ++m)
#pragma unroll
                for (int n = 0; n < 2; ++n) acc[a][b][m][n] = (f32x4){0.f, 0.f, 0.f, 0.f};
    bf16x8 At[4][2], B0[2][2], B1[2][2];
    const char* cA = (const char*)g.A + (size_t)cur.pm * g.a_tstep; const char* cB = (const char*)g.Bt + (size_t)cur.pn * tstep;
    S.a_ready(cur);
    if constexpr (SP2) {
        PG8_STAGE(PG8_SB(0, 0), cB, voffB); PG8_STAGE(PG8_SB(0, 1), cB + hstep, voffB); PG8_STAGE(PG8_SA(0, 0), cA, voffA); PG8_STAGE(PG8_SA(0, 1), cA + hstep, voffA);
        if (wr == 1) PG8_BAR;
        PG8_WAIT_V(2); PG8_BAR;
        PG8_STAGE(PG8_SB(1, 0), cB + kstep, voffB); PG8_STAGE(PG8_SA(1, 0), cA + kstep, voffA); PG8_STAGE(PG8_SB(1, 1), cB + hstep + kstep, voffB);
        PG8_WAIT_V(6); PG8_BAR;
    } else {
        PG8_STAGE(PG8_SB(0, 0), cB, voffB); PG8_STAGE(PG8_SA(0, 0), cA, voffA); PG8_STAGE(PG8_SB(0, 1), cB + hstep, voffB); PG8_STAGE(PG8_SA(0, 1), cA + hstep, voffA);
        if (wr == 1) PG8_BAR;
        PG8_WAIT_V(4); PG8_BAR;
        PG8_STAGE(PG8_SB(1, 0), cB + kstep, voffB); PG8_STAGE(PG8_SA(1, 0), cA + kstep, voffA); PG8_STAGE(PG8_SB(1, 1), cB + hstep + kstep, voffB);
        PG8_WAIT_V(6); PG8_BAR;
    }
    for (;;) {
        const bool has_next = S.next(ui + 1, nxt);
        const char* nA = has_next ? (const char*)g.A + (size_t)nxt.pm * g.a_tstep : cA; const char* nB = has_next ? (const char*)g.Bt + (size_t)nxt.pn * tstep : cB;
        for (int t = 0; t < nt; t += 2) {
            const bool last = (t == nt - 2);
            const char* a1 = cA + (size_t)(t + 1) * kstep;
            const char* a2 = last ? nA : cA + (size_t)(t + 2) * kstep; const char* b2 = last ? nB : cB + (size_t)(t + 2) * kstep;
            const char* a3 = a2 + kstep; const char* b3 = b2 + kstep;
            if (last && has_next) S.a_ready(nxt);
            if constexpr (SP2) {
            PG8_LDB(B0, 0, 0); PG8_LDB(B1, 0, 1); PG8_SCHED; PG8_LDA(At, 0, 0); PG8_STAGE(PG8_SA(1, 1), a1 + hstep, voffA);
            PG8_WAIT_V(8); PG8_WAIT_L(0); PG8_BAR; PG8_MMA(0, 0, At, B0); PG8_MMA(0, 1, At, B1); PG8_BAR; PG8_SCHED;
            PG8_LDA(At, 0, 1); PG8_STAGE(PG8_SB(0, 0), b2, voffB); PG8_STAGE(PG8_SB(0, 1), b2 + hstep, voffB); PG8_STAGE(PG8_SA(0, 0), a2, voffA);
            PG8_WAIT_V(8); PG8_WAIT_L(0); PG8_BAR; PG8_MMA(1, 0, At, B0); PG8_MMA(1, 1, At, B1); PG8_BAR; PG8_SCHED;
            PG8_LDB(B0, 1, 0); PG8_LDB(B1, 1, 1); PG8_SCHED; PG8_LDA(At, 1, 0); PG8_STAGE(PG8_SA(0, 1), a2 + hstep, voffA);
            PG8_WAIT_V(8); PG8_WAIT_L(0); PG8_BAR; PG8_MMA(0, 0, At, B0); PG8_MMA(0, 1, At, B1); PG8_BAR; PG8_SCHED;
            PG8_LDA(At, 1, 1); PG8_STAGE(PG8_SB(1, 0), b3, voffB); PG8_STAGE(PG8_SB(1, 1), b3 + hstep, voffB); PG8_STAGE(PG8_SA(1, 0), a3, voffA);
            PG8_WAIT_V(8); PG8_WAIT_L(0); PG8_BAR; PG8_MMA(1, 0, At, B0); PG8_MMA(1, 1, At, B1); PG8_BAR; PG8_SCHED;
            } else {
            PG8_LDB(B0, 0, 0); PG8_SCHED; PG8_LDA(At, 0, 0); PG8_STAGE(PG8_SA(1, 1), a1 + hstep, voffA);
            PG8_WAIT_L(8); PG8_BAR; PG8_WAIT_L(0); PG8_MMA(0, 0, At, B0); PG8_BAR; PG8_SCHED;
            PG8_LDB(B1, 0, 1); PG8_STAGE(PG8_SB(0, 0), b2, voffB);
            PG8_BAR; PG8_WAIT_L(0); PG8_MMA(0, 1, At, B1); PG8_BAR;
            PG8_LDA(At, 0, 1); PG8_STAGE(PG8_SA(0, 0), a2, voffA);
            PG8_BAR; PG8_WAIT_L(0); PG8_MMA(1, 0, At, B0); PG8_BAR; PG8_SCHED;
            PG8_STAGE(PG8_SB(0, 1), b2 + hstep, voffB);
            PG8_WAIT_V(6); PG8_BAR; PG8_MMA(1, 1, At, B1); PG8_BAR;
            PG8_LDB(B0, 1, 0); PG8_SCHED; PG8_LDA(At, 1, 0); PG8_STAGE(PG8_SA(0, 1), a2 + hstep, voffA);
            PG8_WAIT_L(8); PG8_BAR; PG8_WAIT_L(0); PG8_MMA(0, 0, At, B0); PG8_BAR; PG8_SCHED;
            PG8_LDB(B1, 1, 1); PG8_STAGE(PG8_SB(1, 0), b3, voffB);
            PG8_BAR; PG8_WAIT_L(0); PG8_MMA(0, 1, At, B1); PG8_BAR;
            PG8_LDA(At, 1, 1); PG8_STAGE(PG8_SA(1, 0), a3, voffA);
            PG8_BAR; PG8_WAIT_L(0); PG8_MMA(1, 0, At, B0); PG8_BAR; PG8_SCHED;
            PG8_STAGE(PG8_SB(1, 1), b3 + hstep, voffB);
            PG8_WAIT_V(6); PG8_BAR; PG8_MMA(1, 1, At, B1); PG8_BAR;
            }
        }
        if constexpr (ALIGN_EPI) { if (wr == 0) PG8_BAR; }
        if constexpr (!Epi::AFTER_DRAIN) { E(acc, cur, wr, wc, fr, fq); S.done(cur); }
        if (!has_next) break;
#pragma unroll
        for (int a = 0; a < 2; ++a)
#pragma unroll
            for (int b = 0; b < 2; ++b)
#pragma unroll
                for (int m = 0; m < 4; ++m)
#pragma unroll
                    for (int n = 0; n < 2; ++n) acc[a][b][m][n] = (f32x4){0.f, 0.f, 0.f, 0.f};
        cur = nxt; cA = nA; cB = nB; ++ui;
        if constexpr (ALIGN_EPI) { if (wr == 1) PG8_BAR; }
    }
    PG8_WAIT_V(0);
    if constexpr (!ALIGN_EPI) { if (wr == 0) PG8_BAR; }
    PG8_BAR;
    if constexpr (Epi::AFTER_DRAIN) { E.fused(acc, cur, wr, wc, fr, fq, lds, wid, lane); S.done(cur); }
#undef PG8_SA
#undef PG8_SB
#undef PG8_STAGE
#undef PG8_LDA
#undef PG8_LDB
#undef PG8_MMA
#undef PG8_WAIT_V
#undef PG8_WAIT_L
#undef PG8_BAR
#undef PG8_SCHED
}
}

#include <hip/hip_cooperative_groups.h>
namespace cg = cooperative_groups;
#define LAS __attribute__((address_space(3)))
constexpr int LDS_BYTES = 147456, HALO_OFF = 133120, PT_OFF = 139264, NTHR = 512, NWAVE = 8;
constexpr size_t MiB = (size_t)1 << 20;
constexpr size_t WS_CTL = 0, WS_WIN = 1 * MiB, WS_WOUT = 21 * MiB, WS_WGU = 31 * MiB, WS_WDN = 75 * MiB, WS_METAX = 97 * MiB, WS_RSTD = 98 * MiB, WS_UF = 99 * MiB,
                 WS_DT = 104 * MiB, WS_FCUM = 106 * MiB, WS_CN = 108 * MiB, WS_MASK = 117 * MiB, WS_XB = 134 * MiB, WS_Y = 264 * MiB, WS_R1 = 426 * MiB, WS_XC = WS_R1 + 323 * MiB,
                 WS_YA = 814 * MiB, WS_END = 879 * MiB;
static_assert(WS_WIN + (size_t)NU * DM * 2 <= WS_WOUT && WS_WOUT + (size_t)DM * KOUT * 2 <= WS_WGU && WS_WGU + (size_t)NGU * DM * 2 <= WS_WDN && WS_WDN + (size_t)DM * FF * 2 <= WS_METAX, "ws weights");
static_assert(WS_UF + (size_t)MP * 32 * 4 <= WS_DT && WS_DT + (size_t)T * 8 * 4 <= WS_FCUM && WS_FCUM + (size_t)64 * LKP * 4 <= WS_CN && WS_CN + (size_t)MP * 128 * 2 <= WS_MASK && WS_MASK + (size_t)T * NMW * 8 <= WS_XB, "ws small");
static_assert(WS_XB + (size_t)(MP + 8) * DM * 2 <= WS_Y && WS_Y + (size_t)MP * KOUT * 2 <= WS_R1 && WS_R1 + (size_t)MP * NU * 2 <= WS_XC && WS_XC + (size_t)MP * 1024 * 2 <= WS_YA && WS_R1 + (size_t)MP * FF * 2 <= WS_YA && WS_YA + (size_t)T * 512 * 4 <= WS_END, "ws big");

struct Args { const float* in[25]; float* out; unsigned char* ws; };

struct Ctx {
    int tid, lane, wave, gw, ngw, bid, nb;
    LAS unsigned char* lds;
};
__device__ __forceinline__ Ctx refresh(const Ctx& c0) {
    Ctx c = c0; unsigned z = 0u; int w_ = c0.wave, b_ = (int)blockIdx.x, n_ = (int)gridDim.x; asm volatile("" : "+v"(z), "+s"(w_), "+s"(b_), "+s"(n_));
    const int lane = (int)__builtin_amdgcn_mbcnt_hi(~0u, __builtin_amdgcn_mbcnt_lo(~0u, z));
    c.bid = b_; c.nb = n_; c.ngw = n_ * NWAVE; c.wave = w_; c.lane = lane; c.tid = w_ * 64 + lane; c.gw = b_ * NWAVE + w_;
    { unsigned l_ = (unsigned)(size_t)c0.lds; asm volatile("" : "+s"(l_)); c.lds = (LAS unsigned char*)(size_t)l_; }
    return c;
}
__device__ __forceinline__ unsigned char* pt_get(const Ctx& c, int i) {
    unsigned l_ = (unsigned)(size_t)c.lds; asm volatile("" : "+s"(l_));
    const LAS unsigned* p = (const LAS unsigned*)((LAS unsigned char*)(size_t)l_ + PT_OFF) + 2 * i;
    const unsigned lo = __builtin_amdgcn_readfirstlane(p[0]), hi = __builtin_amdgcn_readfirstlane(p[1]);
    return (unsigned char*)(((unsigned long long)hi << 32) | lo);
}
#define INP(i) ((const float*)pt_get(c, (i)))

__device__ __forceinline__ void ph_prep_x(const Ctx& c0, const float* x, const float* meta, float* dout, float* metax, bf16* XB, float* RSTD) { const Ctx c = refresh(c0);
    const int lane = c.lane;
    for (int w = c.gw; w < MP + 8; w += c.ngw) {
        const int t = w - 8; bf16* xb = XB + (ptrdiff_t)t * DM;
        if (t < 0 || t >= T) {
#pragma unroll
            for (int j = 0; j < 4; ++j) *(uint4*)(xb + 8 * lane + 512 * j) = make_uint4(0, 0, 0, 0);
            if (t >= T && lane == 0) RSTD[t] = 0.f;
            continue;
        }
        const int b = t / L, p = t - b * L;
        const float* src = p < NMETA ? meta + (size_t)p * DM : x + ((size_t)b * SEQ + (p - NMETA)) * DM;
        float* dst = xf_row(dout, metax, t); float ss = 0.f;
#pragma unroll
        for (int j = 0; j < 4; ++j) {
            const float4 a = *(const float4*)(src + 8 * lane + 512 * j), cc = *(const float4*)(src + 8 * lane + 512 * j + 4);
            ss += a.x * a.x + a.y * a.y + a.z * a.z + a.w * a.w + cc.x * cc.x + cc.y * cc.y + cc.z * cc.z + cc.w * cc.w;
            *(float4*)(dst + 8 * lane + 512 * j) = a; *(float4*)(dst + 8 * lane + 512 * j + 4) = cc;
            *(uint4*)(xb + 8 * lane + 512 * j) = make_uint4(pk2(a.x, a.y), pk2(a.z, a.w), pk2(cc.x, cc.y), pk2(cc.z, cc.w));
        }
        ss = wave_sum(ss);
        if (lane == 0) RSTD[t] = rsqrtf(ss * (1.f / DM) + EPSF);
    }
}

template <class F> __device__ __forceinline__ void transpose_tiles(const Ctx& c, bf16* dst, int Kd, int N, const F& val) {
    LAS float* tile = (LAS float*)c.lds + (c.tid >> 8) * (32 * 33);
    const int t2 = c.tid & 255, tx = t2 & 31, ty = t2 >> 5, ntk = Kd / 32, ntiles = ntk * (N / 32);
    for (int it = 2 * c.bid + (c.tid >> 8); it < ntiles; it += 2 * c.nb) {
        const int k0 = (it % ntk) * 32, n0 = (it / ntk) * 32;
#pragma unroll
        for (int i = 0; i < 4; ++i) tile[(ty + 8 * i) * 33 + tx] = val(k0 + ty + 8 * i, n0 + tx);
        __syncthreads();
#pragma unroll
        for (int i = 0; i < 4; ++i) dst[(size_t)(n0 + ty + 8 * i) * Kd + k0 + tx] = f2bf(tile[tx * 33 + ty + 8 * i]);
        __syncthreads();
    }
}
__device__ __forceinline__ void ph_prep_w(const Ctx& c0, int ly, bf16* WIN, bf16* WOUT, bf16* WGU, bf16* WDN) { const Ctx c = refresh(c0);
    {   const float* w_in = INP(6) + (size_t)ly * DM * DIN; const float* g = INP(2) + (size_t)ly * DM; const float* w_uk = INP(17) + (size_t)ly * 8 * 128 * 64;
        transpose_tiles(c, WIN, DM, NU, [=](int k, int n) -> float {
            int src = -1;
            if (n < C_XBC) src = n;
            else if (n < C_POOL) src = 512 + (n - C_XBC);
            else if (n < C_FQ) src = 1544 + (n - C_POOL);
            else if (n < C_QLAT) src = 2056 + (n - C_FQ);
            else if (n < C_DC) { const int h = (n - C_QLAT) >> 7, r = (n - C_QLAT) & 127; const float* wq = w_in + (size_t)k * DIN + 3600 + 64 * h; const float* wu = w_uk + ((size_t)h * 128 + r) * 64;
                float s = 0.f;
                for (int d = 0; d < 64; ++d) s += wq[d] * wu[d];
                return s * 0.125f * g[k]; }
            else if (n < C_QI) src = 4112 + (n - C_DC);
            else if (n < C_KI) src = 4240 + (n - C_QI);
            else if (n < C_SM) src = 4496 + (n - C_KI);
            else if (n < C_SM + 8) src = 1536 + (n - C_SM);
            else if (n < C_SM + 16) src = 3592 + (n - C_SM - 8);
            else if (n < C_SM + 20) src = 4560 + (n - C_SM - 16);
            return src >= 0 ? w_in[(size_t)k * DIN + src] * g[k] : 0.f; }); }
    {   const float* w_out = INP(19) + (size_t)ly * DM * DM; const float* ssd_norm = INP(12) + (size_t)ly * 512; const float* pool_w = INP(13) + (size_t)ly * 4 * 128 * 128;
        const float* pool_scale = INP(14) + (size_t)ly * 512; const float* w_uv = INP(18) + (size_t)ly * 8 * 128 * 64;
        transpose_tiles(c, WOUT, KOUT, DM, [=](int k, int n) -> float {
            if (k < 512) return ssd_norm[k] * w_out[(size_t)k * DM + n];
            if (k < 1024) { const int gi = (k - 512) >> 7, cc = (k - 512) & 127; const float* pw = pool_w + ((size_t)gi * 128 + cc) * 128; float s = 0.f;
                for (int d = 0; d < 128; ++d) s += pw[d] * pool_scale[128 * gi + d] * w_out[(size_t)(512 + 128 * gi + d) * DM + n];
                return s; }
            if (k < 1536) return w_out[(size_t)k * DM + n];
            const int h = (k - 1536) >> 7, r = (k - 1536) & 127; const float* wv = w_uv + ((size_t)h * 128 + r) * 64; float s = 0.f;
            for (int d = 0; d < 64; ++d) s += wv[d] * w_out[(size_t)(1536 + 64 * h + d) * DM + n];
            return s; }); }
    {   const float* wg = INP(20) + (size_t)ly * DM * FF; const float* wu = INP(21) + (size_t)ly * DM * FF; const float* g = INP(4) + (size_t)ly * DM;
        transpose_tiles(c, WGU, DM, NGU, [=](int k, int n) -> float { const int pn = n >> 8, w = n & 255, ch = 128 * pn + (w & 127); return ((w >> 7) ? wu : wg)[(size_t)k * FF + ch] * g[k]; }); }
    {   const float* wd = INP(24) + (size_t)ly * FF * DM;
        transpose_tiles(c, WDN, FF, DM, [=](int k, int n) -> float { return wd[(size_t)k * DM + n]; }); }
}

__device__ __forceinline__ void ph_mixprep(const Ctx& c0, const bf16* U, const float* UF, const float* cw, const float* cb, const float* kvn, const float* dtb, bf16* XC, bf16* Y, bf16* CN, float* DT) { const Ctx c = refresh(c0);
    const int gt = c.bid * NTHR + c.tid, ngt = c.nb * NTHR;
    for (int idx = gt; idx < T * 128; idx += ngt) {
        const int t = idx >> 7, c0 = (idx & 127) * 8, pos = t % L; float acc[8];
#pragma unroll
        for (int j = 0; j < 8; ++j) acc[j] = cb[c0 + j];
#pragma unroll
        for (int k = 0; k < 4; ++k) {
            if (pos - 3 + k < 0) continue;
            const uint4 v = *(const uint4*)(U + (size_t)(t - 3 + k) * NU + C_XBC + c0); const unsigned w[4] = {v.x, v.y, v.z, v.w};
#pragma unroll
            for (int j = 0; j < 8; ++j) acc[j] += cw[k * 1024 + c0 + j] * bf2f((bf16)(w[j >> 1] >> (16 * (j & 1))));
        }
        *(uint4*)(XC + (size_t)t * 1024 + c0) = make_uint4(pk2(siluf(acc[0]), siluf(acc[1])), pk2(siluf(acc[2]), siluf(acc[3])), pk2(siluf(acc[4]), siluf(acc[5])), pk2(siluf(acc[6]), siluf(acc[7])));
    }
    for (int idx = gt; idx < T * 64; idx += ngt) {
        const int t = idx >> 6, c0 = (idx & 63) * 8, pos = t % L, gi = c0 >> 7, win = 2 << gi, n = min(pos + 1, win);
        float acc[8] = {0, 0, 0, 0, 0, 0, 0, 0}, self[8] = {0, 0, 0, 0, 0, 0, 0, 0};
        for (int i = 0; i < n; ++i) {
            const uint4 v = *(const uint4*)(U + (size_t)(t - i) * NU + C_POOL + c0); const unsigned w[4] = {v.x, v.y, v.z, v.w};
#pragma unroll
            for (int j = 0; j < 8; ++j) { const float f = bf2f((bf16)(w[j >> 1] >> (16 * (j & 1)))); acc[j] += f; if (i == 0) self[j] = f; }
        }
        const float inv = 1.f / (float)n; float o[8];
#pragma unroll
        for (int j = 0; j < 8; ++j) o[j] = acc[j] * inv - self[j];
        *(uint4*)(Y + (size_t)t * KOUT + 512 + c0) = make_uint4(pk2(o[0], o[1]), pk2(o[2], o[3]), pk2(o[4], o[5]), pk2(o[6], o[7]));
    }
    for (int t = c.gw; t < T; t += c.ngw) {
        const int lane = c.lane;
        const unsigned v = *(const unsigned*)(U + (size_t)t * NU + C_DC + 2 * lane);
        const float a = bf2f((bf16)(v & 0xffff)), cc = bf2f((bf16)(v >> 16));
        const float rs = rsqrtf(wave_sum(a * a + cc * cc) * (1.f / 128.f) + EPSF);
        *(unsigned*)(CN + (size_t)t * 128 + 2 * lane) = pk2(a * rs * kvn[2 * lane], cc * rs * kvn[2 * lane + 1]);
        if (lane < 8) DT[(size_t)t * 8 + lane] = softplusf(UF[(size_t)t * 32 + lane] + dtb[lane]);
    }
}
__device__ __forceinline__ void ph_fcum(const Ctx& c0, const float* UF, const float* fb, float* FCUM) { const Ctx c = refresh(c0);
    const int lane = c.lane;
    for (int bh = c.gw; bh < 64; bh += c.ngw) {
        const int b = bh >> 3, h = bh & 7; float carry = 0.f; const float bias = fb[h];
        for (int base = 0; base < LKP; base += 64) {
            const int p = base + lane; float v = p < L ? logsigmoidf(UF[(size_t)(b * L + p) * 32 + 8 + h] + bias) : 0.f;
#pragma unroll
            for (int o = 1; o < 64; o <<= 1) { const float n = __shfl_up(v, o); if (lane >= o) v += n; }
            v += carry; FCUM[(size_t)bh * LKP + p] = v; carry = __shfl(v, 63);
        }
    }
}
__device__ __forceinline__ void ph_ssd_rec(const Ctx& c0, const bf16* XC, const float* DT, const float* a_log, const float* dsk, float* YA) { const Ctx c = refresh(c0);
    for (int it = c.gw; it < 256; it += c.ngw) {
        const int bh = it >> 2, b = bh >> 3, hd = bh & 7, g = hd >> 2, p = (it & 3) * 16 + (c.lane >> 2), ns = c.lane & 3;
        const float a_neg = -__expf(a_log[hd]), Dk = dsk[hd];
        float h[32];
#pragma unroll
        for (int i = 0; i < 32; ++i) h[i] = 0.f;
        const bf16* row = XC + (size_t)(b * L) * 1024; const float* dtp = DT + (size_t)(b * L) * 8 + hd; float* ya = YA + (size_t)(b * L) * 512 + 64 * hd + p;
        uint4 Bn[4], Cn[4]; float xn, dtn;
#pragma unroll
        for (int q = 0; q < 4; ++q) { Bn[q] = *(const uint4*)(row + 512 + 128 * g + 32 * ns + 8 * q); Cn[q] = *(const uint4*)(row + 768 + 128 * g + 32 * ns + 8 * q); }
        xn = bf2f(row[64 * hd + p]); dtn = dtp[0];
        for (int s = 0; s < L; ++s) {
            uint4 Bc[4], Cc[4];
#pragma unroll
            for (int q = 0; q < 4; ++q) { Bc[q] = Bn[q]; Cc[q] = Cn[q]; }
            const float xv = xn, dt = dtn;
            if (s + 1 < L) { const bf16* r2 = row + (size_t)(s + 1) * 1024;
#pragma unroll
                for (int q = 0; q < 4; ++q) { Bn[q] = *(const uint4*)(r2 + 512 + 128 * g + 32 * ns + 8 * q); Cn[q] = *(const uint4*)(r2 + 768 + 128 * g + 32 * ns + 8 * q); }
                xn = bf2f(r2[64 * hd + p]); dtn = dtp[(size_t)(s + 1) * 8]; }
            const float da = __expf(dt * a_neg), xd = xv * dt; float y = 0.f;
#pragma unroll
            for (int q = 0; q < 4; ++q) { const unsigned bw[4] = {Bc[q].x, Bc[q].y, Bc[q].z, Bc[q].w}, cw[4] = {Cc[q].x, Cc[q].y, Cc[q].z, Cc[q].w};
#pragma unroll
                for (int j = 0; j < 8; ++j) { const float bv = bf2f((bf16)(bw[j >> 1] >> (16 * (j & 1)))), cv = bf2f((bf16)(cw[j >> 1] >> (16 * (j & 1))));
                    h[8 * q + j] = da * h[8 * q + j] + xd * bv; y += cv * h[8 * q + j]; } }
            y += __shfl_xor(y, 1); y += __shfl_xor(y, 2);
            if (ns == 0) ya[(size_t)s * 512] = y + Dk * xv;
        }
    }
}
__device__ __forceinline__ void ph_ssd_gate(const Ctx& c0, const float* YA, const bf16* U, bf16* Y) { const Ctx c = refresh(c0);
    const int lane = c.lane;
    for (int w = c.gw; w < T * 2; w += c.ngw) {
        const int t = w >> 1, g = w & 1;
        const float4 ya = *(const float4*)(YA + (size_t)t * 512 + 256 * g + 4 * lane);
        const uint2 zz = *(const uint2*)(U + (size_t)t * NU + C_Z + 256 * g + 4 * lane);
        const float g0 = ya.x * siluf(bf2f((bf16)(zz.x & 0xffff))), g1 = ya.y * siluf(bf2f((bf16)(zz.x >> 16))), g2 = ya.z * siluf(bf2f((bf16)(zz.y & 0xffff))), g3 = ya.w * siluf(bf2f((bf16)(zz.y >> 16)));
        const float rs = rsqrtf(wave_sum(g0 * g0 + g1 * g1 + g2 * g2 + g3 * g3) * (1.f / 256.f) + EPSF);
        *(uint2*)(Y + (size_t)t * KOUT + 256 * g + 4 * lane) = make_uint2(pk2(g0 * rs, g1 * rs), pk2(g2 * rs, g3 * rs));
    }
}
__device__ __forceinline__ void ph_fox_naive(const Ctx& c0, const bf16* U, const float* FCUM, bf16* Y) { const Ctx c = refresh(c0);
    for (int blk = c.gw; blk < 64 * 65; blk += c.ngw) {
        const int qb = 64 - (blk / 64), bh = blk % 64, h = bh & 7, b = bh >> 3;
        const int q = qb * 64 + c.lane; const bool valid = q < L; const int qq = valid ? q : L - 1;
        const size_t rowq = (size_t)(b * L + qq);
        float qv[64], o[64];
#pragma unroll
        for (int d = 0; d < 64; d += 2) { const unsigned v = *(const unsigned*)(U + rowq * NU + C_FQ + 64 * h + d); qv[d] = bf2f((bf16)(v & 0xffff)) * 0.125f; qv[d + 1] = bf2f((bf16)(v >> 16)) * 0.125f; o[d] = 0.f; o[d + 1] = 0.f; }
        float m = -1e30f, l = 0.f;
        const int kmax = min(qb * 64 + 63, L - 1);
        const float* fc = FCUM + (size_t)bh * LKP;
        for (int k = 0; k <= kmax; ++k) {
            const bf16* kr = U + (size_t)(b * L + k) * NU + C_FK + 64 * h; const bf16* vr = kr + (C_FV - C_FK);
            float s = 0.f;
#pragma unroll
            for (int d = 0; d < 64; d += 2) { const unsigned v = *(const unsigned*)(kr + d); s += qv[d] * bf2f((bf16)(v & 0xffff)) + qv[d + 1] * bf2f((bf16)(v >> 16)); }
            s -= fc[k];
            const bool ok = k <= qq;
            const float mn = ok ? fmaxf(m, s) : m, alpha = __expf(m - mn), pp = ok ? __expf(s - mn) : 0.f;
            l = l * alpha + pp; m = mn;
#pragma unroll
            for (int d = 0; d < 64; d += 2) { const unsigned v = *(const unsigned*)(vr + d); o[d] = o[d] * alpha + pp * bf2f((bf16)(v & 0xffff)); o[d + 1] = o[d + 1] * alpha + pp * bf2f((bf16)(v >> 16)); }
        }
        if (valid) { const float inv = 1.f / l;
#pragma unroll
            for (int d = 0; d < 64; d += 2) *(unsigned*)(Y + rowq * KOUT + 1024 + 64 * h + d) = pk2(o[d] * inv, o[d + 1] * inv); }
    }
}
__device__ __forceinline__ unsigned fkey(float f) { const unsigned u = __float_as_uint(f); return (u & 0x80000000u) ? ~u : (u | 0x80000000u); }
__device__ __forceinline__ void ph_dsa_naive(const Ctx& c0, const bf16* U, const float* UF, const bf16* CN, u64* MASK, bf16* Y) { const Ctx c = refresh(c0);
    LAS unsigned* sk = (LAS unsigned*)c.lds;
    LAS float* qi_s = (LAS float*)(c.lds + 16896);
    LAS float* ql_s = (LAS float*)(c.lds + 17920);
    LAS float* p_s = (LAS float*)(c.lds + 22016);
    LAS int* sel = (LAS int*)(c.lds + 30208);
    LAS int* cnt = (LAS int*)(c.lds + 31232);
    LAS int* wcnt = (LAS int*)(c.lds + 31488);
    LAS int* wpre = (LAS int*)(c.lds + 31776);
    const int tid = c.tid, lane = c.lane, wv = c.wave;
    for (int t = c.bid; t < T; t += c.nb) {
        const int b = t / L, p = t - b * L;
        const int ch = p < NMETA ? 0 : 1 + (p - NMETA) / 64, nadm = ch == 0 ? NMETA : NMETA + 64 * ch;
        const bf16* urow = U + (size_t)t * NU;
        if (tid < 256) qi_s[tid] = bf2f(urow[C_QI + tid]);
        ql_s[tid] = bf2f(urow[C_QLAT + tid]); ql_s[tid + 512] = bf2f(urow[C_QLAT + tid + 512]);
        if (tid < 40) cnt[tid] = 0;
        const float wi0 = UF[(size_t)t * 32 + 16], wi1 = UF[(size_t)t * 32 + 17], wi2 = UF[(size_t)t * 32 + 18], wi3 = UF[(size_t)t * 32 + 19];
        __syncthreads();
#pragma unroll 1
        for (int k = tid; k < LKP; k += NTHR) {
            unsigned key = 0u;
            asm volatile("" ::: "memory");
            if (k < nadm) {
                const bf16* kr = U + (size_t)(b * L + k) * NU + C_KI; float d0 = 0.f, d1 = 0.f, d2 = 0.f, d3 = 0.f;
#pragma unroll
                for (int d = 0; d < 64; d += 2) { const unsigned v = *(const unsigned*)(kr + d); const float k0 = bf2f((bf16)(v & 0xffff)), k1 = bf2f((bf16)(v >> 16));
                    d0 += qi_s[d] * k0 + qi_s[d + 1] * k1; d1 += qi_s[64 + d] * k0 + qi_s[65 + d] * k1; d2 += qi_s[128 + d] * k0 + qi_s[129 + d] * k1; d3 += qi_s[192 + d] * k0 + qi_s[193 + d] * k1; }
                float s = wi0 * fmaxf(d0, 0.f) + wi1 * fmaxf(d1, 0.f) + wi2 * fmaxf(d2, 0.f) + wi3 * fmaxf(d3, 0.f);
                if (s == 0.f) s = 0.f;
                key = fkey(s);
            }
            sk[k] = key;
        }
        __syncthreads();
        unsigned tau = 0u; int need = 0;
        if (nadm > TOPK) {
            for (int bit = 31; bit >= 0; --bit) {
                const unsigned cand = tau | (1u << bit); int n = 0;
                for (int k = tid; k < nadm; k += NTHR) n += sk[k] >= cand ? 1 : 0;
#pragma unroll
                for (int o = 1; o < 64; o <<= 1) n += __shfl_xor(n, o);
                if (lane == 0) atomicAdd((int*)&cnt[31 - bit], n);
                __syncthreads();
                if (cnt[31 - bit] >= TOPK) tau = cand;
            }
            int n = 0;
            for (int k = tid; k < nadm; k += NTHR) n += sk[k] > tau ? 1 : 0;
#pragma unroll
            for (int o = 1; o < 64; o <<= 1) n += __shfl_xor(n, o);
            if (lane == 0) atomicAdd((int*)&cnt[32], n);
            __syncthreads();
            need = TOPK - cnt[32];
        }
#pragma unroll
        for (int j = 0; j < 9; ++j) { const int k = tid + NTHR * j, w = 8 * j + wv;
            if (w < NMW) { const bool eq = (nadm > TOPK) && k < nadm && sk[k] == tau; const u64 be = __ballot(eq); if (lane == 0) wcnt[w] = __popcll(be); } }
        __syncthreads();
        if (tid == 0) { int s = 0; for (int w = 0; w < NMW; ++w) { wpre[w] = s; s += wcnt[w]; } }
        __syncthreads();
        u64 selw[9];
#pragma unroll
        for (int j = 0; j < 9; ++j) { const int k = tid + NTHR * j, w = 8 * j + wv; selw[j] = 0;
            if (w < NMW) { bool s;
                if (nadm <= TOPK) s = k < nadm;
                else { const bool in = k < nadm, gt = in && sk[k] > tau, eq = in && sk[k] == tau; const u64 be = __ballot(eq);
                    const int rank = wpre[w] + __popcll(be & ((1ull << lane) - 1ull)); s = gt || (eq && rank < need); }
                const u64 bs = __ballot(s); selw[j] = bs;
                if (lane == 0) { MASK[(size_t)t * NMW + w] = bs; wcnt[w] = __popcll(bs); } } }
        __syncthreads();
        if (tid == 0) { int s = 0; for (int w = 0; w < NMW; ++w) { wpre[w] = s; s += wcnt[w]; } wpre[NMW] = s; }
        __syncthreads();
        const int nsel = wpre[NMW];
#pragma unroll
        for (int j = 0; j < 9; ++j) { const int k = tid + NTHR * j, w = 8 * j + wv;
            if (w < NMW && ((selw[j] >> lane) & 1ull)) { const int pos = wpre[w] + __popcll(selw[j] & ((1ull << lane) - 1ull)); if (pos < 256) sel[pos] = k; } }
        __syncthreads();
        if (tid < nsel) { const bf16* cr = CN + (size_t)(b * L + sel[tid]) * 128; float sc8[8];
#pragma unroll
            for (int h = 0; h < 8; ++h) sc8[h] = 0.f;
            for (int r = 0; r < 128; r += 2) { const unsigned v = *(const unsigned*)(cr + r); const float c0 = bf2f((bf16)(v & 0xffff)), c1 = bf2f((bf16)(v >> 16));
#pragma unroll
                for (int h = 0; h < 8; ++h) sc8[h] += ql_s[128 * h + r] * c0 + ql_s[128 * h + r + 1] * c1; }
#pragma unroll
            for (int h = 0; h < 8; ++h) p_s[h * 256 + tid] = sc8[h]; }
        __syncthreads();
        {   const int h = wv; float mx = -1e30f;
            for (int i = lane; i < nsel; i += 64) mx = fmaxf(mx, p_s[h * 256 + i]);
#pragma unroll
            for (int o = 1; o < 64; o <<= 1) mx = fmaxf(mx, __shfl_xor(mx, o));
            float sm = 0.f;
            for (int i = lane; i < nsel; i += 64) { const float e = __expf(p_s[h * 256 + i] - mx); p_s[h * 256 + i] = e; sm += e; }
            sm = wave_sum(sm); const float inv = 1.f / sm;
            for (int i = lane; i < nsel; i += 64) p_s[h * 256 + i] *= inv; }
        __syncthreads();
        const bf16* cbase = CN + (size_t)(b * L) * 128;
#pragma unroll
        for (int mm = 0; mm < 2; ++mm) { const int oi = tid + NTHR * mm, h = oi >> 7, r = oi & 127; float acc = 0.f;
            for (int i = 0; i < nsel; ++i) acc += p_s[h * 256 + i] * bf2f(cbase[(size_t)sel[i] * 128 + r]);
            Y[(size_t)t * KOUT + 1536 + oi] = f2bf(acc); }
        __syncthreads();
    }
}
__device__ __forceinline__ void ph_resid(const Ctx& c0, const bf16* MIX, const float* g, float* dout, float* metax, bf16* XB, float* RSTD) { const Ctx c = refresh(c0);
    const int lane = c.lane;
    for (int t = c.gw; t < T; t += c.ngw) {
        float mv[32]; float ss = 0.f;
#pragma unroll
        for (int j = 0; j < 4; ++j) { const uint4 v = *(const uint4*)(MIX + (size_t)t * DM + 8 * lane + 512 * j); const unsigned w[4] = {v.x, v.y, v.z, v.w};
#pragma unroll
            for (int i = 0; i < 8; ++i) { const float f = bf2f((bf16)(w[i >> 1] >> (16 * (i & 1)))); mv[8 * j + i] = f; ss += f * f; } }
        const float rs = rsqrtf(wave_sum(ss) * (1.f / DM) + EPSF);
        float* xr = xf_row(dout, metax, t); float s2 = 0.f;
#pragma unroll
        for (int j = 0; j < 4; ++j) { const int cc = 8 * lane + 512 * j;
            float4 a = *(const float4*)(xr + cc), b4 = *(const float4*)(xr + cc + 4); const float4 ga = *(const float4*)(g + cc), gb = *(const float4*)(g + cc + 4);
            a.x += mv[8 * j] * rs * ga.x; a.y += mv[8 * j + 1] * rs * ga.y; a.z += mv[8 * j + 2] * rs * ga.z; a.w += mv[8 * j + 3] * rs * ga.w;
            b4.x += mv[8 * j + 4] * rs * gb.x; b4.y += mv[8 * j + 5] * rs * gb.y; b4.z += mv[8 * j + 6] * rs * gb.z; b4.w += mv[8 * j + 7] * rs * gb.w;
            s2 += a.x * a.x + a.y * a.y + a.z * a.z + a.w * a.w + b4.x * b4.x + b4.y * b4.y + b4.z * b4.z + b4.w * b4.w;
            *(float4*)(xr + cc) = a; *(float4*)(xr + cc + 4) = b4;
            *(uint4*)(XB + (size_t)t * DM + cc) = make_uint4(pk2(a.x, a.y), pk2(a.z, a.w), pk2(b4.x, b4.y), pk2(b4.z, b4.w)); }
        s2 = wave_sum(s2);
        if (lane == 0) RSTD[t] = rsqrtf(s2 * (1.f / DM) + EPSF);
    }
}

__device__ __forceinline__ void ph_gemm_plain(const Ctx& c0, const bf16* A, const bf16* Bt, bf16* O, int N, int K, int ldc, const float* rs, float* UF) { const Ctx c = refresh(c0);
    pg8::StaticOrder S; S.init(129 * 256, N, c.nb, c.bid);
    pg8::Gemm g{A, Bt, 129 * 256, N, K, (size_t)256 * K * 2};
    pg8::EpiBf16Plain E{O, ldc, rs, UF, C_SM};
    pg8::gemm_phase<pg8::EpiBf16Plain, pg8::StaticOrder, true, true>(c.lds, g, S, E, c.tid);
}
__device__ __forceinline__ void ph_gemm_gateup(const Ctx& c0, const bf16* XB, const bf16* Bt, bf16* H, const float* rs, const float* cw, const float* cb) { const Ctx c = refresh(c0);
    pg8::StaticOrder S; S.init(130 * 256, NGU, c.nb, c.bid);
    pg8::Gemm g{XB - (size_t)2 * DM, Bt, 130 * 256, NGU, DM, (size_t)254 * DM * 2};
    pg8::EpiGateUp E{H, rs, cw, cb, (LAS float*)(c.lds + HALO_OFF)};
    pg8::gemm_phase<pg8::EpiGateUp, pg8::StaticOrder, true, true>(c.lds, g, S, E, c.tid);
}

__global__ void __launch_bounds__(NTHR, 2) fwd_mega(Args A) {
    extern __shared__ __attribute__((aligned(16))) unsigned char lds_raw[];
    cg::grid_group grid = cg::this_grid();
    Ctx c; c.tid = threadIdx.x; c.lane = c.tid & 63; c.wave = __builtin_amdgcn_readfirstlane(c.tid >> 6); c.bid = blockIdx.x; c.nb = gridDim.x;
    c.gw = c.bid * NWAVE + c.wave; c.ngw = c.nb * NWAVE; c.lds = (LAS unsigned char*)lds_raw;
    if (c.tid == 0) { LAS unsigned long long* PT = (LAS unsigned long long*)(c.lds + PT_OFF);
#pragma unroll
        for (int i = 0; i < 25; ++i) PT[i] = (unsigned long long)A.in[i];
        PT[25] = (unsigned long long)A.out; PT[26] = (unsigned long long)A.ws; }
    __syncthreads();
#define WSP(off) (pt_get(c, 26) + (off))
#define DOUT ((float*)pt_get(c, 25))
#define P_WIN ((bf16*)WSP(WS_WIN))
#define P_WOUT ((bf16*)WSP(WS_WOUT))
#define P_WGU ((bf16*)WSP(WS_WGU))
#define P_WDN ((bf16*)WSP(WS_WDN))
#define P_METAX ((float*)WSP(WS_METAX))
#define P_RSTD ((float*)WSP(WS_RSTD))
#define P_UF ((float*)WSP(WS_UF))
#define P_DT ((float*)WSP(WS_DT))
#define P_FCUM ((float*)WSP(WS_FCUM))
#define P_CN ((bf16*)WSP(WS_CN))
#define P_MASK ((u64*)WSP(WS_MASK))
#define P_XB ((bf16*)WSP(WS_XB) + (size_t)8 * DM)
#define P_Y ((bf16*)WSP(WS_Y))
#define P_U ((bf16*)WSP(WS_R1))
#define P_XC ((bf16*)WSP(WS_XC))
#define P_H ((bf16*)WSP(WS_R1))
#define P_MIX ((bf16*)WSP(WS_R1))
#define P_MIX2 ((bf16*)WSP(WS_Y))
#define P_YA ((float*)WSP(WS_YA))
    ph_prep_x(c, INP(0), INP(1), DOUT, P_METAX, P_XB, P_RSTD);
#pragma unroll 1
    for (int ly = 0; ly < DEPTH; ++ly) {
        ph_prep_w(c, ly, P_WIN, P_WOUT, P_WGU, P_WDN);
        grid.sync();
        ph_gemm_plain(c, P_XB, P_WIN, P_U, NU, DM, NU, P_RSTD, P_UF);
        grid.sync();
        ph_mixprep(c, P_U, P_UF, INP(7) + (size_t)ly * 4 * 1024, INP(8) + (size_t)ly * 1024, INP(16) + (size_t)ly * 128, INP(9) + (size_t)ly * 8, P_XC, P_Y, P_CN, P_DT);
        ph_fcum(c, P_UF, INP(15) + (size_t)ly * 8, P_FCUM);
        grid.sync();
        ph_ssd_rec(c, P_XC, P_DT, INP(10) + (size_t)ly * 8, INP(11) + (size_t)ly * 8, P_YA);
        ph_fox_naive(c, P_U, P_FCUM, P_Y);
        ph_dsa_naive(c, P_U, P_UF, P_CN, P_MASK, P_Y);
        grid.sync();
        ph_ssd_gate(c, P_YA, P_U, P_Y);
        grid.sync();
        ph_gemm_plain(c, P_Y, P_WOUT, P_MIX, DM, KOUT, DM, nullptr, nullptr);
        grid.sync();
        ph_resid(c, P_MIX, INP(3) + (size_t)ly * DM, DOUT, P_METAX, P_XB, P_RSTD);
        grid.sync();
        ph_gemm_gateup(c, P_XB, P_WGU, P_H, P_RSTD, INP(22) + (size_t)ly * 3 * FF, INP(23) + (size_t)ly * FF);
        grid.sync();
        ph_gemm_plain(c, P_H, P_WDN, P_MIX2, DM, FF, DM, nullptr, nullptr);
        grid.sync();
        ph_resid(c, P_MIX2, INP(5) + (size_t)ly * DM, DOUT, P_METAX, P_XB, P_RSTD);
        grid.sync();
    }
}

extern "C" void kernel_launch(void* const* d_in, const int* in_sizes, int n_in, void* d_out, int out_size, void* d_ws, size_t ws_size, hipStream_t stream) {
    static int grid_blocks = 0;
    if (grid_blocks == 0) {
        if (n_in != 25 || in_sizes[0] != NB * SEQ * DM || out_size != NB * SEQ * DM || ws_size < WS_END) { fprintf(stderr, "kernel_launch: unexpected shapes (n_in %d in0 %d out %d ws %zu)\n", n_in, n_in > 0 ? in_sizes[0] : -1, out_size, ws_size); grid_blocks = -1; return; }
        int dev = 0, cus = 0, per_cu = 0;
        (void)hipGetDevice(&dev); (void)hipDeviceGetAttribute(&cus, hipDeviceAttributeMultiprocessorCount, dev);
        if (hipFuncSetAttribute((const void*)fwd_mega, hipFuncAttributeMaxDynamicSharedMemorySize, LDS_BYTES) != hipSuccess) { fprintf(stderr, "kernel_launch: hipFuncSetAttribute failed\n"); grid_blocks = -1; return; }
        if (hipOccupancyMaxActiveBlocksPerMultiprocessor(&per_cu, (const void*)fwd_mega, NTHR, LDS_BYTES) != hipSuccess || per_cu < 1) { fprintf(stderr, "kernel_launch: occupancy query says %d blocks/CU\n", per_cu); grid_blocks = -1; return; }
        grid_blocks = cus;
        fprintf(stderr, "kernel_launch: %d CUs, %d blocks/CU by the occupancy query, grid %d\n", cus, per_cu, grid_blocks);
    }
    if (grid_blocks < 0) return;
    Args a{};
    for (int i = 0; i < 25; ++i) a.in[i] = (const float*)d_in[i];
    a.out = (float*)d_out; a.ws = (unsigned char*)d_ws;
    void* args[] = {&a};
    hipError_t e = hipLaunchCooperativeKernel((const void*)fwd_mega, dim3(grid_blocks), dim3(NTHR), args, LDS_BYTES, stream);
    if (e != hipSuccess) fprintf(stderr, "kernel_launch: cooperative launch failed: %s (grid %d)\n", hipGetErrorString(e), grid_blocks);
}
```

```cpp
#include <hip/hip_runtime.h>
#include <cstdio>
#include <cstdint>

constexpr int NB = 8, SEQ = 4096, NMETA = 16, L = SEQ + NMETA  , T = NB * L  , MP = 33024  , DM = 2048;
constexpr int NU = 5120, KOUT = 2560, FF = 5632, NGU = 2 * FF, DIN = 4564;
constexpr int C_Z = 0, C_XBC = 512, C_POOL = 1536, C_FQ = 2048, C_FK = 2560, C_FV = 3072, C_QLAT = 3584, C_DC = 4608, C_QI = 4736, C_KI = 4992, C_SM = 5056;
constexpr int LKP = 4224, NMW = 66  , TOPK = 256, DEPTH = 4;
constexpr float EPSF = 1e-6f;
typedef unsigned short bf16;
typedef unsigned long long u64;

__device__ __forceinline__ float bf2f(bf16 v) { return __uint_as_float(((unsigned)v) << 16); }
__device__ __forceinline__ bf16 f2bf(float f) { unsigned u = __float_as_uint(f); return (bf16)((u + 0x7fffu + ((u >> 16) & 1u)) >> 16); }
__device__ __forceinline__ unsigned pk2(float lo, float hi) { return (unsigned)f2bf(lo) | ((unsigned)f2bf(hi) << 16); }
__device__ __forceinline__ float siluf(float x) { return x / (1.f + __expf(-x)); }
__device__ __forceinline__ float softplusf(float x) { return fmaxf(x, 0.f) + log1pf(__expf(-fabsf(x))); }
__device__ __forceinline__ float logsigmoidf(float x) { return fminf(x, 0.f) - log1pf(__expf(-fabsf(x))); }
__device__ __forceinline__ float lane_read(float v, int src) { return __int_as_float(__builtin_amdgcn_ds_bpermute(src << 2, __float_as_int(v))); }
__device__ __forceinline__ int lane_readi(int v, int src) { return __builtin_amdgcn_ds_bpermute(src << 2, v); }
__device__ __forceinline__ float wave_sum(float v, int lane) {
#pragma unroll
    for (int o = 1; o < 64; o <<= 1) v += lane_read(v, lane ^ o);
    return v;
}
__device__ __forceinline__ float* xf_row(float* dout, float* metax, int t) {
    const int b = t / L, p = t - b * L;
    return p < NMETA ? metax + (size_t)(b * NMETA + p) * DM : dout + ((size_t)b * SEQ + (p - NMETA)) * DM;
}
namespace pg8 {
#define PG8_LAS __attribute__((address_space(3)))
typedef unsigned short bf16_t;
typedef short bf16x8 __attribute__((ext_vector_type(8)));
typedef float f32x4 __attribute__((ext_vector_type(4)));
typedef unsigned u32x4 __attribute__((ext_vector_type(4)));
constexpr int BM = 256, BK = 64, HALF = 128, HTB = HALF * BK * 2  , STAGE_BYTES = 8 * HTB, NXCD = 8, WGM = 8;

__host__ __device__ __forceinline__ int lds_byte(int r, int c) { const int st = (r >> 4) * 2 + (c >> 5), rr = r & 15, cc = c & 31, ob = rr * 64 + cc * 2; return st * 1024 + (ob ^ (((ob >> 9) & 1) << 5)); }
__host__ __device__ __forceinline__ void stage_rc(int b, int& R, int& C) { const int st = b / 1024, sb = b % 1024, swz = sb ^ (((sb >> 9) & 1) << 5); R = (st >> 1) * 16 + swz / 64; C = (st & 1) * 32 + (swz % 64) / 2; }
__host__ __device__ __forceinline__ int perm32(int rho) { const int n = rho >> 4, i = rho & 15; return 8 * (i >> 2) + 4 * n + (i & 3); }

struct Unit { int pm, pn; };
struct Gemm { const bf16_t* A; const bf16_t* Bt; int M, N, K; size_t a_tstep; };

struct StaticOrder {
    int nM, nN, nwg, G, c;
    __host__ __device__ void init(int M, int N, int G_, int c_) { nM = M / BM; nN = N / BM; nwg = nM * nN; G = G_; c = c_; }
    __host__ __device__ bool next(int i, Unit& u) const {
        const long L = (long)i * G + c; if (L >= nwg) return false;
        int wgid = (int)L; { const int q = nwg / NXCD, r = nwg % NXCD, xcd = wgid % NXCD, off = wgid / NXCD; wgid = (xcd < r ? xcd * (q + 1) : r * (q + 1) + (xcd - r) * q) + off; }
        const int nig = WGM * nN, gid = wgid / nig, fm = gid * WGM, gsz = (nM - fm) < WGM ? (nM - fm) : WGM;
        u.pm = fm + ((wgid % nig) % gsz); u.pn = (wgid % nig) / gsz; return true;
    }
    __device__ __forceinline__ void a_ready(const Unit&) const {}
    __device__ __forceinline__ void done(const Unit&) const {}
};


__device__ __forceinline__ unsigned cvt_pk_bf16(float lo, float hi) { unsigned r; asm volatile("v_cvt_pk_bf16_f32 %0, %1, %2" : "=v"(r) : "v"(lo), "v"(hi)); return r; }

struct EpiBf16Plain {
    static constexpr bool PERM = true, AFTER_DRAIN = false;
    bf16_t* O; int ldc; const float* rs; float* UF; int sm_col0;
    __device__ __forceinline__ void operator()(f32x4 (&acc)[2][2][4][2], const Unit& u, int wr, int wc, int fr, int fq) const {
        const int row0 = u.pm * BM + wr * 64 + fr, col0 = u.pn * BM + wc * 32 + 8 * fq;
#pragma unroll
        for (int ai = 0; ai < 2; ++ai)
#pragma unroll
            for (int m = 0; m < 4; ++m) {
                const int row = row0 + ai * HALF + m * 16; const float s = rs ? rs[row] : 1.f; bf16_t* rowp = O + (size_t)row * ldc + col0;
#pragma unroll
                for (int bj = 0; bj < 2; ++bj) { const f32x4 v0 = acc[ai][bj][m][0] * s, v1 = acc[ai][bj][m][1] * s;
                    u32x4 w; w.x = cvt_pk_bf16(v0[0], v0[1]); w.y = cvt_pk_bf16(v0[2], v0[3]); w.z = cvt_pk_bf16(v1[0], v1[1]); w.w = cvt_pk_bf16(v1[2], v1[3]);
                    *(u32x4*)(rowp + bj * HALF) = w;
                    if (UF) { const int c = col0 + bj * HALF - sm_col0; if (c >= 0 && c < 32) { float* p = UF + (size_t)row * 32 + c; *(f32x4*)p = v0; *(f32x4*)(p + 4) = v1; } } }
            }
    }
};

struct EpiGateUp {
    static constexpr bool PERM = true, AFTER_DRAIN = false;
    bf16_t* H; const float* rs; const float* cw; const float* cb; PG8_LAS float* halo;
    __device__ __forceinline__ void operator()(f32x4 (&acc)[2][2][4][2], const Unit& u, int wr, int wc, int fr, int fq) const {
        const int lane = fq * 16 + fr, chl = wc * 32 + 8 * fq, ch0 = u.pn * 128 + chl, rbase = u.pm * 254 - 2;
#pragma unroll
        for (int ai = 0; ai < 2; ++ai)
#pragma unroll
            for (int m = 0; m < 4; ++m) { const int grow = rbase + ai * 128 + wr * 64 + m * 16 + fr; const float s = grow >= 0 ? rs[grow] : 0.f;
#pragma unroll
                for (int bj = 0; bj < 2; ++bj)
#pragma unroll
                    for (int n = 0; n < 2; ++n) acc[ai][bj][m][n] = acc[ai][bj][m][n] * s; }
        if (fr >= 14) {
#pragma unroll
            for (int ai = 0; ai < 2; ++ai)
#pragma unroll
                for (int n = 0; n < 2; ++n) *(PG8_LAS f32x4*)(halo + ((2 * ai + wr) * 2 + (fr - 14)) * 128 + chl + 4 * n) = acc[ai][0][3][n];
        }
        asm volatile("s_waitcnt lgkmcnt(0)" ::: "memory"); __builtin_amdgcn_s_barrier(); asm volatile("" ::: "memory");
        f32x4 w0[2], w1[2], w2[2], bb[2];
#pragma unroll
        for (int n = 0; n < 2; ++n) { w0[n] = *(const f32x4*)(cw + ch0 + 4 * n); w1[n] = *(const f32x4*)(cw + FF + ch0 + 4 * n); w2[n] = *(const f32x4*)(cw + 2 * FF + ch0 + 4 * n); bb[n] = *(const f32x4*)(cb + ch0 + 4 * n); }
#pragma unroll
        for (int ai = 0; ai < 2; ++ai)
#pragma unroll
            for (int m = 0; m < 4; ++m) {
                const int rl = ai * 128 + wr * 64 + m * 16 + fr, grow = rbase + rl, pos = grow >= 0 ? grow % L : 0, blk = 2 * ai + wr;
                const float t1 = pos >= 1 ? 1.f : 0.f, t2 = pos >= 2 ? 1.f : 0.f;
                unsigned pk[4];
#pragma unroll
                for (int n = 0; n < 2; ++n) {
                    const f32x4 cur = acc[ai][0][m][n]; f32x4 g1, g2;
#pragma unroll
                    for (int j = 0; j < 4; ++j) {
                        const float s1 = lane_read(cur[j], (lane + 63) & 63), s2 = lane_read(cur[j], (lane + 62) & 63);
                        float p15, p14;
                        if (m > 0) { const float pv = acc[ai][0][m > 0 ? m - 1 : 0][n][j]; p15 = lane_read(pv, fq * 16 + 15); p14 = lane_read(pv, fq * 16 + 14); }
                        else if (blk > 0) { p14 = halo[((blk - 1) * 2 + 0) * 128 + chl + 4 * n + j]; p15 = halo[((blk - 1) * 2 + 1) * 128 + chl + 4 * n + j]; }
                        else { p14 = 0.f; p15 = 0.f; }
                        g1[j] = fr >= 1 ? s1 : p15; g2[j] = fr >= 2 ? s2 : (fr == 1 ? p15 : p14);
                    }
                    const f32x4 cv = bb[n] + w2[n] * cur + (w1[n] * g1) * t1 + (w0[n] * g2) * t2;
                    const f32x4 up = acc[ai][1][m][n];
                    float hv[4];
#pragma unroll
                    for (int j = 0; j < 4; ++j) hv[j] = cv[j] / (1.f + __expf(-cv[j])) * up[j];
                    pk[2 * n] = cvt_pk_bf16(hv[0], hv[1]); pk[2 * n + 1] = cvt_pk_bf16(hv[2], hv[3]);
                }
                if (rl >= 2) { u32x4 w; w.x = pk[0]; w.y = pk[1]; w.z = pk[2]; w.w = pk[3]; *(u32x4*)(H + (size_t)grow * FF + ch0) = w; }
            }
    }
};
template <class Epi, class Sched, bool ALIGN_EPI = false, bool SP2 = false>
__device__ __forceinline__ void gemm_phase(PG8_LAS unsigned char* lds, const Gemm g, const Sched& S, const Epi& E, const int tid) {
    const int wid = __builtin_amdgcn_readfirstlane(tid >> 6), lane = tid & 63, wr = wid >> 2, wc = wid & 3, fr = lane & 15, fq = lane >> 4;
    const int K = g.K, nt = K / BK;
    unsigned voffA[2], voffB[2];
#pragma unroll
    for (int i = 0; i < 2; ++i) { int R, C; stage_rc(tid * 16 + i * 8192, R, C); const int Rb = Epi::PERM ? ((R & ~31) + perm32(R & 31)) : R;
        voffA[i] = (unsigned)(R * K + C) * 2u; voffB[i] = (unsigned)(Rb * K + C) * 2u; }
    const size_t kstep = (size_t)(BK * 2);
    const size_t hstep = (size_t)HALF * K * 2;
    const size_t tstep = 2 * hstep;
    const unsigned ldsw = (unsigned)wid * 1024u;
    const int aoff = lds_byte(wr * 64 + fr, fq * 8), boff = lds_byte(wc * 32 + fr, fq * 8);
#define PG8_SA(b, h) (((b) * 2 + (h)) * HTB)
#define PG8_SB(b, h) ((4 + (b) * 2 + (h)) * HTB)
#define PG8_STAGE(bufoff, gbase, voff) do { _Pragma("unroll") for (int _i = 0; _i < 2; ++_i) \
        __builtin_amdgcn_global_load_lds((const unsigned*)((const char*)(gbase) + (voff)[_i]), (PG8_LAS unsigned*)(lds + (bufoff) + ldsw + _i * 8192), 16, 0, 0); } while (0)
#define PG8_LDA(dst, b, h) do { _Pragma("unroll") for (int m = 0; m < 4; ++m) _Pragma("unroll") for (int k = 0; k < 2; ++k) dst[m][k] = *(const PG8_LAS bf16x8*)(lds + PG8_SA(b, h) + aoff + m * 2048 + k * 1024); } while (0)
#define PG8_LDB(dst, b, h) do { _Pragma("unroll") for (int n = 0; n < 2; ++n) _Pragma("unroll") for (int k = 0; k < 2; ++k) dst[n][k] = *(const PG8_LAS bf16x8*)(lds + PG8_SB(b, h) + boff + n * 2048 + k * 1024); } while (0)
#define PG8_MMA(ai, bj, At, Bt) do { __builtin_amdgcn_s_setprio(1); _Pragma("unroll") for (int m = 0; m < 4; ++m) _Pragma("unroll") for (int n = 0; n < 2; ++n) _Pragma("unroll") for (int k = 0; k < 2; ++k) \
        acc[ai][bj][m][n] = __builtin_amdgcn_mfma_f32_16x16x32_bf16(Bt[n][k], At[m][k], acc[ai][bj][m][n], 0, 0, 0); __builtin_amdgcn_s_setprio(0); } while (0)
#define PG8_WAIT_V(n) asm volatile("s_waitcnt vmcnt(" #n ")" ::: "memory")
#define PG8_WAIT_L(n) asm volatile("s_waitcnt lgkmcnt(" #n ")" ::: "memory")
#define PG8_BAR __builtin_amdgcn_s_barrier()
#define PG8_SCHED __builtin_amdgcn_sched_barrier(0)
    Unit cur, nxt; int ui = 0;
    if (!S.next(0, cur)) return;
    f32x4 acc[2][2][4][2];
#pragma unroll
    for (int a = 0; a < 2; ++a)
#pragma unroll
        for (int b = 0; b < 2; ++b)
#pragma unroll
            for (int m = 0; m < 4; ++m)
#pragma unroll
                for (int n = 0; n < 2; ++n) acc[a][b][m][n] = (f32x4){0.f, 0.f, 0.f, 0.f};
    bf16x8 At[4][2], B0[2][2], B1[2][2];
    const char* cA = (const char*)g.A + (size_t)cur.pm * g.a_tstep; const char* cB = (const char*)g.Bt + (size_t)cur.pn * tstep;
    S.a_ready(cur);
    if constexpr (SP2) {
        PG8_STAGE(PG8_SB(0, 0), cB, voffB); PG8_STAGE(PG8_SB(0, 1), cB + hstep, voffB); PG8_STAGE(PG8_SA(0, 0), cA, voffA); PG8_STAGE(PG8_SA(0, 1), cA + hstep, voffA);
        if (wr == 1) PG8_BAR;
        PG8_WAIT_V(2); PG8_BAR;
        PG8_STAGE(PG8_SB(1, 0), cB + kstep, voffB); PG8_STAGE(PG8_SA(1, 0), cA + kstep, voffA); PG8_STAGE(PG8_SB(1, 1), cB + hstep + kstep, voffB);
        PG8_WAIT_V(6); PG8_BAR;
    } else {
        PG8_STAGE(PG8_SB(0, 0), cB, voffB); PG8_STAGE(PG8_SA(0, 0), cA, voffA); PG8_STAGE(PG8_SB(0, 1), cB + hstep, voffB); PG8_STAGE(PG8_SA(0, 1), cA + hstep, voffA);
        if (wr == 1) PG8_BAR;
        PG8_WAIT_V(4); PG8_BAR;
        PG8_STAGE(PG8_SB(1, 0), cB + kstep, voffB); PG8_STAGE(PG8_SA(1, 0), cA + kstep, voffA); PG8_STAGE(PG8_SB(1, 1), cB + hstep + kstep, voffB);
        PG8_WAIT_V(6); PG8_BAR;
    }
    for (;;) {
        const bool has_next = S.next(ui + 1, nxt);
        const char* nA = has_next ? (const char*)g.A + (size_t)nxt.pm * g.a_tstep : cA; const char* nB = has_next ? (const char*)g.Bt + (size_t)nxt.pn * tstep : cB;
        for (int t = 0; t < nt; t += 2) {
            const bool last = (t == nt - 2);
            const char* a1 = cA + (size_t)(t + 1) * kstep;
            const char* a2 = last ? nA : cA + (size_t)(t + 2) * kstep; const char* b2 = last ? nB : cB + (size_t)(t + 2) * kstep;
            const char* a3 = a2 + kstep; const char* b3 = b2 + kstep;
            if (last && has_next) S.a_ready(nxt);
            if constexpr (SP2) {
            PG8_LDB(B0, 0, 0); PG8_LDB(B1, 0, 1); PG8_SCHED; PG8_LDA(At, 0, 0); PG8_STAGE(PG8_SA(1, 1), a1 + hstep, voffA);
            PG8_WAIT_V(8); PG8_WAIT_L(0); PG8_BAR; PG8_MMA(0, 0, At, B0); PG8_MMA(0, 1, At, B1); PG8_BAR; PG8_SCHED;
            PG8_LDA(At, 0, 1); PG8_STAGE(PG8_SB(0, 0), b2, voffB); PG8_STAGE(PG8_SB(0, 1), b2 + hstep, voffB); PG8_STAGE(PG8_SA(0, 0), a2, voffA);
            PG8_WAIT_V(8); PG8_WAIT_L(0); PG8_BAR; PG8_MMA(1, 0, At, B0); PG8_MMA(1, 1, At, B1); PG8_BAR; PG8_SCHED;
            PG8_LDB(B0, 1, 0); PG8_LDB(B1, 1, 1); PG8_SCHED; PG8_LDA(At, 1, 0); PG8_STAGE(PG8_SA(0, 1), a2 + hstep, voffA);
            PG8_WAIT_V(8); PG8_WAIT_L(0); PG8_BAR; PG8_MMA(0, 0, At, B0); PG8_MMA(0, 1, At, B1); PG8_BAR; PG8_SCHED;
            PG8_LDA(At, 1, 1); PG8_STAGE(PG8_SB(1, 0), b3, voffB); PG8_STAGE(PG8_SB(1, 1), b3 + hstep, voffB); PG8_STAGE(PG8_SA(1, 0), a3, voffA);
            PG8_WAIT_V(8); PG8_WAIT_L(0); PG8_BAR; PG8_MMA(1, 0, At, B0); PG8_MMA(1, 1, At, B1); PG8_BAR; PG8_SCHED;
            } else {
            PG8_LDB(B0, 0, 0); PG8_SCHED; PG8_LDA(At, 0, 0); PG8_STAGE(PG8_SA(1, 1), a1 + hstep, voffA);
            PG8_WAIT_L(8); PG8_BAR; PG8_WAIT_L(0); PG8_MMA(0, 0, At, B0); PG8_BAR; PG8_SCHED;
            PG8_LDB(B1, 0, 1); PG8_STAGE(PG8_SB(0, 0), b2, voffB);
            PG8_BAR; PG8_WAIT_L(0); PG8_MMA(0, 1, At, B1); PG8_BAR;
            PG8_LDA(At, 0, 1); PG8_STAGE(PG8_SA(0, 0), a2, voffA);
            PG8_BAR; PG8_WAIT_L(0); PG8_MMA(1, 0, At, B0); PG8_BAR; PG8_SCHED;
            PG8_STAGE(PG8_SB(0, 1), b2 + hstep, voffB);
            PG8_WAIT_V(6); PG8_BAR; PG8_MMA(1, 1, At, B1); PG8_BAR;
            PG8_LDB(B0, 1, 0); PG8_SCHED; PG8_LDA(At, 1, 0); PG8_STAGE(PG8_SA(0, 1), a2 + hstep, voffA);
            PG8_WAIT_L(8); PG8_BAR; PG8_WAIT_L(0); PG8_MMA(0, 0, At, B0); PG8_BAR; PG8_SCHED;
            PG8_LDB(B1, 1, 1); PG8_STAGE(PG8_SB(1, 0), b3, voffB);
            PG8_BAR; PG8_WAIT_L(0); PG8_MMA(0, 1, At, B1); PG8_BAR;
            PG8_LDA(At, 1, 1); PG8_STAGE(PG8_SA(1, 0), a3, voffA);
            PG8_BAR; PG8_WAIT_L(0); PG8_MMA(1, 0, At, B0); PG8_BAR; PG8_SCHED;
            PG8_STAGE(PG8_SB(1, 1), b3 + hstep, voffB);
            PG8_WAIT_V(6); PG8_BAR; PG8_MMA(1, 1, At, B1); PG8_BAR;
            }
        }
        if constexpr (ALIGN_EPI) { if (wr == 0) PG8_BAR; }
        if constexpr (!Epi::AFTER_DRAIN) { E(acc, cur, wr, wc, fr, fq); S.done(cur); }
        if (!has_next) break;
#pragma unroll
        for (int a = 0; a < 2; ++a)
#pragma unroll
            for (int b = 0; b < 2; ++b)
#pragma unroll
                for (int m = 0; m < 4; ++m)
#pragma unroll
                    for (int n = 0; n < 2; ++n) acc[a][b][m][n] = (f32x4){0.f, 0.f, 0.f, 0.f};
        cur = nxt; cA = nA; cB = nB; ++ui;
        if constexpr (ALIGN_EPI) { if (wr == 1) PG8_BAR; }
    }
    PG8_WAIT_V(0);
    if constexpr (!ALIGN_EPI) { if (wr == 0) PG8_BAR; }
    PG8_BAR;
    if constexpr (Epi::AFTER_DRAIN) { E.fused(acc, cur, wr, wc, fr, fq, lds, wid, lane); S.done(cur); }
#undef PG8_SA
#undef PG8_SB
#undef PG8_STAGE
#undef PG8_LDA
#undef PG8_LDB
#undef PG8_MMA
#undef PG8_WAIT_V
#undef PG8_WAIT_L
#undef PG8_BAR
#undef PG8_SCHED
}
}

#include <hip/hip_cooperative_groups.h>
namespace cg = cooperative_groups;
#define LAS __attribute__((address_space(3)))
constexpr int LDS_BYTES = 163840, HALO_OFF = 133120, PT_OFF = 163328, NTHR = 512, NWAVE = 8;
constexpr size_t MiB = (size_t)1 << 20;
constexpr size_t WS_CTL = 0, WS_WIN = 1 * MiB, WS_WOUT = 21 * MiB, WS_WGU = 31 * MiB, WS_WDN = 75 * MiB, WS_METAX = 97 * MiB, WS_RSTD = 98 * MiB, WS_UF = 99 * MiB,
                 WS_DT = 104 * MiB, WS_FCUM = 106 * MiB, WS_CN = 108 * MiB, WS_MASK = 117 * MiB, WS_XB = 134 * MiB, WS_Y = 264 * MiB, WS_R1 = 426 * MiB, WS_XC = WS_R1 + 323 * MiB,
                 WS_YA = 814 * MiB, WS_END = 879 * MiB;
static_assert(WS_WIN + (size_t)NU * DM * 2 <= WS_WOUT && WS_WOUT + (size_t)DM * KOUT * 2 <= WS_WGU && WS_WGU + (size_t)NGU * DM * 2 <= WS_WDN && WS_WDN + (size_t)DM * FF * 2 <= WS_METAX, "ws weights");
static_assert(WS_UF + (size_t)MP * 32 * 4 <= WS_DT && WS_DT + (size_t)T * 8 * 4 <= WS_FCUM && WS_FCUM + (size_t)64 * LKP * 4 <= WS_CN && WS_CN + (size_t)MP * 128 * 2 <= WS_MASK && WS_MASK + (size_t)T * NMW * 8 <= WS_XB, "ws small");
static_assert(WS_XB + (size_t)(MP + 8) * DM * 2 <= WS_Y && WS_Y + (size_t)MP * KOUT * 2 <= WS_R1 && WS_R1 + (size_t)MP * NU * 2 <= WS_XC && WS_XC + (size_t)MP * 1024 * 2 <= WS_YA && WS_R1 + (size_t)MP * FF * 2 <= WS_YA && WS_YA + (size_t)T * 512 * 4 <= WS_END, "ws big");

struct Args { const float* in[25]; float* out; unsigned char* ws; };

struct Ctx {
    int tid, lane, wave, gw, ngw, bid, nb;
    LAS unsigned char* lds;
};
__device__ __forceinline__ Ctx refresh(const Ctx& c0) {
    Ctx c = c0; unsigned z = 0u; int w_ = c0.wave, b_ = (int)blockIdx.x, n_ = (int)gridDim.x; asm volatile("" : "+v"(z), "+s"(w_), "+s"(b_), "+s"(n_));
    const int lane = (int)__builtin_amdgcn_mbcnt_hi(~0u, __builtin_amdgcn_mbcnt_lo(~0u, z));
    c.bid = b_; c.nb = n_; c.ngw = n_ * NWAVE; c.wave = w_; c.lane = lane; c.tid = w_ * 64 + lane; c.gw = b_ * NWAVE + w_;
    { unsigned l_ = (unsigned)(size_t)c0.lds; asm volatile("" : "+s"(l_)); c.lds = (LAS unsigned char*)(size_t)l_; }
    return c;
}
__device__ __forceinline__ unsigned char* pt_get(const Ctx& c, int i) {
    unsigned l_ = (unsigned)(size_t)c.lds; asm volatile("" : "+s"(l_));
    const LAS unsigned* p = (const LAS unsigned*)((LAS unsigned char*)(size_t)l_ + PT_OFF) + 2 * i;
    const unsigned lo = __builtin_amdgcn_readfirstlane(p[0]), hi = __builtin_amdgcn_readfirstlane(p[1]);
    return (unsigned char*)(((unsigned long long)hi << 32) | lo);
}
#define INP(i) ((const float*)pt_get(c, (i)))

#define GAS __attribute__((address_space(1)))
typedef unsigned v4u __attribute__((ext_vector_type(4)));
typedef GAS unsigned gu32;
typedef GAS unsigned long long gu64;
#define RLX_AGENT __ATOMIC_RELAXED, __HIP_MEMORY_SCOPE_AGENT
#define LDS_WAIT() asm volatile("s_waitcnt lgkmcnt(0)" ::: "memory")
#define VM_WAIT() asm volatile("s_waitcnt vmcnt(0)" ::: "memory")
__device__ __forceinline__ unsigned long long rt() { return __builtin_amdgcn_s_memrealtime(); }

#define XB_TMO      128
#define XB_XCNT(j)  (256  + 64 * (j))
#define XB_XSUB(j)  (1280 + 64 * (j))
#define XB_XGEN(j)  (2304 + 64 * (j))
#define XB_TOP      3328
#define XB_TOPGEN   3392
#define XCD_BAR_WORDS 3456
#define XB_SPIN_CAP (1u << 18)

__device__ __forceinline__ unsigned xb_ld(unsigned* p)              { return __hip_atomic_load(p, __ATOMIC_RELAXED, __HIP_MEMORY_SCOPE_AGENT); }
__device__ __forceinline__ unsigned xb_add(unsigned* p, unsigned v) { return __hip_atomic_fetch_add(p, v, __ATOMIC_RELAXED, __HIP_MEMORY_SCOPE_AGENT); }
__device__ __forceinline__ unsigned xb_xcc_id() { return (unsigned)__builtin_amdgcn_s_getreg((3 << 11) | 20) & 0xFu; }
#define XB_SPIN(cond, bar) do { unsigned _sp = 0; while (cond) { __builtin_amdgcn_s_sleep(1); \
    if ((++_sp & 255u) == 0u) { if (xb_ld(&(bar)[XB_TMO])) break; if (_sp > XB_SPIN_CAP) { atomicAdd(&(bar)[XB_TMO], 1u); break; } } } } while (0)

struct XcdBarrier {
    unsigned* bar; unsigned x;
    volatile LAS unsigned* st;
};

__device__ __forceinline__ XcdBarrier xcd_barrier_post(unsigned* bar, volatile LAS unsigned* st, int tid) {
    XcdBarrier b; b.bar = bar; b.x = xb_xcc_id(); b.st = st;
    if (tid == 0) (void)xb_add(&bar[XB_XCNT(b.x)], 1u);
    return b;
}
__device__ __forceinline__ void xcd_barrier_complete(unsigned* bar, unsigned x, unsigned& nloc, unsigned& nx) {
    const unsigned G = gridDim.x * gridDim.y * gridDim.z;
    unsigned sum, cnt, mine, sp = 0u;
    for (;;) {
        sum = 0u; cnt = 0u; mine = 0u;
#pragma unroll
        for (unsigned j = 0; j < 16; ++j) { const unsigned c = xb_ld(&bar[XB_XCNT(j)]); sum += c; cnt += (c > 0u) ? 1u : 0u; mine = (j == x) ? c : mine; }
        if (sum == G) break;
        __builtin_amdgcn_s_sleep(1);
        if ((++sp & 255u) == 0u) { if (xb_ld(&bar[XB_TMO])) break; if (sp > XB_SPIN_CAP) { atomicAdd(&bar[XB_TMO], 1u); break; } }
    }
    nloc = mine > 0u ? mine : 1u; nx = cnt > 0u ? cnt : 1u;
}

__device__ __forceinline__ void xcd_barrier(const XcdBarrier& b, int tid) {
    asm volatile("s_waitcnt vmcnt(0)" ::: "memory");
    __syncthreads();
    if (tid == 0) {
        unsigned* bar = b.bar;
        __builtin_amdgcn_s_waitcnt(0);
        unsigned nloc = b.st[0], nx = b.st[1];
        if (nloc == 0u) { xcd_barrier_complete(bar, b.x, nloc, nx); b.st[0] = nloc; b.st[1] = nx; }
        const unsigned old = xb_add(&bar[XB_XSUB(b.x)], 1u);
        const unsigned gen = old / nloc;
        if (old + 1u == (gen + 1u) * nloc) {
            __builtin_amdgcn_fence(__ATOMIC_RELEASE, "agent");
            asm volatile("s_waitcnt vmcnt(0)" ::: "memory");
            const unsigned og = xb_add(&bar[XB_TOP], 1u);
            const unsigned tg = og / nx;
            if (og + 1u == (tg + 1u) * nx) xb_add(&bar[XB_TOPGEN], 1u);
            else XB_SPIN(xb_ld(&bar[XB_TOPGEN]) == tg, bar);
            __builtin_amdgcn_fence(__ATOMIC_ACQUIRE, "agent");
            xb_add(&bar[XB_XGEN(b.x)], 1u);
            asm volatile("s_waitcnt vmcnt(0)" ::: "memory");
        } else {
            XB_SPIN(xb_ld(&bar[XB_XGEN(b.x)]) == gen, bar);
            __builtin_amdgcn_fence(__ATOMIC_ACQUIRE, "agent");
            asm volatile("s_waitcnt vmcnt(0)" ::: "memory");
        }
    }
    __syncthreads();
}

constexpr int MISC_OFF = 163072, CW_BAR = 4096;
__device__ __forceinline__ void grid_barrier(const Ctx& c0) {
    const Ctx c = refresh(c0);
    XcdBarrier b; b.bar = (unsigned*)(pt_get(c, 26) + WS_CTL) + CW_BAR; b.x = xb_xcc_id(); b.st = (volatile LAS unsigned*)(c.lds + MISC_OFF);
    xcd_barrier(b, c.tid);
}
__device__ __forceinline__ void ph_prep_x(const Ctx& c0, const float* x, const float* meta, float* dout, float* metax, bf16* XB, float* RSTD) { const Ctx c = refresh(c0);
    const int lane = c.lane;
    for (int w = c.gw; w < MP + 8; w += c.ngw) {
        const int t = w - 8; bf16* xb = XB + (ptrdiff_t)t * DM;
        if (t < 0 || t >= T) {
#pragma unroll
            for (int j = 0; j < 4; ++j) *(uint4*)(xb + 8 * lane + 512 * j) = make_uint4(0, 0, 0, 0);
            if (t >= T && lane == 0) RSTD[t] = 0.f;
            continue;
        }
        const int b = t / L, p = t - b * L;
        const float* src = p < NMETA ? meta + (size_t)p * DM : x + ((size_t)b * SEQ + (p - NMETA)) * DM;
        float* dst = xf_row(dout, metax, t); float ss = 0.f;
#pragma unroll
        for (int j = 0; j < 4; ++j) {
            const float4 a = *(const float4*)(src + 8 * lane + 512 * j), cc = *(const float4*)(src + 8 * lane + 512 * j + 4);
            ss += a.x * a.x + a.y * a.y + a.z * a.z + a.w * a.w + cc.x * cc.x + cc.y * cc.y + cc.z * cc.z + cc.w * cc.w;
            *(float4*)(dst + 8 * lane + 512 * j) = a; *(float4*)(dst + 8 * lane + 512 * j + 4) = cc;
            *(uint4*)(xb + 8 * lane + 512 * j) = make_uint4(pk2(a.x, a.y), pk2(a.z, a.w), pk2(cc.x, cc.y), pk2(cc.z, cc.w));
        }
        ss = wave_sum(ss, lane);
        if (lane == 0) RSTD[t] = rsqrtf(ss * (1.f / DM) + EPSF);
    }
}

template <class F> __device__ __forceinline__ void transpose_tiles(const Ctx& c, bf16* dst, int Kd, int N, const F& val) {
    LAS float* tile = (LAS float*)c.lds + (c.tid >> 8) * (32 * 33);
    const int t2 = c.tid & 255, tx = t2 & 31, ty = t2 >> 5, ntk = Kd / 32, ntiles = ntk * (N / 32);
    for (int it = 2 * c.bid + (c.tid >> 8); it < ntiles; it += 2 * c.nb) {
        const int k0 = (it % ntk) * 32, n0 = (it / ntk) * 32;
#pragma unroll
        for (int i = 0; i < 4; ++i) tile[(ty + 8 * i) * 33 + tx] = val(k0 + ty + 8 * i, n0 + tx);
        __syncthreads();
#pragma unroll
        for (int i = 0; i < 4; ++i) dst[(size_t)(n0 + ty + 8 * i) * Kd + k0 + tx] = f2bf(tile[tx * 33 + ty + 8 * i]);
        __syncthreads();
    }
}
__device__ __forceinline__ void ph_prep_w(const Ctx& c0, int ly, bf16* WIN, bf16* WOUT, bf16* WGU, bf16* WDN) { const Ctx c = refresh(c0);
    {   const float* w_in = INP(6) + (size_t)ly * DM * DIN; const float* g = INP(2) + (size_t)ly * DM; const float* w_uk = INP(17) + (size_t)ly * 8 * 128 * 64;
        transpose_tiles(c, WIN, DM, NU, [=](int k, int n) -> float {
            int src = -1;
            if (n < C_XBC) src = n;
            else if (n < C_POOL) src = 512 + (n - C_XBC);
            else if (n < C_FQ) src = 1544 + (n - C_POOL);
            else if (n < C_QLAT) src = 2056 + (n - C_FQ);
            else if (n < C_DC) { const int h = (n - C_QLAT) >> 7, r = (n - C_QLAT) & 127; const float* wq = w_in + (size_t)k * DIN + 3600 + 64 * h; const float* wu = w_uk + ((size_t)h * 128 + r) * 64;
                float s = 0.f;
                for (int d = 0; d < 64; ++d) s += wq[d] * wu[d];
                return s * 0.125f * g[k]; }
            else if (n < C_QI) src = 4112 + (n - C_DC);
            else if (n < C_KI) src = 4240 + (n - C_QI);
            else if (n < C_SM) src = 4496 + (n - C_KI);
            else if (n < C_SM + 8) src = 1536 + (n - C_SM);
            else if (n < C_SM + 16) src = 3592 + (n - C_SM - 8);
            else if (n < C_SM + 20) src = 4560 + (n - C_SM - 16);
            return src >= 0 ? w_in[(size_t)k * DIN + src] * g[k] : 0.f; }); }
    {   const float* w_out = INP(19) + (size_t)ly * DM * DM; const float* ssd_norm = INP(12) + (size_t)ly * 512; const float* pool_w = INP(13) + (size_t)ly * 4 * 128 * 128;
        const float* pool_scale = INP(14) + (size_t)ly * 512; const float* w_uv = INP(18) + (size_t)ly * 8 * 128 * 64;
        transpose_tiles(c, WOUT, KOUT, DM, [=](int k, int n) -> float {
            if (k < 512) return ssd_norm[k] * w_out[(size_t)k * DM + n];
            if (k < 1024) { const int gi = (k - 512) >> 7, cc = (k - 512) & 127; const float* pw = pool_w + ((size_t)gi * 128 + cc) * 128; float s = 0.f;
                for (int d = 0; d < 128; ++d) s += pw[d] * pool_scale[128 * gi + d] * w_out[(size_t)(512 + 128 * gi + d) * DM + n];
                return s; }
            if (k < 1536) return w_out[(size_t)k * DM + n];
            const int h = (k - 1536) >> 7, r = (k - 1536) & 127; const float* wv = w_uv + ((size_t)h * 128 + r) * 64; float s = 0.f;
            for (int d = 0; d < 64; ++d) s += wv[d] * w_out[(size_t)(1536 + 64 * h + d) * DM + n];
            return s; }); }
    {   const float* wg = INP(20) + (size_t)ly * DM * FF; const float* wu = INP(21) + (size_t)ly * DM * FF; const float* g = INP(4) + (size_t)ly * DM;
        transpose_tiles(c, WGU, DM, NGU, [=](int k, int n) -> float { const int pn = n >> 8, w = n & 255, ch = 128 * pn + (w & 127); return ((w >> 7) ? wu : wg)[(size_t)k * FF + ch] * g[k]; }); }
    {   const float* wd = INP(24) + (size_t)ly * FF * DM;
        transpose_tiles(c, WDN, FF, DM, [=](int k, int n) -> float { return wd[(size_t)k * DM + n]; }); }
}

__device__ __forceinline__ void ph_mixprep(const Ctx& c0, const bf16* U, const float* UF, const float* cw, const float* cb, const float* kvn, const float* dtb, bf16* XC, bf16* Y, bf16* CN, float* DT) { const Ctx c = refresh(c0);
    const int gt = c.bid * NTHR + c.tid, ngt = c.nb * NTHR;
    for (int idx = gt; idx < T * 128; idx += ngt) {
        const int t = idx >> 7, c0 = (idx & 127) * 8, pos = t % L; float acc[8];
#pragma unroll
        for (int j = 0; j < 8; ++j) acc[j] = cb[c0 + j];
#pragma unroll
        for (int k = 0; k < 4; ++k) {
            if (pos - 3 + k < 0) continue;
            const uint4 v = *(const uint4*)(U + (size_t)(t - 3 + k) * NU + C_XBC + c0); const unsigned w[4] = {v.x, v.y, v.z, v.w};
#pragma unroll
            for (int j = 0; j < 8; ++j) acc[j] += cw[k * 1024 + c0 + j] * bf2f((bf16)(w[j >> 1] >> (16 * (j & 1))));
        }
        *(uint4*)(XC + (size_t)t * 1024 + c0) = make_uint4(pk2(siluf(acc[0]), siluf(acc[1])), pk2(siluf(acc[2]), siluf(acc[3])), pk2(siluf(acc[4]), siluf(acc[5])), pk2(siluf(acc[6]), siluf(acc[7])));
    }
    for (int idx = gt; idx < T * 64; idx += ngt) {
        const int t = idx >> 6, c0 = (idx & 63) * 8, pos = t % L, gi = c0 >> 7, win = 2 << gi, n = min(pos + 1, win);
        float acc[8] = {0, 0, 0, 0, 0, 0, 0, 0}, self[8] = {0, 0, 0, 0, 0, 0, 0, 0};
        for (int i = 0; i < n; ++i) {
            const uint4 v = *(const uint4*)(U + (size_t)(t - i) * NU + C_POOL + c0); const unsigned w[4] = {v.x, v.y, v.z, v.w};
#pragma unroll
            for (int j = 0; j < 8; ++j) { const float f = bf2f((bf16)(w[j >> 1] >> (16 * (j & 1)))); acc[j] += f; if (i == 0) self[j] = f; }
        }
        const float inv = 1.f / (float)n; float o[8];
#pragma unroll
        for (int j = 0; j < 8; ++j) o[j] = acc[j] * inv - self[j];
        *(uint4*)(Y + (size_t)t * KOUT + 512 + c0) = make_uint4(pk2(o[0], o[1]), pk2(o[2], o[3]), pk2(o[4], o[5]), pk2(o[6], o[7]));
    }
    for (int t = c.gw; t < T; t += c.ngw) {
        const int lane = c.lane;
        const unsigned v = *(const unsigned*)(U + (size_t)t * NU + C_DC + 2 * lane);
        const float a = bf2f((bf16)(v & 0xffff)), cc = bf2f((bf16)(v >> 16));
        const float rs = rsqrtf(wave_sum(a * a + cc * cc, lane) * (1.f / 128.f) + EPSF);
        *(unsigned*)(CN + (size_t)t * 128 + 2 * lane) = pk2(a * rs * kvn[2 * lane], cc * rs * kvn[2 * lane + 1]);
        if (lane < 8) DT[(size_t)t * 8 + lane] = softplusf(UF[(size_t)t * 32 + lane] + dtb[lane]);
    }
}
__device__ __forceinline__ void ph_fcum(const Ctx& c0, const float* UF, const float* fb, float* FCUM) { const Ctx c = refresh(c0);
    const int lane = c.lane;
    for (int bh = c.gw; bh < 64; bh += c.ngw) {
        const int b = bh >> 3, h = bh & 7; float carry = 0.f; const float bias = fb[h];
        for (int base = 0; base < LKP; base += 64) {
            const int p = base + lane; float v = p < L ? logsigmoidf(UF[(size_t)(b * L + p) * 32 + 8 + h] + bias) : 0.f;
#pragma unroll
            for (int o = 1; o < 64; o <<= 1) { const float n = lane_read(v, (lane - o) & 63); if (lane >= o) v += n; }
            v += carry; FCUM[(size_t)bh * LKP + p] = v; carry = lane_read(v, 63);
        }
    }
}
__device__ __forceinline__ unsigned fkey(float f) { const unsigned u = __float_as_uint(f); return (u & 0x80000000u) ? ~u : (u | 0x80000000u); }
__device__ __forceinline__ int crow(int r, int hi) { return (r & 3) + 8 * (r >> 2) + 4 * hi; }
typedef short bf16x8 __attribute__((ext_vector_type(8)));
typedef float f32x16 __attribute__((ext_vector_type(16)));
typedef float f32x4v __attribute__((ext_vector_type(4)));
typedef float f32x2v __attribute__((ext_vector_type(2)));
typedef __bf16 bf16x2v __attribute__((ext_vector_type(2)));
typedef unsigned u32x4v __attribute__((ext_vector_type(4)));
typedef unsigned u32x2v __attribute__((ext_vector_type(2)));
#define MFMA32(a, b, c) __builtin_amdgcn_mfma_f32_32x32x16_bf16((a), (b), (c), 0, 0, 0)
__device__ __forceinline__ unsigned cvtpk(float lo, float hi) { f32x2v v = {lo, hi}; bf16x2v b = __builtin_convertvector(v, bf16x2v); return __builtin_bit_cast(unsigned, b); }
__device__ __forceinline__ bf16x8 pack8(const f32x16& p, int s) {
    u32x4v r; r.x = cvtpk(p[8 * s], p[8 * s + 1]); r.y = cvtpk(p[8 * s + 2], p[8 * s + 3]); r.z = cvtpk(p[8 * s + 4], p[8 * s + 5]); r.w = cvtpk(p[8 * s + 6], p[8 * s + 7]);
    return __builtin_bit_cast(bf16x8, r);
}
constexpr int AT_KSTR = 72;
__device__ __forceinline__ void ph_fox(const Ctx& c0, const bf16* U, const float* FCUM, bf16* Y) {
    const Ctx c = refresh(c0);
    LAS bf16* KS = (LAS bf16*)c.lds;
    LAS bf16* VT = KS + 64 * AT_KSTR;
    LAS float* FB = (LAS float*)(c.lds + 2 * 64 * AT_KSTR * 2);
    const int lane = c.lane, w = c.wave, r32 = lane & 31, hi = lane >> 5, tid = c.tid;
    const float C2 = 0.18033688011112042f, LOG2E = 1.4426950408889634f;
    for (int it = c.bid; it < 64 * 17; it += c.nb) {
        const int rnd = it >> 8, cu = it & 255, k4 = cu >> 6, bh = cu & 63, b = bh >> 3, h = bh & 7;
        const int j = rnd == 0 ? 16 - k4 : rnd == 1 ? 9 + k4 : rnd == 2 ? 8 - k4 : rnd == 3 ? 1 + k4 : 0;
        const int q0 = j == 0 ? 0 : 16 + 256 * (j - 1), qrow = q0 + 32 * w + r32, ntiles = 1 + 4 * j;
        const bool wave_on = (j > 0) || (w == 0), row_ok = (j > 0) || (r32 < 16);
        const bf16* Ub = U + (size_t)(b * L) * NU;
        bf16x8 qf[4];
#pragma unroll
        for (int s = 0; s < 4; ++s) qf[s] = (bf16x8){0, 0, 0, 0, 0, 0, 0, 0};
        if (wave_on && row_ok) {
#pragma unroll
            for (int s = 0; s < 4; ++s) qf[s] = *(const bf16x8*)(Ub + (size_t)qrow * NU + C_FQ + 64 * h + 16 * s + 8 * hi);
        }
        f32x16 o0, o1;
#pragma unroll
        for (int r = 0; r < 16; ++r) { o0[r] = 0.f; o1[r] = 0.f; }
        float m = -1e30f, l = 0.f;
        const float* fc = FCUM + (size_t)bh * LKP;
        u32x4v kreg, vreg; float fbreg = 0.f;
        {   const int kb = 0;
            kreg = *(const u32x4v*)(Ub + (size_t)(kb + (tid >> 3)) * NU + C_FK + 64 * h + 8 * (tid & 7));
            vreg = *(const u32x4v*)(Ub + (size_t)(kb + lane) * NU + C_FV + 64 * h + 8 * w);
            if (tid < 64) fbreg = fc[kb + tid] * LOG2E; }
        for (int i = 0; i < ntiles; ++i) {
            const int kb = i == 0 ? 0 : 16 + 64 * (i - 1);
            *(LAS u32x4v*)(KS + (tid >> 3) * AT_KSTR + 8 * (tid & 7)) = kreg;
            {   const unsigned vv[4] = {vreg.x, vreg.y, vreg.z, vreg.w};
#pragma unroll
                for (int e = 0; e < 8; ++e) VT[(8 * w + e) * AT_KSTR + lane] = (bf16)(vv[e >> 1] >> (16 * (e & 1))); }
            if (tid < 64) FB[tid] = fbreg;
            __syncthreads();
            if (i + 1 < ntiles) { const int kn = 16 + 64 * i;
                kreg = *(const u32x4v*)(Ub + (size_t)(kn + (tid >> 3)) * NU + C_FK + 64 * h + 8 * (tid & 7));
                vreg = *(const u32x4v*)(Ub + (size_t)(kn + lane) * NU + C_FV + 64 * h + 8 * w);
                if (tid < 64) fbreg = fc[kn + tid] * LOG2E; }
            if (wave_on && kb <= q0 + 32 * w + 31) {
                f32x16 p0, p1;
#pragma unroll
                for (int r = 0; r < 16; ++r) { p0[r] = 0.f; p1[r] = 0.f; }
#pragma unroll
                for (int s = 0; s < 4; ++s) {
                    const bf16x8 a0 = *(const LAS bf16x8*)(KS + r32 * AT_KSTR + 16 * s + 8 * hi), a1 = *(const LAS bf16x8*)(KS + (32 + r32) * AT_KSTR + 16 * s + 8 * hi);
                    p0 = MFMA32(a0, qf[s], p0); p1 = MFMA32(a1, qf[s], p1);
                }
#pragma unroll
                for (int i4 = 0; i4 < 4; ++i4) {
                    const f32x4v f0 = *(const LAS f32x4v*)(FB + 8 * i4 + 4 * hi), f1 = *(const LAS f32x4v*)(FB + 32 + 8 * i4 + 4 * hi);
#pragma unroll
                    for (int e = 0; e < 4; ++e) { p0[4 * i4 + e] = p0[4 * i4 + e] * C2 - f0[e]; p1[4 * i4 + e] = p1[4 * i4 + e] * C2 - f1[e]; }
                }
                if (i == 0 || kb + 63 > q0 + 32 * w) {
                    const int klim = i == 0 ? 16 : 64;
#pragma unroll
                    for (int r = 0; r < 16; ++r) { const int k0 = crow(r, hi), k1 = 32 + k0;
                        if (!(k0 < klim && kb + k0 <= qrow)) p0[r] = -1e30f;
                        if (!(k1 < klim && kb + k1 <= qrow)) p1[r] = -1e30f; }
                }
                float mx = fmaxf(p0[0], p1[0]);
#pragma unroll
                for (int r = 1; r < 16; ++r) mx = fmaxf(mx, fmaxf(p0[r], p1[r]));
                mx = fmaxf(mx, lane_read(mx, lane ^ 32));
                const float mn = fmaxf(m, mx), alpha = exp2f(m - mn); m = mn;
                float sum = 0.f;
#pragma unroll
                for (int r = 0; r < 16; ++r) { p0[r] = exp2f(p0[r] - mn); p1[r] = exp2f(p1[r] - mn); sum += p0[r] + p1[r]; }
                l = l * alpha + sum;
#pragma unroll
                for (int r = 0; r < 16; ++r) { o0[r] *= alpha; o1[r] *= alpha; }
#pragma unroll
                for (int blk = 0; blk < 2; ++blk)
#pragma unroll
                    for (int s = 0; s < 2; ++s) {
                        const bf16x8 xs = pack8(blk == 0 ? p0 : p1, s);
                        typedef short s16x4v __attribute__((ext_vector_type(4)));
                        const LAS bf16* vp = VT + r32 * AT_KSTR + 32 * blk + 16 * s + 4 * hi;
                        const s16x4v lo0 = *(const LAS s16x4v*)vp, hi0 = *(const LAS s16x4v*)(vp + 8);
                        const s16x4v lo1 = *(const LAS s16x4v*)(vp + 32 * AT_KSTR), hi1 = *(const LAS s16x4v*)(vp + 32 * AT_KSTR + 8);
                        const bf16x8 pa0 = __builtin_shufflevector(lo0, hi0, 0, 1, 2, 3, 4, 5, 6, 7), pa1 = __builtin_shufflevector(lo1, hi1, 0, 1, 2, 3, 4, 5, 6, 7);
                        o0 = MFMA32(pa0, xs, o0); o1 = MFMA32(pa1, xs, o1);
                    }
            }
            __syncthreads();
        }
        l += lane_read(l, lane ^ 32);
        if (wave_on && row_ok) {
            const float inv = 1.f / l; bf16* yr = Y + (size_t)(b * L + qrow) * KOUT + 1024 + 64 * h;
#pragma unroll
            for (int i4 = 0; i4 < 4; ++i4) {
                *(u32x2v*)(yr + 8 * i4 + 4 * hi) = (u32x2v){cvtpk(o0[4 * i4] * inv, o0[4 * i4 + 1] * inv), cvtpk(o0[4 * i4 + 2] * inv, o0[4 * i4 + 3] * inv)};
                *(u32x2v*)(yr + 32 + 8 * i4 + 4 * hi) = (u32x2v){cvtpk(o1[4 * i4] * inv, o1[4 * i4 + 1] * inv), cvtpk(o1[4 * i4 + 2] * inv, o1[4 * i4 + 3] * inv)};
            }
        }
    }
}

constexpr int DSA_SC_STR = 4128, DSA_MW_OFF = 8 * DSA_SC_STR * 4  , DSA_KSTR = 136, DSA_VT_OFF = 64 * DSA_KSTR * 2  ;
__device__ __forceinline__ void ph_dsa(const Ctx& c0, const bf16* U, const float* UF, const bf16* CN, bf16* Y) {
    const Ctx c = refresh(c0);
    LAS unsigned* SC = (LAS unsigned*)c.lds;
    LAS u64* MW = (LAS u64*)(c.lds + DSA_MW_OFF);
    LAS bf16* KS = (LAS bf16*)c.lds;
    LAS bf16* VT = (LAS bf16*)(c.lds + DSA_VT_OFF);
    const int lane = c.lane, w = c.wave, r32 = lane & 31, hi = lane >> 5, tid = c.tid;
    const float LOG2E = 1.4426950408889634f;
    for (int it = c.bid; it < 1032; it += c.nb) {
        const int rnd = it >> 8, cu = it & 255, g16 = cu >> 4, wi16 = cu & 15;
        const int ch = rnd == 0 ? 64 - g16 : rnd == 1 ? 33 + g16 : rnd == 2 ? 32 - g16 : rnd == 3 ? 1 + g16 : 0;
        const int b = rnd == 4 ? cu : (wi16 >> 1), half = rnd == 4 ? 0 : (wi16 & 1);
        const int p0q = ch == 0 ? 0 : 16 + 64 * (ch - 1) + 32 * half, nq = ch == 0 ? 16 : 32, nadm = ch == 0 ? 16 : 16 + 64 * ch, nw = ch + 1;
        const int t0 = b * L + p0q;
        const bf16* Ub = U + (size_t)(b * L) * NU;
        if (nadm <= TOPK) {
            for (int i = tid; i < 32 * 65; i += NTHR) { const int wd = i % 65; const int lo = 64 * wd; const int nb_ = nadm - lo;
                MW[i] = (wd < nw && nb_ > 0) ? (nb_ >= 64 ? ~0ull : ((1ull << nb_) - 1ull)) : 0ull; }
            __syncthreads();
        } else {
            const int nkb = 2 * nw;
#pragma unroll 1
            for (int sb = 0; sb < 4; ++sb) {
                const int tq = t0 + 8 * sb;
                {
                    bf16x8 aq[4]; float wq[4][4];
#pragma unroll
                    for (int s = 0; s < 4; ++s) aq[s] = *(const bf16x8*)(U + (size_t)(tq + (r32 >> 2)) * NU + C_QI + 64 * (r32 & 3) + 16 * s + 8 * hi);
#pragma unroll
                    for (int i4 = 0; i4 < 4; ++i4) { const f32x4v t4 = *(const f32x4v*)(UF + (size_t)(tq + 2 * i4 + hi) * 32 + 16); wq[i4][0] = t4[0]; wq[i4][1] = t4[1]; wq[i4][2] = t4[2]; wq[i4][3] = t4[3]; }
#pragma unroll 1
                    for (int kb = w; kb < nkb; kb += NWAVE) {
                        const int key = 32 * kb + r32; f32x16 acc;
#pragma unroll
                        for (int r = 0; r < 16; ++r) acc[r] = 0.f;
#pragma unroll
                        for (int s = 0; s < 4; ++s) { const bf16x8 bk = *(const bf16x8*)(Ub + (size_t)key * NU + C_KI + 16 * s + 8 * hi); acc = MFMA32(aq[s], bk, acc); }
#pragma unroll
                        for (int i4 = 0; i4 < 4; ++i4) {
                            float s = wq[i4][0] * fmaxf(acc[4 * i4], 0.f) + wq[i4][1] * fmaxf(acc[4 * i4 + 1], 0.f) + wq[i4][2] * fmaxf(acc[4 * i4 + 2], 0.f) + wq[i4][3] * fmaxf(acc[4 * i4 + 3], 0.f);
                            if (s == 0.f) s = 0.f;
                            SC[(2 * i4 + hi) * DSA_SC_STR + key] = key < nadm ? fkey(s) : 0u;
                        }
                    }
                }
                __syncthreads();
                {
                    unsigned kk[65];
#pragma unroll
                    for (int j = 0; j < 65; ++j) kk[j] = (j < nw) ? SC[w * DSA_SC_STR + 64 * j + lane] : 0u;
                    unsigned tau = 0u; bool exact = false;
#pragma unroll 1
                    for (int bit = 31; bit >= 0; --bit) {
                        const unsigned cand = tau | (1u << bit); int n = 0;
#pragma unroll
                        for (int j = 0; j < 65; ++j) if (j < nw) n += __popcll(__ballot(kk[j] >= cand));
                        if (n >= TOPK) tau = cand;
                        if (n == TOPK) { exact = true; break; }
                    }
                    int need = 0;
                    if (!exact) { int n = 0;
#pragma unroll
                        for (int j = 0; j < 65; ++j) if (j < nw) n += __popcll(__ballot(kk[j] > tau));
                        need = TOPK - n; }
                    int run = 0; u64 mine0 = 0ull, mine1 = 0ull;
#pragma unroll
                    for (int j = 0; j < 65; ++j) if (j < nw) {
                        bool sel;
                        if (exact) sel = kk[j] >= tau;
                        else { const bool eq = kk[j] == tau; const u64 be = __ballot(eq); const int rank = run + __popcll(be & ((1ull << lane) - 1ull)); sel = kk[j] > tau || (eq && rank < need); run += __popcll(be); }
                        const u64 bs = __ballot(sel);
                        if (j < 64) { if (lane == j) mine0 = bs; } else mine1 = bs;
                    }
                    MW[(8 * sb + w) * 65 + lane] = lane < nw ? mine0 : 0ull;
                    if (lane == 0) MW[(8 * sb + w) * 65 + 64] = nw > 64 ? mine1 : 0ull;
                }
                __syncthreads();
            }
        }
        bf16x8 qf[8];
#pragma unroll
        for (int s = 0; s < 8; ++s) qf[s] = (bf16x8){0, 0, 0, 0, 0, 0, 0, 0};
        if (r32 < nq) {
#pragma unroll
            for (int s = 0; s < 8; ++s) qf[s] = *(const bf16x8*)(U + (size_t)(t0 + r32) * NU + C_QLAT + 128 * w + 16 * s + 8 * hi);
        }
        f32x16 o[4];
#pragma unroll
        for (int db = 0; db < 4; ++db)
#pragma unroll
            for (int r = 0; r < 16; ++r) o[db][r] = 0.f;
        float m = -1e30f, l = 0.f;
        const bf16* Cb = CN + (size_t)(b * L) * 128;
        u32x4v kr0, kr1, vr0, vr1;
        {   const bf16* kp = Cb + (size_t)(tid >> 3) * 128 + 16 * (tid & 7); kr0 = *(const u32x4v*)kp; kr1 = *(const u32x4v*)(kp + 8);
            const bf16* vp = Cb + (size_t)lane * 128 + 16 * w; vr0 = *(const u32x4v*)vp; vr1 = *(const u32x4v*)(vp + 8); }
        for (int i = 0; i < nw; ++i) {
            {   LAS bf16* kd = KS + (tid >> 3) * DSA_KSTR + 16 * (tid & 7); *(LAS u32x4v*)kd = kr0; *(LAS u32x4v*)(kd + 8) = kr1;
                const unsigned vv[8] = {vr0.x, vr0.y, vr0.z, vr0.w, vr1.x, vr1.y, vr1.z, vr1.w};
#pragma unroll
                for (int e = 0; e < 16; ++e) VT[(16 * w + e) * AT_KSTR + lane] = (bf16)(vv[e >> 1] >> (16 * (e & 1))); }
            __syncthreads();
            if (i + 1 < nw) { const bf16* kp = Cb + (size_t)(64 * (i + 1) + (tid >> 3)) * 128 + 16 * (tid & 7); kr0 = *(const u32x4v*)kp; kr1 = *(const u32x4v*)(kp + 8);
                const bf16* vp = Cb + (size_t)(64 * (i + 1) + lane) * 128 + 16 * w; vr0 = *(const u32x4v*)vp; vr1 = *(const u32x4v*)(vp + 8); }
            const u64 m64 = MW[r32 * 65 + i];
            if (__ballot(m64 != 0ull) != 0ull) {
                f32x16 p0, p1;
#pragma unroll
                for (int r = 0; r < 16; ++r) { p0[r] = 0.f; p1[r] = 0.f; }
#pragma unroll
                for (int s = 0; s < 8; ++s) {
                    const bf16x8 a0 = *(const LAS bf16x8*)(KS + r32 * DSA_KSTR + 16 * s + 8 * hi), a1 = *(const LAS bf16x8*)(KS + (32 + r32) * DSA_KSTR + 16 * s + 8 * hi);
                    p0 = MFMA32(a0, qf[s], p0); p1 = MFMA32(a1, qf[s], p1);
                }
                const unsigned mlo = (unsigned)m64, mhi = (unsigned)(m64 >> 32);
                float mx = -1e30f;
#pragma unroll
                for (int r = 0; r < 16; ++r) { const int kbit = crow(r, hi);
                    p0[r] = ((mlo >> kbit) & 1u) ? p0[r] * LOG2E : -1e30f; p1[r] = ((mhi >> kbit) & 1u) ? p1[r] * LOG2E : -1e30f;
                    mx = fmaxf(mx, fmaxf(p0[r], p1[r])); }
                mx = fmaxf(mx, lane_read(mx, lane ^ 32));
                const float mn = fmaxf(m, mx), alpha = exp2f(m - mn); m = mn;
                float sum = 0.f;
#pragma unroll
                for (int r = 0; r < 16; ++r) { const int kbit = crow(r, hi);
                    p0[r] = ((mlo >> kbit) & 1u) ? exp2f(p0[r] - mn) : 0.f; p1[r] = ((mhi >> kbit) & 1u) ? exp2f(p1[r] - mn) : 0.f; sum += p0[r] + p1[r]; }
                l = l * alpha + sum;
#pragma unroll
                for (int db = 0; db < 4; ++db)
#pragma unroll
                    for (int r = 0; r < 16; ++r) o[db][r] *= alpha;
#pragma unroll
                for (int blk = 0; blk < 2; ++blk)
#pragma unroll
                    for (int s = 0; s < 2; ++s) {
                        const bf16x8 xs = pack8(blk == 0 ? p0 : p1, s);
                        typedef short s16x4v __attribute__((ext_vector_type(4)));
                        const LAS bf16* vp = VT + r32 * AT_KSTR + 32 * blk + 16 * s + 4 * hi;
#pragma unroll
                        for (int db = 0; db < 4; ++db) {
                            const s16x4v lo = *(const LAS s16x4v*)(vp + 32 * db * AT_KSTR), hh = *(const LAS s16x4v*)(vp + 32 * db * AT_KSTR + 8);
                            const bf16x8 pa = __builtin_shufflevector(lo, hh, 0, 1, 2, 3, 4, 5, 6, 7);
                            o[db] = MFMA32(pa, xs, o[db]);
                        }
                    }
            }
            __syncthreads();
        }
        l += lane_read(l, lane ^ 32);
        if (r32 < nq) {
            const float inv = 1.f / l; bf16* yr = Y + (size_t)(t0 + r32) * KOUT + 1536 + 128 * w;
#pragma unroll
            for (int db = 0; db < 4; ++db)
#pragma unroll
                for (int i4 = 0; i4 < 4; ++i4)
                    *(u32x2v*)(yr + 32 * db + 8 * i4 + 4 * hi) = (u32x2v){cvtpk(o[db][4 * i4] * inv, o[db][4 * i4 + 1] * inv), cvtpk(o[db][4 * i4 + 2] * inv, o[db][4 * i4 + 3] * inv)};
        }
    }
}

__device__ __forceinline__ float wave_scan_incl(float v, int lane) {
#pragma unroll
    for (int o = 1; o < 64; o <<= 1) { const float n = lane_read(v, (lane - o) & 63); if (lane >= o) v += n; }
    return v;
}
__device__ __forceinline__ void ph_ssd_states(const Ctx& c0, const bf16* XC, const float* DT, const float* a_log, bf16* ST, float* CD) {
    const Ctx c = refresh(c0);
    const int lane = c.lane, w = c.wave, r32 = lane & 31, hi = lane >> 5, g = w >> 2;
    LAS bf16* XT = (LAS bf16*)c.lds + w * (64 * 72);
    LAS bf16* BT = (LAS bf16*)(c.lds + 73728);
    const float a_neg = -__expf(a_log[w]);
    for (int it = c.bid; it < NB * 65; it += c.nb) {
        const int b = it / 65, ch = it - b * 65, pseq = 64 * ch - 48 + lane; const bool valid = pseq >= 0; const size_t t = (size_t)(b * L + (valid ? pseq : 0));
        const float dtv = valid ? DT[t * 8 + w] : 0.f, acs = wave_scan_incl(dtv * a_neg, lane), tot = lane_read(acs, 63), scale = dtv * __expf(tot - acs);
        if (lane == 0) CD[(b * 65 + ch) * 8 + w] = __expf(tot);
        const bf16* xrow = XC + t * 1024 + 64 * w;
#pragma unroll
        for (int q = 0; q < 8; ++q) { u32x4v v = (u32x4v){0u, 0u, 0u, 0u}; if (valid) v = *(const u32x4v*)(xrow + 8 * q); const unsigned vv[4] = {v.x, v.y, v.z, v.w};
#pragma unroll
            for (int e = 0; e < 8; ++e) XT[(8 * q + e) * 72 + lane] = f2bf(bf2f((bf16)(vv[e >> 1] >> (16 * (e & 1)))) * scale); }
        const bf16* brow = XC + t * 1024 + 512 + 32 * w;
#pragma unroll
        for (int q = 0; q < 4; ++q) { u32x4v v = (u32x4v){0u, 0u, 0u, 0u}; if (valid) v = *(const u32x4v*)(brow + 8 * q); const unsigned vv[4] = {v.x, v.y, v.z, v.w};
#pragma unroll
            for (int e = 0; e < 8; ++e) BT[(32 * w + 8 * q + e) * 72 + lane] = (bf16)(vv[e >> 1] >> (16 * (e & 1))); }
        __syncthreads();
        bf16* st = ST + ((size_t)(b * 65 + ch) * 8 + w) * 8192;
#pragma unroll 1
        for (int pb = 0; pb < 2; ++pb)
#pragma unroll 1
            for (int nb = 0; nb < 4; ++nb) {
                f32x16 acc;
#pragma unroll
                for (int r = 0; r < 16; ++r) acc[r] = 0.f;
#pragma unroll
                for (int s = 0; s < 4; ++s) { const bf16x8 a = *(const LAS bf16x8*)(XT + (32 * pb + r32) * 72 + 16 * s + 8 * hi), bb = *(const LAS bf16x8*)(BT + (128 * g + 32 * nb + r32) * 72 + 16 * s + 8 * hi);
                    acc = MFMA32(a, bb, acc); }
#pragma unroll
                for (int r = 0; r < 16; ++r) st[(32 * pb + crow(r, hi)) * 128 + 32 * nb + r32] = f2bf(acc[r]);
            }
        __syncthreads();
    }
}
__device__ __forceinline__ void ph_ssd_scan(const Ctx& c0, bf16* ST, const float* CD) {
    const Ctx c = refresh(c0);
    for (int idx = c.bid * NTHR + c.tid; idx < NB * 8 * 64 * 32; idx += c.nb * NTHR) {
        const int n4 = idx & 31, p = (idx >> 5) & 63, h = (idx >> 11) & 7, b = idx >> 14;
        float h0 = 0.f, h1 = 0.f, h2 = 0.f, h3 = 0.f;
        bf16* base = ST + ((size_t)(b * 65) * 8 + h) * 8192 + p * 128 + 4 * n4; const float* cd = CD + (size_t)(b * 65) * 8 + h;
        u32x2v nxt = *(const u32x2v*)base;
#pragma unroll 5
        for (int ch = 0; ch < 65; ++ch) {
            const u32x2v v = nxt; bf16* pc = base + (size_t)ch * 8 * 8192;
            if (ch + 1 < 65) nxt = *(const u32x2v*)(pc + 8 * 8192);
            *(u32x2v*)pc = (u32x2v){pk2(h0, h1), pk2(h2, h3)};
            const float d = cd[ch * 8];
            h0 = d * h0 + bf2f((bf16)(v.x & 0xffff)); h1 = d * h1 + bf2f((bf16)(v.x >> 16)); h2 = d * h2 + bf2f((bf16)(v.y & 0xffff)); h3 = d * h3 + bf2f((bf16)(v.y >> 16));
        }
    }
}
__device__ __forceinline__ void ph_ssd_out(const Ctx& c0, const bf16* XC, const bf16* U, const float* DT, const float* a_log, const float* dsk, const bf16* ST, bf16* Y) {
    const Ctx c = refresh(c0);
    const int lane = c.lane, w = c.wave, r32 = lane & 31, hi = lane >> 5, g = w >> 2;
    LAS bf16* XT = (LAS bf16*)c.lds + w * (64 * 72);
    LAS float* ACS = (LAS float*)(c.lds + 73728) + w * 64;
    LAS float* SS = (LAS float*)(c.lds + 73728 + 2048);
    const float a_neg = -__expf(a_log[w]), Dk = dsk[w];
    typedef short s16x4v __attribute__((ext_vector_type(4)));
    for (int it = c.bid; it < NB * 65; it += c.nb) {
        const int b = it / 65, ch = it - b * 65, p0 = 64 * ch - 48, pseq = p0 + lane; const bool valid = pseq >= 0; const size_t t = (size_t)(b * L + (valid ? pseq : 0));
        const float dtv = valid ? DT[t * 8 + w] : 0.f, acs = wave_scan_incl(dtv * a_neg, lane);
        ACS[lane] = acs;
        {   const bf16* xrow = XC + t * 1024 + 64 * w;
#pragma unroll
            for (int q = 0; q < 8; ++q) { u32x4v v = (u32x4v){0u, 0u, 0u, 0u}; if (valid) v = *(const u32x4v*)(xrow + 8 * q); const unsigned vv[4] = {v.x, v.y, v.z, v.w};
#pragma unroll
                for (int e = 0; e < 8; ++e) XT[(8 * q + e) * 72 + lane] = f2bf(bf2f((bf16)(vv[e >> 1] >> (16 * (e & 1)))) * dtv); } }
        const bool vl0 = p0 + r32 >= 0, vl1 = p0 + 32 + r32 >= 0;
        const size_t tl0 = (size_t)(b * L + (vl0 ? p0 + r32 : 0)), tl1 = (size_t)(b * L + (vl1 ? p0 + 32 + r32 : 0));
        f32x16 acc[2][2];
#pragma unroll
        for (int pb = 0; pb < 2; ++pb)
#pragma unroll
            for (int lb = 0; lb < 2; ++lb)
#pragma unroll
                for (int r = 0; r < 16; ++r) acc[pb][lb][r] = 0.f;
        const bf16* hin = ST + ((size_t)(b * 65 + ch) * 8 + w) * 8192;
#pragma unroll
        for (int k = 0; k < 8; ++k) {
            bf16x8 c0f = (bf16x8){0, 0, 0, 0, 0, 0, 0, 0}, c1f = c0f;
            if (vl0) c0f = *(const bf16x8*)(XC + tl0 * 1024 + 768 + 128 * g + 16 * k + 8 * hi);
            if (vl1) c1f = *(const bf16x8*)(XC + tl1 * 1024 + 768 + 128 * g + 16 * k + 8 * hi);
            const bf16x8 h0f = *(const bf16x8*)(hin + (size_t)r32 * 128 + 16 * k + 8 * hi), h1f = *(const bf16x8*)(hin + (size_t)(32 + r32) * 128 + 16 * k + 8 * hi);
            acc[0][0] = MFMA32(h0f, c0f, acc[0][0]); acc[0][1] = MFMA32(h0f, c1f, acc[0][1]); acc[1][0] = MFMA32(h1f, c0f, acc[1][0]); acc[1][1] = MFMA32(h1f, c1f, acc[1][1]);
        }
        const float acl0 = ACS[r32], acl1 = ACS[32 + r32], e0 = __expf(acl0), e1 = __expf(acl1);
#pragma unroll
        for (int pb = 0; pb < 2; ++pb)
#pragma unroll
            for (int r = 0; r < 16; ++r) { acc[pb][0][r] *= e0; acc[pb][1][r] *= e1; }
#pragma unroll
        for (int sb = 0; sb < 2; ++sb)
#pragma unroll
            for (int lb = sb; lb < 2; ++lb) {
                f32x16 x;
#pragma unroll
                for (int r = 0; r < 16; ++r) x[r] = 0.f;
                const bool vs = p0 + 32 * sb + r32 >= 0; const size_t ts = (size_t)(b * L + (vs ? p0 + 32 * sb + r32 : 0));
                const bool vl = lb == 0 ? vl0 : vl1; const size_t tl = lb == 0 ? tl0 : tl1;
#pragma unroll
                for (int k = 0; k < 8; ++k) {
                    bf16x8 bf_ = (bf16x8){0, 0, 0, 0, 0, 0, 0, 0}, cf_ = bf_;
                    if (vs) bf_ = *(const bf16x8*)(XC + ts * 1024 + 512 + 128 * g + 16 * k + 8 * hi);
                    if (vl) cf_ = *(const bf16x8*)(XC + tl * 1024 + 768 + 128 * g + 16 * k + 8 * hi);
                    x = MFMA32(bf_, cf_, x);
                }
                const float acl = lb == 0 ? acl0 : acl1; const int lrow = 32 * lb + r32;
#pragma unroll
                for (int i4 = 0; i4 < 4; ++i4) { const f32x4v as = *(const LAS f32x4v*)(ACS + 32 * sb + 8 * i4 + 4 * hi);
#pragma unroll
                    for (int e = 0; e < 4; ++e) { const int srow = 32 * sb + 8 * i4 + 4 * hi + e; x[4 * i4 + e] = srow <= lrow ? x[4 * i4 + e] * __expf(fminf(acl - as[e], 0.f)) : 0.f; } }
#pragma unroll
                for (int ks = 0; ks < 2; ++ks) {
                    const bf16x8 xs = pack8(x, ks);
#pragma unroll
                    for (int pb = 0; pb < 2; ++pb) {
                        const LAS bf16* vp = XT + (32 * pb + r32) * 72 + 32 * sb + 16 * ks + 4 * hi;
                        const s16x4v lo = *(const LAS s16x4v*)vp, hh = *(const LAS s16x4v*)(vp + 8);
                        const bf16x8 pa = __builtin_shufflevector(lo, hh, 0, 1, 2, 3, 4, 5, 6, 7);
                        if (lb == 0) acc[pb][0] = MFMA32(pa, xs, acc[pb][0]); else acc[pb][1] = MFMA32(pa, xs, acc[pb][1]);
                    }
                }
            }
        float ssq0 = 0.f, ssq1 = 0.f;
#pragma unroll
        for (int lb = 0; lb < 2; ++lb) { const bool vl = lb == 0 ? vl0 : vl1; const size_t tl = lb == 0 ? tl0 : tl1;
#pragma unroll
            for (int pb = 0; pb < 2; ++pb)
#pragma unroll
                for (int i4 = 0; i4 < 4; ++i4) { const int pc = 64 * w + 32 * pb + 8 * i4 + 4 * hi;
                    u32x2v xv = (u32x2v){0u, 0u}, zv = xv;
                    if (vl) { xv = *(const u32x2v*)(XC + tl * 1024 + pc); zv = *(const u32x2v*)(U + tl * NU + C_Z + pc); }
                    const float xe[4] = {bf2f((bf16)(xv.x & 0xffff)), bf2f((bf16)(xv.x >> 16)), bf2f((bf16)(xv.y & 0xffff)), bf2f((bf16)(xv.y >> 16))};
                    const float ze[4] = {bf2f((bf16)(zv.x & 0xffff)), bf2f((bf16)(zv.x >> 16)), bf2f((bf16)(zv.y & 0xffff)), bf2f((bf16)(zv.y >> 16))};
#pragma unroll
                    for (int e = 0; e < 4; ++e) { const float y = acc[pb][lb][4 * i4 + e] + Dk * xe[e], gz = y * siluf(ze[e]); acc[pb][lb][4 * i4 + e] = gz; if (lb == 0) ssq0 += gz * gz; else ssq1 += gz * gz; } } }
        ssq0 += lane_read(ssq0, lane ^ 32); ssq1 += lane_read(ssq1, lane ^ 32);
        if (hi == 0) { SS[w * 64 + r32] = ssq0; SS[w * 64 + 32 + r32] = ssq1; }
        __syncthreads();
        const float tot0 = SS[(4 * g) * 64 + r32] + SS[(4 * g + 1) * 64 + r32] + SS[(4 * g + 2) * 64 + r32] + SS[(4 * g + 3) * 64 + r32];
        const float tot1 = SS[(4 * g) * 64 + 32 + r32] + SS[(4 * g + 1) * 64 + 32 + r32] + SS[(4 * g + 2) * 64 + 32 + r32] + SS[(4 * g + 3) * 64 + 32 + r32];
        const float rs0 = rsqrtf(tot0 * (1.f / 256.f) + EPSF), rs1 = rsqrtf(tot1 * (1.f / 256.f) + EPSF);
#pragma unroll
        for (int lb = 0; lb < 2; ++lb) { const bool vl = lb == 0 ? vl0 : vl1; const size_t tl = lb == 0 ? tl0 : tl1; const float rs = lb == 0 ? rs0 : rs1;
            if (vl) {
#pragma unroll
                for (int pb = 0; pb < 2; ++pb)
#pragma unroll
                    for (int i4 = 0; i4 < 4; ++i4)
                        *(u32x2v*)(Y + tl * KOUT + 64 * w + 32 * pb + 8 * i4 + 4 * hi) = (u32x2v){cvtpk(acc[pb][lb][4 * i4] * rs, acc[pb][lb][4 * i4 + 1] * rs), cvtpk(acc[pb][lb][4 * i4 + 2] * rs, acc[pb][lb][4 * i4 + 3] * rs)};
            } }
        __syncthreads();
    }
}

__device__ __forceinline__ void ph_resid(const Ctx& c0, const bf16* MIX, const float* g, float* dout, float* metax, bf16* XB, float* RSTD) { const Ctx c = refresh(c0);
    const int lane = c.lane;
    for (int t = c.gw; t < T; t += c.ngw) {
        float mv[32]; float ss = 0.f;
#pragma unroll
        for (int j = 0; j < 4; ++j) { const uint4 v = *(const uint4*)(MIX + (size_t)t * DM + 8 * lane + 512 * j); const unsigned w[4] = {v.x, v.y, v.z, v.w};
#pragma unroll
            for (int i = 0; i < 8; ++i) { const float f = bf2f((bf16)(w[i >> 1] >> (16 * (i & 1)))); mv[8 * j + i] = f; ss += f * f; } }
        const float rs = rsqrtf(wave_sum(ss, lane) * (1.f / DM) + EPSF);
        float* xr = xf_row(dout, metax, t); float s2 = 0.f;
#pragma unroll
        for (int j = 0; j < 4; ++j) { const int cc = 8 * lane + 512 * j;
            float4 a = *(const float4*)(xr + cc), b4 = *(const float4*)(xr + cc + 4); const float4 ga = *(const float4*)(g + cc), gb = *(const float4*)(g + cc + 4);
            a.x += mv[8 * j] * rs * ga.x; a.y += mv[8 * j + 1] * rs * ga.y; a.z += mv[8 * j + 2] * rs * ga.z; a.w += mv[8 * j + 3] * rs * ga.w;
            b4.x += mv[8 * j + 4] * rs * gb.x; b4.y += mv[8 * j + 5] * rs * gb.y; b4.z += mv[8 * j + 6] * rs * gb.z; b4.w += mv[8 * j + 7] * rs * gb.w;
            s2 += a.x * a.x + a.y * a.y + a.z * a.z + a.w * a.w + b4.x * b4.x + b4.y * b4.y + b4.z * b4.z + b4.w * b4.w;
            *(float4*)(xr + cc) = a; *(float4*)(xr + cc + 4) = b4;
            *(uint4*)(XB + (size_t)t * DM + cc) = make_uint4(pk2(a.x, a.y), pk2(a.z, a.w), pk2(b4.x, b4.y), pk2(b4.z, b4.w)); }
        s2 = wave_sum(s2, lane);
        if (lane == 0) RSTD[t] = rsqrtf(s2 * (1.f / DM) + EPSF);
    }
}

__device__ __forceinline__ void ph_gemm_plain(const Ctx& c0, const bf16* A, const bf16* Bt, bf16* O, int N, int K, int ldc, const float* rs, float* UF) { const Ctx c = refresh(c0);
    pg8::StaticOrder S; S.init(129 * 256, N, c.nb, c.bid);
    pg8::Gemm g{A, Bt, 129 * 256, N, K, (size_t)256 * K * 2};
    pg8::EpiBf16Plain E{O, ldc, rs, UF, C_SM};
    pg8::gemm_phase<pg8::EpiBf16Plain, pg8::StaticOrder, true, true>(c.lds, g, S, E, c.tid);
}
__device__ __forceinline__ void ph_gemm_gateup(const Ctx& c0, const bf16* XB, const bf16* Bt, bf16* H, const float* rs, const float* cw, const float* cb) { const Ctx c = refresh(c0);
    pg8::StaticOrder S; S.init(130 * 256, NGU, c.nb, c.bid);
    pg8::Gemm g{XB - (size_t)2 * DM, Bt, 130 * 256, NGU, DM, (size_t)254 * DM * 2};
    pg8::EpiGateUp E{H, rs, cw, cb, (LAS float*)(c.lds + HALO_OFF)};
    pg8::gemm_phase<pg8::EpiGateUp, pg8::StaticOrder, true, true>(c.lds, g, S, E, c.tid);
}

__global__ void __launch_bounds__(NTHR, 2) fwd_mega(Args A) {
    extern __shared__ __attribute__((aligned(16))) unsigned char lds_raw[];
    cg::grid_group grid = cg::this_grid();
    Ctx c; c.tid = threadIdx.x; c.lane = c.tid & 63; c.wave = __builtin_amdgcn_readfirstlane(c.tid >> 6); c.bid = blockIdx.x; c.nb = gridDim.x;
    c.gw = c.bid * NWAVE + c.wave; c.ngw = c.nb * NWAVE; c.lds = (LAS unsigned char*)lds_raw;
    if (c.tid == 0) { LAS unsigned long long* PT = (LAS unsigned long long*)(c.lds + PT_OFF);
#pragma unroll
        for (int i = 0; i < 25; ++i) PT[i] = (unsigned long long)A.in[i];
        PT[25] = (unsigned long long)A.out; PT[26] = (unsigned long long)A.ws; }
    if (c.tid < 2) ((LAS unsigned*)(c.lds + MISC_OFF))[c.tid] = 0u;
    __syncthreads();
    (void)xcd_barrier_post((unsigned*)(A.ws + WS_CTL) + CW_BAR, (volatile LAS unsigned*)(c.lds + MISC_OFF), c.tid);
#define WSP(off) (pt_get(c, 26) + (off))
#define DOUT ((float*)pt_get(c, 25))
#define P_WIN ((bf16*)WSP(WS_WIN))
#define P_WOUT ((bf16*)WSP(WS_WOUT))
#define P_WGU ((bf16*)WSP(WS_WGU))
#define P_WDN ((bf16*)WSP(WS_WDN))
#define P_METAX ((float*)WSP(WS_METAX))
#define P_RSTD ((float*)WSP(WS_RSTD))
#define P_UF ((float*)WSP(WS_UF))
#define P_DT ((float*)WSP(WS_DT))
#define P_FCUM ((float*)WSP(WS_FCUM))
#define P_CN ((bf16*)WSP(WS_CN))
#define P_MASK ((u64*)WSP(WS_MASK))
#define P_XB ((bf16*)WSP(WS_XB) + (size_t)8 * DM)
#define P_Y ((bf16*)WSP(WS_Y))
#define P_U ((bf16*)WSP(WS_R1))
#define P_XC ((bf16*)WSP(WS_XC))
#define P_H ((bf16*)WSP(WS_R1))
#define P_MIX ((bf16*)WSP(WS_R1))
#define P_MIX2 ((bf16*)WSP(WS_Y))
#define P_ST ((bf16*)WSP(WS_YA))
#define P_CD ((float*)WSP(WS_DT + 1536 * 1024))
    ph_prep_x(c, INP(0), INP(1), DOUT, P_METAX, P_XB, P_RSTD);
    grid.sync();
#pragma unroll 1
    for (int ly = 0; ly < DEPTH; ++ly) {
        ph_prep_w(c, ly, P_WIN, P_WOUT, P_WGU, P_WDN);
        grid_barrier(c);
        ph_gemm_plain(c, P_XB, P_WIN, P_U, NU, DM, NU, P_RSTD, P_UF);
        grid_barrier(c);
        ph_mixprep(c, P_U, P_UF, INP(7) + (size_t)ly * 4 * 1024, INP(8) + (size_t)ly * 1024, INP(16) + (size_t)ly * 128, INP(9) + (size_t)ly * 8, P_XC, P_Y, P_CN, P_DT);
        ph_fcum(c, P_UF, INP(15) + (size_t)ly * 8, P_FCUM);
        grid_barrier(c);
        ph_ssd_states(c, P_XC, P_DT, INP(10) + (size_t)ly * 8, P_ST, P_CD);
        ph_fox(c, P_U, P_FCUM, P_Y);
        grid_barrier(c);
        ph_ssd_scan(c, P_ST, P_CD);
        ph_dsa(c, P_U, P_UF, P_CN, P_Y);
        grid_barrier(c);
        ph_ssd_out(c, P_XC, P_U, P_DT, INP(10) + (size_t)ly * 8, INP(11) + (size_t)ly * 8, P_ST, P_Y);
        grid_barrier(c);
        ph_gemm_plain(c, P_Y, P_WOUT, P_MIX, DM, KOUT, DM, nullptr, nullptr);
        grid_barrier(c);
        ph_resid(c, P_MIX, INP(3) + (size_t)ly * DM, DOUT, P_METAX, P_XB, P_RSTD);
        grid_barrier(c);
        ph_gemm_gateup(c, P_XB, P_WGU, P_H, P_RSTD, INP(22) + (size_t)ly * 3 * FF, INP(23) + (size_t)ly * FF);
        grid_barrier(c);
        ph_gemm_plain(c, P_H, P_WDN, P_MIX2, DM, FF, DM, nullptr, nullptr);
        grid_barrier(c);
        ph_resid(c, P_MIX2, INP(5) + (size_t)ly * DM, DOUT, P_METAX, P_XB, P_RSTD);
        grid_barrier(c);
    }
}

extern "C" void kernel_launch(void* const* d_in, const int* in_sizes, int n_in, void* d_out, int out_size, void* d_ws, size_t ws_size, hipStream_t stream) {
    static int grid_blocks = 0;
    if (grid_blocks == 0) {
        if (n_in != 25 || in_sizes[0] != NB * SEQ * DM || out_size != NB * SEQ * DM || ws_size < WS_END) { fprintf(stderr, "kernel_launch: unexpected shapes (n_in %d in0 %d out %d ws %zu)\n", n_in, n_in > 0 ? in_sizes[0] : -1, out_size, ws_size); grid_blocks = -1; return; }
        int dev = 0, cus = 0, per_cu = 0;
        (void)hipGetDevice(&dev); (void)hipDeviceGetAttribute(&cus, hipDeviceAttributeMultiprocessorCount, dev);
        if (hipFuncSetAttribute((const void*)fwd_mega, hipFuncAttributeMaxDynamicSharedMemorySize, LDS_BYTES) != hipSuccess) { fprintf(stderr, "kernel_launch: hipFuncSetAttribute failed\n"); grid_blocks = -1; return; }
        if (hipOccupancyMaxActiveBlocksPerMultiprocessor(&per_cu, (const void*)fwd_mega, NTHR, LDS_BYTES) != hipSuccess || per_cu < 1) { fprintf(stderr, "kernel_launch: occupancy query says %d blocks/CU\n", per_cu); grid_blocks = -1; return; }
        grid_blocks = cus;
        fprintf(stderr, "kernel_launch: %d CUs, %d blocks/CU by the occupancy query, grid %d\n", cus, per_cu, grid_blocks);
    }
    if (grid_blocks < 0) return;
    if (hipMemsetAsync((char*)d_ws + WS_CTL, 0, 65536, stream) != hipSuccess) { fprintf(stderr, "kernel_launch: memset failed\n"); return; }
    Args a{};
    for (int i = 0; i < 25; ++i) a.in[i] = (const float*)d_in[i];
    a.out = (float*)d_out; a.ws = (unsigned char*)d_ws;
    void* args[] = {&a};
    hipError_t e = hipLaunchCooperativeKernel((const void*)fwd_mega, dim3(grid_blocks), dim3(NTHR), args, LDS_BYTES, stream);
    if (e != hipSuccess) fprintf(stderr, "kernel_launch: cooperative launch failed: %s (grid %d)\n", hipGetErrorString(e), grid_blocks);
}
```

```cpp
#include <hip/hip_runtime.h>
#include <cstdio>
#include <cstdint>

constexpr int NB = 8, SEQ = 4096, NMETA = 16, L = SEQ + NMETA  , T = NB * L  , MP = 33024  , DM = 2048;
constexpr int NU = 5120, KOUT = 2560, FF = 5632, NGU = 2 * FF, DIN = 4564;
constexpr int C_Z = 0, C_XBC = 512, C_POOL = 1536, C_FQ = 2048, C_FK = 2560, C_FV = 3072, C_QLAT = 3584, C_DC = 4608, C_QI = 4736, C_KI = 4992, C_SM = 5056;
constexpr int LKP = 4224, NMW = 66  , TOPK = 256, DEPTH = 4;
constexpr float EPSF = 1e-6f;
typedef unsigned short bf16;
typedef unsigned long long u64;

__device__ __forceinline__ float bf2f(bf16 v) { return __uint_as_float(((unsigned)v) << 16); }
__device__ __forceinline__ bf16 f2bf(float f) { unsigned u = __float_as_uint(f); return (bf16)((u + 0x7fffu + ((u >> 16) & 1u)) >> 16); }
__device__ __forceinline__ unsigned pk2(float lo, float hi) { return (unsigned)f2bf(lo) | ((unsigned)f2bf(hi) << 16); }
__device__ __forceinline__ float siluf(float x) { return x / (1.f + __expf(-x)); }
__device__ __forceinline__ float softplusf(float x) { return fmaxf(x, 0.f) + log1pf(__expf(-fabsf(x))); }
__device__ __forceinline__ float logsigmoidf(float x) { return fminf(x, 0.f) - log1pf(__expf(-fabsf(x))); }
__device__ __forceinline__ float lane_read(float v, int src) { return __int_as_float(__builtin_amdgcn_ds_bpermute(src << 2, __float_as_int(v))); }
__device__ __forceinline__ int lane_readi(int v, int src) { return __builtin_amdgcn_ds_bpermute(src << 2, v); }
__device__ __forceinline__ float wave_sum(float v, int lane) {
#pragma unroll
    for (int o = 1; o < 64; o <<= 1) v += lane_read(v, lane ^ o);
    return v;
}
__device__ __forceinline__ float* xf_row(float* dout, float* metax, int t) {
    const int b = t / L, p = t - b * L;
    return p < NMETA ? metax + (size_t)(b * NMETA + p) * DM : dout + ((size_t)b * SEQ + (p - NMETA)) * DM;
}
namespace pg8 {
#define PG8_LAS __attribute__((address_space(3)))
typedef unsigned short bf16_t;
typedef short bf16x8 __attribute__((ext_vector_type(8)));
typedef float f32x4 __attribute__((ext_vector_type(4)));
typedef unsigned u32x4 __attribute__((ext_vector_type(4)));
constexpr int BM = 256, BK = 64, HALF = 128, HTB = HALF * BK * 2  , STAGE_BYTES = 8 * HTB, NXCD = 8, WGM = 8;

__host__ __device__ __forceinline__ int lds_byte(int r, int c) { const int st = (r >> 4) * 2 + (c >> 5), rr = r & 15, cc = c & 31, ob = rr * 64 + cc * 2; return st * 1024 + (ob ^ (((ob >> 9) & 1) << 5)); }
__host__ __device__ __forceinline__ void stage_rc(int b, int& R, int& C) { const int st = b / 1024, sb = b % 1024, swz = sb ^ (((sb >> 9) & 1) << 5); R = (st >> 1) * 16 + swz / 64; C = (st & 1) * 32 + (swz % 64) / 2; }
__host__ __device__ __forceinline__ int perm32(int rho) { const int n = rho >> 4, i = rho & 15; return 8 * (i >> 2) + 4 * n + (i & 3); }

struct Unit { int pm, pn; };
struct Gemm { const bf16_t* A; const bf16_t* Bt; int M, N, K; size_t a_tstep; };

struct StaticOrder {
    int nM, nN, nwg, G, c;
    __host__ __device__ void init(int M, int N, int G_, int c_) { nM = M / BM; nN = N / BM; nwg = nM * nN; G = G_; c = c_; }
    __host__ __device__ bool next(int i, Unit& u) const {
        const long L = (long)i * G + c; if (L >= nwg) return false;
        int wgid = (int)L; { const int q = nwg / NXCD, r = nwg % NXCD, xcd = wgid % NXCD, off = wgid / NXCD; wgid = (xcd < r ? xcd * (q + 1) : r * (q + 1) + (xcd - r) * q) + off; }
        const int nig = WGM * nN, gid = wgid / nig, fm = gid * WGM, gsz = (nM - fm) < WGM ? (nM - fm) : WGM;
        u.pm = fm + ((wgid % nig) % gsz); u.pn = (wgid % nig) / gsz; return true;
    }
    __device__ __forceinline__ void a_ready(const Unit&) const {}
    __device__ __forceinline__ void done(const Unit&) const {}
};


__device__ __forceinline__ unsigned cvt_pk_bf16(float lo, float hi) { unsigned r; asm volatile("v_cvt_pk_bf16_f32 %0, %1, %2" : "=v"(r) : "v"(lo), "v"(hi)); return r; }

struct EpiBf16Plain {
    static constexpr bool PERM = true, AFTER_DRAIN = false;
    bf16_t* O; int ldc; const float* rs; float* UF; int sm_col0;
    __device__ __forceinline__ void operator()(f32x4 (&acc)[2][2][4][2], const Unit& u, int wr, int wc, int fr, int fq) const {
        const int row0 = u.pm * BM + wr * 64 + fr, col0 = u.pn * BM + wc * 32 + 8 * fq;
#pragma unroll
        for (int ai = 0; ai < 2; ++ai)
#pragma unroll
            for (int m = 0; m < 4; ++m) {
                const int row = row0 + ai * HALF + m * 16; const float s = rs ? rs[row] : 1.f; bf16_t* rowp = O + (size_t)row * ldc + col0;
#pragma unroll
                for (int bj = 0; bj < 2; ++bj) { const f32x4 v0 = acc[ai][bj][m][0] * s, v1 = acc[ai][bj][m][1] * s;
                    u32x4 w; w.x = cvt_pk_bf16(v0[0], v0[1]); w.y = cvt_pk_bf16(v0[2], v0[3]); w.z = cvt_pk_bf16(v1[0], v1[1]); w.w = cvt_pk_bf16(v1[2], v1[3]);
                    *(u32x4*)(rowp + bj * HALF) = w;
                    if (UF) { const int c = col0 + bj * HALF - sm_col0; if (c >= 0 && c < 32) { float* p = UF + (size_t)row * 32 + c; *(f32x4*)p = v0; *(f32x4*)(p + 4) = v1; } } }
            }
    }
};

struct EpiGateUp {
    static constexpr bool PERM = true, AFTER_DRAIN = false;
    bf16_t* H; const float* rs; const float* cw; const float* cb; PG8_LAS float* halo;
    __device__ __forceinline__ void operator()(f32x4 (&acc)[2][2][4][2], const Unit& u, int wr, int wc, int fr, int fq) const {
        const int lane = fq * 16 + fr, chl = wc * 32 + 8 * fq, ch0 = u.pn * 128 + chl, rbase = u.pm * 254 - 2;
#pragma unroll
        for (int ai = 0; ai < 2; ++ai)
#pragma unroll
            for (int m = 0; m < 4; ++m) { const int grow = rbase + ai * 128 + wr * 64 + m * 16 + fr; const float s = grow >= 0 ? rs[grow] : 0.f;
#pragma unroll
                for (int bj = 0; bj < 2; ++bj)
#pragma unroll
                    for (int n = 0; n < 2; ++n) acc[ai][bj][m][n] = acc[ai][bj][m][n] * s; }
        if (fr >= 14) {
#pragma unroll
            for (int ai = 0; ai < 2; ++ai)
#pragma unroll
                for (int n = 0; n < 2; ++n) *(PG8_LAS f32x4*)(halo + ((2 * ai + wr) * 2 + (fr - 14)) * 128 + chl + 4 * n) = acc[ai][0][3][n];
        }
        asm volatile("s_waitcnt lgkmcnt(0)" ::: "memory"); __builtin_amdgcn_s_barrier(); asm volatile("" ::: "memory");
        f32x4 w0[2], w1[2], w2[2], bb[2];
#pragma unroll
        for (int n = 0; n < 2; ++n) { w0[n] = *(const f32x4*)(cw + ch0 + 4 * n); w1[n] = *(const f32x4*)(cw + FF + ch0 + 4 * n); w2[n] = *(const f32x4*)(cw + 2 * FF + ch0 + 4 * n); bb[n] = *(const f32x4*)(cb + ch0 + 4 * n); }
#pragma unroll
        for (int ai = 0; ai < 2; ++ai)
#pragma unroll
            for (int m = 0; m < 4; ++m) {
                const int rl = ai * 128 + wr * 64 + m * 16 + fr, grow = rbase + rl, pos = grow >= 0 ? grow % L : 0, blk = 2 * ai + wr;
                const float t1 = pos >= 1 ? 1.f : 0.f, t2 = pos >= 2 ? 1.f : 0.f;
                unsigned pk[4];
#pragma unroll
                for (int n = 0; n < 2; ++n) {
                    const f32x4 cur = acc[ai][0][m][n]; f32x4 g1, g2;
#pragma unroll
                    for (int j = 0; j < 4; ++j) {
                        const float s1 = lane_read(cur[j], (lane + 63) & 63), s2 = lane_read(cur[j], (lane + 62) & 63);
                        float p15, p14;
                        if (m > 0) { const float pv = acc[ai][0][m > 0 ? m - 1 : 0][n][j]; p15 = lane_read(pv, fq * 16 + 15); p14 = lane_read(pv, fq * 16 + 14); }
                        else if (blk > 0) { p14 = halo[((blk - 1) * 2 + 0) * 128 + chl + 4 * n + j]; p15 = halo[((blk - 1) * 2 + 1) * 128 + chl + 4 * n + j]; }
                        else { p14 = 0.f; p15 = 0.f; }
                        g1[j] = fr >= 1 ? s1 : p15; g2[j] = fr >= 2 ? s2 : (fr == 1 ? p15 : p14);
                    }
                    const f32x4 cv = bb[n] + w2[n] * cur + (w1[n] * g1) * t1 + (w0[n] * g2) * t2;
                    const f32x4 up = acc[ai][1][m][n];
                    float hv[4];
#pragma unroll
                    for (int j = 0; j < 4; ++j) hv[j] = cv[j] / (1.f + __expf(-cv[j])) * up[j];
                    pk[2 * n] = cvt_pk_bf16(hv[0], hv[1]); pk[2 * n + 1] = cvt_pk_bf16(hv[2], hv[3]);
                }
                if (rl >= 2) { u32x4 w; w.x = pk[0]; w.y = pk[1]; w.z = pk[2]; w.w = pk[3]; *(u32x4*)(H + (size_t)grow * FF + ch0) = w; }
            }
    }
};
template <class Epi, class Sched, bool ALIGN_EPI = false, bool SP2 = false>
__device__ __forceinline__ void gemm_phase(PG8_LAS unsigned char* lds, const Gemm g, const Sched& S, const Epi& E, const int tid) {
    const int wid = __builtin_amdgcn_readfirstlane(tid >> 6), lane = tid & 63, wr = wid >> 2, wc = wid & 3, fr = lane & 15, fq = lane >> 4;
    const int K = g.K, nt = K / BK;
    unsigned voffA[2], voffB[2];
#pragma unroll
    for (int i = 0; i < 2; ++i) { int R, C; stage_rc(tid * 16 + i * 8192, R, C); const int Rb = Epi::PERM ? ((R & ~31) + perm32(R & 31)) : R;
        voffA[i] = (unsigned)(R * K + C) * 2u; voffB[i] = (unsigned)(Rb * K + C) * 2u; }
    const size_t kstep = (size_t)(BK * 2);
    const size_t hstep = (size_t)HALF * K * 2;
    const size_t tstep = 2 * hstep;
    const unsigned ldsw = (unsigned)wid * 1024u;
    const int aoff = lds_byte(wr * 64 + fr, fq * 8), boff = lds_byte(wc * 32 + fr, fq * 8);
#define PG8_SA(b, h) (((b) * 2 + (h)) * HTB)
#define PG8_SB(b, h) ((4 + (b) * 2 + (h)) * HTB)
#define PG8_STAGE(bufoff, gbase, voff) do { _Pragma("unroll") for (int _i = 0; _i < 2; ++_i) \
        __builtin_amdgcn_global_load_lds((const unsigned*)((const char*)(gbase) + (voff)[_i]), (PG8_LAS unsigned*)(lds + (bufoff) + ldsw + _i * 8192), 16, 0, 0); } while (0)
#define PG8_LDA(dst, b, h) do { _Pragma("unroll") for (int m = 0; m < 4; ++m) _Pragma("unroll") for (int k = 0; k < 2; ++k) dst[m][k] = *(const PG8_LAS bf16x8*)(lds + PG8_SA(b, h) + aoff + m * 2048 + k * 1024); } while (0)
#define PG8_LDB(dst, b, h) do { _Pragma("unroll") for (int n = 0; n < 2; ++n) _Pragma("unroll") for (int k = 0; k < 2; ++k) dst[n][k] = *(const PG8_LAS bf16x8*)(lds + PG8_SB(b, h) + boff + n * 2048 + k * 1024); } while (0)
#define PG8_MMA(ai, bj, At, Bt) do { __builtin_amdgcn_s_setprio(1); _Pragma("unroll") for (int m = 0; m < 4; ++m) _Pragma("unroll") for (int n = 0; n < 2; ++n) _Pragma("unroll") for (int k = 0; k < 2; ++k) \
        acc[ai][bj][m][n] = __builtin_amdgcn_mfma_f32_16x16x32_bf16(Bt[n][k], At[m][k], acc[ai][bj][m][n], 0, 0, 0); __builtin_amdgcn_s_setprio(0); } while (0)
#define PG8_WAIT_V(n) asm volatile("s_waitcnt vmcnt(" #n ")" ::: "memory")
#define PG8_WAIT_L(n) asm volatile("s_waitcnt lgkmcnt(" #n ")" ::: "memory")
#define PG8_BAR __builtin_amdgcn_s_barrier()
#define PG8_SCHED __builtin_amdgcn_sched_barrier(0)
    Unit cur, nxt; int ui = 0;
    if (!S.next(0, cur)) return;
    f32x4 acc[2][2][4][2];
#pragma unroll
    for (int a = 0; a < 2; ++a)
#pragma unroll
        for (int b = 0; b < 2; ++b)
#pragma unroll
            for (int m = 0; m < 4; ++m)
#pragma unroll
                for (int n = 0; n < 2; ++n) acc[a][b][m][n] = (f32x4){0.f, 0.f, 0.f, 0.f};
    bf16x8 At[4][2], B0[2][2], B1[2][2];
    const char* cA = (const char*)g.A + (size_t)cur.pm * g.a_tstep; const char* cB = (const char*)g.Bt + (size_t)cur.pn * tstep;
    S.a_ready(cur);
    if constexpr (SP2) {
        PG8_STAGE(PG8_SB(0, 0), cB, voffB); PG8_STAGE(PG8_SB(0, 1), cB + hstep, voffB); PG8_STAGE(PG8_SA(0, 0), cA, voffA); PG8_STAGE(PG8_SA(0, 1), cA + hstep, voffA);
        if (wr == 1) PG8_BAR;
        PG8_WAIT_V(2); PG8_BAR;
        PG8_STAGE(PG8_SB(1, 0), cB + kstep, voffB); PG8_STAGE(PG8_SA(1, 0), cA + kstep, voffA); PG8_STAGE(PG8_SB(1, 1), cB + hstep + kstep, voffB);
        PG8_WAIT_V(6); PG8_BAR;
    } else {
        PG8_STAGE(PG8_SB(0, 0), cB, voffB); PG8_STAGE(PG8_SA(0, 0), cA, voffA); PG8_STAGE(PG8_SB(0, 1), cB + hstep, voffB); PG8_STAGE(PG8_SA(0, 1), cA + hstep, voffA);
        if (wr == 1) PG8_BAR;
        PG8_WAIT_V(4); PG8_BAR;
        PG8_STAGE(PG8_SB(1, 0), cB + kstep, voffB); PG8_STAGE(PG8_SA(1, 0), cA + kstep, voffA); PG8_STAGE(PG8_SB(1, 1), cB + hstep + kstep, voffB);
        PG8_WAIT_V(6); PG8_BAR;
    }
    for (;;) {
        const bool has_next = S.next(ui + 1, nxt);
        const char* nA = has_next ? (const char*)g.A + (size_t)nxt.pm * g.a_tstep : cA; const char* nB = has_next ? (const char*)g.Bt + (size_t)nxt.pn * tstep : cB;
        for (int t = 0; t < nt; t += 2) {
            const bool last = (t == nt - 2);
            const char* a1 = cA + (size_t)(t + 1) * kstep;
            const char* a2 = last ? nA : cA + (size_t)(t + 2) * kstep; const char* b2 = last ? nB : cB + (size_t)(t + 2) * kstep;
            const char* a3 = a2 + kstep; const char* b3 = b2 + kstep;
            if (last && has_next) S.a_ready(nxt);
            if constexpr (SP2) {
            PG8_LDB(B0, 0, 0); PG8_LDB(B1, 0, 1); PG8_SCHED; PG8_LDA(At, 0, 0); PG8_STAGE(PG8_SA(1, 1), a1 + hstep, voffA);
            PG8_WAIT_V(8); PG8_WAIT_L(0); PG8_BAR; PG8_MMA(0, 0, At, B0); PG8_MMA(0, 1, At, B1); PG8_BAR; PG8_SCHED;
            PG8_LDA(At, 0, 1); PG8_STAGE(PG8_SB(0, 0), b2, voffB); PG8_STAGE(PG8_SB(0, 1), b2 + hstep, voffB); PG8_STAGE(PG8_SA(0, 0), a2, voffA);
            PG8_WAIT_V(8); PG8_WAIT_L(0); PG8_BAR; PG8_MMA(1, 0, At, B0); PG8_MMA(1, 1, At, B1); PG8_BAR; PG8_SCHED;
            PG8_LDB(B0, 1, 0); PG8_LDB(B1, 1, 1); PG8_SCHED; PG8_LDA(At, 1, 0); PG8_STAGE(PG8_SA(0, 1), a2 + hstep, voffA);
            PG8_WAIT_V(8); PG8_WAIT_L(0); PG8_BAR; PG8_MMA(0, 0, At, B0); PG8_MMA(0, 1, At, B1); PG8_BAR; PG8_SCHED;
            PG8_LDA(At, 1, 1); PG8_STAGE(PG8_SB(1, 0), b3, voffB); PG8_STAGE(PG8_SB(1, 1), b3 + hstep, voffB); PG8_STAGE(PG8_SA(1, 0), a3, voffA);
            PG8_WAIT_V(8); PG8_WAIT_L(0); PG8_BAR; PG8_MMA(1, 0, At, B0); PG8_MMA(1, 1, At, B1); PG8_BAR; PG8_SCHED;
            } else {
            PG8_LDB(B0, 0, 0); PG8_SCHED; PG8_LDA(At, 0, 0); PG8_STAGE(PG8_SA(1, 1), a1 + hstep, voffA);
            PG8_WAIT_L(8); PG8_BAR; PG8_WAIT_L(0); PG8_MMA(0, 0, At, B0); PG8_BAR; PG8_SCHED;
            PG8_LDB(B1, 0, 1); PG8_STAGE(PG8_SB(0, 0), b2, voffB);
            PG8_BAR; PG8_WAIT_L(0); PG8_MMA(0, 1, At, B1); PG8_BAR;
            PG8_LDA(At, 0, 1); PG8_STAGE(PG8_SA(0, 0), a2, voffA);
            PG8_BAR; PG8_WAIT_L(0); PG8_MMA(1, 0, At, B0); PG8_BAR; PG8_SCHED;
            PG8_STAGE(PG8_SB(0, 1), b2 + hstep, voffB);
            PG8_WAIT_V(6); PG8_BAR; PG8_MMA(1, 1, At, B1); PG8_BAR;
            PG8_LDB(B0, 1, 0); PG8_SCHED; PG8_LDA(At, 1, 0); PG8_STAGE(PG8_SA(0, 1), a2 + hstep, voffA);
            PG8_WAIT_L(8); PG8_BAR; PG8_WAIT_L(0); PG8_MMA(0, 0, At, B0); PG8_BAR; PG8_SCHED;
            PG8_LDB(B1, 1, 1); PG8_STAGE(PG8_SB(1, 0), b3, voffB);
            PG8_BAR; PG8_WAIT_L(0); PG8_MMA(0, 1, At, B1); PG8_BAR;
            PG8_LDA(At, 1, 1); PG8_STAGE(PG8_SA(1, 0), a3, voffA);
            PG8_BAR; PG8_WAIT_L(0); PG8_MMA(1, 0, At, B0); PG8_BAR; PG8_SCHED;
            PG8_STAGE(PG8_SB(1, 1), b3 + hstep, voffB);
            PG8_WAIT_V(6); PG8_BAR; PG8_MMA(1, 1, At, B1); PG8_BAR;
            }
        }
        if constexpr (ALIGN_EPI) { if (wr == 0) PG8_BAR; }
        if constexpr (!Epi::AFTER_DRAIN) { E(acc, cur, wr, wc, fr, fq); S.done(cur); }
        if (!has_next) break;
#pragma unroll
        for (int a = 0; a < 2; ++a)
#pragma unroll
            for (int b = 0; b < 2; ++b)
#pragma unroll
                for (int m = 0; m < 4; ++m)
#pragma unroll
                    for (int n = 0; n < 2; ++n) acc[a][b][m][n] = (f32x4){0.f, 0.f, 0.f, 0.f};
        cur = nxt; cA = nA; cB = nB; ++ui;
        if constexpr (ALIGN_EPI) { if (wr == 1) PG8_BAR; }
    }
    PG8_WAIT_V(0);
    if constexpr (!ALIGN_EPI) { if (wr == 0) PG8_BAR; }
    PG8_BAR;
    if constexpr (Epi::AFTER_DRAIN) { E.fused(acc, cur, wr, wc, fr, fq, lds, wid, lane); S.done(cur); }
#undef PG8_SA
#undef PG8_SB
#undef PG8_STAGE
#undef PG8_LDA
#undef PG8_LDB
#undef PG8_MMA
#undef PG8_WAIT_V
#undef PG8_WAIT_L
#undef PG8_BAR
#undef PG8_SCHED
}
}

constexpr int REP_SCORE = 1, REP_SEL = 1, REP_ATT = 1;

#include <hip/hip_cooperative_groups.h>
namespace cg = cooperative_groups;
#define LAS __attribute__((address_space(3)))
constexpr int LDS_BYTES = 163840, HALO_OFF = 133120, PT_OFF = 163328, NTHR = 512, NWAVE = 8;
constexpr size_t MiB = (size_t)1 << 20;
constexpr size_t WS_CTL = 0, WS_WIN = 1 * MiB, WS_WOUT = 21 * MiB, WS_WGU = 31 * MiB, WS_WDN = 75 * MiB, WS_METAX = 97 * MiB, WS_RSTD = 98 * MiB, WS_UF = 99 * MiB,
                 WS_DT = 104 * MiB, WS_FCUM = 106 * MiB, WS_CN = 108 * MiB, WS_MASK = 117 * MiB, WS_XB = 134 * MiB, WS_Y = 264 * MiB, WS_R1 = 426 * MiB, WS_XC = WS_R1 + 323 * MiB,
                 WS_YA = 814 * MiB, WS_END = 879 * MiB;
static_assert(WS_WIN + (size_t)NU * DM * 2 <= WS_WOUT && WS_WOUT + (size_t)DM * KOUT * 2 <= WS_WGU && WS_WGU + (size_t)NGU * DM * 2 <= WS_WDN && WS_WDN + (size_t)DM * FF * 2 <= WS_METAX, "ws weights");
static_assert(WS_UF + (size_t)MP * 32 * 4 <= WS_DT && WS_DT + (size_t)T * 8 * 4 <= WS_FCUM && WS_FCUM + (size_t)64 * LKP * 4 <= WS_CN && WS_CN + (size_t)MP * 128 * 2 <= WS_MASK && WS_MASK + (size_t)T * NMW * 8 <= WS_XB, "ws small");
static_assert(WS_XB + (size_t)(MP + 8) * DM * 2 <= WS_Y && WS_Y + (size_t)MP * KOUT * 2 <= WS_R1 && WS_R1 + (size_t)MP * NU * 2 <= WS_XC && WS_XC + (size_t)MP * 1024 * 2 <= WS_YA && WS_R1 + (size_t)MP * FF * 2 <= WS_YA && WS_YA + (size_t)T * 512 * 4 <= WS_END, "ws big");

typedef unsigned u32x4v __attribute__((ext_vector_type(4)));
typedef unsigned u32x2v __attribute__((ext_vector_type(2)));
typedef float f32x4v __attribute__((ext_vector_type(4)));
struct Args { const float* in[25]; float* out; unsigned char* ws; };

struct Ctx {
    int tid, lane, wave, gw, ngw, bid, nb;
    LAS unsigned char* lds;
};
__device__ __forceinline__ Ctx refresh(const Ctx& c0) {
    Ctx c = c0; unsigned z = 0u; int w_ = c0.wave, b_ = (int)blockIdx.x, n_ = (int)gridDim.x; asm volatile("" : "+v"(z), "+s"(w_), "+s"(b_), "+s"(n_));
    const int lane = (int)__builtin_amdgcn_mbcnt_hi(~0u, __builtin_amdgcn_mbcnt_lo(~0u, z));
    c.bid = b_; c.nb = n_; c.ngw = n_ * NWAVE; c.wave = w_; c.lane = lane; c.tid = w_ * 64 + lane; c.gw = b_ * NWAVE + w_;
    { unsigned l_ = (unsigned)(size_t)c0.lds; asm volatile("" : "+s"(l_)); c.lds = (LAS unsigned char*)(size_t)l_; }
    return c;
}
__device__ __forceinline__ unsigned char* pt_get(const Ctx& c, int i) {
    unsigned l_ = (unsigned)(size_t)c.lds; asm volatile("" : "+s"(l_));
    const LAS unsigned* p = (const LAS unsigned*)((LAS unsigned char*)(size_t)l_ + PT_OFF) + 2 * i;
    const unsigned lo = __builtin_amdgcn_readfirstlane(p[0]), hi = __builtin_amdgcn_readfirstlane(p[1]);
    __attribute__((address_space(1))) unsigned char* gp = (__attribute__((address_space(1))) unsigned char*)(((unsigned long long)hi << 32) | lo);
    return (unsigned char*)gp;
}
#define INP(i) ((const float*)pt_get(c, (i)))

#define GAS __attribute__((address_space(1)))
typedef unsigned v4u __attribute__((ext_vector_type(4)));
typedef GAS unsigned gu32;
typedef GAS unsigned long long gu64;
#define RLX_AGENT __ATOMIC_RELAXED, __HIP_MEMORY_SCOPE_AGENT
#define LDS_WAIT() asm volatile("s_waitcnt lgkmcnt(0)" ::: "memory")
#define VM_WAIT() asm volatile("s_waitcnt vmcnt(0)" ::: "memory")
__device__ __forceinline__ unsigned long long rt() { return __builtin_amdgcn_s_memrealtime(); }

#define XB_TMO      128
#define XB_XCNT(j)  (256  + 64 * (j))
#define XB_XSUB(j)  (1280 + 64 * (j))
#define XB_XGEN(j)  (2304 + 64 * (j))
#define XB_TOP      3328
#define XB_TOPGEN   3392
#define XCD_BAR_WORDS 3456
#define XB_SPIN_CAP (1u << 18)

__device__ __forceinline__ unsigned xb_ld(unsigned* p)              { return __hip_atomic_load(p, __ATOMIC_RELAXED, __HIP_MEMORY_SCOPE_AGENT); }
__device__ __forceinline__ unsigned xb_add(unsigned* p, unsigned v) { return __hip_atomic_fetch_add(p, v, __ATOMIC_RELAXED, __HIP_MEMORY_SCOPE_AGENT); }
__device__ __forceinline__ unsigned xb_xcc_id() { return (unsigned)__builtin_amdgcn_s_getreg((3 << 11) | 20) & 0xFu; }
#define XB_SPIN(cond, bar) do { unsigned _sp = 0; while (cond) { __builtin_amdgcn_s_sleep(1); \
    if ((++_sp & 255u) == 0u) { if (xb_ld(&(bar)[XB_TMO])) break; if (_sp > XB_SPIN_CAP) { atomicAdd(&(bar)[XB_TMO], 1u); break; } } } } while (0)

struct XcdBarrier {
    unsigned* bar; unsigned x;
    volatile LAS unsigned* st;
};

__device__ __forceinline__ XcdBarrier xcd_barrier_post(unsigned* bar, volatile LAS unsigned* st, int tid) {
    XcdBarrier b; b.bar = bar; b.x = xb_xcc_id(); b.st = st;
    if (tid == 0) (void)xb_add(&bar[XB_XCNT(b.x)], 1u);
    return b;
}
__device__ __forceinline__ void xcd_barrier_complete(unsigned* bar, unsigned x, unsigned& nloc, unsigned& nx) {
    const unsigned G = gridDim.x * gridDim.y * gridDim.z;
    unsigned sum, cnt, mine, sp = 0u;
    for (;;) {
        sum = 0u; cnt = 0u; mine = 0u;
#pragma unroll
        for (unsigned j = 0; j < 16; ++j) { const unsigned c = xb_ld(&bar[XB_XCNT(j)]); sum += c; cnt += (c > 0u) ? 1u : 0u; mine = (j == x) ? c : mine; }
        if (sum == G) break;
        __builtin_amdgcn_s_sleep(1);
        if ((++sp & 255u) == 0u) { if (xb_ld(&bar[XB_TMO])) break; if (sp > XB_SPIN_CAP) { atomicAdd(&bar[XB_TMO], 1u); break; } }
    }
    nloc = mine > 0u ? mine : 1u; nx = cnt > 0u ? cnt : 1u;
}

__device__ __forceinline__ void xcd_barrier(const XcdBarrier& b, int tid) {
    asm volatile("s_waitcnt vmcnt(0)" ::: "memory");
    __syncthreads();
    if (tid == 0) {
        unsigned* bar = b.bar;
        __builtin_amdgcn_s_waitcnt(0);
        unsigned nloc = b.st[0], nx = b.st[1];
        if (nloc == 0u) { xcd_barrier_complete(bar, b.x, nloc, nx); b.st[0] = nloc; b.st[1] = nx; }
        const unsigned old = xb_add(&bar[XB_XSUB(b.x)], 1u);
        const unsigned gen = old / nloc;
        if (old + 1u == (gen + 1u) * nloc) {
            __builtin_amdgcn_fence(__ATOMIC_RELEASE, "agent");
            asm volatile("s_waitcnt vmcnt(0)" ::: "memory");
            const unsigned og = xb_add(&bar[XB_TOP], 1u);
            const unsigned tg = og / nx;
            if (og + 1u == (tg + 1u) * nx) xb_add(&bar[XB_TOPGEN], 1u);
            else XB_SPIN(xb_ld(&bar[XB_TOPGEN]) == tg, bar);
            __builtin_amdgcn_fence(__ATOMIC_ACQUIRE, "agent");
            xb_add(&bar[XB_XGEN(b.x)], 1u);
            asm volatile("s_waitcnt vmcnt(0)" ::: "memory");
        } else {
            XB_SPIN(xb_ld(&bar[XB_XGEN(b.x)]) == gen, bar);
            __builtin_amdgcn_fence(__ATOMIC_ACQUIRE, "agent");
            asm volatile("s_waitcnt vmcnt(0)" ::: "memory");
        }
    }
    __syncthreads();
}

constexpr int MISC_OFF = 163072, CW_BAR = 4096;
__device__ __forceinline__ void grid_barrier(const Ctx& c0) {
    const Ctx c = refresh(c0);
    XcdBarrier b; b.bar = (unsigned*)(pt_get(c, 26) + WS_CTL) + CW_BAR; b.x = xb_xcc_id(); b.st = (volatile LAS unsigned*)(c.lds + MISC_OFF);
    xcd_barrier(b, c.tid);
}
__device__ __forceinline__ void ph_prep_x(const Ctx& c0, const float* x, const float* meta, bf16* XB, float* RSTD) { const Ctx c = refresh(c0);
    const int lane = c.lane;
    for (int w = c.gw; w < MP + 8; w += c.ngw) {
        const int t = w - 8; bf16* xb = XB + (ptrdiff_t)t * DM;
        if (t < 0 || t >= T) {
#pragma unroll
            for (int j = 0; j < 4; ++j) *(u32x4v*)(xb + 8 * lane + 512 * j) = (u32x4v){0u, 0u, 0u, 0u};
            if (t >= T && lane == 0) RSTD[t] = 0.f;
            continue;
        }
        const int b = t / L, p = t - b * L;
        const float* src = p < NMETA ? meta + (size_t)p * DM : x + ((size_t)b * SEQ + (p - NMETA)) * DM;
        float ss = 0.f;
#pragma unroll
        for (int j = 0; j < 4; ++j) {
            const f32x4v a = *(const f32x4v*)(src + 8 * lane + 512 * j), cc = *(const f32x4v*)(src + 8 * lane + 512 * j + 4);
            ss += a.x * a.x + a.y * a.y + a.z * a.z + a.w * a.w + cc.x * cc.x + cc.y * cc.y + cc.z * cc.z + cc.w * cc.w;
            *(u32x4v*)(xb + 8 * lane + 512 * j) = (u32x4v){pk2(a.x, a.y), pk2(a.z, a.w), pk2(cc.x, cc.y), pk2(cc.z, cc.w)};
        }
        ss = wave_sum(ss, lane);
        if (lane == 0) RSTD[t] = rsqrtf(ss * (1.f / DM) + EPSF);
    }
}

template <class F> __device__ __forceinline__ void transpose_tiles(const Ctx& c, bf16* dst, int Kd, int N, const F& val) {
    LAS float* tile = (LAS float*)c.lds + (c.tid >> 8) * (32 * 33);
    const int t2 = c.tid & 255, tx = t2 & 31, ty = t2 >> 5, ntk = Kd / 32, ntiles = ntk * (N / 32);
    for (int it = 2 * c.bid + (c.tid >> 8); it < ntiles; it += 2 * c.nb) {
        const int k0 = (it % ntk) * 32, n0 = (it / ntk) * 32;
#pragma unroll
        for (int i = 0; i < 4; ++i) tile[(ty + 8 * i) * 33 + tx] = val(k0 + ty + 8 * i, n0 + tx);
        __syncthreads();
#pragma unroll
        for (int i = 0; i < 4; ++i) dst[(size_t)(n0 + ty + 8 * i) * Kd + k0 + tx] = f2bf(tile[tx * 33 + ty + 8 * i]);
        __syncthreads();
    }
}
__device__ __forceinline__ void ph_prep_w(const Ctx& c0, int ly, bf16* WIN, bf16* WOUT, bf16* WGU, bf16* WDN) { const Ctx c = refresh(c0);
    {   const float* w_in = INP(6) + (size_t)ly * DM * DIN; const float* g = INP(2) + (size_t)ly * DM; const float* w_uk = INP(17) + (size_t)ly * 8 * 128 * 64;
        transpose_tiles(c, WIN, DM, NU, [=](int k, int n) -> float {
            int src = -1;
            if (n < C_XBC) src = n;
            else if (n < C_POOL) src = 512 + (n - C_XBC);
            else if (n < C_FQ) src = 1544 + (n - C_POOL);
            else if (n < C_QLAT) src = 2056 + (n - C_FQ);
            else if (n < C_DC) { const int h = (n - C_QLAT) >> 7, r = (n - C_QLAT) & 127; const float* wq = w_in + (size_t)k * DIN + 3600 + 64 * h; const float* wu = w_uk + ((size_t)h * 128 + r) * 64;
                float s = 0.f;
                for (int d = 0; d < 64; ++d) s += wq[d] * wu[d];
                return s * (0.125f * 1.4426950408889634f) * g[k]; }
            else if (n < C_QI) src = 4112 + (n - C_DC);
            else if (n < C_KI) src = 4240 + (n - C_QI);
            else if (n < C_SM) src = 4496 + (n - C_KI);
            else if (n < C_SM + 8) src = 1536 + (n - C_SM);
            else if (n < C_SM + 16) src = 3592 + (n - C_SM - 8);
            else if (n < C_SM + 20) src = 4560 + (n - C_SM - 16);
            return src >= 0 ? w_in[(size_t)k * DIN + src] * g[k] : 0.f; }); }
    {   const float* w_out = INP(19) + (size_t)ly * DM * DM; const float* ssd_norm = INP(12) + (size_t)ly * 512; const float* pool_w = INP(13) + (size_t)ly * 4 * 128 * 128;
        const float* pool_scale = INP(14) + (size_t)ly * 512; const float* w_uv = INP(18) + (size_t)ly * 8 * 128 * 64;
        transpose_tiles(c, WOUT, KOUT, DM, [=](int k, int n) -> float {
            if (k < 512) return ssd_norm[k] * w_out[(size_t)k * DM + n];
            if (k < 1024) { const int gi = (k - 512) >> 7, cc = (k - 512) & 127; const float* pw = pool_w + ((size_t)gi * 128 + cc) * 128; float s = 0.f;
                for (int d = 0; d < 128; ++d) s += pw[d] * pool_scale[128 * gi + d] * w_out[(size_t)(512 + 128 * gi + d) * DM + n];
                return s; }
            if (k < 1536) return w_out[(size_t)k * DM + n];
            const int h = (k - 1536) >> 7, r = (k - 1536) & 127; const float* wv = w_uv + ((size_t)h * 128 + r) * 64; float s = 0.f;
            for (int d = 0; d < 64; ++d) s += wv[d] * w_out[(size_t)(1536 + 64 * h + d) * DM + n];
            return s; }); }
    {   const float* wg = INP(20) + (size_t)ly * DM * FF; const float* wu = INP(21) + (size_t)ly * DM * FF; const float* g = INP(4) + (size_t)ly * DM;
        transpose_tiles(c, WGU, DM, NGU, [=](int k, int n) -> float { const int pn = n >> 8, w = n & 255, ch = 128 * pn + (w & 127); return ((w >> 7) ? wu : wg)[(size_t)k * FF + ch] * g[k]; }); }
    {   const float* wd = INP(24) + (size_t)ly * FF * DM;
        transpose_tiles(c, WDN, FF, DM, [=](int k, int n) -> float { return wd[(size_t)k * DM + n]; }); }
}

__device__ __forceinline__ void ph_mixprep(const Ctx& c0, const bf16* U, const float* UF, const float* cw, const float* cb, const float* kvn, const float* dtb, bf16* XC, bf16* Y, bf16* CN, float* DT, bf16* KI) { const Ctx c = refresh(c0);
    const int gt = c.bid * NTHR + c.tid, ngt = c.nb * NTHR;
    for (int idx = gt; idx < T * 128; idx += ngt) {
        const int t = idx >> 7, c0 = (idx & 127) * 8, pos = t % L; float acc[8];
#pragma unroll
        for (int j = 0; j < 8; ++j) acc[j] = cb[c0 + j];
#pragma unroll
        for (int k = 0; k < 4; ++k) {
            if (pos - 3 + k < 0) continue;
            const uint4 v = *(const uint4*)(U + (size_t)(t - 3 + k) * NU + C_XBC + c0); const unsigned w[4] = {v.x, v.y, v.z, v.w};
#pragma unroll
            for (int j = 0; j < 8; ++j) acc[j] += cw[k * 1024 + c0 + j] * bf2f((bf16)(w[j >> 1] >> (16 * (j & 1))));
        }
        *(uint4*)(XC + (size_t)t * 1024 + c0) = make_uint4(pk2(siluf(acc[0]), siluf(acc[1])), pk2(siluf(acc[2]), siluf(acc[3])), pk2(siluf(acc[4]), siluf(acc[5])), pk2(siluf(acc[6]), siluf(acc[7])));
    }
    for (int idx = gt; idx < T * 64; idx += ngt) {
        const int t = idx >> 6, c0 = (idx & 63) * 8, pos = t % L, gi = c0 >> 7, win = 2 << gi, n = min(pos + 1, win);
        float acc[8] = {0, 0, 0, 0, 0, 0, 0, 0}, self[8] = {0, 0, 0, 0, 0, 0, 0, 0};
        for (int i = 0; i < n; ++i) {
            const uint4 v = *(const uint4*)(U + (size_t)(t - i) * NU + C_POOL + c0); const unsigned w[4] = {v.x, v.y, v.z, v.w};
#pragma unroll
            for (int j = 0; j < 8; ++j) { const float f = bf2f((bf16)(w[j >> 1] >> (16 * (j & 1)))); acc[j] += f; if (i == 0) self[j] = f; }
        }
        const float inv = 1.f / (float)n; float o[8];
#pragma unroll
        for (int j = 0; j < 8; ++j) o[j] = acc[j] * inv - self[j];
        *(uint4*)(Y + (size_t)t * KOUT + 512 + c0) = make_uint4(pk2(o[0], o[1]), pk2(o[2], o[3]), pk2(o[4], o[5]), pk2(o[6], o[7]));
    }
    for (int t = c.gw; t < T; t += c.ngw) {
        const int lane = c.lane;
        const unsigned v = *(const unsigned*)(U + (size_t)t * NU + C_DC + 2 * lane);
        const float a = bf2f((bf16)(v & 0xffff)), cc = bf2f((bf16)(v >> 16));
        const float rs = rsqrtf(wave_sum(a * a + cc * cc, lane) * (1.f / 128.f) + EPSF);
        *(unsigned*)(CN + (size_t)t * 128 + 2 * lane) = pk2(a * rs * kvn[2 * lane], cc * rs * kvn[2 * lane + 1]);
        if (lane < 8) DT[(size_t)t * 8 + lane] = softplusf(UF[(size_t)t * 32 + lane] + dtb[lane]);
        if (lane < 32) *(unsigned*)(KI + (size_t)t * 64 + 2 * lane) = *(const unsigned*)(U + (size_t)t * NU + C_KI + 2 * lane);
    }
}
__device__ __forceinline__ void ph_fcum(const Ctx& c0, const float* UF, const float* fb, float* FCUM) { const Ctx c = refresh(c0);
    const int lane = c.lane;
    for (int bh = c.gw; bh < 64; bh += c.ngw) {
        const int b = bh >> 3, h = bh & 7; float carry = 0.f; const float bias = fb[h];
        for (int base = 0; base < LKP; base += 64) {
            const int p = base + lane; float v = p < L ? logsigmoidf(UF[(size_t)(b * L + p) * 32 + 8 + h] + bias) : 0.f;
#pragma unroll
            for (int o = 1; o < 64; o <<= 1) { const float n = lane_read(v, (lane - o) & 63); if (lane >= o) v += n; }
            v += carry; FCUM[(size_t)bh * LKP + p] = v; carry = lane_read(v, 63);
        }
    }
}
__device__ __forceinline__ unsigned fkey(float f) { const unsigned u = __float_as_uint(f); return (u & 0x80000000u) ? ~u : (u | 0x80000000u); }
__device__ __forceinline__ int crow(int r, int hi) { return (r & 3) + 8 * (r >> 2) + 4 * hi; }
typedef short bf16x8 __attribute__((ext_vector_type(8)));
typedef float f32x16 __attribute__((ext_vector_type(16)));
typedef float f32x2v __attribute__((ext_vector_type(2)));
typedef __bf16 bf16x2v __attribute__((ext_vector_type(2)));
#define MFMA32(a, b, c) __builtin_amdgcn_mfma_f32_32x32x16_bf16((a), (b), (c), 0, 0, 0)
__device__ __forceinline__ unsigned cvtpk(float lo, float hi) { f32x2v v = {lo, hi}; bf16x2v b = __builtin_convertvector(v, bf16x2v); return __builtin_bit_cast(unsigned, b); }
__device__ __forceinline__ bf16x8 pack8(const f32x16& p, int s) {
    u32x4v r; r.x = cvtpk(p[8 * s], p[8 * s + 1]); r.y = cvtpk(p[8 * s + 2], p[8 * s + 3]); r.z = cvtpk(p[8 * s + 4], p[8 * s + 5]); r.w = cvtpk(p[8 * s + 6], p[8 * s + 7]);
    return __builtin_bit_cast(bf16x8, r);
}
constexpr int AT_KSTR = 72;
__device__ __forceinline__ void ph_fox(const Ctx& c0, const bf16* U, const float* FCUM, bf16* Y) {
    const Ctx c = refresh(c0);
    LAS bf16* KS = (LAS bf16*)c.lds;
    LAS bf16* VT = KS + 64 * AT_KSTR;
    LAS float* FB = (LAS float*)(c.lds + 2 * 64 * AT_KSTR * 2);
    const int lane = c.lane, w = c.wave, r32 = lane & 31, hi = lane >> 5, tid = c.tid;
    const float C2 = 0.18033688011112042f, LOG2E = 1.4426950408889634f;
    for (int it = c.bid; it < 64 * 17; it += c.nb) {
        const int rnd = it >> 8, cu = it & 255, k4 = cu >> 6, bh = cu & 63, b = bh >> 3, h = bh & 7;
        const int j = rnd == 0 ? 16 - k4 : rnd == 1 ? 9 + k4 : rnd == 2 ? 8 - k4 : rnd == 3 ? 1 + k4 : 0;
        const int q0 = j == 0 ? 0 : 16 + 256 * (j - 1), qrow = q0 + 32 * w + r32, ntiles = 1 + 4 * j;
        const bool wave_on = (j > 0) || (w == 0), row_ok = (j > 0) || (r32 < 16);
        const bf16* Ub = U + (size_t)(b * L) * NU;
        bf16x8 qf[4];
#pragma unroll
        for (int s = 0; s < 4; ++s) qf[s] = (bf16x8){0, 0, 0, 0, 0, 0, 0, 0};
        if (wave_on && row_ok) {
#pragma unroll
            for (int s = 0; s < 4; ++s) qf[s] = *(const bf16x8*)(Ub + (size_t)qrow * NU + C_FQ + 64 * h + 16 * s + 8 * hi);
        }
        f32x16 o0, o1;
#pragma unroll
        for (int r = 0; r < 16; ++r) { o0[r] = 0.f; o1[r] = 0.f; }
        float m = -1e30f, l = 0.f;
        const float* fc = FCUM + (size_t)bh * LKP;
        u32x4v kreg, vreg; float fbreg = 0.f;
        {   const int kb = 0;
            kreg = *(const u32x4v*)(Ub + (size_t)(kb + (tid >> 3)) * NU + C_FK + 64 * h + 8 * (tid & 7));
            vreg = *(const u32x4v*)(Ub + (size_t)(kb + lane) * NU + C_FV + 64 * h + 8 * w);
            if (tid < 64) fbreg = fc[kb + tid] * LOG2E; }
        for (int i = 0; i < ntiles; ++i) {
            const int kb = i == 0 ? 0 : 16 + 64 * (i - 1);
            *(LAS u32x4v*)(KS + (tid >> 3) * AT_KSTR + 8 * (tid & 7)) = kreg;
            {   const unsigned vv[4] = {vreg.x, vreg.y, vreg.z, vreg.w};
#pragma unroll
                for (int e = 0; e < 8; ++e) VT[(8 * w + e) * AT_KSTR + lane] = (bf16)(vv[e >> 1] >> (16 * (e & 1))); }
            if (tid < 64) FB[tid] = fbreg;
            __syncthreads();
            if (i + 1 < ntiles) { const int kn = 16 + 64 * i;
                kreg = *(const u32x4v*)(Ub + (size_t)(kn + (tid >> 3)) * NU + C_FK + 64 * h + 8 * (tid & 7));
                vreg = *(const u32x4v*)(Ub + (size_t)(kn + lane) * NU + C_FV + 64 * h + 8 * w);
                if (tid < 64) fbreg = fc[kn + tid] * LOG2E; }
            if (wave_on && kb <= q0 + 32 * w + 31) {
                f32x16 p0, p1;
#pragma unroll
                for (int r = 0; r < 16; ++r) { p0[r] = 0.f; p1[r] = 0.f; }
#pragma unroll
                for (int s = 0; s < 4; ++s) {
                    const bf16x8 a0 = *(const LAS bf16x8*)(KS + r32 * AT_KSTR + 16 * s + 8 * hi), a1 = *(const LAS bf16x8*)(KS + (32 + r32) * AT_KSTR + 16 * s + 8 * hi);
                    p0 = MFMA32(a0, qf[s], p0); p1 = MFMA32(a1, qf[s], p1);
                }
#pragma unroll
                for (int i4 = 0; i4 < 4; ++i4) {
                    const f32x4v f0 = *(const LAS f32x4v*)(FB + 8 * i4 + 4 * hi), f1 = *(const LAS f32x4v*)(FB + 32 + 8 * i4 + 4 * hi);
#pragma unroll
                    for (int e = 0; e < 4; ++e) { p0[4 * i4 + e] = p0[4 * i4 + e] * C2 - f0[e]; p1[4 * i4 + e] = p1[4 * i4 + e] * C2 - f1[e]; }
                }
                if (i == 0 || kb + 63 > q0 + 32 * w) {
                    const int klim = i == 0 ? 16 : 64;
#pragma unroll
                    for (int r = 0; r < 16; ++r) { const int k0 = crow(r, hi), k1 = 32 + k0;
                        if (!(k0 < klim && kb + k0 <= qrow)) p0[r] = -1e30f;
                        if (!(k1 < klim && kb + k1 <= qrow)) p1[r] = -1e30f; }
                }
                float mx = fmaxf(p0[0], p1[0]);
#pragma unroll
                for (int r = 1; r < 16; ++r) mx = fmaxf(mx, fmaxf(p0[r], p1[r]));
                mx = fmaxf(mx, lane_read(mx, lane ^ 32));
                const float mn = fmaxf(m, mx), alpha = __builtin_amdgcn_exp2f(m - mn); const bool grew = __ballot(mn > m) != 0ull; m = mn;
                float sum = 0.f;
#pragma unroll
                for (int r = 0; r < 16; ++r) { p0[r] = __builtin_amdgcn_exp2f(p0[r] - mn); p1[r] = __builtin_amdgcn_exp2f(p1[r] - mn); sum += p0[r] + p1[r]; }
                l = l * alpha + sum;
                if (grew) {
#pragma unroll
                    for (int r = 0; r < 16; ++r) { o0[r] *= alpha; o1[r] *= alpha; } }
#pragma unroll
                for (int blk = 0; blk < 2; ++blk)
#pragma unroll
                    for (int s = 0; s < 2; ++s) {
                        const bf16x8 xs = pack8(blk == 0 ? p0 : p1, s);
                        typedef short s16x4v __attribute__((ext_vector_type(4)));
                        const LAS bf16* vp = VT + r32 * AT_KSTR + 32 * blk + 16 * s + 4 * hi;
                        const s16x4v lo0 = *(const LAS s16x4v*)vp, hi0 = *(const LAS s16x4v*)(vp + 8);
                        const s16x4v lo1 = *(const LAS s16x4v*)(vp + 32 * AT_KSTR), hi1 = *(const LAS s16x4v*)(vp + 32 * AT_KSTR + 8);
                        const bf16x8 pa0 = __builtin_shufflevector(lo0, hi0, 0, 1, 2, 3, 4, 5, 6, 7), pa1 = __builtin_shufflevector(lo1, hi1, 0, 1, 2, 3, 4, 5, 6, 7);
                        o0 = MFMA32(pa0, xs, o0); o1 = MFMA32(pa1, xs, o1);
                    }
            }
            __syncthreads();
        }
        l += lane_read(l, lane ^ 32);
        if (wave_on && row_ok) {
            const float inv = 1.f / l; bf16* yr = Y + (size_t)(b * L + qrow) * KOUT + 1024 + 64 * h;
#pragma unroll
            for (int i4 = 0; i4 < 4; ++i4) {
                *(u32x2v*)(yr + 8 * i4 + 4 * hi) = (u32x2v){cvtpk(o0[4 * i4] * inv, o0[4 * i4 + 1] * inv), cvtpk(o0[4 * i4 + 2] * inv, o0[4 * i4 + 3] * inv)};
                *(u32x2v*)(yr + 32 + 8 * i4 + 4 * hi) = (u32x2v){cvtpk(o1[4 * i4] * inv, o1[4 * i4 + 1] * inv), cvtpk(o1[4 * i4 + 2] * inv, o1[4 * i4 + 3] * inv)};
            }
        }
    }
}

constexpr int DSA_BUF_ELEMS = 17920  , DSA_SC_STR = 4160, DSA_MW_OFF = 8 * DSA_SC_STR * 4  , DSA_KSTR = 136, DSA_VT_OFF = 64 * DSA_KSTR * 2  ;
__device__ __forceinline__ void ph_dsa(const Ctx& c0, const bf16* U, const float* UF, const bf16* CN, const bf16* KI, bf16* Y) {
    const Ctx c = refresh(c0);
    LAS unsigned* SC = (LAS unsigned*)c.lds;
    LAS u64* MW = (LAS u64*)(c.lds + DSA_MW_OFF);
    LAS bf16* KS = (LAS bf16*)c.lds;
    LAS bf16* VT = (LAS bf16*)(c.lds + DSA_VT_OFF);
    const int lane = c.lane, w = c.wave, r32 = lane & 31, hi = lane >> 5, tid = c.tid;
    const float LOG2E = 1.4426950408889634f;
    for (int it = c.bid; it < 1032; it += c.nb) {
        const int rnd = it >> 8, cu = it & 255, g16 = cu >> 4, wi16 = cu & 15;
        const int ch = rnd == 0 ? 64 - g16 : rnd == 1 ? 33 + g16 : rnd == 2 ? 32 - g16 : rnd == 3 ? 1 + g16 : 0;
        const int b = rnd == 4 ? cu : (wi16 >> 1), half = rnd == 4 ? 0 : (wi16 & 1);
        const int p0q = ch == 0 ? 0 : 16 + 64 * (ch - 1) + 32 * half, nq = ch == 0 ? 16 : 32, nadm = ch == 0 ? 16 : 16 + 64 * ch, nw = ch + 1;
        const int t0 = b * L + p0q;
        const bf16* Ub = U + (size_t)(b * L) * NU;
        if (nadm <= TOPK) {
            for (int i = tid; i < 32 * 65; i += NTHR) { const int wd = i % 65; const int lo = 64 * wd; const int nb_ = nadm - lo;
                MW[i] = (wd < nw && nb_ > 0) ? (nb_ >= 64 ? ~0ull : ((1ull << nb_) - 1ull)) : 0ull; }
            __syncthreads();
        } else {
            const int nkb = 2 * nw;
#pragma unroll 1
            for (int sb = 0; sb < 4; ++sb) {
                const int tq = t0 + 8 * sb;
                for (int rs_ = 0; rs_ < REP_SCORE; ++rs_) {
                    bf16x8 aq[4]; float wq[4][4];
#pragma unroll
                    for (int s = 0; s < 4; ++s) aq[s] = *(const bf16x8*)(U + (size_t)(tq + (r32 >> 2)) * NU + C_QI + 64 * (r32 & 3) + 32 * hi + 8 * s);
#pragma unroll
                    for (int i4 = 0; i4 < 4; ++i4) { const f32x4v t4 = *(const f32x4v*)(UF + (size_t)(tq + 2 * i4 + hi) * 32 + 16); wq[i4][0] = t4[0]; wq[i4][1] = t4[1]; wq[i4][2] = t4[2]; wq[i4][3] = t4[3]; }
                    const bf16* kib = KI + (size_t)(b * L) * 64 + (size_t)r32 * 64 + 32 * hi;
                    bf16x8 bk[4], bn[4], bm[4];
#pragma unroll
                    for (int s = 0; s < 4; ++s) { bk[s] = *(const bf16x8*)(kib + (size_t)(32 * w) * 64 + 8 * s); bn[s] = bk[s]; bm[s] = bk[s]; }
                    if (w + NWAVE < nkb) {
#pragma unroll
                        for (int s = 0; s < 4; ++s) bn[s] = *(const bf16x8*)(kib + (size_t)(32 * (w + NWAVE)) * 64 + 8 * s); }
#pragma unroll 1
                    for (int kb = w; kb < nkb; kb += NWAVE) {
                        if (kb + 2 * NWAVE < nkb) {
#pragma unroll
                            for (int s = 0; s < 4; ++s) bm[s] = *(const bf16x8*)(kib + (size_t)(32 * (kb + 2 * NWAVE)) * 64 + 8 * s); }
                        const int key = 32 * kb + r32; f32x16 acc;
#pragma unroll
                        for (int r = 0; r < 16; ++r) acc[r] = 0.f;
#pragma unroll
                        for (int s = 0; s < 4; ++s) acc = MFMA32(aq[s], bk[s], acc);
#pragma unroll
                        for (int i4 = 0; i4 < 4; ++i4) {
                            float s = wq[i4][0] * fmaxf(acc[4 * i4], 0.f) + wq[i4][1] * fmaxf(acc[4 * i4 + 1], 0.f) + wq[i4][2] * fmaxf(acc[4 * i4 + 2], 0.f) + wq[i4][3] * fmaxf(acc[4 * i4 + 3], 0.f);
                            if (s == 0.f) s = 0.f;
                            SC[(2 * i4 + hi) * DSA_SC_STR + key] = key < nadm ? fkey(s) : 0u;
                        }
#pragma unroll
                        for (int s = 0; s < 4; ++s) { bk[s] = bn[s]; bn[s] = bm[s]; }
                    }
                }
                __syncthreads();
                for (int rs_ = 0; rs_ < REP_SEL; ++rs_) {
                    unsigned kk[65];
#pragma unroll
                    for (int j = 0; j < 65; ++j) kk[j] = 0u;
#define DSA_BUCKETS(F) { F(0, 17) if (nw > 17) { F(17, 33) } if (nw > 33) { F(33, 49) } if (nw > 49) { F(49, 65) } }
#define DSA_LOAD(j0, j1) _Pragma("unroll") for (int j = j0; j < j1; ++j) kk[j] = SC[w * DSA_SC_STR + 64 * j + lane];
                    DSA_BUCKETS(DSA_LOAD)
#pragma unroll
                    for (int j = 0; j < 65; ++j) if (j >= 5) kk[j] = j < nw ? kk[j] : 0u;
                    unsigned tau = 0u; bool exact = false;
#pragma unroll 1
                    for (int bit = 31; bit >= 0; --bit) {
                        const unsigned cand = tau | (1u << bit); int nl = 0;
#define DSA_CNT(j0, j1) _Pragma("unroll") for (int j = j0; j < j1; ++j) nl += kk[j] >= cand ? 1 : 0;
                        DSA_BUCKETS(DSA_CNT)
                        int n = 0;
#pragma unroll
                        for (int k = 0; k < 7; ++k) n += __popcll(__ballot((nl >> k) & 1)) << k;
                        if (n >= TOPK) tau = cand;
                        if (n == TOPK) { exact = true; break; }
                    }
                    int need = 0;
                    if (!exact) { int n = 0;
#define DSA_CNTGT(j0, j1) _Pragma("unroll") for (int j = j0; j < j1; ++j) n += __popcll(__ballot(kk[j] > tau));
                        DSA_BUCKETS(DSA_CNTGT)
                        need = TOPK - n; }
                    int run = 0; u64 mine0 = 0ull, mine1 = 0ull;
#define DSA_SEL(j0, j1) _Pragma("unroll") for (int j = j0; j < j1; ++j) { bool sel; \
                        if (exact) sel = kk[j] >= tau; \
                        else { const bool eq = kk[j] == tau; const u64 be = __ballot(eq); const int rank = run + __popcll(be & ((1ull << lane) - 1ull)); sel = kk[j] > tau || (eq && rank < need); run += __popcll(be); } \
                        const u64 bs = __ballot(sel); if (j < 64) { if (lane == j) mine0 = bs; } else mine1 = bs; }
                    DSA_BUCKETS(DSA_SEL)
                    MW[(8 * sb + w) * 65 + lane] = lane < nw ? mine0 : 0ull;
                    if (lane == 0) MW[(8 * sb + w) * 65 + 64] = nw > 64 ? mine1 : 0ull;
                }
                __syncthreads();
            }
        }
        for (int ra_ = 0; ra_ < REP_ATT; ++ra_) {
        bf16x8 qf[8];
#pragma unroll
        for (int s = 0; s < 8; ++s) qf[s] = (bf16x8){0, 0, 0, 0, 0, 0, 0, 0};
        if (r32 < nq) {
#pragma unroll
            for (int s = 0; s < 8; ++s) qf[s] = *(const bf16x8*)(U + (size_t)(t0 + r32) * NU + C_QLAT + 128 * w + 16 * s + 8 * hi);
        }
        f32x16 o[4];
#pragma unroll
        for (int db = 0; db < 4; ++db)
#pragma unroll
            for (int r = 0; r < 16; ++r) o[db][r] = 0.f;
        float m = -1e4f, l = 0.f;
        const bf16* Cb = CN + (size_t)(b * L) * 128;
        u32x4v kr0, kr1, vr0, vr1;
        {   const bf16* kp = Cb + (size_t)(tid >> 3) * 128 + 16 * (tid & 7); kr0 = *(const u32x4v*)kp; kr1 = *(const u32x4v*)(kp + 8);
            const bf16* vp = Cb + (size_t)lane * 128 + 16 * w; vr0 = *(const u32x4v*)vp; vr1 = *(const u32x4v*)(vp + 8); }
#define DSA_STAGE(buf) do { LAS bf16* ks_ = KS + (buf) * DSA_BUF_ELEMS; LAS bf16* vt_ = VT + (buf) * DSA_BUF_ELEMS; \
            LAS bf16* kd = ks_ + (tid >> 3) * DSA_KSTR + 16 * (tid & 7); *(LAS u32x4v*)kd = kr0; *(LAS u32x4v*)(kd + 8) = kr1; \
            const unsigned vv[8] = {vr0.x, vr0.y, vr0.z, vr0.w, vr1.x, vr1.y, vr1.z, vr1.w}; \
            _Pragma("unroll") for (int e = 0; e < 16; ++e) vt_[(16 * w + e) * AT_KSTR + lane] = (bf16)(vv[e >> 1] >> (16 * (e & 1))); } while (0)
#define DSA_FETCH(ti) do { const bf16* kp = Cb + (size_t)(64 * (ti) + (tid >> 3)) * 128 + 16 * (tid & 7); kr0 = *(const u32x4v*)kp; kr1 = *(const u32x4v*)(kp + 8); \
            const bf16* vp = Cb + (size_t)(64 * (ti) + lane) * 128 + 16 * w; vr0 = *(const u32x4v*)vp; vr1 = *(const u32x4v*)(vp + 8); } while (0)
        DSA_STAGE(0);
        if (nw > 1) DSA_FETCH(1);
        __syncthreads();
        for (int i = 0; i < nw; ++i) {
            const int cur = i & 1;
            if (i + 1 < nw) { DSA_STAGE(cur ^ 1); if (i + 2 < nw) DSA_FETCH(i + 2); }
            const LAS bf16* ksc = KS + cur * DSA_BUF_ELEMS; const LAS bf16* vtc = VT + cur * DSA_BUF_ELEMS;
            const u64 m64 = MW[r32 * 65 + i];
            if (__ballot(m64 != 0ull) != 0ull) {
                f32x16 p0, p1;
#pragma unroll
                for (int r = 0; r < 16; ++r) { p0[r] = 0.f; p1[r] = 0.f; }
#pragma unroll
                for (int s = 0; s < 8; ++s) {
                    const bf16x8 a0 = *(const LAS bf16x8*)(ksc + r32 * DSA_KSTR + 16 * s + 8 * hi), a1 = *(const LAS bf16x8*)(ksc + (32 + r32) * DSA_KSTR + 16 * s + 8 * hi);
                    p0 = MFMA32(a0, qf[s], p0); p1 = MFMA32(a1, qf[s], p1);
                }
                const unsigned mlo = (unsigned)m64, mhi = (unsigned)(m64 >> 32);
                float mx = -1e30f;
#pragma unroll
                for (int r = 0; r < 16; ++r) { const int kbit = crow(r, hi);
                    p0[r] = ((mlo >> kbit) & 1u) ? p0[r] : -1e30f; p1[r] = ((mhi >> kbit) & 1u) ? p1[r] : -1e30f;
                    mx = fmaxf(mx, fmaxf(p0[r], p1[r])); }
                mx = fmaxf(mx, lane_read(mx, lane ^ 32));
                const float mn = fmaxf(m, mx), alpha = __builtin_amdgcn_exp2f(m - mn); const bool grew = __ballot(mn > m) != 0ull; m = mn;
                float sum = 0.f;
#pragma unroll
                for (int r = 0; r < 16; ++r) { p0[r] = __builtin_amdgcn_exp2f(p0[r] - mn); p1[r] = __builtin_amdgcn_exp2f(p1[r] - mn); sum += p0[r] + p1[r]; }
                l = l * alpha + sum;
                if (grew) {
#pragma unroll
                    for (int db = 0; db < 4; ++db)
#pragma unroll
                        for (int r = 0; r < 16; ++r) o[db][r] *= alpha; }
#pragma unroll
                for (int blk = 0; blk < 2; ++blk)
#pragma unroll
                    for (int s = 0; s < 2; ++s) {
                        const bf16x8 xs = pack8(blk == 0 ? p0 : p1, s);
                        typedef short s16x4v __attribute__((ext_vector_type(4)));
                        const LAS bf16* vp = vtc + r32 * AT_KSTR + 32 * blk + 16 * s + 4 * hi;
#pragma unroll
                        for (int db = 0; db < 4; ++db) {
                            const s16x4v lo = *(const LAS s16x4v*)(vp + 32 * db * AT_KSTR), hh = *(const LAS s16x4v*)(vp + 32 * db * AT_KSTR + 8);
                            const bf16x8 pa = __builtin_shufflevector(lo, hh, 0, 1, 2, 3, 4, 5, 6, 7);
                            o[db] = MFMA32(pa, xs, o[db]);
                        }
                    }
            }
            __syncthreads();
        }
        l += lane_read(l, lane ^ 32);
        if (r32 < nq) {
            const float inv = 1.f / l; bf16* yr = Y + (size_t)(t0 + r32) * KOUT + 1536 + 128 * w;
#pragma unroll
            for (int db = 0; db < 4; ++db)
#pragma unroll
                for (int i4 = 0; i4 < 4; ++i4)
                    *(u32x2v*)(yr + 32 * db + 8 * i4 + 4 * hi) = (u32x2v){cvtpk(o[db][4 * i4] * inv, o[db][4 * i4 + 1] * inv), cvtpk(o[db][4 * i4 + 2] * inv, o[db][4 * i4 + 3] * inv)};
        }
        }
    }
}

__device__ __forceinline__ float wave_scan_incl(float v, int lane) {
#pragma unroll
    for (int o = 1; o < 64; o <<= 1) { const float n = lane_read(v, (lane - o) & 63); if (lane >= o) v += n; }
    return v;
}
__device__ __forceinline__ void ph_ssd_states(const Ctx& c0, const bf16* XC, const float* DT, const float* a_log, bf16* ST, float* CD) {
    const Ctx c = refresh(c0);
    const int lane = c.lane, w = c.wave, r32 = lane & 31, hi = lane >> 5, g = w >> 2;
    LAS bf16* XT = (LAS bf16*)c.lds + w * (64 * 72);
    LAS bf16* BT = (LAS bf16*)(c.lds + 73728);
    const float a_neg = -__expf(a_log[w]);
    for (int it = c.bid; it < NB * 65; it += c.nb) {
        const int b = it / 65, ch = it - b * 65, pseq = 64 * ch - 48 + lane; const bool valid = pseq >= 0; const size_t t = (size_t)(b * L + (valid ? pseq : 0));
        const float dtv = valid ? DT[t * 8 + w] : 0.f, acs = wave_scan_incl(dtv * a_neg, lane), tot = lane_read(acs, 63), scale = dtv * __expf(tot - acs);
        if (lane == 0) CD[(b * 65 + ch) * 8 + w] = __expf(tot);
        const bf16* xrow = XC + t * 1024 + 64 * w;
#pragma unroll
        for (int q = 0; q < 8; ++q) { u32x4v v = (u32x4v){0u, 0u, 0u, 0u}; if (valid) v = *(const u32x4v*)(xrow + 8 * q); const unsigned vv[4] = {v.x, v.y, v.z, v.w};
#pragma unroll
            for (int e = 0; e < 8; ++e) XT[(8 * q + e) * 72 + lane] = f2bf(bf2f((bf16)(vv[e >> 1] >> (16 * (e & 1)))) * scale); }
        const bf16* brow = XC + t * 1024 + 512 + 32 * w;
#pragma unroll
        for (int q = 0; q < 4; ++q) { u32x4v v = (u32x4v){0u, 0u, 0u, 0u}; if (valid) v = *(const u32x4v*)(brow + 8 * q); const unsigned vv[4] = {v.x, v.y, v.z, v.w};
#pragma unroll
            for (int e = 0; e < 8; ++e) BT[(32 * w + 8 * q + e) * 72 + lane] = (bf16)(vv[e >> 1] >> (16 * (e & 1))); }
        __syncthreads();
        bf16* st = ST + ((size_t)(b * 65 + ch) * 8 + w) * 8192;
#pragma unroll 1
        for (int pb = 0; pb < 2; ++pb)
#pragma unroll 1
            for (int nb = 0; nb < 4; ++nb) {
                f32x16 acc;
#pragma unroll
                for (int r = 0; r < 16; ++r) acc[r] = 0.f;
#pragma unroll
                for (int s = 0; s < 4; ++s) { const bf16x8 a = *(const LAS bf16x8*)(XT + (32 * pb + r32) * 72 + 16 * s + 8 * hi), bb = *(const LAS bf16x8*)(BT + (128 * g + 32 * nb + r32) * 72 + 16 * s + 8 * hi);
                    acc = MFMA32(a, bb, acc); }
#pragma unroll
                for (int r = 0; r < 16; ++r) st[(32 * pb + crow(r, hi)) * 128 + 32 * nb + r32] = f2bf(acc[r]);
            }
        __syncthreads();
    }
}
__device__ __forceinline__ void ph_ssd_scan(const Ctx& c0, bf16* ST, const float* CD) {
    const Ctx c = refresh(c0);
    for (int idx = c.bid * NTHR + c.tid; idx < NB * 8 * 64 * 32; idx += c.nb * NTHR) {
        const int n4 = idx & 31, p = (idx >> 5) & 63, h = (idx >> 11) & 7, b = idx >> 14;
        float h0 = 0.f, h1 = 0.f, h2 = 0.f, h3 = 0.f;
        bf16* base = ST + ((size_t)(b * 65) * 8 + h) * 8192 + p * 128 + 4 * n4; const float* cd = CD + (size_t)(b * 65) * 8 + h;
        u32x2v nxt = *(const u32x2v*)base;
#pragma unroll 5
        for (int ch = 0; ch < 65; ++ch) {
            const u32x2v v = nxt; bf16* pc = base + (size_t)ch * 8 * 8192;
            if (ch + 1 < 65) nxt = *(const u32x2v*)(pc + 8 * 8192);
            *(u32x2v*)pc = (u32x2v){pk2(h0, h1), pk2(h2, h3)};
            const float d = cd[ch * 8];
            h0 = d * h0 + bf2f((bf16)(v.x & 0xffff)); h1 = d * h1 + bf2f((bf16)(v.x >> 16)); h2 = d * h2 + bf2f((bf16)(v.y & 0xffff)); h3 = d * h3 + bf2f((bf16)(v.y >> 16));
        }
    }
}
__device__ __forceinline__ void ph_ssd_out(const Ctx& c0, const bf16* XC, const bf16* U, const float* DT, const float* a_log, const float* dsk, const bf16* ST, bf16* Y) {
    const Ctx c = refresh(c0);
    const int lane = c.lane, w = c.wave, r32 = lane & 31, hi = lane >> 5, g = w >> 2;
    LAS bf16* XT = (LAS bf16*)c.lds + w * (64 * 72);
    LAS float* ACS = (LAS float*)(c.lds + 73728) + w * 64;
    LAS float* SS = (LAS float*)(c.lds + 73728 + 2048);
    const float a_neg = -__expf(a_log[w]), Dk = dsk[w];
    typedef short s16x4v __attribute__((ext_vector_type(4)));
    for (int it = c.bid; it < NB * 65; it += c.nb) {
        const int b = it / 65, ch = it - b * 65, p0 = 64 * ch - 48, pseq = p0 + lane; const bool valid = pseq >= 0; const size_t t = (size_t)(b * L + (valid ? pseq : 0));
        const float dtv = valid ? DT[t * 8 + w] : 0.f, acs = wave_scan_incl(dtv * a_neg, lane);
        ACS[lane] = acs;
        {   const bf16* xrow = XC + t * 1024 + 64 * w;
#pragma unroll
            for (int q = 0; q < 8; ++q) { u32x4v v = (u32x4v){0u, 0u, 0u, 0u}; if (valid) v = *(const u32x4v*)(xrow + 8 * q); const unsigned vv[4] = {v.x, v.y, v.z, v.w};
#pragma unroll
                for (int e = 0; e < 8; ++e) XT[(8 * q + e) * 72 + lane] = f2bf(bf2f((bf16)(vv[e >> 1] >> (16 * (e & 1)))) * dtv); } }
        const bool vl0 = p0 + r32 >= 0, vl1 = p0 + 32 + r32 >= 0;
        const size_t tl0 = (size_t)(b * L + (vl0 ? p0 + r32 : 0)), tl1 = (size_t)(b * L + (vl1 ? p0 + 32 + r32 : 0));
        f32x16 acc[2][2];
#pragma unroll
        for (int pb = 0; pb < 2; ++pb)
#pragma unroll
            for (int lb = 0; lb < 2; ++lb)
#pragma unroll
                for (int r = 0; r < 16; ++r) acc[pb][lb][r] = 0.f;
        const bf16* hin = ST + ((size_t)(b * 65 + ch) * 8 + w) * 8192;
#pragma unroll
        for (int k = 0; k < 8; ++k) {
            bf16x8 c0f = (bf16x8){0, 0, 0, 0, 0, 0, 0, 0}, c1f = c0f;
            if (vl0) c0f = *(const bf16x8*)(XC + tl0 * 1024 + 768 + 128 * g + 16 * k + 8 * hi);
            if (vl1) c1f = *(const bf16x8*)(XC + tl1 * 1024 + 768 + 128 * g + 16 * k + 8 * hi);
            const bf16x8 h0f = *(const bf16x8*)(hin + (size_t)r32 * 128 + 16 * k + 8 * hi), h1f = *(const bf16x8*)(hin + (size_t)(32 + r32) * 128 + 16 * k + 8 * hi);
            acc[0][0] = MFMA32(h0f, c0f, acc[0][0]); acc[0][1] = MFMA32(h0f, c1f, acc[0][1]); acc[1][0] = MFMA32(h1f, c0f, acc[1][0]); acc[1][1] = MFMA32(h1f, c1f, acc[1][1]);
        }
        const float acl0 = ACS[r32], acl1 = ACS[32 + r32], e0 = __expf(acl0), e1 = __expf(acl1);
#pragma unroll
        for (int pb = 0; pb < 2; ++pb)
#pragma unroll
            for (int r = 0; r < 16; ++r) { acc[pb][0][r] *= e0; acc[pb][1][r] *= e1; }
#pragma unroll
        for (int sb = 0; sb < 2; ++sb)
#pragma unroll
            for (int lb = sb; lb < 2; ++lb) {
                f32x16 x;
#pragma unroll
                for (int r = 0; r < 16; ++r) x[r] = 0.f;
                const bool vs = p0 + 32 * sb + r32 >= 0; const size_t ts = (size_t)(b * L + (vs ? p0 + 32 * sb + r32 : 0));
                const bool vl = lb == 0 ? vl0 : vl1; const size_t tl = lb == 0 ? tl0 : tl1;
#pragma unroll
                for (int k = 0; k < 8; ++k) {
                    bf16x8 bf_ = (bf16x8){0, 0, 0, 0, 0, 0, 0, 0}, cf_ = bf_;
                    if (vs) bf_ = *(const bf16x8*)(XC + ts * 1024 + 512 + 128 * g + 16 * k + 8 * hi);
                    if (vl) cf_ = *(const bf16x8*)(XC + tl * 1024 + 768 + 128 * g + 16 * k + 8 * hi);
                    x = MFMA32(bf_, cf_, x);
                }
                const float acl = lb == 0 ? acl0 : acl1; const int lrow = 32 * lb + r32;
#pragma unroll
                for (int i4 = 0; i4 < 4; ++i4) { const f32x4v as = *(const LAS f32x4v*)(ACS + 32 * sb + 8 * i4 + 4 * hi);
#pragma unroll
                    for (int e = 0; e < 4; ++e) { const int srow = 32 * sb + 8 * i4 + 4 * hi + e; x[4 * i4 + e] = srow <= lrow ? x[4 * i4 + e] * __expf(fminf(acl - as[e], 0.f)) : 0.f; } }
#pragma unroll
                for (int ks = 0; ks < 2; ++ks) {
                    const bf16x8 xs = pack8(x, ks);
#pragma unroll
                    for (int pb = 0; pb < 2; ++pb) {
                        const LAS bf16* vp = XT + (32 * pb + r32) * 72 + 32 * sb + 16 * ks + 4 * hi;
                        const s16x4v lo = *(const LAS s16x4v*)vp, hh = *(const LAS s16x4v*)(vp + 8);
                        const bf16x8 pa = __builtin_shufflevector(lo, hh, 0, 1, 2, 3, 4, 5, 6, 7);
                        if (lb == 0) acc[pb][0] = MFMA32(pa, xs, acc[pb][0]); else acc[pb][1] = MFMA32(pa, xs, acc[pb][1]);
                    }
                }
            }
        float ssq0 = 0.f, ssq1 = 0.f;
#pragma unroll
        for (int lb = 0; lb < 2; ++lb) { const bool vl = lb == 0 ? vl0 : vl1; const size_t tl = lb == 0 ? tl0 : tl1;
#pragma unroll
            for (int pb = 0; pb < 2; ++pb)
#pragma unroll
                for (int i4 = 0; i4 < 4; ++i4) { const int pc = 64 * w + 32 * pb + 8 * i4 + 4 * hi;
                    u32x2v xv = (u32x2v){0u, 0u}, zv = xv;
                    if (vl) { xv = *(const u32x2v*)(XC + tl * 1024 + pc); zv = *(const u32x2v*)(U + tl * NU + C_Z + pc); }
                    const float xe[4] = {bf2f((bf16)(xv.x & 0xffff)), bf2f((bf16)(xv.x >> 16)), bf2f((bf16)(xv.y & 0xffff)), bf2f((bf16)(xv.y >> 16))};
                    const float ze[4] = {bf2f((bf16)(zv.x & 0xffff)), bf2f((bf16)(zv.x >> 16)), bf2f((bf16)(zv.y & 0xffff)), bf2f((bf16)(zv.y >> 16))};
#pragma unroll
                    for (int e = 0; e < 4; ++e) { const float y = acc[pb][lb][4 * i4 + e] + Dk * xe[e], gz = y * siluf(ze[e]); acc[pb][lb][4 * i4 + e] = gz; if (lb == 0) ssq0 += gz * gz; else ssq1 += gz * gz; } } }
        ssq0 += lane_read(ssq0, lane ^ 32); ssq1 += lane_read(ssq1, lane ^ 32);
        if (hi == 0) { SS[w * 64 + r32] = ssq0; SS[w * 64 + 32 + r32] = ssq1; }
        __syncthreads();
        const float tot0 = SS[(4 * g) * 64 + r32] + SS[(4 * g + 1) * 64 + r32] + SS[(4 * g + 2) * 64 + r32] + SS[(4 * g + 3) * 64 + r32];
        const float tot1 = SS[(4 * g) * 64 + 32 + r32] + SS[(4 * g + 1) * 64 + 32 + r32] + SS[(4 * g + 2) * 64 + 32 + r32] + SS[(4 * g + 3) * 64 + 32 + r32];
        const float rs0 = rsqrtf(tot0 * (1.f / 256.f) + EPSF), rs1 = rsqrtf(tot1 * (1.f / 256.f) + EPSF);
#pragma unroll
        for (int lb = 0; lb < 2; ++lb) { const bool vl = lb == 0 ? vl0 : vl1; const size_t tl = lb == 0 ? tl0 : tl1; const float rs = lb == 0 ? rs0 : rs1;
            if (vl) {
#pragma unroll
                for (int pb = 0; pb < 2; ++pb)
#pragma unroll
                    for (int i4 = 0; i4 < 4; ++i4)
                        *(u32x2v*)(Y + tl * KOUT + 64 * w + 32 * pb + 8 * i4 + 4 * hi) = (u32x2v){cvtpk(acc[pb][lb][4 * i4] * rs, acc[pb][lb][4 * i4 + 1] * rs), cvtpk(acc[pb][lb][4 * i4 + 2] * rs, acc[pb][lb][4 * i4 + 3] * rs)};
            } }
        __syncthreads();
    }
}

__device__ __forceinline__ void ph_resid(const Ctx& c0, const bf16* MIX, const float* g, bf16* XB, float* RSTD, float* dout) { const Ctx c = refresh(c0);
    const int lane = c.lane;
    for (int t = c.gw; t < T; t += c.ngw) {
        float mv[32], xv[32]; float ss = 0.f;
#pragma unroll
        for (int j = 0; j < 4; ++j) { const u32x4v v = *(const u32x4v*)(MIX + (size_t)t * DM + 8 * lane + 512 * j), xx = *(const u32x4v*)(XB + (size_t)t * DM + 8 * lane + 512 * j);
            const unsigned w[4] = {v.x, v.y, v.z, v.w}, xw[4] = {xx.x, xx.y, xx.z, xx.w};
#pragma unroll
            for (int i = 0; i < 8; ++i) { const float f = bf2f((bf16)(w[i >> 1] >> (16 * (i & 1)))); mv[8 * j + i] = f; ss += f * f; xv[8 * j + i] = bf2f((bf16)(xw[i >> 1] >> (16 * (i & 1)))); } }
        const float rs = rsqrtf(wave_sum(ss, lane) * (1.f / DM) + EPSF);
        float s2 = 0.f;
        const int b = t / L, p = t - b * L; float* orow = (dout != nullptr && p >= NMETA) ? dout + ((size_t)b * SEQ + (p - NMETA)) * DM : nullptr;
#pragma unroll
        for (int j = 0; j < 4; ++j) { const int cc = 8 * lane + 512 * j;
            const f32x4v ga = *(const f32x4v*)(g + cc), gb = *(const f32x4v*)(g + cc + 4); float a[8];
#pragma unroll
            for (int i = 0; i < 4; ++i) { a[i] = xv[8 * j + i] + mv[8 * j + i] * rs * ga[i]; a[4 + i] = xv[8 * j + 4 + i] + mv[8 * j + 4 + i] * rs * gb[i]; }
#pragma unroll
            for (int i = 0; i < 8; ++i) s2 += a[i] * a[i];
            if (orow) { *(f32x4v*)(orow + cc) = (f32x4v){a[0], a[1], a[2], a[3]}; *(f32x4v*)(orow + cc + 4) = (f32x4v){a[4], a[5], a[6], a[7]}; }
            *(u32x4v*)(XB + (size_t)t * DM + cc) = (u32x4v){pk2(a[0], a[1]), pk2(a[2], a[3]), pk2(a[4], a[5]), pk2(a[6], a[7])}; }
        s2 = wave_sum(s2, lane);
        if (lane == 0) RSTD[t] = rsqrtf(s2 * (1.f / DM) + EPSF);
    }
}

__device__ __forceinline__ void ph_gemm_plain(const Ctx& c0, const bf16* A, const bf16* Bt, bf16* O, int N, int K, int ldc, const float* rs, float* UF) { const Ctx c = refresh(c0);
    pg8::StaticOrder S; S.init(129 * 256, N, c.nb, c.bid);
    pg8::Gemm g{A, Bt, 129 * 256, N, K, (size_t)256 * K * 2};
    pg8::EpiBf16Plain E{O, ldc, rs, UF, C_SM};
    pg8::gemm_phase<pg8::EpiBf16Plain, pg8::StaticOrder, true, true>(c.lds, g, S, E, c.tid);
}
__device__ __forceinline__ void ph_gemm_gateup(const Ctx& c0, const bf16* XB, const bf16* Bt, bf16* H, const float* rs, const float* cw, const float* cb) { const Ctx c = refresh(c0);
    pg8::StaticOrder S; S.init(130 * 256, NGU, c.nb, c.bid);
    pg8::Gemm g{XB - (size_t)2 * DM, Bt, 130 * 256, NGU, DM, (size_t)254 * DM * 2};
    pg8::EpiGateUp E{H, rs, cw, cb, (LAS float*)(c.lds + HALO_OFF)};
    pg8::gemm_phase<pg8::EpiGateUp, pg8::StaticOrder, true, true>(c.lds, g, S, E, c.tid);
}

constexpr int REP_PREPW = 1, REP_G1 = 1, REP_G2 = 1, REP_G3 = 1, REP_G4 = 1, REP_M1 = 1, REP_SSD = 1, REP_FOX = 1, REP_DSA = 1;
__global__ void __launch_bounds__(NTHR, 2) fwd_mega(Args A) {
    extern __shared__ __attribute__((aligned(16))) unsigned char lds_raw[];
    cg::grid_group grid = cg::this_grid();
    Ctx c; c.tid = threadIdx.x; c.lane = c.tid & 63; c.wave = __builtin_amdgcn_readfirstlane(c.tid >> 6); c.bid = blockIdx.x; c.nb = gridDim.x;
    c.gw = c.bid * NWAVE + c.wave; c.ngw = c.nb * NWAVE; c.lds = (LAS unsigned char*)lds_raw;
    if (c.tid == 0) { LAS unsigned long long* PT = (LAS unsigned long long*)(c.lds + PT_OFF);
#pragma unroll
        for (int i = 0; i < 25; ++i) PT[i] = (unsigned long long)A.in[i];
        PT[25] = (unsigned long long)A.out; PT[26] = (unsigned long long)A.ws; }
    if (c.tid < 2) ((LAS unsigned*)(c.lds + MISC_OFF))[c.tid] = 0u;
    __syncthreads();
    (void)xcd_barrier_post((unsigned*)(A.ws + WS_CTL) + CW_BAR, (volatile LAS unsigned*)(c.lds + MISC_OFF), c.tid);
#define WSP(off) (pt_get(c, 26) + (off))
#define DOUT ((float*)pt_get(c, 25))
#define P_WIN ((bf16*)WSP(WS_WIN))
#define P_WOUT ((bf16*)WSP(WS_WOUT))
#define P_WGU ((bf16*)WSP(WS_WGU))
#define P_WDN ((bf16*)WSP(WS_WDN))
#define P_METAX ((float*)WSP(WS_METAX))
#define P_RSTD ((float*)WSP(WS_RSTD))
#define P_UF ((float*)WSP(WS_UF))
#define P_DT ((float*)WSP(WS_DT))
#define P_FCUM ((float*)WSP(WS_FCUM))
#define P_CN ((bf16*)WSP(WS_CN))
#define P_MASK ((u64*)WSP(WS_MASK))
#define P_KI ((bf16*)WSP(WS_MASK))
#define P_XB ((bf16*)WSP(WS_XB) + (size_t)8 * DM)
#define P_Y ((bf16*)WSP(WS_Y))
#define P_U ((bf16*)WSP(WS_R1))
#define P_XC ((bf16*)WSP(WS_XC))
#define P_H ((bf16*)WSP(WS_R1))
#define P_MIX ((bf16*)WSP(WS_R1))
#define P_MIX2 ((bf16*)WSP(WS_Y))
#define P_ST ((bf16*)WSP(WS_YA))
#define P_CD ((float*)WSP(WS_DT + 1536 * 1024))
    ph_prep_x(c, INP(0), INP(1), P_XB, P_RSTD);
    grid.sync();
#define LAYER_BODY(ly) do { \
        for (int rep = 0; rep < REP_PREPW; ++rep) ph_prep_w(c, ly, P_WIN, P_WOUT, P_WGU, P_WDN); \
        grid_barrier(c); \
        for (int rep = 0; rep < REP_G1; ++rep) ph_gemm_plain(c, P_XB, P_WIN, P_U, NU, DM, NU, P_RSTD, P_UF); \
        grid_barrier(c); \
        for (int rep = 0; rep < REP_M1; ++rep) { \
        ph_mixprep(c, P_U, P_UF, INP(7) + (size_t)ly * 4 * 1024, INP(8) + (size_t)ly * 1024, INP(16) + (size_t)ly * 128, INP(9) + (size_t)ly * 8, P_XC, P_Y, P_CN, P_DT, P_KI); \
        ph_fcum(c, P_UF, INP(15) + (size_t)ly * 8, P_FCUM); } \
        grid_barrier(c); \
        for (int rep = 0; rep < REP_SSD; ++rep) ph_ssd_states(c, P_XC, P_DT, INP(10) + (size_t)ly * 8, P_ST, P_CD); \
        for (int rep = 0; rep < REP_FOX; ++rep) ph_fox(c, P_U, P_FCUM, P_Y); \
        grid_barrier(c); \
        ph_ssd_scan(c, P_ST, P_CD); \
        for (int rep = 0; rep < REP_DSA; ++rep) ph_dsa(c, P_U, P_UF, P_CN, P_KI, P_Y); \
        grid_barrier(c); \
        for (int rep = 0; rep < REP_SSD; ++rep) ph_ssd_out(c, P_XC, P_U, P_DT, INP(10) + (size_t)ly * 8, INP(11) + (size_t)ly * 8, P_ST, P_Y); \
        grid_barrier(c); \
        for (int rep = 0; rep < REP_G2; ++rep) ph_gemm_plain(c, P_Y, P_WOUT, P_MIX, DM, KOUT, DM, nullptr, nullptr); \
        grid_barrier(c); \
        ph_resid(c, P_MIX, INP(3) + (size_t)ly * DM, P_XB, P_RSTD, nullptr); \
        grid_barrier(c); \
        for (int rep = 0; rep < REP_G3; ++rep) ph_gemm_gateup(c, P_XB, P_WGU, P_H, P_RSTD, INP(22) + (size_t)ly * 3 * FF, INP(23) + (size_t)ly * FF); \
        grid_barrier(c); \
        for (int rep = 0; rep < REP_G4; ++rep) ph_gemm_plain(c, P_H, P_WDN, P_MIX2, DM, FF, DM, nullptr, nullptr); \
        grid_barrier(c); \
        ph_resid(c, P_MIX2, INP(5) + (size_t)ly * DM, P_XB, P_RSTD, (ly) == DEPTH - 1 ? DOUT : nullptr); \
        grid_barrier(c); \
    } while (0)
    LAYER_BODY(0); LAYER_BODY(1); LAYER_BODY(2); LAYER_BODY(3);
}

extern "C" void kernel_launch(void* const* d_in, const int* in_sizes, int n_in, void* d_out, int out_size, void* d_ws, size_t ws_size, hipStream_t stream) {
    static int grid_blocks = 0;
    if (grid_blocks == 0) {
        if (n_in != 25 || in_sizes[0] != NB * SEQ * DM || out_size != NB * SEQ * DM || ws_size < WS_END) { fprintf(stderr, "kernel_launch: unexpected shapes (n_in %d in0 %d out %d ws %zu)\n", n_in, n_in > 0 ? in_sizes[0] : -1, out_size, ws_size); grid_blocks = -1; return; }
        int dev = 0, cus = 0, per_cu = 0;
        (void)hipGetDevice(&dev); (void)hipDeviceGetAttribute(&cus, hipDeviceAttributeMultiprocessorCount, dev);
        if (hipFuncSetAttribute((const void*)fwd_mega, hipFuncAttributeMaxDynamicSharedMemorySize, LDS_BYTES) != hipSuccess) { fprintf(stderr, "kernel_launch: hipFuncSetAttribute failed\n"); grid_blocks = -1; return; }
        if (hipOccupancyMaxActiveBlocksPerMultiprocessor(&per_cu, (const void*)fwd_mega, NTHR, LDS_BYTES) != hipSuccess || per_cu < 1) { fprintf(stderr, "kernel_launch: occupancy query says %d blocks/CU\n", per_cu); grid_blocks = -1; return; }
        grid_blocks = cus;
        fprintf(stderr, "kernel_launch: %d CUs, %d blocks/CU by the occupancy query, grid %d\n", cus, per_cu, grid_blocks);
    }
    if (grid_blocks < 0) return;
    if (hipMemsetAsync((char*)d_ws + WS_CTL, 0, 65536, stream) != hipSuccess) { fprintf(stderr, "kernel_launch: memset failed\n"); return; }
    Args a{};
    for (int i = 0; i < 25; ++i) a.in[i] = (const float*)d_in[i];
    a.out = (float*)d_out; a.ws = (unsigned char*)d_ws;
    void* args[] = {&a};
    hipError_t e = hipLaunchCooperativeKernel((const void*)fwd_mega, dim3(grid_blocks), dim3(NTHR), args, LDS_BYTES, stream);
    if (e != hipSuccess) fprintf(stderr, "kernel_launch: cooperative launch failed: %s (grid %d)\n", hipGetErrorString(e), grid_blocks);
}
```

```cpp
#include <hip/hip_runtime.h>
#include <cstdio>
#include <cstdint>

constexpr int NB = 8, SEQ = 4096, NMETA = 16, L = SEQ + NMETA  , T = NB * L  , MP = 33024  , DM = 2048;
constexpr int NU = 5120, KOUT = 2560, FF = 5632, NGU = 2 * FF, DIN = 4564;
constexpr int C_Z = 0, C_XBC = 512, C_POOL = 1536, C_FQ = 2048, C_FK = 2560, C_FV = 3072, C_QLAT = 3584, C_DC = 4608, C_QI = 4736, C_KI = 4992, C_SM = 5056;
constexpr int LKP = 4224, NMW = 66  , TOPK = 256, DEPTH = 4;
constexpr float EPSF = 1e-6f;
typedef unsigned short bf16;
typedef unsigned long long u64;

__device__ __forceinline__ float bf2f(bf16 v) { return __uint_as_float(((unsigned)v) << 16); }
__device__ __forceinline__ bf16 f2bf(float f) { unsigned u = __float_as_uint(f); return (bf16)((u + 0x7fffu + ((u >> 16) & 1u)) >> 16); }
typedef float f32x2v_ __attribute__((ext_vector_type(2)));
typedef __bf16 bf16x2v_ __attribute__((ext_vector_type(2)));
__device__ __forceinline__ unsigned pk2(float lo, float hi) { f32x2v_ v = {lo, hi}; bf16x2v_ b = __builtin_convertvector(v, bf16x2v_); return __builtin_bit_cast(unsigned, b); }
__device__ __forceinline__ float siluf(float x) { return x * __builtin_amdgcn_rcpf(1.f + __expf(-x)); }
__device__ __forceinline__ float softplusf(float x) { return fmaxf(x, 0.f) + log1pf(__expf(-fabsf(x))); }
__device__ __forceinline__ float logsigmoidf(float x) { return fminf(x, 0.f) - log1pf(__expf(-fabsf(x))); }
__device__ __forceinline__ float lane_read(float v, int src) { return __int_as_float(__builtin_amdgcn_ds_bpermute(src << 2, __float_as_int(v))); }
__device__ __forceinline__ int lane_readi(int v, int src) { return __builtin_amdgcn_ds_bpermute(src << 2, v); }
__device__ __forceinline__ float wave_sum(float v, int lane) {
#pragma unroll
    for (int o = 1; o < 64; o <<= 1) v += lane_read(v, lane ^ o);
    return v;
}
__device__ __forceinline__ float* xf_row(float* dout, float* metax, int t) {
    const int b = t / L, p = t - b * L;
    return p < NMETA ? metax + (size_t)(b * NMETA + p) * DM : dout + ((size_t)b * SEQ + (p - NMETA)) * DM;
}
namespace pg8 {
#define PG8_LAS __attribute__((address_space(3)))
typedef unsigned short bf16_t;
typedef short bf16x8 __attribute__((ext_vector_type(8)));
typedef float f32x4 __attribute__((ext_vector_type(4)));
typedef unsigned u32x4 __attribute__((ext_vector_type(4)));
constexpr int BM = 256, BK = 64, HALF = 128, HTB = HALF * BK * 2  , STAGE_BYTES = 8 * HTB, NXCD = 8, WGM = 8;

__host__ __device__ __forceinline__ int lds_byte(int r, int c) { const int st = (r >> 4) * 2 + (c >> 5), rr = r & 15, cc = c & 31, ob = rr * 64 + cc * 2; return st * 1024 + (ob ^ (((ob >> 9) & 1) << 5)); }
__host__ __device__ __forceinline__ void stage_rc(int b, int& R, int& C) { const int st = b / 1024, sb = b % 1024, swz = sb ^ (((sb >> 9) & 1) << 5); R = (st >> 1) * 16 + swz / 64; C = (st & 1) * 32 + (swz % 64) / 2; }
__host__ __device__ __forceinline__ int perm32(int rho) { const int n = rho >> 4, i = rho & 15; return 8 * (i >> 2) + 4 * n + (i & 3); }

struct Unit { int pm, pn; };
struct Gemm { const bf16_t* A; const bf16_t* Bt; int M, N, K; size_t a_tstep; int rowmap; };
__host__ __device__ __forceinline__ int tile_row0(int rowmap, int pm) { return rowmap ? (pm >> 4) * 4112 + 16 + 256 * (pm & 15) : pm * 256; }

struct StaticOrder {
    int nM, nN, nwg, G, c;
    __host__ __device__ void init(int M, int N, int G_, int c_) { nM = M / BM; nN = N / BM; nwg = nM * nN; G = G_; c = c_; }
    __host__ __device__ bool next(int i, Unit& u) const {
        const long L = (long)i * G + c; if (L >= nwg) return false;
        int wgid = (int)L; { const int q = nwg / NXCD, r = nwg % NXCD, xcd = wgid % NXCD, off = wgid / NXCD; wgid = (xcd < r ? xcd * (q + 1) : r * (q + 1) + (xcd - r) * q) + off; }
        const int nig = WGM * nN, gid = wgid / nig, fm = gid * WGM, gsz = (nM - fm) < WGM ? (nM - fm) : WGM;
        u.pm = fm + ((wgid % nig) % gsz); u.pn = (wgid % nig) / gsz; return true;
    }
    __device__ __forceinline__ void a_ready(const Unit&) const {}
    __device__ __forceinline__ void done(const Unit&) const {}
};


__device__ __forceinline__ unsigned cvt_pk_bf16(float lo, float hi) { unsigned r; asm volatile("v_cvt_pk_bf16_f32 %0, %1, %2" : "=v"(r) : "v"(lo), "v"(hi)); return r; }

struct EpiBf16Plain {
    static constexpr bool PERM = true, AFTER_DRAIN = false;
    bf16_t* O; int ldc; const float* rs; float* UF; int sm_col0; int rowmap;
    __device__ __forceinline__ void operator()(f32x4 (&acc)[2][2][4][2], const Unit& u, int wr, int wc, int fr, int fq) const {
        const int row0 = tile_row0(rowmap, u.pm) + wr * 64 + fr, col0 = u.pn * BM + wc * 32 + 8 * fq;
#pragma unroll
        for (int ai = 0; ai < 2; ++ai)
#pragma unroll
            for (int m = 0; m < 4; ++m) {
                const int row = row0 + ai * HALF + m * 16; const float s = rs ? rs[row] : 1.f; bf16_t* rowp = O + (size_t)row * ldc + col0;
#pragma unroll
                for (int bj = 0; bj < 2; ++bj) { const f32x4 v0 = acc[ai][bj][m][0] * s, v1 = acc[ai][bj][m][1] * s;
                    u32x4 w; w.x = cvt_pk_bf16(v0[0], v0[1]); w.y = cvt_pk_bf16(v0[2], v0[3]); w.z = cvt_pk_bf16(v1[0], v1[1]); w.w = cvt_pk_bf16(v1[2], v1[3]);
                    *(u32x4*)(rowp + bj * HALF) = w;
                    if (UF) { const int c = col0 + bj * HALF - sm_col0; if (c >= 0 && c < 32) { float* p = UF + (size_t)row * 32 + c; *(f32x4*)p = v0; *(f32x4*)(p + 4) = v1; } } }
            }
    }
};

struct EpiGateUp {
    static constexpr bool PERM = true, AFTER_DRAIN = false;
    bf16_t* H; const float* rs; const float* cw; const float* cb; PG8_LAS float* halo;
    __device__ __forceinline__ void operator()(f32x4 (&acc)[2][2][4][2], const Unit& u, int wr, int wc, int fr, int fq) const {
        const int lane = fq * 16 + fr, chl = wc * 32 + 8 * fq, ch0 = u.pn * 128 + chl, rbase = u.pm * 254 - 2;
#pragma unroll
        for (int ai = 0; ai < 2; ++ai)
#pragma unroll
            for (int m = 0; m < 4; ++m) { const int grow = rbase + ai * 128 + wr * 64 + m * 16 + fr; const float s = grow >= 0 ? rs[grow] : 0.f;
#pragma unroll
                for (int bj = 0; bj < 2; ++bj)
#pragma unroll
                    for (int n = 0; n < 2; ++n) acc[ai][bj][m][n] = acc[ai][bj][m][n] * s; }
        if (fr >= 14) {
#pragma unroll
            for (int ai = 0; ai < 2; ++ai)
#pragma unroll
                for (int n = 0; n < 2; ++n) *(PG8_LAS f32x4*)(halo + ((2 * ai + wr) * 2 + (fr - 14)) * 128 + chl + 4 * n) = acc[ai][0][3][n];
        }
        asm volatile("s_waitcnt lgkmcnt(0)" ::: "memory"); __builtin_amdgcn_s_barrier(); asm volatile("" ::: "memory");
        f32x4 w0[2], w1[2], w2[2], bb[2];
#pragma unroll
        for (int n = 0; n < 2; ++n) { w0[n] = *(const f32x4*)(cw + ch0 + 4 * n); w1[n] = *(const f32x4*)(cw + FF + ch0 + 4 * n); w2[n] = *(const f32x4*)(cw + 2 * FF + ch0 + 4 * n); bb[n] = *(const f32x4*)(cb + ch0 + 4 * n); }
#pragma unroll
        for (int ai = 0; ai < 2; ++ai)
#pragma unroll
            for (int m = 0; m < 4; ++m) {
                const int rl = ai * 128 + wr * 64 + m * 16 + fr, grow = rbase + rl, pos = grow >= 0 ? grow % L : 0, blk = 2 * ai + wr;
                const float t1 = pos >= 1 ? 1.f : 0.f, t2 = pos >= 2 ? 1.f : 0.f;
                unsigned pk[4];
#pragma unroll
                for (int n = 0; n < 2; ++n) {
                    const f32x4 cur = acc[ai][0][m][n]; f32x4 g1, g2;
#pragma unroll
                    for (int j = 0; j < 4; ++j) {
                        const float s1 = lane_read(cur[j], (lane + 63) & 63), s2 = lane_read(cur[j], (lane + 62) & 63);
                        float p15, p14;
                        if (m > 0) { const float pv = acc[ai][0][m > 0 ? m - 1 : 0][n][j]; p15 = lane_read(pv, fq * 16 + 15); p14 = lane_read(pv, fq * 16 + 14); }
                        else if (blk > 0) { p14 = halo[((blk - 1) * 2 + 0) * 128 + chl + 4 * n + j]; p15 = halo[((blk - 1) * 2 + 1) * 128 + chl + 4 * n + j]; }
                        else { p14 = 0.f; p15 = 0.f; }
                        g1[j] = fr >= 1 ? s1 : p15; g2[j] = fr >= 2 ? s2 : (fr == 1 ? p15 : p14);
                    }
                    const f32x4 cv = bb[n] + w2[n] * cur + (w1[n] * g1) * t1 + (w0[n] * g2) * t2;
                    const f32x4 up = acc[ai][1][m][n];
                    float hv[4];
#pragma unroll
                    for (int j = 0; j < 4; ++j) hv[j] = cv[j] * __builtin_amdgcn_rcpf(1.f + __expf(-cv[j])) * up[j];
                    pk[2 * n] = cvt_pk_bf16(hv[0], hv[1]); pk[2 * n + 1] = cvt_pk_bf16(hv[2], hv[3]);
                }
                if (rl >= 2) { u32x4 w; w.x = pk[0]; w.y = pk[1]; w.z = pk[2]; w.w = pk[3]; *(u32x4*)(H + (size_t)grow * FF + ch0) = w; }
            }
    }
};
template <class Epi, class Sched, bool ALIGN_EPI = false, bool SP2 = false>
__device__ __forceinline__ void gemm_phase(PG8_LAS unsigned char* lds, const Gemm g, const Sched& S, const Epi& E, const int tid) {
    const int wid = __builtin_amdgcn_readfirstlane(tid >> 6), lane = tid & 63, wr = wid >> 2, wc = wid & 3, fr = lane & 15, fq = lane >> 4;
    const int K = g.K, nt = K / BK;
    unsigned voffA[2], voffB[2];
#pragma unroll
    for (int i = 0; i < 2; ++i) { int R, C; stage_rc(tid * 16 + i * 8192, R, C); const int Rb = Epi::PERM ? ((R & ~31) + perm32(R & 31)) : R;
        voffA[i] = (unsigned)(R * K + C) * 2u; voffB[i] = (unsigned)(Rb * K + C) * 2u; }
    const size_t kstep = (size_t)(BK * 2);
    const size_t hstep = (size_t)HALF * K * 2;
    const size_t tstep = 2 * hstep;
    const unsigned ldsw = (unsigned)wid * 1024u;
    const int aoff = lds_byte(wr * 64 + fr, fq * 8), boff = lds_byte(wc * 32 + fr, fq * 8);
#define PG8_SA(b, h) (((b) * 2 + (h)) * HTB)
#define PG8_SB(b, h) ((4 + (b) * 2 + (h)) * HTB)
#define PG8_STAGE(bufoff, gbase, voff) do { _Pragma("unroll") for (int _i = 0; _i < 2; ++_i) \
        __builtin_amdgcn_global_load_lds((const unsigned*)((const char*)(gbase) + (voff)[_i]), (PG8_LAS unsigned*)(lds + (bufoff) + ldsw + _i * 8192), 16, 0, 0); } while (0)
#define PG8_LDA(dst, b, h) do { _Pragma("unroll") for (int m = 0; m < 4; ++m) _Pragma("unroll") for (int k = 0; k < 2; ++k) dst[m][k] = *(const PG8_LAS bf16x8*)(lds + PG8_SA(b, h) + aoff + m * 2048 + k * 1024); } while (0)
#define PG8_LDB(dst, b, h) do { _Pragma("unroll") for (int n = 0; n < 2; ++n) _Pragma("unroll") for (int k = 0; k < 2; ++k) dst[n][k] = *(const PG8_LAS bf16x8*)(lds + PG8_SB(b, h) + boff + n * 2048 + k * 1024); } while (0)
#define PG8_MMA(ai, bj, At, Bt) do { __builtin_amdgcn_s_setprio(1); _Pragma("unroll") for (int m = 0; m < 4; ++m) _Pragma("unroll") for (int n = 0; n < 2; ++n) _Pragma("unroll") for (int k = 0; k < 2; ++k) \
        acc[ai][bj][m][n] = __builtin_amdgcn_mfma_f32_16x16x32_bf16(Bt[n][k], At[m][k], acc[ai][bj][m][n], 0, 0, 0); __builtin_amdgcn_s_setprio(0); } while (0)
#define PG8_WAIT_V(n) asm volatile("s_waitcnt vmcnt(" #n ")" ::: "memory")
#define PG8_WAIT_L(n) asm volatile("s_waitcnt lgkmcnt(" #n ")" ::: "memory")
#define PG8_BAR __builtin_amdgcn_s_barrier()
#define PG8_SCHED __builtin_amdgcn_sched_barrier(0)
    Unit cur, nxt; int ui = 0;
    if (!S.next(0, cur)) return;
    f32x4 acc[2][2][4][2];
#pragma unroll
    for (int a = 0; a < 2; ++a)
#pragma unroll
        for (int b = 0; b < 2; ++b)
#pragma unroll
            for (int m = 0; m < 4; ++m)
#pragma unroll
                for (int n = 0; n < 2; ++n) acc[a][b][m][n] = (f32x4){0.f, 0.f, 0.f, 0.f};
    bf16x8 At[4][2], B0[2][2], B1[2][2];
    const char* cA = (const char*)g.A + (g.rowmap ? (size_t)tile_row0(1, cur.pm) * K * 2 : (size_t)cur.pm * g.a_tstep); const char* cB = (const char*)g.Bt + (size_t)cur.pn * tstep;
    S.a_ready(cur);
    if constexpr (SP2) {
        PG8_STAGE(PG8_SB(0, 0), cB, voffB); PG8_STAGE(PG8_SB(0, 1), cB + hstep, voffB); PG8_STAGE(PG8_SA(0, 0), cA, voffA); PG8_STAGE(PG8_SA(0, 1), cA + hstep, voffA);
        if (wr == 1) PG8_BAR;
        PG8_WAIT_V(2); PG8_BAR;
        PG8_STAGE(PG8_SB(1, 0), cB + kstep, voffB); PG8_STAGE(PG8_SA(1, 0), cA + kstep, voffA); PG8_STAGE(PG8_SB(1, 1), cB + hstep + kstep, voffB);
        PG8_WAIT_V(6); PG8_BAR;
    } else {
        PG8_STAGE(PG8_SB(0, 0), cB, voffB); PG8_STAGE(PG8_SA(0, 0), cA, voffA); PG8_STAGE(PG8_SB(0, 1), cB + hstep, voffB); PG8_STAGE(PG8_SA(0, 1), cA + hstep, voffA);
        if (wr == 1) PG8_BAR;
        PG8_WAIT_V(4); PG8_BAR;
        PG8_STAGE(PG8_SB(1, 0), cB + kstep, voffB); PG8_STAGE(PG8_SA(1, 0), cA + kstep, voffA); PG8_STAGE(PG8_SB(1, 1), cB + hstep + kstep, voffB);
        PG8_WAIT_V(6); PG8_BAR;
    }
    for (;;) {
        const bool has_next = S.next(ui + 1, nxt);
        const char* nA = has_next ? (const char*)g.A + (g.rowmap ? (size_t)tile_row0(1, nxt.pm) * K * 2 : (size_t)nxt.pm * g.a_tstep) : cA; const char* nB = has_next ? (const char*)g.Bt + (size_t)nxt.pn * tstep : cB;
        for (int t = 0; t < nt; t += 2) {
            const bool last = (t == nt - 2);
            const char* a1 = cA + (size_t)(t + 1) * kstep;
            const char* a2 = last ? nA : cA + (size_t)(t + 2) * kstep; const char* b2 = last ? nB : cB + (size_t)(t + 2) * kstep;
            const char* a3 = a2 + kstep; const char* b3 = b2 + kstep;
            if (last && has_next) S.a_ready(nxt);
            if constexpr (SP2) {
            PG8_LDB(B0, 0, 0); PG8_LDB(B1, 0, 1); PG8_SCHED; PG8_LDA(At, 0, 0); PG8_STAGE(PG8_SA(1, 1), a1 + hstep, voffA);
            PG8_WAIT_V(8); PG8_WAIT_L(0); PG8_BAR; PG8_MMA(0, 0, At, B0); PG8_MMA(0, 1, At, B1); PG8_BAR; PG8_SCHED;
            PG8_LDA(At, 0, 1); PG8_STAGE(PG8_SB(0, 0), b2, voffB); PG8_STAGE(PG8_SB(0, 1), b2 + hstep, voffB); PG8_STAGE(PG8_SA(0, 0), a2, voffA);
            PG8_WAIT_V(8); PG8_WAIT_L(0); PG8_BAR; PG8_MMA(1, 0, At, B0); PG8_MMA(1, 1, At, B1); PG8_BAR; PG8_SCHED;
            PG8_LDB(B0, 1, 0); PG8_LDB(B1, 1, 1); PG8_SCHED; PG8_LDA(At, 1, 0); PG8_STAGE(PG8_SA(0, 1), a2 + hstep, voffA);
            PG8_WAIT_V(8); PG8_WAIT_L(0); PG8_BAR; PG8_MMA(0, 0, At, B0); PG8_MMA(0, 1, At, B1); PG8_BAR; PG8_SCHED;
            PG8_LDA(At, 1, 1); PG8_STAGE(PG8_SB(1, 0), b3, voffB); PG8_STAGE(PG8_SB(1, 1), b3 + hstep, voffB); PG8_STAGE(PG8_SA(1, 0), a3, voffA);
            PG8_WAIT_V(8); PG8_WAIT_L(0); PG8_BAR; PG8_MMA(1, 0, At, B0); PG8_MMA(1, 1, At, B1); PG8_BAR; PG8_SCHED;
            } else {
            PG8_LDB(B0, 0, 0); PG8_SCHED; PG8_LDA(At, 0, 0); PG8_STAGE(PG8_SA(1, 1), a1 + hstep, voffA);
            PG8_WAIT_L(8); PG8_BAR; PG8_WAIT_L(0); PG8_MMA(0, 0, At, B0); PG8_BAR; PG8_SCHED;
            PG8_LDB(B1, 0, 1); PG8_STAGE(PG8_SB(0, 0), b2, voffB);
            PG8_BAR; PG8_WAIT_L(0); PG8_MMA(0, 1, At, B1); PG8_BAR;
            PG8_LDA(At, 0, 1); PG8_STAGE(PG8_SA(0, 0), a2, voffA);
            PG8_BAR; PG8_WAIT_L(0); PG8_MMA(1, 0, At, B0); PG8_BAR; PG8_SCHED;
            PG8_STAGE(PG8_SB(0, 1), b2 + hstep, voffB);
            PG8_WAIT_V(6); PG8_BAR; PG8_MMA(1, 1, At, B1); PG8_BAR;
            PG8_LDB(B0, 1, 0); PG8_SCHED; PG8_LDA(At, 1, 0); PG8_STAGE(PG8_SA(0, 1), a2 + hstep, voffA);
            PG8_WAIT_L(8); PG8_BAR; PG8_WAIT_L(0); PG8_MMA(0, 0, At, B0); PG8_BAR; PG8_SCHED;
            PG8_LDB(B1, 1, 1); PG8_STAGE(PG8_SB(1, 0), b3, voffB);
            PG8_BAR; PG8_WAIT_L(0); PG8_MMA(0, 1, At, B1); PG8_BAR;
            PG8_LDA(At, 1, 1); PG8_STAGE(PG8_SA(1, 0), a3, voffA);
            PG8_BAR; PG8_WAIT_L(0); PG8_MMA(1, 0, At, B0); PG8_BAR; PG8_SCHED;
            PG8_STAGE(PG8_SB(1, 1), b3 + hstep, voffB);
            PG8_WAIT_V(6); PG8_BAR; PG8_MMA(1, 1, At, B1); PG8_BAR;
            }
        }
        if constexpr (ALIGN_EPI) { if (wr == 0) PG8_BAR; }
        if constexpr (!Epi::AFTER_DRAIN) { E(acc, cur, wr, wc, fr, fq); S.done(cur); }
        if (!has_next) break;
#pragma unroll
        for (int a = 0; a < 2; ++a)
#pragma unroll
            for (int b = 0; b < 2; ++b)
#pragma unroll
                for (int m = 0; m < 4; ++m)
#pragma unroll
                    for (int n = 0; n < 2; ++n) acc[a][b][m][n] = (f32x4){0.f, 0.f, 0.f, 0.f};
        cur = nxt; cA = nA; cB = nB; ++ui;
        if constexpr (ALIGN_EPI) { if (wr == 1) PG8_BAR; }
    }
    PG8_WAIT_V(0);
    if constexpr (!ALIGN_EPI) { if (wr == 0) PG8_BAR; }
    PG8_BAR;
    if constexpr (Epi::AFTER_DRAIN) { E.fused(acc, cur, wr, wc, fr, fq, lds, wid, lane); S.done(cur); }
#undef PG8_SA
#undef PG8_SB
#undef PG8_STAGE
#undef PG8_LDA
#undef PG8_LDB
#undef PG8_MMA
#undef PG8_WAIT_V
#undef PG8_WAIT_L
#undef PG8_BAR
#undef PG8_SCHED
}
}

constexpr int REP_SCORE = 1, REP_SEL = 1, REP_ATT = 1, REP_SLOW = 1, REP_FAST = 1;

#include <hip/hip_cooperative_groups.h>
namespace cg = cooperative_groups;
#define LAS __attribute__((address_space(3)))
constexpr int LDS_BYTES = 163840, HALO_OFF = 133120, PT_OFF = 163328, NTHR = 512, NWAVE = 8;
constexpr size_t MiB = (size_t)1 << 20;
constexpr size_t WS_CTL = 0, WS_WIN = 1 * MiB, WS_WOUT = 21 * MiB, WS_WGU = 31 * MiB, WS_WDN = 75 * MiB, WS_METAX = 97 * MiB, WS_RSTD = 98 * MiB, WS_UF = 99 * MiB,
                 WS_DT = 104 * MiB, WS_FCUM = 106 * MiB, WS_CN = 108 * MiB, WS_MASK = 117 * MiB, WS_XB = 134 * MiB, WS_Y = 264 * MiB, WS_R1 = 426 * MiB, WS_XC = WS_R1 + 323 * MiB,
                 WS_YA = 814 * MiB, WS_END = 879 * MiB;
static_assert(WS_WIN + (size_t)NU * DM * 2 <= WS_WOUT && WS_WOUT + (size_t)DM * KOUT * 2 <= WS_WGU && WS_WGU + (size_t)NGU * DM * 2 <= WS_WDN && WS_WDN + (size_t)DM * FF * 2 <= WS_METAX, "ws weights");
static_assert(WS_UF + (size_t)MP * 32 * 4 <= WS_DT && WS_DT + (size_t)T * 8 * 4 <= WS_FCUM && WS_FCUM + (size_t)64 * LKP * 4 <= WS_CN && WS_CN + (size_t)MP * 128 * 2 <= WS_MASK && WS_MASK + (size_t)T * NMW * 8 <= WS_XB, "ws small");
static_assert(WS_XB + (size_t)(MP + 8) * DM * 2 <= WS_Y && WS_Y + (size_t)MP * KOUT * 2 <= WS_R1 && WS_R1 + (size_t)MP * NU * 2 <= WS_XC && WS_XC + (size_t)MP * 1024 * 2 <= WS_YA && WS_R1 + (size_t)MP * FF * 2 <= WS_YA && WS_YA + (size_t)T * 512 * 4 <= WS_END, "ws big");

typedef unsigned u32x4v __attribute__((ext_vector_type(4)));
typedef unsigned u32x2v __attribute__((ext_vector_type(2)));
typedef float f32x4v __attribute__((ext_vector_type(4)));
struct Args { const float* in[25]; float* out; unsigned char* ws; };

struct Ctx {
    int tid, lane, wave, gw, ngw, bid, nb;
    LAS unsigned char* lds;
};
__device__ __forceinline__ Ctx refresh(const Ctx& c0) {
    Ctx c = c0; unsigned z = 0u; int w_ = c0.wave, b_ = (int)blockIdx.x, n_ = (int)gridDim.x; asm volatile("" : "+v"(z), "+s"(w_), "+s"(b_), "+s"(n_));
    const int lane = (int)__builtin_amdgcn_mbcnt_hi(~0u, __builtin_amdgcn_mbcnt_lo(~0u, z));
    c.bid = b_; c.nb = n_; c.ngw = n_ * NWAVE; c.wave = w_; c.lane = lane; c.tid = w_ * 64 + lane; c.gw = b_ * NWAVE + w_;
    { unsigned l_ = (unsigned)(size_t)c0.lds; asm volatile("" : "+s"(l_)); c.lds = (LAS unsigned char*)(size_t)l_; }
    return c;
}
__device__ __forceinline__ unsigned char* pt_get(const Ctx& c, int i) {
    unsigned l_ = (unsigned)(size_t)c.lds; asm volatile("" : "+s"(l_));
    const LAS unsigned* p = (const LAS unsigned*)((LAS unsigned char*)(size_t)l_ + PT_OFF) + 2 * i;
    const unsigned lo = __builtin_amdgcn_readfirstlane(p[0]), hi = __builtin_amdgcn_readfirstlane(p[1]);
    __attribute__((address_space(1))) unsigned char* gp = (__attribute__((address_space(1))) unsigned char*)(((unsigned long long)hi << 32) | lo);
    return (unsigned char*)gp;
}
#define INP(i) ((const float*)pt_get(c, (i)))

#define GAS __attribute__((address_space(1)))
typedef unsigned v4u __attribute__((ext_vector_type(4)));
typedef GAS unsigned gu32;
typedef GAS unsigned long long gu64;
#define RLX_AGENT __ATOMIC_RELAXED, __HIP_MEMORY_SCOPE_AGENT
#define LDS_WAIT() asm volatile("s_waitcnt lgkmcnt(0)" ::: "memory")
#define VM_WAIT() asm volatile("s_waitcnt vmcnt(0)" ::: "memory")
__device__ __forceinline__ unsigned long long rt() { return __builtin_amdgcn_s_memrealtime(); }

#define XB_TMO      128
#define XB_XCNT(j)  (256  + 64 * (j))
#define XB_XSUB(j)  (1280 + 64 * (j))
#define XB_XGEN(j)  (2304 + 64 * (j))
#define XB_TOP      3328
#define XB_TOPGEN   3392
#define XCD_BAR_WORDS 3456
#define XB_SPIN_CAP (1u << 18)

__device__ __forceinline__ unsigned xb_ld(unsigned* p)              { return __hip_atomic_load(p, __ATOMIC_RELAXED, __HIP_MEMORY_SCOPE_AGENT); }
__device__ __forceinline__ unsigned xb_add(unsigned* p, unsigned v) { return __hip_atomic_fetch_add(p, v, __ATOMIC_RELAXED, __HIP_MEMORY_SCOPE_AGENT); }
__device__ __forceinline__ unsigned xb_xcc_id() { return (unsigned)__builtin_amdgcn_s_getreg((3 << 11) | 20) & 0xFu; }
#define XB_SPIN(cond, bar) do { unsigned _sp = 0; while (cond) { __builtin_amdgcn_s_sleep(1); \
    if ((++_sp & 255u) == 0u) { if (xb_ld(&(bar)[XB_TMO])) break; if (_sp > XB_SPIN_CAP) { atomicAdd(&(bar)[XB_TMO], 1u); break; } } } } while (0)

struct XcdBarrier {
    unsigned* bar; unsigned x;
    volatile LAS unsigned* st;
};

__device__ __forceinline__ XcdBarrier xcd_barrier_post(unsigned* bar, volatile LAS unsigned* st, int tid) {
    XcdBarrier b; b.bar = bar; b.x = xb_xcc_id(); b.st = st;
    if (tid == 0) (void)xb_add(&bar[XB_XCNT(b.x)], 1u);
    return b;
}
__device__ __forceinline__ void xcd_barrier_complete(unsigned* bar, unsigned x, unsigned& nloc, unsigned& nx) {
    const unsigned G = gridDim.x * gridDim.y * gridDim.z;
    unsigned sum, cnt, mine, sp = 0u;
    for (;;) {
        sum = 0u; cnt = 0u; mine = 0u;
#pragma unroll
        for (unsigned j = 0; j < 16; ++j) { const unsigned c = xb_ld(&bar[XB_XCNT(j)]); sum += c; cnt += (c > 0u) ? 1u : 0u; mine = (j == x) ? c : mine; }
        if (sum == G) break;
        __builtin_amdgcn_s_sleep(1);
        if ((++sp & 255u) == 0u) { if (xb_ld(&bar[XB_TMO])) break; if (sp > XB_SPIN_CAP) { atomicAdd(&bar[XB_TMO], 1u); break; } }
    }
    nloc = mine > 0u ? mine : 1u; nx = cnt > 0u ? cnt : 1u;
}

__device__ __forceinline__ void xcd_barrier(const XcdBarrier& b, int tid) {
    asm volatile("s_waitcnt vmcnt(0)" ::: "memory");
    __syncthreads();
    if (tid == 0) {
        unsigned* bar = b.bar;
        __builtin_amdgcn_s_waitcnt(0);
        unsigned nloc = b.st[0], nx = b.st[1];
        if (nloc == 0u) { xcd_barrier_complete(bar, b.x, nloc, nx); b.st[0] = nloc; b.st[1] = nx; }
        const unsigned old = xb_add(&bar[XB_XSUB(b.x)], 1u);
        const unsigned gen = old / nloc;
        if (old + 1u == (gen + 1u) * nloc) {
            __builtin_amdgcn_fence(__ATOMIC_RELEASE, "agent");
            asm volatile("s_waitcnt vmcnt(0)" ::: "memory");
            const unsigned og = xb_add(&bar[XB_TOP], 1u);
            const unsigned tg = og / nx;
            if (og + 1u == (tg + 1u) * nx) xb_add(&bar[XB_TOPGEN], 1u);
            else XB_SPIN(xb_ld(&bar[XB_TOPGEN]) == tg, bar);
            __builtin_amdgcn_fence(__ATOMIC_ACQUIRE, "agent");
            xb_add(&bar[XB_XGEN(b.x)], 1u);
            asm volatile("s_waitcnt vmcnt(0)" ::: "memory");
        } else {
            XB_SPIN(xb_ld(&bar[XB_XGEN(b.x)]) == gen, bar);
            __builtin_amdgcn_fence(__ATOMIC_ACQUIRE, "agent");
            asm volatile("s_waitcnt vmcnt(0)" ::: "memory");
        }
    }
    __syncthreads();
}

constexpr int MISC_OFF = 163072, CW_BAR = 4096;
__device__ __forceinline__ void grid_barrier(const Ctx& c0) {
    const Ctx c = refresh(c0);
    XcdBarrier b; b.bar = (unsigned*)(pt_get(c, 26) + WS_CTL) + CW_BAR; b.x = xb_xcc_id(); b.st = (volatile LAS unsigned*)(c.lds + MISC_OFF);
    xcd_barrier(b, c.tid);
}
__device__ __forceinline__ void ph_prep_x(const Ctx& c0, const float* x, const float* meta, bf16* XB, float* RSTD) { const Ctx c = refresh(c0);
    const int lane = c.lane;
    for (int w = c.gw; w < MP + 8; w += c.ngw) {
        const int t = w - 8; bf16* xb = XB + (ptrdiff_t)t * DM;
        if (t < 0 || t >= T) {
#pragma unroll
            for (int j = 0; j < 4; ++j) *(u32x4v*)(xb + 8 * lane + 512 * j) = (u32x4v){0u, 0u, 0u, 0u};
            if (t >= T && lane == 0) RSTD[t] = 0.f;
            continue;
        }
        const int b = t / L, p = t - b * L;
        const float* src = p < NMETA ? meta + (size_t)p * DM : x + ((size_t)b * SEQ + (p - NMETA)) * DM;
        float ss = 0.f;
#pragma unroll
        for (int j = 0; j < 4; ++j) {
            const f32x4v a = *(const f32x4v*)(src + 8 * lane + 512 * j), cc = *(const f32x4v*)(src + 8 * lane + 512 * j + 4);
            ss += a.x * a.x + a.y * a.y + a.z * a.z + a.w * a.w + cc.x * cc.x + cc.y * cc.y + cc.z * cc.z + cc.w * cc.w;
            *(u32x4v*)(xb + 8 * lane + 512 * j) = (u32x4v){pk2(a.x, a.y), pk2(a.z, a.w), pk2(cc.x, cc.y), pk2(cc.z, cc.w)};
        }
        ss = wave_sum(ss, lane);
        if (lane == 0) RSTD[t] = rsqrtf(ss * (1.f / DM) + EPSF);
    }
}

__device__ __forceinline__ void tp_tile(LAS float* tl, int lane, const float* src, int ld, const float* scale, float mul, bf16* dst, int Kd) {
    const int kk = lane >> 4, n4 = lane & 15;
    f32x4v v[16];
#pragma unroll
    for (int i = 0; i < 16; ++i) v[i] = *(const f32x4v*)(src + (size_t)(4 * i + kk) * ld + 4 * n4);
    if (scale) {
#pragma unroll
        for (int i = 0; i < 16; ++i) v[i] = v[i] * (scale[4 * i + kk] * mul); }
#pragma unroll
    for (int i = 0; i < 16; ++i)
#pragma unroll
        for (int e = 0; e < 4; ++e) tl[(4 * n4 + e) * 65 + 4 * i + kk] = v[i][e];
#pragma unroll
    for (int jj = 0; jj < 8; ++jj) { const int n = (lane >> 3) + 8 * jj, kc = (lane & 7) * 8; const LAS float* tp = tl + n * 65 + kc;
        *(u32x4v*)(dst + (size_t)n * Kd + kc) = (u32x4v){pk2(tp[0], tp[1]), pk2(tp[2], tp[3]), pk2(tp[4], tp[5]), pk2(tp[6], tp[7])}; }
}
template <class F, class M> __device__ __forceinline__ void transpose_tiles_map(const Ctx& c, bf16* dst, int Kd, int ntiles, const F& val, const M& map) {
    LAS float* tile = (LAS float*)c.lds + (c.tid >> 8) * (32 * 33);
    const int t2 = c.tid & 255, tx = t2 & 31, ty = t2 >> 5;
    for (int it = 2 * c.bid + (c.tid >> 8); it < ntiles; it += 2 * c.nb) {
        int k0, n0; map(it, k0, n0);
#pragma unroll
        for (int i = 0; i < 4; ++i) tile[(ty + 8 * i) * 33 + tx] = val(k0 + ty + 8 * i, n0 + tx);
        __syncthreads();
#pragma unroll
        for (int i = 0; i < 4; ++i) dst[(size_t)(n0 + ty + 8 * i) * Kd + k0 + tx] = f2bf(tile[tx * 33 + ty + 8 * i]);
        __syncthreads();
    }
}
__device__ __forceinline__ void ph_prep_w(const Ctx& c0, int ly, bf16* WIN, bf16* WOUT, bf16* WGU, bf16* WDN) { const Ctx c = refresh(c0);
    const float* w_in = INP(6) + (size_t)ly * DM * DIN; const float* g1 = INP(2) + (size_t)ly * DM; const float* w_uk = INP(17) + (size_t)ly * 8 * 128 * 64;
    const float* w_out = INP(19) + (size_t)ly * DM * DM; const float* ssd_norm = INP(12) + (size_t)ly * 512; const float* pool_w = INP(13) + (size_t)ly * 4 * 128 * 128;
    const float* pool_scale = INP(14) + (size_t)ly * 512; const float* w_uv = INP(18) + (size_t)ly * 8 * 128 * 64;
    const float* wg = INP(20) + (size_t)ly * DM * FF; const float* wu = INP(21) + (size_t)ly * DM * FF; const float* g3 = INP(4) + (size_t)ly * DM;
    const float* wd = INP(24) + (size_t)ly * FF * DM;
    {
        LAS float* tl = (LAS float*)c.lds + c.wave * (64 * 65);
        constexpr int N_WIN = 63 * 32, N_WGU = 176 * 32, N_WDN = 32 * 88, N_WOUT = 32 * 16, N_ALL = N_WIN + N_WGU + N_WDN + N_WOUT;
#pragma unroll 1
        for (int it0 = c.gw; it0 < N_ALL * REP_FAST; it0 += c.ngw) { const int it = it0 % N_ALL;
            int r = it; const float* src; const float* scl; bf16* dst; int ld, Kd; float mul = 1.f;
            if (r < N_WGU) { const int kt = r / 176, ct = r - kt * 176, pn = ct >> 2, up = (ct >> 1) & 1, hf = ct & 1;
                src = (up ? wu : wg) + (size_t)(64 * kt) * FF + 128 * pn + 64 * hf; ld = FF; scl = g3 + 64 * kt; dst = WGU + (size_t)(256 * pn + 128 * up + 64 * hf) * DM + 64 * kt; Kd = DM; }
            else if ((r -= N_WGU) < N_WDN) { const int kt = r >> 5, ct = r & 31;
                src = wd + (size_t)(64 * kt) * DM + 64 * ct; ld = DM; scl = nullptr; dst = WDN + (size_t)(64 * ct) * FF + 64 * kt; Kd = FF; }
            else if ((r -= N_WDN) < N_WIN) { const int kt = r / 63, ct = r - kt * 63;
                int dcol, scol;
                if (ct < 24) { dcol = 64 * ct; scol = dcol; }
                else if (ct < 32) { dcol = 64 * ct; scol = 1544 + 64 * (ct - 24); }
                else if (ct < 56) { dcol = 64 * ct; scol = 2056 + 64 * (ct - 32); if (ct < 40) mul = 0.18033688011112042f; }
                else if (ct < 58) { dcol = C_DC + 64 * (ct - 56); scol = 4112 + 64 * (ct - 56); }
                else if (ct < 62) { dcol = C_QI + 64 * (ct - 58); scol = 4240 + 64 * (ct - 58); }
                else { dcol = C_KI; scol = 4496; }
                src = w_in + (size_t)(64 * kt) * DIN + scol; ld = DIN; scl = g1 + 64 * kt; dst = WIN + (size_t)dcol * DM + 64 * kt; Kd = DM; }
            else { r -= N_WIN; const int kq = r >> 5, nt = r & 31, k0 = kq < 8 ? 64 * kq : 1024 + 64 * (kq - 8);
                src = w_out + (size_t)k0 * DM + 64 * nt; ld = DM; scl = kq < 8 ? ssd_norm + k0 : nullptr; dst = WOUT + (size_t)(64 * nt) * KOUT + k0; Kd = KOUT; }
            tp_tile(tl, c.lane, src, ld, scl, mul, dst, Kd);
        }
    }
    __syncthreads();
    {   const int gt = c.bid * NTHR + c.tid, ngt = c.nb * NTHR;
        for (int it = gt; it < 8 * 512 * 32; it += ngt) {
            const int rq = it & 31, kq = (it >> 5) & 511, h = it >> 14, k0 = 4 * kq, r0 = 4 * rq;
            float acc[4][4];
#pragma unroll
            for (int a = 0; a < 4; ++a)
#pragma unroll
                for (int b = 0; b < 4; ++b) acc[a][b] = 0.f;
            const float* ap = w_in + (size_t)k0 * DIN + 3600 + 64 * h; const float* bp = w_uk + ((size_t)h * 128 + r0) * 64;
#pragma unroll 4
            for (int d = 0; d < 64; d += 4) {
                f32x4v av[4], bv[4];
#pragma unroll
                for (int a = 0; a < 4; ++a) { av[a] = *(const f32x4v*)(ap + (size_t)a * DIN + d); bv[a] = *(const f32x4v*)(bp + a * 64 + d); }
#pragma unroll
                for (int a = 0; a < 4; ++a)
#pragma unroll
                    for (int b = 0; b < 4; ++b) acc[a][b] += av[a][0] * bv[b][0] + av[a][1] * bv[b][1] + av[a][2] * bv[b][2] + av[a][3] * bv[b][3];
            }
            const f32x4v gk = *(const f32x4v*)(g1 + k0);
#pragma unroll
            for (int b = 0; b < 4; ++b) { const float sc = 0.125f * 1.4426950408889634f;
                *(u32x2v*)(WIN + (size_t)(C_QLAT + 128 * h + r0 + b) * DM + k0) = (u32x2v){pk2(acc[0][b] * sc * gk[0], acc[1][b] * sc * gk[1]), pk2(acc[2][b] * sc * gk[2], acc[3][b] * sc * gk[3])}; }
        }
        for (int it = gt; it < 4 * 32 * 512; it += ngt) {
            const int nq = it & 511, cq = (it >> 9) & 31, gi = it >> 14, n0 = 4 * nq, c0_ = 4 * cq;
            float acc[4][4];
#pragma unroll
            for (int a = 0; a < 4; ++a)
#pragma unroll
                for (int b = 0; b < 4; ++b) acc[a][b] = 0.f;
            const float* ap = pool_w + ((size_t)gi * 128 + c0_) * 128; const float* sp = pool_scale + 128 * gi; const float* bp = w_out + (size_t)(512 + 128 * gi) * DM + n0;
#pragma unroll 2
            for (int d = 0; d < 128; d += 4) {
                f32x4v av[4], bv[4]; const f32x4v sv = *(const f32x4v*)(sp + d);
#pragma unroll
                for (int a = 0; a < 4; ++a) { av[a] = *(const f32x4v*)(ap + a * 128 + d) * sv; bv[a] = *(const f32x4v*)(bp + (size_t)(d + a) * DM); }
#pragma unroll
                for (int a = 0; a < 4; ++a)
#pragma unroll
                    for (int b = 0; b < 4; ++b) acc[a][b] += av[a][0] * bv[0][b] + av[a][1] * bv[1][b] + av[a][2] * bv[2][b] + av[a][3] * bv[3][b];
            }
#pragma unroll
            for (int b = 0; b < 4; ++b) *(u32x2v*)(WOUT + (size_t)(n0 + b) * KOUT + 512 + 128 * gi + c0_) = (u32x2v){pk2(acc[0][b], acc[1][b]), pk2(acc[2][b], acc[3][b])};
        }
        for (int it = gt; it < 8 * 32 * 512; it += ngt) {
            const int nq = it & 511, rq = (it >> 9) & 31, h = it >> 14, n0 = 4 * nq, r0 = 4 * rq;
            float acc[4][4];
#pragma unroll
            for (int a = 0; a < 4; ++a)
#pragma unroll
                for (int b = 0; b < 4; ++b) acc[a][b] = 0.f;
            const float* ap = w_uv + ((size_t)h * 128 + r0) * 64; const float* bp = w_out + (size_t)(1536 + 64 * h) * DM + n0;
#pragma unroll 2
            for (int d = 0; d < 64; d += 4) {
                f32x4v av[4], bv[4];
#pragma unroll
                for (int a = 0; a < 4; ++a) { av[a] = *(const f32x4v*)(ap + a * 64 + d); bv[a] = *(const f32x4v*)(bp + (size_t)(d + a) * DM); }
#pragma unroll
                for (int a = 0; a < 4; ++a)
#pragma unroll
                    for (int b = 0; b < 4; ++b) acc[a][b] += av[a][0] * bv[0][b] + av[a][1] * bv[1][b] + av[a][2] * bv[2][b] + av[a][3] * bv[3][b];
            }
#pragma unroll
            for (int b = 0; b < 4; ++b) *(u32x2v*)(WOUT + (size_t)(n0 + b) * KOUT + 1536 + 128 * h + r0) = (u32x2v){pk2(acc[0][b], acc[1][b]), pk2(acc[2][b], acc[3][b])};
        }
    }
    transpose_tiles_map(c, WIN, DM, 2 * 64, [=](int k, int n) -> float {
            int src = -1;
            if (n < C_SM + 8) src = 1536 + (n - C_SM);
            else if (n < C_SM + 16) src = 3592 + (n - C_SM - 8);
            else if (n < C_SM + 20) src = 4560 + (n - C_SM - 16);
            return src >= 0 ? w_in[(size_t)k * DIN + src] * g1[k] : 0.f; },
        [=](int it, int& k0, int& n0) { k0 = 32 * (it & 63); n0 = C_SM + 32 * (it >> 6); });
}

__device__ __forceinline__ void ph_mixprep(const Ctx& c0, const bf16* U, const float* UF, const float* cw, const float* cb, const float* kvn, const float* dtb, bf16* XC, bf16* Y, bf16* CN, float* DT, bf16* KI) { const Ctx c = refresh(c0);
    const int gt = c.bid * NTHR + c.tid, ngt = c.nb * NTHR;
    for (int idx = gt; idx < T * 128; idx += ngt) {
        const int t = idx >> 7, c0 = (idx & 127) * 8, pos = t % L; float acc[8];
        u32x4v v[4]; f32x4v wa[4], wb[4];
#pragma unroll
        for (int k = 0; k < 4; ++k) { const bool ok = pos - 3 + k >= 0; v[k] = *(const u32x4v*)(U + (size_t)(ok ? t - 3 + k : t) * NU + C_XBC + c0);
            wa[k] = *(const f32x4v*)(cw + k * 1024 + c0); wb[k] = *(const f32x4v*)(cw + k * 1024 + c0 + 4); if (!ok) { wa[k] = (f32x4v){0.f, 0.f, 0.f, 0.f}; wb[k] = wa[k]; } }
        const f32x4v ba = *(const f32x4v*)(cb + c0), bb = *(const f32x4v*)(cb + c0 + 4);
#pragma unroll
        for (int j = 0; j < 4; ++j) { acc[j] = ba[j]; acc[4 + j] = bb[j]; }
#pragma unroll
        for (int k = 0; k < 4; ++k) { const unsigned w[4] = {v[k].x, v[k].y, v[k].z, v[k].w};
#pragma unroll
            for (int j = 0; j < 8; ++j) acc[j] += (j < 4 ? wa[k][j] : wb[k][j - 4]) * bf2f((bf16)(w[j >> 1] >> (16 * (j & 1)))); }
        *(u32x4v*)(XC + (size_t)t * 1024 + c0) = (u32x4v){pk2(siluf(acc[0]), siluf(acc[1])), pk2(siluf(acc[2]), siluf(acc[3])), pk2(siluf(acc[4]), siluf(acc[5])), pk2(siluf(acc[6]), siluf(acc[7]))};
    }
    for (int idx = gt; idx < T * 64; idx += ngt) {
        const int t = idx >> 6, c0 = (idx & 63) * 8, pos = t % L, gi = c0 >> 7, win = 2 << gi, n = min(pos + 1, win);
        float acc[8] = {0, 0, 0, 0, 0, 0, 0, 0}, self[8] = {0, 0, 0, 0, 0, 0, 0, 0};
        const bf16* up = U + (size_t)t * NU + C_POOL + c0;
#define POOL_WIN(W) { u32x4v v[W]; _Pragma("unroll") for (int i = 0; i < W; ++i) v[i] = i < n ? *(const u32x4v*)(up - (ptrdiff_t)i * NU) : (u32x4v){0u, 0u, 0u, 0u}; \
            _Pragma("unroll") for (int i = 0; i < W; ++i) { const unsigned w[4] = {v[i].x, v[i].y, v[i].z, v[i].w}; \
                _Pragma("unroll") for (int j = 0; j < 8; ++j) { const float f = bf2f((bf16)(w[j >> 1] >> (16 * (j & 1)))); acc[j] += f; if (i == 0) self[j] = f; } } }
        if (gi == 0) POOL_WIN(2) else if (gi == 1) POOL_WIN(4) else if (gi == 2) POOL_WIN(8) else POOL_WIN(16)
        const float inv = 1.f / (float)n; float o[8];
#pragma unroll
        for (int j = 0; j < 8; ++j) o[j] = acc[j] * inv - self[j];
        *(uint4*)(Y + (size_t)t * KOUT + 512 + c0) = make_uint4(pk2(o[0], o[1]), pk2(o[2], o[3]), pk2(o[4], o[5]), pk2(o[6], o[7]));
    }
    for (int t = c.gw; t < T; t += c.ngw) {
        const int lane = c.lane;
        const unsigned v = *(const unsigned*)(U + (size_t)t * NU + C_DC + 2 * lane);
        const float a = bf2f((bf16)(v & 0xffff)), cc = bf2f((bf16)(v >> 16));
        const float rs = rsqrtf(wave_sum(a * a + cc * cc, lane) * (1.f / 128.f) + EPSF);
        *(unsigned*)(CN + (size_t)t * 128 + 2 * lane) = pk2(a * rs * kvn[2 * lane], cc * rs * kvn[2 * lane + 1]);
        if (lane < 8) DT[(size_t)t * 8 + lane] = softplusf(UF[(size_t)t * 32 + lane] + dtb[lane]);
        if (lane < 32) *(unsigned*)(KI + (size_t)t * 64 + 2 * lane) = *(const unsigned*)(U + (size_t)t * NU + C_KI + 2 * lane);
    }
}
__device__ __forceinline__ void ph_fcum(const Ctx& c0, const float* UF, const float* fb, float* FCUM) { const Ctx c = refresh(c0);
    const int lane = c.lane, w = c.wave;
    LAS float* tot = (LAS float*)c.lds;
    for (int bh = c.bid; bh < 64; bh += c.nb) {
        const int b = bh >> 3, h = bh & 7; const float bias = fb[h]; float v[9]; float carry = 0.f;
#pragma unroll
        for (int i = 0; i < 9; ++i) { const int p = 576 * w + 64 * i + lane; v[i] = p < L ? logsigmoidf(UF[(size_t)(b * L + p) * 32 + 8 + h] + bias) : 0.f; }
#pragma unroll
        for (int i = 0; i < 9; ++i) { float x = v[i];
#pragma unroll
            for (int o = 1; o < 64; o <<= 1) { const float n = lane_read(x, (lane - o) & 63); if (lane >= o) x += n; }
            x += carry; v[i] = x; carry = lane_read(x, 63); }
        if (lane == 0) tot[w] = carry;
        __syncthreads();
        float off = 0.f;
#pragma unroll
        for (int ww = 0; ww < NWAVE; ++ww) off += ww < w ? tot[ww] : 0.f;
#pragma unroll
        for (int i = 0; i < 9; ++i) { const int p = 576 * w + 64 * i + lane; if (p < LKP) FCUM[(size_t)bh * LKP + p] = v[i] + off; }
        __syncthreads();
    }
}
__device__ __forceinline__ unsigned fkey(float f) { const unsigned u = __float_as_uint(f); return (u & 0x80000000u) ? ~u : (u | 0x80000000u); }
__device__ __forceinline__ int crow(int r, int hi) { return (r & 3) + 8 * (r >> 2) + 4 * hi; }
typedef short bf16x8 __attribute__((ext_vector_type(8)));
typedef float f32x16 __attribute__((ext_vector_type(16)));
typedef float f32x2v __attribute__((ext_vector_type(2)));
typedef __bf16 bf16x2v __attribute__((ext_vector_type(2)));
#define MFMA32(a, b, c) __builtin_amdgcn_mfma_f32_32x32x16_bf16((a), (b), (c), 0, 0, 0)
__device__ __forceinline__ float max3f(float a, float b, float c) { float r; asm("v_max3_f32 %0, %1, %2, %3" : "=v"(r) : "v"(a), "v"(b), "v"(c)); return r; }
__device__ __forceinline__ unsigned cvtpk(float lo, float hi) { f32x2v v = {lo, hi}; bf16x2v b = __builtin_convertvector(v, bf16x2v); return __builtin_bit_cast(unsigned, b); }
__device__ __forceinline__ bf16x8 pack8(const f32x16& p, int s) {
    u32x4v r; r.x = cvtpk(p[8 * s], p[8 * s + 1]); r.y = cvtpk(p[8 * s + 2], p[8 * s + 3]); r.z = cvtpk(p[8 * s + 4], p[8 * s + 5]); r.w = cvtpk(p[8 * s + 6], p[8 * s + 7]);
    return __builtin_bit_cast(bf16x8, r);
}
constexpr int AT_KSTR = 72;
constexpr int FOX_KB = 64 * AT_KSTR;
__device__ __forceinline__ void ph_fox(const Ctx& c0, const bf16* U, const float* FCUM, bf16* Y) {
    const Ctx c = refresh(c0);
    LAS bf16* KS = (LAS bf16*)c.lds;
    LAS bf16* VT = KS + 2 * FOX_KB;
    LAS float* FB = (LAS float*)(c.lds + 4 * FOX_KB * 2);
    const int lane = c.lane, w = c.wave, r32 = lane & 31, hi = lane >> 5, tid = c.tid;
    const float LOG2E = 1.4426950408889634f;
    typedef short s16x4v __attribute__((ext_vector_type(4)));
    for (int it = c.bid; it < 64 * 17; it += c.nb) {
        const int rnd = it >> 8, cu = it & 255, k4 = cu >> 6, bh = cu & 63, b = bh >> 3, h = bh & 7;
        const int j = rnd == 0 ? 16 - k4 : rnd == 1 ? 9 + k4 : rnd == 2 ? 8 - k4 : rnd == 3 ? 1 + k4 : 0;
        const int q0 = j == 0 ? 0 : 16 + 256 * (j - 1), qrow = q0 + 32 * w + r32, ntiles = 1 + 4 * j, qmax = q0 + 32 * w + 31;
        const bool wave_on = (j > 0) || (w == 0), row_ok = (j > 0) || (r32 < 16);
        const bf16* Ub = U + (size_t)(b * L) * NU;
        bf16x8 qf[4];
#pragma unroll
        for (int s = 0; s < 4; ++s) qf[s] = (bf16x8){0, 0, 0, 0, 0, 0, 0, 0};
        if (wave_on && row_ok) {
#pragma unroll
            for (int s = 0; s < 4; ++s) qf[s] = *(const bf16x8*)(Ub + (size_t)qrow * NU + C_FQ + 64 * h + 16 * s + 8 * hi);
        }
        f32x16 o0, o1;
#pragma unroll
        for (int r = 0; r < 16; ++r) { o0[r] = 0.f; o1[r] = 0.f; }
        float m = -1e30f, l = 0.f;
        const float* fc = FCUM + (size_t)bh * LKP;
        const bf16* kg = Ub + (size_t)(tid >> 3) * NU + C_FK + 64 * h + 8 * (tid & 7);
        const bf16* vg = Ub + (size_t)lane * NU + C_FV + 64 * h + 8 * w;
#define FOX_KB0(t) ((t) == 0 ? 0 : 16 + 64 * ((t) - 1))
#define FOX_PUT_K(buf, kr, fr) do { *(LAS u32x4v*)(KS + (buf) * FOX_KB + (tid >> 3) * AT_KSTR + 8 * (tid & 7)) = kr; if (tid < 64) FB[(buf) * 64 + tid] = fr; } while (0)
#define FOX_PUT_V(buf, vr) do { const unsigned vv_[4] = {vr.x, vr.y, vr.z, vr.w}; \
            _Pragma("unroll") for (int e = 0; e < 8; ++e) VT[(buf) * FOX_KB + (8 * w + e) * AT_KSTR + lane] = (bf16)(vv_[e >> 1] >> (16 * (e & 1))); } while (0)
#define FOX_GET_K(t, kr, fr) do { const int kb_ = FOX_KB0(t); kr = *(const u32x4v*)(kg + (size_t)kb_ * NU); if (tid < 64) fr = -fc[kb_ + tid] * LOG2E; } while (0)
#define FOX_GET_V(t, vr) do { vr = *(const u32x4v*)(vg + (size_t)FOX_KB0(t) * NU); } while (0)
#define FOX_QK(buf, P0, P1) do { const LAS float* fb_ = FB + (buf) * 64; \
            _Pragma("unroll") for (int i4 = 0; i4 < 4; ++i4) { const f32x4v f0 = *(const LAS f32x4v*)(fb_ + 8 * i4 + 4 * hi), f1 = *(const LAS f32x4v*)(fb_ + 32 + 8 * i4 + 4 * hi); \
                _Pragma("unroll") for (int e = 0; e < 4; ++e) { P0[4 * i4 + e] = f0[e]; P1[4 * i4 + e] = f1[e]; } } \
            _Pragma("unroll") for (int s = 0; s < 4; ++s) { \
                const bf16x8 a0 = *(const LAS bf16x8*)(KS + (buf) * FOX_KB + r32 * AT_KSTR + 16 * s + 8 * hi), a1 = *(const LAS bf16x8*)(KS + (buf) * FOX_KB + (32 + r32) * AT_KSTR + 16 * s + 8 * hi); \
                P0 = MFMA32(a0, qf[s], P0); P1 = MFMA32(a1, qf[s], P1); } } while (0)
        u32x4v kreg, vreg; float fbreg = 0.f;
        FOX_GET_K(0, kreg, fbreg); FOX_GET_V(0, vreg);
        FOX_PUT_K(0, kreg, fbreg); FOX_PUT_V(0, vreg);
        if (ntiles > 1) { FOX_GET_K(1, kreg, fbreg); FOX_GET_V(1, vreg); FOX_PUT_K(1, kreg, fbreg); }
        if (ntiles > 2) FOX_GET_K(2, kreg, fbreg);
        __syncthreads();
        f32x16 pc0, pc1, pn0, pn1;
#pragma unroll
        for (int r = 0; r < 16; ++r) { pc0[r] = 0.f; pc1[r] = 0.f; pn0[r] = 0.f; pn1[r] = 0.f; }
        if (wave_on) FOX_QK(0, pc0, pc1);
        __syncthreads();
        for (int i = 0; i < ntiles; ++i) {
            const int cur = i & 1, kb = FOX_KB0(i), kbn = FOX_KB0(i + 1);
            if (i + 2 < ntiles) FOX_PUT_K(cur, kreg, fbreg);
            if (i + 1 < ntiles) FOX_PUT_V(cur ^ 1, vreg);
            if (i + 3 < ntiles) FOX_GET_K(i + 3, kreg, fbreg);
            if (i + 2 < ntiles) FOX_GET_V(i + 2, vreg);
            const bool on_next = wave_on && (i + 1 < ntiles) && kbn <= qmax, on_cur = wave_on && kb <= qmax;
            if (on_next) FOX_QK(cur ^ 1, pn0, pn1);
            if (on_cur) {
                if (i == 0 || kb + 63 > q0 + 32 * w) {
                    const int klim = i == 0 ? 16 : 64;
#pragma unroll
                    for (int r = 0; r < 16; ++r) { const int k0 = crow(r, hi), k1 = 32 + k0;
                        if (!(k0 < klim && kb + k0 <= qrow)) pc0[r] = -1e30f;
                        if (!(k1 < klim && kb + k1 <= qrow)) pc1[r] = -1e30f; }
                }
                float mx = max3f(pc0[0], pc1[0], pc0[1]), mx2 = max3f(pc1[1], pc0[2], pc1[2]);
#pragma unroll
                for (int r = 3; r < 15; r += 2) { mx = max3f(mx, pc0[r], pc1[r]); mx2 = max3f(mx2, pc0[r + 1], pc1[r + 1]); }
                mx = max3f(mx, pc0[15], pc1[15]); mx = max3f(mx, mx2, mx2);
                const float mn = max3f(m, mx, lane_read(mx, lane ^ 32)), alpha = __builtin_amdgcn_exp2f(m - mn); const bool grew = __ballot(mn > m) != 0ull; m = mn;
                float sum = 0.f;
#pragma unroll
                for (int r = 0; r < 16; ++r) { pc0[r] = __builtin_amdgcn_exp2f(pc0[r] - mn); pc1[r] = __builtin_amdgcn_exp2f(pc1[r] - mn); sum += pc0[r] + pc1[r]; }
                l = l * alpha + sum;
                if (grew) {
#pragma unroll
                    for (int r = 0; r < 16; ++r) { o0[r] *= alpha; o1[r] *= alpha; } }
#pragma unroll
                for (int blk = 0; blk < 2; ++blk)
#pragma unroll
                    for (int s = 0; s < 2; ++s) {
                        const bf16x8 xs = pack8(blk == 0 ? pc0 : pc1, s);
                        const LAS bf16* vp = VT + cur * FOX_KB + r32 * AT_KSTR + 32 * blk + 16 * s + 4 * hi;
                        const s16x4v lo0 = *(const LAS s16x4v*)vp, hi0 = *(const LAS s16x4v*)(vp + 8);
                        const s16x4v lo1 = *(const LAS s16x4v*)(vp + 32 * AT_KSTR), hi1 = *(const LAS s16x4v*)(vp + 32 * AT_KSTR + 8);
                        const bf16x8 pa0 = __builtin_shufflevector(lo0, hi0, 0, 1, 2, 3, 4, 5, 6, 7), pa1 = __builtin_shufflevector(lo1, hi1, 0, 1, 2, 3, 4, 5, 6, 7);
                        o0 = MFMA32(pa0, xs, o0); o1 = MFMA32(pa1, xs, o1);
                    }
            }
            pc0 = pn0; pc1 = pn1;
            __syncthreads();
        }
        l += lane_read(l, lane ^ 32);
        if (wave_on && row_ok) {
            const float inv = 1.f / l; bf16* yr = Y + (size_t)(b * L + qrow) * KOUT + 1024 + 64 * h;
#pragma unroll
            for (int i4 = 0; i4 < 4; ++i4) {
                *(u32x2v*)(yr + 8 * i4 + 4 * hi) = (u32x2v){cvtpk(o0[4 * i4] * inv, o0[4 * i4 + 1] * inv), cvtpk(o0[4 * i4 + 2] * inv, o0[4 * i4 + 3] * inv)};
                *(u32x2v*)(yr + 32 + 8 * i4 + 4 * hi) = (u32x2v){cvtpk(o1[4 * i4] * inv, o1[4 * i4 + 1] * inv), cvtpk(o1[4 * i4 + 2] * inv, o1[4 * i4 + 3] * inv)};
            }
        }
    }
}
constexpr int DSA_LIST_OFF = 150016  , DSA_BUF_ELEMS = 17920  , DSA_SC_STR = 4160, DSA_MW_OFF = 8 * DSA_SC_STR * 4  , DSA_KSTR = 136, DSA_VT_OFF = 64 * DSA_KSTR * 2  ;
__device__ __forceinline__ void ph_dsa(const Ctx& c0, const bf16* U, const float* UF, const bf16* CN, const bf16* KI, bf16* Y) {
    const Ctx c = refresh(c0);
    LAS unsigned* SC = (LAS unsigned*)c.lds;
    LAS u64* MW = (LAS u64*)(c.lds + DSA_MW_OFF);
    LAS bf16* KS = (LAS bf16*)c.lds;
    LAS bf16* VT = (LAS bf16*)(c.lds + DSA_VT_OFF);
    const int lane = c.lane, w = c.wave, r32 = lane & 31, hi = lane >> 5, tid = c.tid;
    const float LOG2E = 1.4426950408889634f;
    for (int it = c.bid; it < 1032; it += c.nb) {
        const int rnd = it >> 8, cu = it & 255, g16 = cu >> 4, wi16 = cu & 15;
        const int ch = rnd == 0 ? 64 - g16 : rnd == 1 ? 33 + g16 : rnd == 2 ? 32 - g16 : rnd == 3 ? 1 + g16 : 0;
        const int b = rnd == 4 ? cu : (wi16 >> 1), half = rnd == 4 ? 0 : (wi16 & 1);
        const int p0q = ch == 0 ? 0 : 16 + 64 * (ch - 1) + 32 * half, nq = ch == 0 ? 16 : 32, nadm = ch == 0 ? 16 : 16 + 64 * ch, nw = ch + 1;
        const int t0 = b * L + p0q;
        const bf16* Ub = U + (size_t)(b * L) * NU;
        if (nadm <= TOPK) {
            for (int i = tid; i < 32 * 65; i += NTHR) { const int wd = i % 65; const int lo = 64 * wd; const int nb_ = nadm - lo;
                MW[i] = (wd < nw && nb_ > 0) ? (nb_ >= 64 ? ~0ull : ((1ull << nb_) - 1ull)) : 0ull; }
            __syncthreads();
        } else {
            const int nkb = 2 * nw;
#pragma unroll 1
            for (int sb = 0; sb < 4; ++sb) {
                const int tq = t0 + 8 * sb;
                for (int rs_ = 0; rs_ < REP_SCORE; ++rs_) {
                    bf16x8 aq[4]; float wq[4][4];
#pragma unroll
                    for (int s = 0; s < 4; ++s) aq[s] = *(const bf16x8*)(U + (size_t)(tq + (r32 >> 2)) * NU + C_QI + 64 * (r32 & 3) + 32 * hi + 8 * s);
#pragma unroll
                    for (int i4 = 0; i4 < 4; ++i4) { const f32x4v t4 = *(const f32x4v*)(UF + (size_t)(tq + 2 * i4 + hi) * 32 + 16); wq[i4][0] = t4[0]; wq[i4][1] = t4[1]; wq[i4][2] = t4[2]; wq[i4][3] = t4[3]; }
                    const bf16* kib = KI + (size_t)(b * L) * 64 + (size_t)r32 * 64 + 32 * hi;
                    bf16x8 bk[4], bn[4], bm[4];
#pragma unroll
                    for (int s = 0; s < 4; ++s) { bk[s] = *(const bf16x8*)(kib + (size_t)(32 * w) * 64 + 8 * s); bn[s] = bk[s]; bm[s] = bk[s]; }
                    if (w + NWAVE < nkb) {
#pragma unroll
                        for (int s = 0; s < 4; ++s) bn[s] = *(const bf16x8*)(kib + (size_t)(32 * (w + NWAVE)) * 64 + 8 * s); }
#pragma unroll 1
                    for (int kb = w; kb < nkb; kb += NWAVE) {
                        if (kb + 2 * NWAVE < nkb) {
#pragma unroll
                            for (int s = 0; s < 4; ++s) bm[s] = *(const bf16x8*)(kib + (size_t)(32 * (kb + 2 * NWAVE)) * 64 + 8 * s); }
                        const int key = 32 * kb + r32; f32x16 acc;
#pragma unroll
                        for (int r = 0; r < 16; ++r) acc[r] = 0.f;
#pragma unroll
                        for (int s = 0; s < 4; ++s) acc = MFMA32(aq[s], bk[s], acc);
#pragma unroll
                        for (int i4 = 0; i4 < 4; ++i4) {
                            float s = wq[i4][0] * fmaxf(acc[4 * i4], 0.f) + wq[i4][1] * fmaxf(acc[4 * i4 + 1], 0.f) + wq[i4][2] * fmaxf(acc[4 * i4 + 2], 0.f) + wq[i4][3] * fmaxf(acc[4 * i4 + 3], 0.f);
                            if (s == 0.f) s = 0.f;
                            SC[(2 * i4 + hi) * DSA_SC_STR + key] = key < nadm ? fkey(s) : 0u;
                        }
#pragma unroll
                        for (int s = 0; s < 4; ++s) { bk[s] = bn[s]; bn[s] = bm[s]; }
                    }
                }
                __syncthreads();
                for (int rs_ = 0; rs_ < REP_SEL; ++rs_) {
                    unsigned kk[65];
#pragma unroll
                    for (int j = 0; j < 65; ++j) kk[j] = 0u;
#define DSA_BUCKETS(F) { F(0, 16) if (nw > 16) { F(16, 32) } if (nw > 32) { F(32, 48) } if (nw > 48) { F(48, 64) } if (nw > 64) { F(64, 65) } }
#define DSA_LOAD(j0, j1) _Pragma("unroll") for (int j = j0; j < j1; ++j) kk[j] = SC[w * DSA_SC_STR + 64 * j + lane];
                    DSA_BUCKETS(DSA_LOAD)
#pragma unroll
                    for (int j = 0; j < 65; ++j) if (j >= 5) kk[j] = j < nw ? kk[j] : 0u;
#define DSA_C4(a, b, c_, d) asm volatile("v_cmp_ge_u32_e64 %1, %5, %9\n\tv_cmp_ge_u32_e64 %2, %6, %9\n\tv_cmp_ge_u32_e64 %3, %7, %9\n\tv_cmp_ge_u32_e64 %4, %8, %9\n\t" \
                        "v_addc_co_u32_e64 %0, vcc, 0, %0, %1\n\tv_addc_co_u32_e64 %0, vcc, 0, %0, %2\n\tv_addc_co_u32_e64 %0, vcc, 0, %0, %3\n\tv_addc_co_u32_e64 %0, vcc, 0, %0, %4" \
                        : "+v"(nl_), "=&s"(m0_), "=&s"(m1_), "=&s"(m2_), "=&s"(m3_) : "v"(a), "v"(b), "v"(c_), "v"(d), "v"(cand_) : "vcc");
#define DSA_CNT16(j0, j1) if (j1 - j0 == 16) { DSA_C4(kk[j0], kk[j0 + 1], kk[j0 + 2], kk[j0 + 3]) DSA_C4(kk[j0 + 4], kk[j0 + 5], kk[j0 + 6], kk[j0 + 7]) DSA_C4(kk[j0 + 8], kk[j0 + 9], kk[j0 + 10], kk[j0 + 11]) DSA_C4(kk[j0 + 12], kk[j0 + 13], kk[j0 + 14], kk[j0 + 15]) } \
                        else { nl_ += kk[64] >= cand_ ? 1 : 0; }
#define DSA_COUNT(CAND, N) { const unsigned cand_ = (CAND); int nl_ = 0; u64 m0_, m1_, m2_, m3_; DSA_BUCKETS(DSA_CNT16) N = 0; \
                        _Pragma("unroll") for (int k_ = 0; k_ < 7; ++k_) N += __popcll(__ballot((nl_ >> k_) & 1)) << k_; }
                    unsigned kmax = 0u;
#define DSA_MAX(j0, j1) _Pragma("unroll") for (int j = j0; j < j1; ++j) kmax = kk[j] > kmax ? kk[j] : kmax;
                    DSA_BUCKETS(DSA_MAX)
#pragma unroll
                    for (int o = 1; o < 64; o <<= 1) { const unsigned t_ = (unsigned)lane_readi((int)kmax, lane ^ o); kmax = t_ > kmax ? t_ : kmax; }
                    kmax = (unsigned)__builtin_amdgcn_readfirstlane((int)kmax);
                    unsigned lo = 0u, hi = (kmax >> 23) + 1u, tau = 0u; int nhi = 0; bool exact = false;
                    {   unsigned step = 1u;
#pragma unroll 1
                        while (hi - lo > 1u) {
                            const unsigned e = step ? (hi - lo > step ? hi - step : lo + 1u) : lo + ((hi - lo) >> 1);
                            int n; DSA_COUNT(e << 23, n)
                            if (n == TOPK) { exact = true; tau = e << 23; break; }
                            if (n > TOPK) { lo = e; step = 0u; } else { hi = e; nhi = n; if (step) step <<= 1; }
                        }
                    }
                    int need = 0;
                    if (!exact) {
                        tau = lo << 23; unsigned width = 1u << 23;
#pragma unroll 1
                        for (int bit = 22; bit >= 20; --bit) { const unsigned cand = tau | (1u << bit); int n; DSA_COUNT(cand, n)
                            if (n == TOPK) { exact = true; tau = cand; break; }
                            if (n > TOPK) tau = cand; else nhi = n;
                            width >>= 1; }
                    }
                    if (!exact) {
                        int nin; DSA_COUNT(tau, nin)
                        const int nc = nin - nhi, needc = TOPK - nhi;
                        if (nc <= 128) {
                            LAS unsigned* lst = (LAS unsigned*)(c.lds + DSA_LIST_OFF) + w * 128; int base = 0;
#define DSA_COMPACT(j0, j1) _Pragma("unroll") for (int j = j0; j < j1; ++j) { const bool inb = (kk[j] - tau) < (1u << 20); const u64 be = __ballot(inb); \
                                if (inb) lst[base + __popcll(be & ((1ull << lane) - 1ull))] = kk[j]; base += __popcll(be); }
                            DSA_BUCKETS(DSA_COMPACT)
                            const unsigned c0 = lane < nc ? lst[lane] : 0u, c1 = lane + 64 < nc ? lst[lane + 64] : 0u;
#pragma unroll 1
                            for (int bit = 19; bit >= 0; --bit) { const unsigned cand = tau | (1u << bit);
                                const int n = __popcll(__ballot(c0 >= cand)) + __popcll(__ballot(c1 >= cand));
                                if (n >= needc) tau = cand;
                                if (n == needc) { exact = true; break; } }
                            if (!exact) need = needc - (__popcll(__ballot(c0 > tau)) + __popcll(__ballot(c1 > tau)));
                        } else {
#pragma unroll 1
                            for (int bit = 19; bit >= 0; --bit) { const unsigned cand = tau | (1u << bit); int n; DSA_COUNT(cand, n)
                                if (n >= TOPK) tau = cand;
                                if (n == TOPK) { exact = true; break; } }
                            if (!exact) { int n; DSA_COUNT(tau + 1u, n) need = TOPK - n; }
                        }
                    }
                    int run = 0; u64 mine0 = 0ull, mine1 = 0ull;
#define DSA_SEL(j0, j1) _Pragma("unroll") for (int j = j0; j < j1; ++j) { bool sel; \
                        if (exact) sel = kk[j] >= tau; \
                        else { const bool eq = kk[j] == tau; const u64 be = __ballot(eq); const int rank = run + __popcll(be & ((1ull << lane) - 1ull)); sel = kk[j] > tau || (eq && rank < need); run += __popcll(be); } \
                        const u64 bs = __ballot(sel); if (j < 64) { if (lane == j) mine0 = bs; } else mine1 = bs; }
                    DSA_BUCKETS(DSA_SEL)
                    MW[(8 * sb + w) * 65 + lane] = lane < nw ? mine0 : 0ull;
                    if (lane == 0) MW[(8 * sb + w) * 65 + 64] = nw > 64 ? mine1 : 0ull;
                }
                __syncthreads();
            }
        }
        for (int ra_ = 0; ra_ < REP_ATT; ++ra_) {
        bf16x8 qf[8];
#pragma unroll
        for (int s = 0; s < 8; ++s) qf[s] = (bf16x8){0, 0, 0, 0, 0, 0, 0, 0};
        if (r32 < nq) {
#pragma unroll
            for (int s = 0; s < 8; ++s) qf[s] = *(const bf16x8*)(U + (size_t)(t0 + r32) * NU + C_QLAT + 128 * w + 16 * s + 8 * hi);
        }
        f32x16 o[4];
#pragma unroll
        for (int db = 0; db < 4; ++db)
#pragma unroll
            for (int r = 0; r < 16; ++r) o[db][r] = 0.f;
        float m = -1e4f, l = 0.f;
        const bf16* Cb = CN + (size_t)(b * L) * 128;
        u32x4v kr0, kr1, vr0, vr1;
        {   const bf16* kp = Cb + (size_t)(tid >> 3) * 128 + 16 * (tid & 7); kr0 = *(const u32x4v*)kp; kr1 = *(const u32x4v*)(kp + 8);
            const bf16* vp = Cb + (size_t)lane * 128 + 16 * w; vr0 = *(const u32x4v*)vp; vr1 = *(const u32x4v*)(vp + 8); }
#define DSA_STAGE(buf) do { LAS bf16* ks_ = KS + (buf) * DSA_BUF_ELEMS; LAS bf16* vt_ = VT + (buf) * DSA_BUF_ELEMS; \
            LAS bf16* kd = ks_ + (tid >> 3) * DSA_KSTR + 16 * (tid & 7); *(LAS u32x4v*)kd = kr0; *(LAS u32x4v*)(kd + 8) = kr1; \
            const unsigned vv[8] = {vr0.x, vr0.y, vr0.z, vr0.w, vr1.x, vr1.y, vr1.z, vr1.w}; \
            _Pragma("unroll") for (int e = 0; e < 16; ++e) vt_[(16 * w + e) * AT_KSTR + lane] = (bf16)(vv[e >> 1] >> (16 * (e & 1))); } while (0)
#define DSA_FETCH(ti) do { const bf16* kp = Cb + (size_t)(64 * (ti) + (tid >> 3)) * 128 + 16 * (tid & 7); kr0 = *(const u32x4v*)kp; kr1 = *(const u32x4v*)(kp + 8); \
            const bf16* vp = Cb + (size_t)(64 * (ti) + lane) * 128 + 16 * w; vr0 = *(const u32x4v*)vp; vr1 = *(const u32x4v*)(vp + 8); } while (0)
        DSA_STAGE(0);
        if (nw > 1) DSA_FETCH(1);
        __syncthreads();
        for (int i = 0; i < nw; ++i) {
            const int cur = i & 1;
            if (i + 1 < nw) { DSA_STAGE(cur ^ 1); if (i + 2 < nw) DSA_FETCH(i + 2); }
            const LAS bf16* ksc = KS + cur * DSA_BUF_ELEMS; const LAS bf16* vtc = VT + cur * DSA_BUF_ELEMS;
            const u64 m64 = MW[r32 * 65 + i];
            if (__ballot(m64 != 0ull) != 0ull) {
                f32x16 p0, p1;
#pragma unroll
                for (int r = 0; r < 16; ++r) { p0[r] = 0.f; p1[r] = 0.f; }
#pragma unroll
                for (int s = 0; s < 8; ++s) {
                    const bf16x8 a0 = *(const LAS bf16x8*)(ksc + r32 * DSA_KSTR + 16 * s + 8 * hi), a1 = *(const LAS bf16x8*)(ksc + (32 + r32) * DSA_KSTR + 16 * s + 8 * hi);
                    p0 = MFMA32(a0, qf[s], p0); p1 = MFMA32(a1, qf[s], p1);
                }
                const unsigned mlo = (unsigned)m64, mhi = (unsigned)(m64 >> 32);
                float mx = -1e30f, mx2 = -1e30f;
#pragma unroll
                for (int r = 0; r < 16; ++r) { const int kbit = crow(r, hi);
                    p0[r] = ((mlo >> kbit) & 1u) ? p0[r] : -1e30f; p1[r] = ((mhi >> kbit) & 1u) ? p1[r] : -1e30f;
                    if (r & 1) mx = max3f(mx, p0[r], p1[r]); else mx2 = max3f(mx2, p0[r], p1[r]); }
                mx = max3f(mx, mx2, mx2);
                const float mn = max3f(m, mx, lane_read(mx, lane ^ 32)), alpha = __builtin_amdgcn_exp2f(m - mn); const bool grew = __ballot(mn > m) != 0ull; m = mn;
                float sum = 0.f;
#pragma unroll
                for (int r = 0; r < 16; ++r) { p0[r] = __builtin_amdgcn_exp2f(p0[r] - mn); p1[r] = __builtin_amdgcn_exp2f(p1[r] - mn); sum += p0[r] + p1[r]; }
                l = l * alpha + sum;
                if (grew) {
#pragma unroll
                    for (int db = 0; db < 4; ++db)
#pragma unroll
                        for (int r = 0; r < 16; ++r) o[db][r] *= alpha; }
#pragma unroll
                for (int blk = 0; blk < 2; ++blk)
#pragma unroll
                    for (int s = 0; s < 2; ++s) {
                        const bf16x8 xs = pack8(blk == 0 ? p0 : p1, s);
                        typedef short s16x4v __attribute__((ext_vector_type(4)));
                        const LAS bf16* vp = vtc + r32 * AT_KSTR + 32 * blk + 16 * s + 4 * hi;
#pragma unroll
                        for (int db = 0; db < 4; ++db) {
                            const s16x4v lo = *(const LAS s16x4v*)(vp + 32 * db * AT_KSTR), hh = *(const LAS s16x4v*)(vp + 32 * db * AT_KSTR + 8);
                            const bf16x8 pa = __builtin_shufflevector(lo, hh, 0, 1, 2, 3, 4, 5, 6, 7);
                            o[db] = MFMA32(pa, xs, o[db]);
                        }
                    }
            }
            __syncthreads();
        }
        l += lane_read(l, lane ^ 32);
        if (r32 < nq) {
            const float inv = 1.f / l; bf16* yr = Y + (size_t)(t0 + r32) * KOUT + 1536 + 128 * w;
#pragma unroll
            for (int db = 0; db < 4; ++db)
#pragma unroll
                for (int i4 = 0; i4 < 4; ++i4)
                    *(u32x2v*)(yr + 32 * db + 8 * i4 + 4 * hi) = (u32x2v){cvtpk(o[db][4 * i4] * inv, o[db][4 * i4 + 1] * inv), cvtpk(o[db][4 * i4 + 2] * inv, o[db][4 * i4 + 3] * inv)};
        }
        }
    }
}

__device__ __forceinline__ float wave_scan_incl(float v, int lane) {
#pragma unroll
    for (int o = 1; o < 64; o <<= 1) { const float n = lane_read(v, (lane - o) & 63); if (lane >= o) v += n; }
    return v;
}
__device__ __forceinline__ void ph_ssd_states(const Ctx& c0, const bf16* XC, const float* DT, const float* a_log, bf16* ST, float* CD) {
    const Ctx c = refresh(c0);
    const int lane = c.lane, w = c.wave, r32 = lane & 31, hi = lane >> 5, g = w >> 2;
    LAS bf16* XT = (LAS bf16*)c.lds + w * (64 * 72);
    LAS bf16* BT = (LAS bf16*)(c.lds + 73728);
    const float a_neg = -__expf(a_log[w]);
    for (int it = c.bid; it < NB * 65; it += c.nb) {
        const int b = it / 65, ch = it - b * 65, pseq = 64 * ch - 48 + lane; const bool valid = pseq >= 0; const size_t t = (size_t)(b * L + (valid ? pseq : 0));
        const float dtv = valid ? DT[t * 8 + w] : 0.f, acs = wave_scan_incl(dtv * a_neg, lane), tot = lane_read(acs, 63), scale = dtv * __expf(tot - acs);
        if (lane == 0) CD[(b * 65 + ch) * 8 + w] = __expf(tot);
        const bf16* xrow = XC + t * 1024 + 64 * w;
#pragma unroll
        for (int q = 0; q < 8; ++q) { u32x4v v = (u32x4v){0u, 0u, 0u, 0u}; if (valid) v = *(const u32x4v*)(xrow + 8 * q); const unsigned vv[4] = {v.x, v.y, v.z, v.w};
#pragma unroll
            for (int e = 0; e < 8; ++e) XT[(8 * q + e) * 72 + lane] = f2bf(bf2f((bf16)(vv[e >> 1] >> (16 * (e & 1)))) * scale); }
        const bf16* brow = XC + t * 1024 + 512 + 32 * w;
#pragma unroll
        for (int q = 0; q < 4; ++q) { u32x4v v = (u32x4v){0u, 0u, 0u, 0u}; if (valid) v = *(const u32x4v*)(brow + 8 * q); const unsigned vv[4] = {v.x, v.y, v.z, v.w};
#pragma unroll
            for (int e = 0; e < 8; ++e) BT[(32 * w + 8 * q + e) * 72 + lane] = (bf16)(vv[e >> 1] >> (16 * (e & 1))); }
        __syncthreads();
        bf16* st = ST + ((size_t)(b * 65 + ch) * 8 + w) * 8192;
#pragma unroll 1
        for (int pb = 0; pb < 2; ++pb)
#pragma unroll 1
            for (int nb = 0; nb < 4; ++nb) {
                f32x16 acc;
#pragma unroll
                for (int r = 0; r < 16; ++r) acc[r] = 0.f;
#pragma unroll
                for (int s = 0; s < 4; ++s) { const bf16x8 a = *(const LAS bf16x8*)(XT + (32 * pb + r32) * 72 + 16 * s + 8 * hi), bb = *(const LAS bf16x8*)(BT + (128 * g + 32 * nb + r32) * 72 + 16 * s + 8 * hi);
                    acc = MFMA32(a, bb, acc); }
#pragma unroll
                for (int r = 0; r < 16; ++r) st[(32 * pb + crow(r, hi)) * 128 + 32 * nb + r32] = f2bf(acc[r]);
            }
        __syncthreads();
    }
}
__device__ __forceinline__ void ph_ssd_scan(const Ctx& c0, bf16* ST, const float* CD) {
    const Ctx c = refresh(c0);
    for (int idx = c.bid * NTHR + c.tid; idx < NB * 8 * 64 * 32; idx += c.nb * NTHR) {
        const int n4 = idx & 31, p = (idx >> 5) & 63, h = (idx >> 11) & 7, b = idx >> 14;
        float h0 = 0.f, h1 = 0.f, h2 = 0.f, h3 = 0.f;
        bf16* base = ST + ((size_t)(b * 65) * 8 + h) * 8192 + p * 128 + 4 * n4; const float* cd = CD + (size_t)(b * 65) * 8 + h;
        u32x2v nxt = *(const u32x2v*)base;
#pragma unroll 5
        for (int ch = 0; ch < 65; ++ch) {
            const u32x2v v = nxt; bf16* pc = base + (size_t)ch * 8 * 8192;
            if (ch + 1 < 65) nxt = *(const u32x2v*)(pc + 8 * 8192);
            *(u32x2v*)pc = (u32x2v){pk2(h0, h1), pk2(h2, h3)};
            const float d = cd[ch * 8];
            h0 = d * h0 + bf2f((bf16)(v.x & 0xffff)); h1 = d * h1 + bf2f((bf16)(v.x >> 16)); h2 = d * h2 + bf2f((bf16)(v.y & 0xffff)); h3 = d * h3 + bf2f((bf16)(v.y >> 16));
        }
    }
}
__device__ __forceinline__ void ph_ssd_out(const Ctx& c0, const bf16* XC, const bf16* U, const float* DT, const float* a_log, const float* dsk, const bf16* ST, bf16* Y) {
    const Ctx c = refresh(c0);
    const int lane = c.lane, w = c.wave, r32 = lane & 31, hi = lane >> 5, g = w >> 2;
    LAS bf16* XT = (LAS bf16*)c.lds + w * (64 * 72);
    LAS float* ACS = (LAS float*)(c.lds + 73728) + w * 64;
    LAS float* SS = (LAS float*)(c.lds + 73728 + 2048);
    const float a_neg = -__expf(a_log[w]), Dk = dsk[w];
    typedef short s16x4v __attribute__((ext_vector_type(4)));
    for (int it = c.bid; it < NB * 65; it += c.nb) {
        const int b = it / 65, ch = it - b * 65, p0 = 64 * ch - 48, pseq = p0 + lane; const bool valid = pseq >= 0; const size_t t = (size_t)(b * L + (valid ? pseq : 0));
        const float dtv = valid ? DT[t * 8 + w] : 0.f, acs = wave_scan_incl(dtv * a_neg, lane);
        ACS[lane] = acs;
        {   const bf16* xrow = XC + t * 1024 + 64 * w;
#pragma unroll
            for (int q = 0; q < 8; ++q) { u32x4v v = (u32x4v){0u, 0u, 0u, 0u}; if (valid) v = *(const u32x4v*)(xrow + 8 * q); const unsigned vv[4] = {v.x, v.y, v.z, v.w};
#pragma unroll
                for (int e = 0; e < 8; ++e) XT[(8 * q + e) * 72 + lane] = f2bf(bf2f((bf16)(vv[e >> 1] >> (16 * (e & 1)))) * dtv); } }
        const bool vl0 = p0 + r32 >= 0, vl1 = p0 + 32 + r32 >= 0;
        const size_t tl0 = (size_t)(b * L + (vl0 ? p0 + r32 : 0)), tl1 = (size_t)(b * L + (vl1 ? p0 + 32 + r32 : 0));
        f32x16 acc[2][2];
#pragma unroll
        for (int pb = 0; pb < 2; ++pb)
#pragma unroll
            for (int lb = 0; lb < 2; ++lb)
#pragma unroll
                for (int r = 0; r < 16; ++r) acc[pb][lb][r] = 0.f;
        const bf16* hin = ST + ((size_t)(b * 65 + ch) * 8 + w) * 8192;
#pragma unroll
        for (int k = 0; k < 8; ++k) {
            bf16x8 c0f = (bf16x8){0, 0, 0, 0, 0, 0, 0, 0}, c1f = c0f;
            if (vl0) c0f = *(const bf16x8*)(XC + tl0 * 1024 + 768 + 128 * g + 16 * k + 8 * hi);
            if (vl1) c1f = *(const bf16x8*)(XC + tl1 * 1024 + 768 + 128 * g + 16 * k + 8 * hi);
            const bf16x8 h0f = *(const bf16x8*)(hin + (size_t)r32 * 128 + 16 * k + 8 * hi), h1f = *(const bf16x8*)(hin + (size_t)(32 + r32) * 128 + 16 * k + 8 * hi);
            acc[0][0] = MFMA32(h0f, c0f, acc[0][0]); acc[0][1] = MFMA32(h0f, c1f, acc[0][1]); acc[1][0] = MFMA32(h1f, c0f, acc[1][0]); acc[1][1] = MFMA32(h1f, c1f, acc[1][1]);
        }
        const float acl0 = ACS[r32], acl1 = ACS[32 + r32], e0 = __expf(acl0), e1 = __expf(acl1);
#pragma unroll
        for (int pb = 0; pb < 2; ++pb)
#pragma unroll
            for (int r = 0; r < 16; ++r) { acc[pb][0][r] *= e0; acc[pb][1][r] *= e1; }
#pragma unroll
        for (int sb = 0; sb < 2; ++sb)
#pragma unroll
            for (int lb = sb; lb < 2; ++lb) {
                f32x16 x;
#pragma unroll
                for (int r = 0; r < 16; ++r) x[r] = 0.f;
                const bool vs = p0 + 32 * sb + r32 >= 0; const size_t ts = (size_t)(b * L + (vs ? p0 + 32 * sb + r32 : 0));
                const bool vl = lb == 0 ? vl0 : vl1; const size_t tl = lb == 0 ? tl0 : tl1;
#pragma unroll
                for (int k = 0; k < 8; ++k) {
                    bf16x8 bf_ = (bf16x8){0, 0, 0, 0, 0, 0, 0, 0}, cf_ = bf_;
                    if (vs) bf_ = *(const bf16x8*)(XC + ts * 1024 + 512 + 128 * g + 16 * k + 8 * hi);
                    if (vl) cf_ = *(const bf16x8*)(XC + tl * 1024 + 768 + 128 * g + 16 * k + 8 * hi);
                    x = MFMA32(bf_, cf_, x);
                }
                const float acl = lb == 0 ? acl0 : acl1; const int lrow = 32 * lb + r32;
#pragma unroll
                for (int i4 = 0; i4 < 4; ++i4) { const f32x4v as = *(const LAS f32x4v*)(ACS + 32 * sb + 8 * i4 + 4 * hi);
#pragma unroll
                    for (int e = 0; e < 4; ++e) { const int srow = 32 * sb + 8 * i4 + 4 * hi + e; x[4 * i4 + e] = srow <= lrow ? x[4 * i4 + e] * __expf(fminf(acl - as[e], 0.f)) : 0.f; } }
#pragma unroll
                for (int ks = 0; ks < 2; ++ks) {
                    const bf16x8 xs = pack8(x, ks);
#pragma unroll
                    for (int pb = 0; pb < 2; ++pb) {
                        const LAS bf16* vp = XT + (32 * pb + r32) * 72 + 32 * sb + 16 * ks + 4 * hi;
                        const s16x4v lo = *(const LAS s16x4v*)vp, hh = *(const LAS s16x4v*)(vp + 8);
                        const bf16x8 pa = __builtin_shufflevector(lo, hh, 0, 1, 2, 3, 4, 5, 6, 7);
                        if (lb == 0) acc[pb][0] = MFMA32(pa, xs, acc[pb][0]); else acc[pb][1] = MFMA32(pa, xs, acc[pb][1]);
                    }
                }
            }
        float ssq0 = 0.f, ssq1 = 0.f;
#pragma unroll
        for (int lb = 0; lb < 2; ++lb) { const bool vl = lb == 0 ? vl0 : vl1; const size_t tl = lb == 0 ? tl0 : tl1;
#pragma unroll
            for (int pb = 0; pb < 2; ++pb)
#pragma unroll
                for (int i4 = 0; i4 < 4; ++i4) { const int pc = 64 * w + 32 * pb + 8 * i4 + 4 * hi;
                    u32x2v xv = (u32x2v){0u, 0u}, zv = xv;
                    if (vl) { xv = *(const u32x2v*)(XC + tl * 1024 + pc); zv = *(const u32x2v*)(U + tl * NU + C_Z + pc); }
                    const float xe[4] = {bf2f((bf16)(xv.x & 0xffff)), bf2f((bf16)(xv.x >> 16)), bf2f((bf16)(xv.y & 0xffff)), bf2f((bf16)(xv.y >> 16))};
                    const float ze[4] = {bf2f((bf16)(zv.x & 0xffff)), bf2f((bf16)(zv.x >> 16)), bf2f((bf16)(zv.y & 0xffff)), bf2f((bf16)(zv.y >> 16))};
#pragma unroll
                    for (int e = 0; e < 4; ++e) { const float y = acc[pb][lb][4 * i4 + e] + Dk * xe[e], gz = y * siluf(ze[e]); acc[pb][lb][4 * i4 + e] = gz; if (lb == 0) ssq0 += gz * gz; else ssq1 += gz * gz; } } }
        ssq0 += lane_read(ssq0, lane ^ 32); ssq1 += lane_read(ssq1, lane ^ 32);
        if (hi == 0) { SS[w * 64 + r32] = ssq0; SS[w * 64 + 32 + r32] = ssq1; }
        __syncthreads();
        const float tot0 = SS[(4 * g) * 64 + r32] + SS[(4 * g + 1) * 64 + r32] + SS[(4 * g + 2) * 64 + r32] + SS[(4 * g + 3) * 64 + r32];
        const float tot1 = SS[(4 * g) * 64 + 32 + r32] + SS[(4 * g + 1) * 64 + 32 + r32] + SS[(4 * g + 2) * 64 + 32 + r32] + SS[(4 * g + 3) * 64 + 32 + r32];
        const float rs0 = rsqrtf(tot0 * (1.f / 256.f) + EPSF), rs1 = rsqrtf(tot1 * (1.f / 256.f) + EPSF);
#pragma unroll
        for (int lb = 0; lb < 2; ++lb) { const bool vl = lb == 0 ? vl0 : vl1; const size_t tl = lb == 0 ? tl0 : tl1; const float rs = lb == 0 ? rs0 : rs1;
            if (vl) {
#pragma unroll
                for (int pb = 0; pb < 2; ++pb)
#pragma unroll
                    for (int i4 = 0; i4 < 4; ++i4)
                        *(u32x2v*)(Y + tl * KOUT + 64 * w + 32 * pb + 8 * i4 + 4 * hi) = (u32x2v){cvtpk(acc[pb][lb][4 * i4] * rs, acc[pb][lb][4 * i4 + 1] * rs), cvtpk(acc[pb][lb][4 * i4 + 2] * rs, acc[pb][lb][4 * i4 + 3] * rs)};
            } }
        __syncthreads();
    }
}

__device__ __forceinline__ void ph_resid(const Ctx& c0, const bf16* MIX, const float* g, bf16* XB, float* RSTD, float* dout) { const Ctx c = refresh(c0);
    const int lane = c.lane;
    for (int t = c.gw; t < T; t += c.ngw) {
        float mv[32], xv[32]; float ss = 0.f;
#pragma unroll
        for (int j = 0; j < 4; ++j) { const u32x4v v = *(const u32x4v*)(MIX + (size_t)t * DM + 8 * lane + 512 * j), xx = *(const u32x4v*)(XB + (size_t)t * DM + 8 * lane + 512 * j);
            const unsigned w[4] = {v.x, v.y, v.z, v.w}, xw[4] = {xx.x, xx.y, xx.z, xx.w};
#pragma unroll
            for (int i = 0; i < 8; ++i) { const float f = bf2f((bf16)(w[i >> 1] >> (16 * (i & 1)))); mv[8 * j + i] = f; ss += f * f; xv[8 * j + i] = bf2f((bf16)(xw[i >> 1] >> (16 * (i & 1)))); } }
        const float rs = rsqrtf(wave_sum(ss, lane) * (1.f / DM) + EPSF);
        float s2 = 0.f;
        const int b = t / L, p = t - b * L; float* orow = (dout != nullptr && p >= NMETA) ? dout + ((size_t)b * SEQ + (p - NMETA)) * DM : nullptr;
#pragma unroll
        for (int j = 0; j < 4; ++j) { const int cc = 8 * lane + 512 * j;
            const f32x4v ga = *(const f32x4v*)(g + cc), gb = *(const f32x4v*)(g + cc + 4); float a[8];
#pragma unroll
            for (int i = 0; i < 4; ++i) { a[i] = xv[8 * j + i] + mv[8 * j + i] * rs * ga[i]; a[4 + i] = xv[8 * j + 4 + i] + mv[8 * j + 4 + i] * rs * gb[i]; }
#pragma unroll
            for (int i = 0; i < 8; ++i) s2 += a[i] * a[i];
            if (orow) { *(f32x4v*)(orow + cc) = (f32x4v){a[0], a[1], a[2], a[3]}; *(f32x4v*)(orow + cc + 4) = (f32x4v){a[4], a[5], a[6], a[7]}; }
            *(u32x4v*)(XB + (size_t)t * DM + cc) = (u32x4v){pk2(a[0], a[1]), pk2(a[2], a[3]), pk2(a[4], a[5]), pk2(a[6], a[7])}; }
        s2 = wave_sum(s2, lane);
        if (lane == 0) RSTD[t] = rsqrtf(s2 * (1.f / DM) + EPSF);
    }
}

__device__ __forceinline__ void gemm_meta_rows(const Ctx& c, const bf16* A, const bf16* Bt, bf16* O, int N, int K, int ldc, const float* rs, float* UF) {
    const int lane = c.lane, r32 = lane & 31, hi = lane >> 5, w = c.wave;
    LAS float* red = (LAS float*)c.lds;
    for (int strip = c.bid; strip < N / 32; strip += c.nb) {
        const bf16* ap = A + (size_t)(r32 & 15) * K + 8 * hi; const bf16* bp = Bt + (size_t)(32 * strip + r32) * K + 8 * hi;
        f32x16 acc;
#pragma unroll
        for (int r = 0; r < 16; ++r) acc[r] = 0.f;
#pragma unroll 4
        for (int s = w; s < K / 16; s += NWAVE) acc = MFMA32(*(const bf16x8*)(ap + 16 * s), *(const bf16x8*)(bp + 16 * s), acc);
#pragma unroll
        for (int r = 0; r < 8; ++r) red[(w * 8 + r) * 64 + lane] = acc[r];
        __syncthreads();
        if (w == 0) {
            float v8[8];
#pragma unroll
            for (int r = 0; r < 8; ++r) { float t = 0.f;
#pragma unroll
                for (int ww = 0; ww < NWAVE; ++ww) t += red[(ww * 8 + r) * 64 + lane];
                v8[r] = t * (rs ? rs[crow(r, hi)] : 1.f); }
            const int n = 32 * strip + r32; const bool sm = UF != nullptr && n >= C_SM && n < C_SM + 32;
#pragma unroll 1
            for (int b = 0; b < NB; ++b) {
                bf16* ob = O + (size_t)(b * L) * ldc + n; float* ub = UF + (size_t)(b * L) * 32 + (n - C_SM);
#pragma unroll
                for (int r = 0; r < 8; ++r) { const int p = crow(r, hi); ob[(size_t)p * ldc] = f2bf(v8[r]); if (sm) ub[(size_t)p * 32] = v8[r]; }
            }
        }
        __syncthreads();
    }
}
__device__ __forceinline__ void ph_gemm_plain(const Ctx& c0, const bf16* A, const bf16* Bt, bf16* O, int N, int K, int ldc, const float* rs, float* UF) { const Ctx c = refresh(c0);
    gemm_meta_rows(c, A, Bt, O, N, K, ldc, rs, UF);
    pg8::StaticOrder S; S.init(128 * 256, N, c.nb, c.bid);
    pg8::Gemm g{A, Bt, 128 * 256, N, K, (size_t)256 * K * 2, 1};
    pg8::EpiBf16Plain E{O, ldc, rs, UF, C_SM, 1};
    pg8::gemm_phase<pg8::EpiBf16Plain, pg8::StaticOrder, true, true>(c.lds, g, S, E, c.tid);
}
__device__ __forceinline__ void ph_gemm_gateup(const Ctx& c0, const bf16* XB, const bf16* Bt, bf16* H, const float* rs, const float* cw, const float* cb) { const Ctx c = refresh(c0);
    pg8::StaticOrder S; S.init(130 * 256, NGU, c.nb, c.bid);
    pg8::Gemm g{XB - (size_t)2 * DM, Bt, 130 * 256, NGU, DM, (size_t)254 * DM * 2, 0};
    pg8::EpiGateUp E{H, rs, cw, cb, (LAS float*)(c.lds + HALO_OFF)};
    pg8::gemm_phase<pg8::EpiGateUp, pg8::StaticOrder, true, true>(c.lds, g, S, E, c.tid);
}

constexpr int REP_PREPW = 1, REP_G1 = 1, REP_G2 = 1, REP_G3 = 1, REP_G4 = 1, REP_M1 = 1, REP_SSD = 1, REP_FOX = 1, REP_DSA = 1;
__global__ void __launch_bounds__(NTHR, 2) fwd_mega(Args A) {
    extern __shared__ __attribute__((aligned(16))) unsigned char lds_raw[];
    cg::grid_group grid = cg::this_grid();
    Ctx c; c.tid = threadIdx.x; c.lane = c.tid & 63; c.wave = __builtin_amdgcn_readfirstlane(c.tid >> 6); c.bid = blockIdx.x; c.nb = gridDim.x;
    c.gw = c.bid * NWAVE + c.wave; c.ngw = c.nb * NWAVE; c.lds = (LAS unsigned char*)lds_raw;
    if (c.tid == 0) { LAS unsigned long long* PT = (LAS unsigned long long*)(c.lds + PT_OFF);
#pragma unroll
        for (int i = 0; i < 25; ++i) PT[i] = (unsigned long long)A.in[i];
        PT[25] = (unsigned long long)A.out; PT[26] = (unsigned long long)A.ws; }
    if (c.tid < 2) ((LAS unsigned*)(c.lds + MISC_OFF))[c.tid] = 0u;
    __syncthreads();
    (void)xcd_barrier_post((unsigned*)(A.ws + WS_CTL) + CW_BAR, (volatile LAS unsigned*)(c.lds + MISC_OFF), c.tid);
#define WSP(off) (pt_get(c, 26) + (off))
#define DOUT ((float*)pt_get(c, 25))
#define P_WIN ((bf16*)WSP(WS_WIN))
#define P_WOUT ((bf16*)WSP(WS_WOUT))
#define P_WGU ((bf16*)WSP(WS_WGU))
#define P_WDN ((bf16*)WSP(WS_WDN))
#define P_METAX ((float*)WSP(WS_METAX))
#define P_RSTD ((float*)WSP(WS_RSTD))
#define P_UF ((float*)WSP(WS_UF))
#define P_DT ((float*)WSP(WS_DT))
#define P_FCUM ((float*)WSP(WS_FCUM))
#define P_CN ((bf16*)WSP(WS_CN))
#define P_MASK ((u64*)WSP(WS_MASK))
#define P_KI ((bf16*)WSP(WS_MASK))
#define P_XB ((bf16*)WSP(WS_XB) + (size_t)8 * DM)
#define P_Y ((bf16*)WSP(WS_Y))
#define P_U ((bf16*)WSP(WS_R1))
#define P_XC ((bf16*)WSP(WS_XC))
#define P_H ((bf16*)WSP(WS_R1))
#define P_MIX ((bf16*)WSP(WS_R1))
#define P_MIX2 ((bf16*)WSP(WS_Y))
#define P_ST ((bf16*)WSP(WS_YA))
#define P_CD ((float*)WSP(WS_DT + 1536 * 1024))
    ph_prep_x(c, INP(0), INP(1), P_XB, P_RSTD);
    grid.sync();
#define LAYER_BODY(ly) do { \
        for (int rep = 0; rep < REP_PREPW; ++rep) ph_prep_w(c, ly, P_WIN, P_WOUT, P_WGU, P_WDN); \
        grid_barrier(c); \
        for (int rep = 0; rep < REP_G1; ++rep) ph_gemm_plain(c, P_XB, P_WIN, P_U, NU, DM, NU, P_RSTD, P_UF); \
        grid_barrier(c); \
        for (int rep = 0; rep < REP_M1; ++rep) { \
        ph_mixprep(c, P_U, P_UF, INP(7) + (size_t)ly * 4 * 1024, INP(8) + (size_t)ly * 1024, INP(16) + (size_t)ly * 128, INP(9) + (size_t)ly * 8, P_XC, P_Y, P_CN, P_DT, P_KI); \
        ph_fcum(c, P_UF, INP(15) + (size_t)ly * 8, P_FCUM); } \
        grid_barrier(c); \
        for (int rep = 0; rep < REP_SSD; ++rep) ph_ssd_states(c, P_XC, P_DT, INP(10) + (size_t)ly * 8, P_ST, P_CD); \
        for (int rep = 0; rep < REP_FOX; ++rep) ph_fox(c, P_U, P_FCUM, P_Y); \
        grid_barrier(c); \
        ph_ssd_scan(c, P_ST, P_CD); \
        for (int rep = 0; rep < REP_DSA; ++rep) ph_dsa(c, P_U, P_UF, P_CN, P_KI, P_Y); \
        grid_barrier(c); \
        for (int rep = 0; rep < REP_SSD; ++rep) ph_ssd_out(c, P_XC, P_U, P_DT, INP(10) + (size_t)ly * 8, INP(11) + (size_t)ly * 8, P_ST, P_Y); \
        grid_barrier(c); \
        for (int rep = 0; rep < REP_G2; ++rep) ph_gemm_plain(c, P_Y, P_WOUT, P_MIX, DM, KOUT, DM, nullptr, nullptr); \
        grid_barrier(c); \
        ph_resid(c, P_MIX, INP(3) + (size_t)ly * DM, P_XB, P_RSTD, nullptr); \
        grid_barrier(c); \
        for (int rep = 0; rep < REP_G3; ++rep) ph_gemm_gateup(c, P_XB, P_WGU, P_H, P_RSTD, INP(22) + (size_t)ly * 3 * FF, INP(23) + (size_t)ly * FF); \
        grid_barrier(c); \
        for (int rep = 0; rep < REP_G4; ++rep) ph_gemm_plain(c, P_H, P_WDN, P_MIX2, DM, FF, DM, nullptr, nullptr); \
        grid_barrier(c); \
        ph_resid(c, P_MIX2, INP(5) + (size_t)ly * DM, P_XB, P_RSTD, (ly) == DEPTH - 1 ? DOUT : nullptr); \
        grid_barrier(c); \
    } while (0)
    LAYER_BODY(0); LAYER_BODY(1); LAYER_BODY(2); LAYER_BODY(3);
}

extern "C" void kernel_launch(void* const* d_in, const int* in_sizes, int n_in, void* d_out, int out_size, void* d_ws, size_t ws_size, hipStream_t stream) {
    static int grid_blocks = 0;
    if (grid_blocks == 0) {
        if (n_in != 25 || in_sizes[0] != NB * SEQ * DM || out_size != NB * SEQ * DM || ws_size < WS_END) { fprintf(stderr, "kernel_launch: unexpected shapes (n_in %d in0 %d out %d ws %zu)\n", n_in, n_in > 0 ? in_sizes[0] : -1, out_size, ws_size); grid_blocks = -1; return; }
        int dev = 0, cus = 0, per_cu = 0;
        (void)hipGetDevice(&dev); (void)hipDeviceGetAttribute(&cus, hipDeviceAttributeMultiprocessorCount, dev);
        if (hipFuncSetAttribute((const void*)fwd_mega, hipFuncAttributeMaxDynamicSharedMemorySize, LDS_BYTES) != hipSuccess) { fprintf(stderr, "kernel_launch: hipFuncSetAttribute failed\n"); grid_blocks = -1; return; }
        if (hipOccupancyMaxActiveBlocksPerMultiprocessor(&per_cu, (const void*)fwd_mega, NTHR, LDS_BYTES) != hipSuccess || per_cu < 1) { fprintf(stderr, "kernel_launch: occupancy query says %d blocks/CU\n", per_cu); grid_blocks = -1; return; }
        grid_blocks = cus;
        fprintf(stderr, "kernel_launch: %d CUs, %d blocks/CU by the occupancy query, grid %d\n", cus, per_cu, grid_blocks);
    }
    if (grid_blocks < 0) return;
    if (hipMemsetAsync((char*)d_ws + WS_CTL, 0, 65536, stream) != hipSuccess) { fprintf(stderr, "kernel_launch: memset failed\n"); return; }
    Args a{};
    for (int i = 0; i < 25; ++i) a.in[i] = (const float*)d_in[i];
    a.out = (float*)d_out; a.ws = (unsigned char*)d_ws;
    void* args[] = {&a};
    hipError_t e = hipLaunchCooperativeKernel((const void*)fwd_mega, dim3(grid_blocks), dim3(NTHR), args, LDS_BYTES, stream);
    if (e != hipSuccess) fprintf(stderr, "kernel_launch: cooperative launch failed: %s (grid %d)\n", hipGetErrorString(e), grid_blocks);
}
```

```cpp
#include <hip/hip_runtime.h>
#include <cstdio>
#include <cstdint>

constexpr int NB = 8, SEQ = 4096, NMETA = 16, L = SEQ + NMETA  , T = NB * L  , MP = 33024  , DM = 2048;
constexpr int NU = 4608, KOUT = 2048, FF = 5632, NGU = 2 * FF, DIN = 4564;
constexpr int C_Z = 0, C_XBC = 512, C_POOL = 1536, C_FQ = 2048, C_FK = 2560, C_FV = 3072, C_DQ = 3584, C_DC = 4096, C_QI = 4224, C_KI = 4480, C_SM = 4544;
constexpr int LKP = 4224, NMW = 66  , TOPK = 256, DEPTH = 4;
constexpr float EPSF = 1e-6f;
typedef unsigned short bf16;
typedef unsigned long long u64;

__device__ __forceinline__ float bf2f(bf16 v) { return __uint_as_float(((unsigned)v) << 16); }
__device__ __forceinline__ bf16 f2bf(float f) { unsigned u = __float_as_uint(f); return (bf16)((u + 0x7fffu + ((u >> 16) & 1u)) >> 16); }
typedef float f32x2v_ __attribute__((ext_vector_type(2)));
typedef __bf16 bf16x2v_ __attribute__((ext_vector_type(2)));
__device__ __forceinline__ unsigned pk2(float lo, float hi) { f32x2v_ v = {lo, hi}; bf16x2v_ b = __builtin_convertvector(v, bf16x2v_); return __builtin_bit_cast(unsigned, b); }
__device__ __forceinline__ float siluf(float x) { return x * __builtin_amdgcn_rcpf(1.f + __expf(-x)); }
__device__ __forceinline__ float softplusf(float x) { return fmaxf(x, 0.f) + log1pf(__expf(-fabsf(x))); }
__device__ __forceinline__ float logsigmoidf(float x) { return fminf(x, 0.f) - log1pf(__expf(-fabsf(x))); }
__device__ __forceinline__ float lane_read(float v, int src) { return __int_as_float(__builtin_amdgcn_ds_bpermute(src << 2, __float_as_int(v))); }
__device__ __forceinline__ int lane_readi(int v, int src) { return __builtin_amdgcn_ds_bpermute(src << 2, v); }
__device__ __forceinline__ float wave_sum(float v, int lane) {
#pragma unroll
    for (int o = 1; o < 64; o <<= 1) v += lane_read(v, lane ^ o);
    return v;
}
__device__ __forceinline__ float* xf_row(float* dout, float* metax, int t) {
    const int b = t / L, p = t - b * L;
    return p < NMETA ? metax + (size_t)(b * NMETA + p) * DM : dout + ((size_t)b * SEQ + (p - NMETA)) * DM;
}
namespace pg8 {
#define PG8_LAS __attribute__((address_space(3)))
typedef unsigned short bf16_t;
typedef short bf16x8 __attribute__((ext_vector_type(8)));
typedef float f32x4 __attribute__((ext_vector_type(4)));
typedef unsigned u32x4 __attribute__((ext_vector_type(4)));
constexpr int BM = 256, BK = 64, HALF = 128, HTB = HALF * BK * 2  , STAGE_BYTES = 8 * HTB, NXCD = 8, WGM = 8;

__host__ __device__ __forceinline__ int lds_byte(int r, int c) { const int st = (r >> 4) * 2 + (c >> 5), rr = r & 15, cc = c & 31, ob = rr * 64 + cc * 2; return st * 1024 + (ob ^ (((ob >> 9) & 1) << 5)); }
__host__ __device__ __forceinline__ void stage_rc(int b, int& R, int& C) { const int st = b / 1024, sb = b % 1024, swz = sb ^ (((sb >> 9) & 1) << 5); R = (st >> 1) * 16 + swz / 64; C = (st & 1) * 32 + (swz % 64) / 2; }
__host__ __device__ __forceinline__ int perm32(int rho) { const int n = rho >> 4, i = rho & 15; return 8 * (i >> 2) + 4 * n + (i & 3); }

struct Unit { int pm, pn; };
struct Gemm { const bf16_t* A; const bf16_t* Bt; int M, N, K; size_t a_tstep; int rowmap; };
__host__ __device__ __forceinline__ int tile_row0(int rowmap, int pm) { return rowmap ? (pm >> 4) * 4112 + 16 + 256 * (pm & 15) : pm * 256; }

struct StaticOrder {
    int nM, nN, nwg, G, c;
    __host__ __device__ void init(int M, int N, int G_, int c_) { nM = M / BM; nN = N / BM; nwg = nM * nN; G = G_; c = c_; }
    __host__ __device__ bool next(int i, Unit& u) const {
        const long L = (long)i * G + c; if (L >= nwg) return false;
        int wgid = (int)L; { const int q = nwg / NXCD, r = nwg % NXCD, xcd = wgid % NXCD, off = wgid / NXCD; wgid = (xcd < r ? xcd * (q + 1) : r * (q + 1) + (xcd - r) * q) + off; }
        const int nig = WGM * nN, gid = wgid / nig, fm = gid * WGM, gsz = (nM - fm) < WGM ? (nM - fm) : WGM;
        u.pm = fm + ((wgid % nig) % gsz); u.pn = (wgid % nig) / gsz; return true;
    }
    __device__ __forceinline__ void a_ready(const Unit&) const {}
    __device__ __forceinline__ void done(const Unit&) const {}
};


__device__ __forceinline__ unsigned cvt_pk_bf16(float lo, float hi) { unsigned r; asm volatile("v_cvt_pk_bf16_f32 %0, %1, %2" : "=v"(r) : "v"(lo), "v"(hi)); return r; }

struct EpiBf16Plain {
    static constexpr bool PERM = true, AFTER_DRAIN = false;
    bf16_t* O; int ldc; const float* rs; float* UF; int sm_col0; int rowmap;
    __device__ __forceinline__ void operator()(f32x4 (&acc)[2][2][4][2], const Unit& u, int wr, int wc, int fr, int fq) const {
        const int row0 = tile_row0(rowmap, u.pm) + wr * 64 + fr, col0 = u.pn * BM + wc * 32 + 8 * fq;
#pragma unroll
        for (int ai = 0; ai < 2; ++ai)
#pragma unroll
            for (int m = 0; m < 4; ++m) {
                const int row = row0 + ai * HALF + m * 16; const float s = rs ? rs[row] : 1.f; bf16_t* rowp = O + (size_t)row * ldc + col0;
#pragma unroll
                for (int bj = 0; bj < 2; ++bj) { const f32x4 v0 = acc[ai][bj][m][0] * s, v1 = acc[ai][bj][m][1] * s;
                    u32x4 w; w.x = cvt_pk_bf16(v0[0], v0[1]); w.y = cvt_pk_bf16(v0[2], v0[3]); w.z = cvt_pk_bf16(v1[0], v1[1]); w.w = cvt_pk_bf16(v1[2], v1[3]);
                    *(u32x4*)(rowp + bj * HALF) = w;
                    if (UF) { const int c = col0 + bj * HALF - sm_col0; if (c >= 0 && c < 32) { float* p = UF + (size_t)row * 32 + c; *(f32x4*)p = v0; *(f32x4*)(p + 4) = v1; } } }
            }
    }
};

struct EpiGateUp {
    static constexpr bool PERM = true, AFTER_DRAIN = false;
    bf16_t* H; const float* rs; const float* cw; const float* cb; PG8_LAS float* halo;
    __device__ __forceinline__ void operator()(f32x4 (&acc)[2][2][4][2], const Unit& u, int wr, int wc, int fr, int fq) const {
        const int lane = fq * 16 + fr, chl = wc * 32 + 8 * fq, ch0 = u.pn * 128 + chl, rbase = u.pm * 254 - 2;
#pragma unroll
        for (int ai = 0; ai < 2; ++ai)
#pragma unroll
            for (int m = 0; m < 4; ++m) { const int grow = rbase + ai * 128 + wr * 64 + m * 16 + fr; const float s = grow >= 0 ? rs[grow] : 0.f;
#pragma unroll
                for (int bj = 0; bj < 2; ++bj)
#pragma unroll
                    for (int n = 0; n < 2; ++n) acc[ai][bj][m][n] = acc[ai][bj][m][n] * s; }
        if (fr >= 14) {
#pragma unroll
            for (int ai = 0; ai < 2; ++ai)
#pragma unroll
                for (int n = 0; n < 2; ++n) *(PG8_LAS f32x4*)(halo + ((2 * ai + wr) * 2 + (fr - 14)) * 128 + chl + 4 * n) = acc[ai][0][3][n];
        }
        asm volatile("s_waitcnt lgkmcnt(0)" ::: "memory"); __builtin_amdgcn_s_barrier(); asm volatile("" ::: "memory");
        f32x4 w0[2], w1[2], w2[2], bb[2];
#pragma unroll
        for (int n = 0; n < 2; ++n) { w0[n] = *(const f32x4*)(cw + ch0 + 4 * n); w1[n] = *(const f32x4*)(cw + FF + ch0 + 4 * n); w2[n] = *(const f32x4*)(cw + 2 * FF + ch0 + 4 * n); bb[n] = *(const f32x4*)(cb + ch0 + 4 * n); }
#pragma unroll
        for (int ai = 0; ai < 2; ++ai)
#pragma unroll
            for (int m = 0; m < 4; ++m) {
                const int rl = ai * 128 + wr * 64 + m * 16 + fr, grow = rbase + rl, pos = grow >= 0 ? grow % L : 0, blk = 2 * ai + wr;
                const float t1 = pos >= 1 ? 1.f : 0.f, t2 = pos >= 2 ? 1.f : 0.f;
                unsigned pk[4];
#pragma unroll
                for (int n = 0; n < 2; ++n) {
                    const f32x4 cur = acc[ai][0][m][n]; f32x4 g1, g2;
#pragma unroll
                    for (int j = 0; j < 4; ++j) {
                        const float s1 = __int_as_float(__builtin_amdgcn_update_dpp(0, __float_as_int(cur[j]), 0x111, 0xf, 0xf, false)), s2 = __int_as_float(__builtin_amdgcn_update_dpp(0, __float_as_int(cur[j]), 0x112, 0xf, 0xf, false));
                        float p15, p14;
                        if (m > 0) { const float pv = acc[ai][0][m > 0 ? m - 1 : 0][n][j]; p15 = __int_as_float(__builtin_amdgcn_update_dpp(0, __float_as_int(pv), 0x15f, 0xf, 0xf, false)); p14 = __int_as_float(__builtin_amdgcn_update_dpp(0, __float_as_int(pv), 0x15e, 0xf, 0xf, false)); }
                        else if (blk > 0) { p14 = halo[((blk - 1) * 2 + 0) * 128 + chl + 4 * n + j]; p15 = halo[((blk - 1) * 2 + 1) * 128 + chl + 4 * n + j]; }
                        else { p14 = 0.f; p15 = 0.f; }
                        g1[j] = fr >= 1 ? s1 : p15; g2[j] = fr >= 2 ? s2 : (fr == 1 ? p15 : p14);
                    }
                    const f32x4 cv = bb[n] + w2[n] * cur + (w1[n] * g1) * t1 + (w0[n] * g2) * t2;
                    const f32x4 up = acc[ai][1][m][n];
                    float hv[4];
#pragma unroll
                    for (int j = 0; j < 4; ++j) hv[j] = cv[j] * __builtin_amdgcn_rcpf(1.f + __expf(-cv[j])) * up[j];
                    pk[2 * n] = cvt_pk_bf16(hv[0], hv[1]); pk[2 * n + 1] = cvt_pk_bf16(hv[2], hv[3]);
                }
                if (rl >= 2) { u32x4 w; w.x = pk[0]; w.y = pk[1]; w.z = pk[2]; w.w = pk[3]; *(u32x4*)(H + (size_t)grow * FF + ch0) = w; }
            }
    }
};
template <class Epi, class Sched, bool ALIGN_EPI = false, bool SP2 = false>
__device__ __forceinline__ void gemm_phase(PG8_LAS unsigned char* lds, const Gemm g, const Sched& S, const Epi& E, const int tid) {
    const int wid = __builtin_amdgcn_readfirstlane(tid >> 6), lane = tid & 63, wr = wid >> 2, wc = wid & 3, fr = lane & 15, fq = lane >> 4;
    const int K = g.K, nt = K / BK;
    unsigned voffA[2], voffB[2];
#pragma unroll
    for (int i = 0; i < 2; ++i) { int R, C; stage_rc(tid * 16 + i * 8192, R, C); const int Rb = Epi::PERM ? ((R & ~31) + perm32(R & 31)) : R;
        voffA[i] = (unsigned)(R * K + C) * 2u; voffB[i] = (unsigned)(Rb * K + C) * 2u; }
    const size_t kstep = (size_t)(BK * 2);
    const size_t hstep = (size_t)HALF * K * 2;
    const size_t tstep = 2 * hstep;
    const unsigned ldsw = (unsigned)wid * 1024u;
    const int aoff = lds_byte(wr * 64 + fr, fq * 8), boff = lds_byte(wc * 32 + fr, fq * 8);
#define PG8_SA(b, h) (((b) * 2 + (h)) * HTB)
#define PG8_SB(b, h) ((4 + (b) * 2 + (h)) * HTB)
#define PG8_STAGE(bufoff, gbase, voff) do { _Pragma("unroll") for (int _i = 0; _i < 2; ++_i) \
        __builtin_amdgcn_global_load_lds((const unsigned*)((const char*)(gbase) + (voff)[_i]), (PG8_LAS unsigned*)(lds + (bufoff) + ldsw + _i * 8192), 16, 0, 0); } while (0)
#define PG8_LDA(dst, b, h) do { _Pragma("unroll") for (int m = 0; m < 4; ++m) _Pragma("unroll") for (int k = 0; k < 2; ++k) dst[m][k] = *(const PG8_LAS bf16x8*)(lds + PG8_SA(b, h) + aoff + m * 2048 + k * 1024); } while (0)
#define PG8_LDB(dst, b, h) do { _Pragma("unroll") for (int n = 0; n < 2; ++n) _Pragma("unroll") for (int k = 0; k < 2; ++k) dst[n][k] = *(const PG8_LAS bf16x8*)(lds + PG8_SB(b, h) + boff + n * 2048 + k * 1024); } while (0)
#define PG8_MMA(ai, bj, At, Bt) do { __builtin_amdgcn_s_setprio(1); _Pragma("unroll") for (int m = 0; m < 4; ++m) _Pragma("unroll") for (int n = 0; n < 2; ++n) _Pragma("unroll") for (int k = 0; k < 2; ++k) \
        acc[ai][bj][m][n] = __builtin_amdgcn_mfma_f32_16x16x32_bf16(Bt[n][k], At[m][k], acc[ai][bj][m][n], 0, 0, 0); __builtin_amdgcn_s_setprio(0); } while (0)
#define PG8_WAIT_V(n) asm volatile("s_waitcnt vmcnt(" #n ")" ::: "memory")
#define PG8_WAIT_L(n) asm volatile("s_waitcnt lgkmcnt(" #n ")" ::: "memory")
#define PG8_BAR __builtin_amdgcn_s_barrier()
#define PG8_SCHED __builtin_amdgcn_sched_barrier(0)
    Unit cur, nxt; int ui = 0;
    if (!S.next(0, cur)) return;
    f32x4 acc[2][2][4][2];
#pragma unroll
    for (int a = 0; a < 2; ++a)
#pragma unroll
        for (int b = 0; b < 2; ++b)
#pragma unroll
            for (int m = 0; m < 4; ++m)
#pragma unroll
                for (int n = 0; n < 2; ++n) acc[a][b][m][n] = (f32x4){0.f, 0.f, 0.f, 0.f};
    bf16x8 At[4][2], B0[2][2], B1[2][2];
    const char* cA = (const char*)g.A + (g.rowmap ? (size_t)tile_row0(1, cur.pm) * K * 2 : (size_t)cur.pm * g.a_tstep); const char* cB = (const char*)g.Bt + (size_t)cur.pn * tstep;
    S.a_ready(cur);
    if constexpr (SP2) {
        PG8_STAGE(PG8_SB(0, 0), cB, voffB); PG8_STAGE(PG8_SB(0, 1), cB + hstep, voffB); PG8_STAGE(PG8_SA(0, 0), cA, voffA); PG8_STAGE(PG8_SA(0, 1), cA + hstep, voffA);
        if (wr == 1) PG8_BAR;
        PG8_WAIT_V(2); PG8_BAR;
        PG8_STAGE(PG8_SB(1, 0), cB + kstep, voffB); PG8_STAGE(PG8_SA(1, 0), cA + kstep, voffA); PG8_STAGE(PG8_SB(1, 1), cB + hstep + kstep, voffB);
        PG8_WAIT_V(6); PG8_BAR;
    } else {
        PG8_STAGE(PG8_SB(0, 0), cB, voffB); PG8_STAGE(PG8_SA(0, 0), cA, voffA); PG8_STAGE(PG8_SB(0, 1), cB + hstep, voffB); PG8_STAGE(PG8_SA(0, 1), cA + hstep, voffA);
        if (wr == 1) PG8_BAR;
        PG8_WAIT_V(4); PG8_BAR;
        PG8_STAGE(PG8_SB(1, 0), cB + kstep, voffB); PG8_STAGE(PG8_SA(1, 0), cA + kstep, voffA); PG8_STAGE(PG8_SB(1, 1), cB + hstep + kstep, voffB);
        PG8_WAIT_V(6); PG8_BAR;
    }
    for (;;) {
        const bool has_next = S.next(ui + 1, nxt);
        const char* nA = has_next ? (const char*)g.A + (g.rowmap ? (size_t)tile_row0(1, nxt.pm) * K * 2 : (size_t)nxt.pm * g.a_tstep) : cA; const char* nB = has_next ? (const char*)g.Bt + (size_t)nxt.pn * tstep : cB;
        for (int t = 0; t < nt; t += 2) {
            const bool last = (t == nt - 2);
            const char* a1 = cA + (size_t)(t + 1) * kstep;
            const char* a2 = last ? nA : cA + (size_t)(t + 2) * kstep; const char* b2 = last ? nB : cB + (size_t)(t + 2) * kstep;
            const char* a3 = a2 + kstep; const char* b3 = b2 + kstep;
            if (last && has_next) S.a_ready(nxt);
            if constexpr (SP2) {
            PG8_LDB(B0, 0, 0); PG8_LDB(B1, 0, 1); PG8_SCHED; PG8_LDA(At, 0, 0); PG8_STAGE(PG8_SA(1, 1), a1 + hstep, voffA);
            PG8_WAIT_V(8); PG8_WAIT_L(0); PG8_BAR; PG8_MMA(0, 0, At, B0); PG8_MMA(0, 1, At, B1); PG8_BAR; PG8_SCHED;
            PG8_LDA(At, 0, 1); PG8_STAGE(PG8_SB(0, 0), b2, voffB); PG8_STAGE(PG8_SB(0, 1), b2 + hstep, voffB); PG8_STAGE(PG8_SA(0, 0), a2, voffA);
            PG8_WAIT_V(8); PG8_WAIT_L(0); PG8_BAR; PG8_MMA(1, 0, At, B0); PG8_MMA(1, 1, At, B1); PG8_BAR; PG8_SCHED;
            PG8_LDB(B0, 1, 0); PG8_LDB(B1, 1, 1); PG8_SCHED; PG8_LDA(At, 1, 0); PG8_STAGE(PG8_SA(0, 1), a2 + hstep, voffA);
            PG8_WAIT_V(8); PG8_WAIT_L(0); PG8_BAR; PG8_MMA(0, 0, At, B0); PG8_MMA(0, 1, At, B1); PG8_BAR; PG8_SCHED;
            PG8_LDA(At, 1, 1); PG8_STAGE(PG8_SB(1, 0), b3, voffB); PG8_STAGE(PG8_SB(1, 1), b3 + hstep, voffB); PG8_STAGE(PG8_SA(1, 0), a3, voffA);
            PG8_WAIT_V(8); PG8_WAIT_L(0); PG8_BAR; PG8_MMA(1, 0, At, B0); PG8_MMA(1, 1, At, B1); PG8_BAR; PG8_SCHED;
            } else {
            PG8_LDB(B0, 0, 0); PG8_SCHED; PG8_LDA(At, 0, 0); PG8_STAGE(PG8_SA(1, 1), a1 + hstep, voffA);
            PG8_WAIT_L(8); PG8_BAR; PG8_WAIT_L(0); PG8_MMA(0, 0, At, B0); PG8_BAR; PG8_SCHED;
            PG8_LDB(B1, 0, 1); PG8_STAGE(PG8_SB(0, 0), b2, voffB);
            PG8_BAR; PG8_WAIT_L(0); PG8_MMA(0, 1, At, B1); PG8_BAR;
            PG8_LDA(At, 0, 1); PG8_STAGE(PG8_SA(0, 0), a2, voffA);
            PG8_BAR; PG8_WAIT_L(0); PG8_MMA(1, 0, At, B0); PG8_BAR; PG8_SCHED;
            PG8_STAGE(PG8_SB(0, 1), b2 + hstep, voffB);
            PG8_WAIT_V(6); PG8_BAR; PG8_MMA(1, 1, At, B1); PG8_BAR;
            PG8_LDB(B0, 1, 0); PG8_SCHED; PG8_LDA(At, 1, 0); PG8_STAGE(PG8_SA(0, 1), a2 + hstep, voffA);
            PG8_WAIT_L(8); PG8_BAR; PG8_WAIT_L(0); PG8_MMA(0, 0, At, B0); PG8_BAR; PG8_SCHED;
            PG8_LDB(B1, 1, 1); PG8_STAGE(PG8_SB(1, 0), b3, voffB);
            PG8_BAR; PG8_WAIT_L(0); PG8_MMA(0, 1, At, B1); PG8_BAR;
            PG8_LDA(At, 1, 1); PG8_STAGE(PG8_SA(1, 0), a3, voffA);
            PG8_BAR; PG8_WAIT_L(0); PG8_MMA(1, 0, At, B0); PG8_BAR; PG8_SCHED;
            PG8_STAGE(PG8_SB(1, 1), b3 + hstep, voffB);
            PG8_WAIT_V(6); PG8_BAR; PG8_MMA(1, 1, At, B1); PG8_BAR;
            }
        }
        if constexpr (ALIGN_EPI) { if (wr == 0) PG8_BAR; }
        if constexpr (!Epi::AFTER_DRAIN) { E(acc, cur, wr, wc, fr, fq); S.done(cur); }
        if (!has_next) break;
#pragma unroll
        for (int a = 0; a < 2; ++a)
#pragma unroll
            for (int b = 0; b < 2; ++b)
#pragma unroll
                for (int m = 0; m < 4; ++m)
#pragma unroll
                    for (int n = 0; n < 2; ++n) acc[a][b][m][n] = (f32x4){0.f, 0.f, 0.f, 0.f};
        cur = nxt; cA = nA; cB = nB; ++ui;
        if constexpr (ALIGN_EPI) { if (wr == 1) PG8_BAR; }
    }
    PG8_WAIT_V(0);
    if constexpr (!ALIGN_EPI) { if (wr == 0) PG8_BAR; }
    PG8_BAR;
    if constexpr (Epi::AFTER_DRAIN) { E.fused(acc, cur, wr, wc, fr, fq, lds, wid, lane); S.done(cur); }
#undef PG8_SA
#undef PG8_SB
#undef PG8_STAGE
#undef PG8_LDA
#undef PG8_LDB
#undef PG8_MMA
#undef PG8_WAIT_V
#undef PG8_WAIT_L
#undef PG8_BAR
#undef PG8_SCHED
}
}

constexpr int REP_SCORE = 1, REP_SEL = 1, REP_ATT = 1, REP_SLOW = 1, REP_FAST = 1;

#include <hip/hip_cooperative_groups.h>
namespace cg = cooperative_groups;
#define LAS __attribute__((address_space(3)))
constexpr int LDS_BYTES = 163840, HALO_OFF = 133120, PT_OFF = 163328, NTHR = 512, NWAVE = 8;
constexpr size_t MiB = (size_t)1 << 20;
constexpr size_t WS_CTL = 0, WS_WIN = 1 * MiB, WS_WOUT = 21 * MiB, WS_WGU = 31 * MiB, WS_WDN = 75 * MiB, WS_METAX = 97 * MiB, WS_RSTD = 98 * MiB, WS_UF = 99 * MiB,
                 WS_DT = 104 * MiB, WS_FCUM = 106 * MiB, WS_CN = 108 * MiB, WS_MASK = 117 * MiB, WS_XB = 134 * MiB, WS_Y = 264 * MiB, WS_R1 = 426 * MiB, WS_XC = WS_R1 + 323 * MiB,
                 WS_YA = 814 * MiB, WS_END = 879 * MiB;
static_assert(WS_WIN + (size_t)NU * DM * 2 <= WS_WOUT && WS_WOUT + (size_t)DM * KOUT * 2 <= WS_WGU && WS_WGU + (size_t)NGU * DM * 2 <= WS_WDN && WS_WDN + (size_t)DM * FF * 2 <= WS_METAX, "ws weights");
static_assert(WS_UF + (size_t)MP * 32 * 4 <= WS_DT && WS_DT + (size_t)T * 8 * 4 <= WS_FCUM && WS_FCUM + (size_t)64 * LKP * 4 <= WS_CN && WS_CN + (size_t)MP * 128 * 2 <= WS_MASK && WS_MASK + (size_t)T * NMW * 8 <= WS_XB, "ws small");
static_assert(WS_XB + (size_t)(MP + 8) * DM * 2 <= WS_Y && WS_Y + (size_t)MP * KOUT * 2 <= WS_R1 && WS_R1 + (size_t)MP * NU * 2 <= WS_XC && WS_XC + (size_t)MP * 1024 * 2 <= WS_YA && WS_R1 + (size_t)MP * FF * 2 <= WS_YA && WS_YA + (size_t)T * 512 * 4 <= WS_END, "ws big");

typedef unsigned u32x4v __attribute__((ext_vector_type(4)));
typedef unsigned u32x2v __attribute__((ext_vector_type(2)));
typedef float f32x4v __attribute__((ext_vector_type(4)));
struct Args { const float* in[25]; float* out; unsigned char* ws; };

struct Ctx {
    int tid, lane, wave, gw, ngw, bid, nb;
    LAS unsigned char* lds;
};
__device__ __forceinline__ Ctx refresh(const Ctx& c0) {
    Ctx c = c0; unsigned z = 0u; int w_ = c0.wave, b_ = (int)blockIdx.x, n_ = (int)gridDim.x; asm volatile("" : "+v"(z), "+s"(w_), "+s"(b_), "+s"(n_));
    const int lane = (int)__builtin_amdgcn_mbcnt_hi(~0u, __builtin_amdgcn_mbcnt_lo(~0u, z));
    c.bid = b_; c.nb = n_; c.ngw = n_ * NWAVE; c.wave = w_; c.lane = lane; c.tid = w_ * 64 + lane; c.gw = b_ * NWAVE + w_;
    { unsigned l_ = (unsigned)(size_t)c0.lds; asm volatile("" : "+s"(l_)); c.lds = (LAS unsigned char*)(size_t)l_; }
    return c;
}
__device__ __forceinline__ unsigned char* pt_get(const Ctx& c, int i) {
    unsigned l_ = (unsigned)(size_t)c.lds; asm volatile("" : "+s"(l_));
    const LAS unsigned* p = (const LAS unsigned*)((LAS unsigned char*)(size_t)l_ + PT_OFF) + 2 * i;
    const unsigned lo = __builtin_amdgcn_readfirstlane(p[0]), hi = __builtin_amdgcn_readfirstlane(p[1]);
    __attribute__((address_space(1))) unsigned char* gp = (__attribute__((address_space(1))) unsigned char*)(((unsigned long long)hi << 32) | lo);
    return (unsigned char*)gp;
}
#define INP(i) ((const float*)pt_get(c, (i)))

#define GAS __attribute__((address_space(1)))
typedef unsigned v4u __attribute__((ext_vector_type(4)));
typedef GAS unsigned gu32;
typedef GAS unsigned long long gu64;
#define RLX_AGENT __ATOMIC_RELAXED, __HIP_MEMORY_SCOPE_AGENT
#define LDS_WAIT() asm volatile("s_waitcnt lgkmcnt(0)" ::: "memory")
#define VM_WAIT() asm volatile("s_waitcnt vmcnt(0)" ::: "memory")
__device__ __forceinline__ unsigned long long rt() { return __builtin_amdgcn_s_memrealtime(); }

#define XB_TMO      128
#define XB_XCNT(j)  (256  + 64 * (j))
#define XB_XSUB(j)  (1280 + 64 * (j))
#define XB_XGEN(j)  (2304 + 64 * (j))
#define XB_TOP      3328
#define XB_TOPGEN   3392
#define XCD_BAR_WORDS 3456
#define XB_SPIN_CAP (1u << 18)

__device__ __forceinline__ unsigned xb_ld(unsigned* p)              { return __hip_atomic_load(p, __ATOMIC_RELAXED, __HIP_MEMORY_SCOPE_AGENT); }
__device__ __forceinline__ unsigned xb_add(unsigned* p, unsigned v) { return __hip_atomic_fetch_add(p, v, __ATOMIC_RELAXED, __HIP_MEMORY_SCOPE_AGENT); }
__device__ __forceinline__ unsigned xb_xcc_id() { return (unsigned)__builtin_amdgcn_s_getreg((3 << 11) | 20) & 0xFu; }
#define XB_SPIN(cond, bar) do { unsigned _sp = 0; while (cond) { __builtin_amdgcn_s_sleep(1); \
    if ((++_sp & 255u) == 0u) { if (xb_ld(&(bar)[XB_TMO])) break; if (_sp > XB_SPIN_CAP) { atomicAdd(&(bar)[XB_TMO], 1u); break; } } } } while (0)

struct XcdBarrier {
    unsigned* bar; unsigned x;
    volatile LAS unsigned* st;
};

__device__ __forceinline__ XcdBarrier xcd_barrier_post(unsigned* bar, volatile LAS unsigned* st, int tid) {
    XcdBarrier b; b.bar = bar; b.x = xb_xcc_id(); b.st = st;
    if (tid == 0) (void)xb_add(&bar[XB_XCNT(b.x)], 1u);
    return b;
}
__device__ __forceinline__ void xcd_barrier_complete(unsigned* bar, unsigned x, unsigned& nloc, unsigned& nx) {
    const unsigned G = gridDim.x * gridDim.y * gridDim.z;
    unsigned sum, cnt, mine, sp = 0u;
    for (;;) {
        sum = 0u; cnt = 0u; mine = 0u;
#pragma unroll
        for (unsigned j = 0; j < 16; ++j) { const unsigned c = xb_ld(&bar[XB_XCNT(j)]); sum += c; cnt += (c > 0u) ? 1u : 0u; mine = (j == x) ? c : mine; }
        if (sum == G) break;
        __builtin_amdgcn_s_sleep(1);
        if ((++sp & 255u) == 0u) { if (xb_ld(&bar[XB_TMO])) break; if (sp > XB_SPIN_CAP) { atomicAdd(&bar[XB_TMO], 1u); break; } }
    }
    nloc = mine > 0u ? mine : 1u; nx = cnt > 0u ? cnt : 1u;
}

__device__ __forceinline__ void xcd_barrier(const XcdBarrier& b, int tid) {
    asm volatile("s_waitcnt vmcnt(0)" ::: "memory");
    __syncthreads();
    if (tid == 0) {
        unsigned* bar = b.bar;
        __builtin_amdgcn_s_waitcnt(0);
        unsigned nloc = b.st[0], nx = b.st[1];
        if (nloc == 0u) { xcd_barrier_complete(bar, b.x, nloc, nx); b.st[0] = nloc; b.st[1] = nx; }
        const unsigned old = xb_add(&bar[XB_XSUB(b.x)], 1u);
        const unsigned gen = old / nloc;
        if (old + 1u == (gen + 1u) * nloc) {
            __builtin_amdgcn_fence(__ATOMIC_RELEASE, "agent");
            asm volatile("s_waitcnt vmcnt(0)" ::: "memory");
            const unsigned og = xb_add(&bar[XB_TOP], 1u);
            const unsigned tg = og / nx;
            if (og + 1u == (tg + 1u) * nx) xb_add(&bar[XB_TOPGEN], 1u);
            else XB_SPIN(xb_ld(&bar[XB_TOPGEN]) == tg, bar);
            __builtin_amdgcn_fence(__ATOMIC_ACQUIRE, "agent");
            xb_add(&bar[XB_XGEN(b.x)], 1u);
            asm volatile("s_waitcnt vmcnt(0)" ::: "memory");
        } else {
            XB_SPIN(xb_ld(&bar[XB_XGEN(b.x)]) == gen, bar);
            __builtin_amdgcn_fence(__ATOMIC_ACQUIRE, "agent");
            asm volatile("s_waitcnt vmcnt(0)" ::: "memory");
        }
    }
    __syncthreads();
}

constexpr int MISC_OFF = 163072, CW_BAR = 4096;
__device__ __forceinline__ void grid_barrier(const Ctx& c0) {
    const Ctx c = refresh(c0);
    XcdBarrier b; b.bar = (unsigned*)(pt_get(c, 26) + WS_CTL) + CW_BAR; b.x = xb_xcc_id(); b.st = (volatile LAS unsigned*)(c.lds + MISC_OFF);
    xcd_barrier(b, c.tid);
}
__device__ __forceinline__ void ph_prep_x(const Ctx& c0, const float* x, const float* meta, bf16* XB, float* RSTD) { const Ctx c = refresh(c0);
    const int lane = c.lane;
    for (int w = c.gw; w < MP + 8; w += c.ngw) {
        const int t = w - 8; bf16* xb = XB + (ptrdiff_t)t * DM;
        if (t < 0 || t >= T) {
#pragma unroll
            for (int j = 0; j < 4; ++j) *(u32x4v*)(xb + 8 * lane + 512 * j) = (u32x4v){0u, 0u, 0u, 0u};
            if (t >= T && lane == 0) RSTD[t] = 0.f;
            continue;
        }
        const int b = t / L, p = t - b * L;
        const float* src = p < NMETA ? meta + (size_t)p * DM : x + ((size_t)b * SEQ + (p - NMETA)) * DM;
        float ss = 0.f;
#pragma unroll
        for (int j = 0; j < 4; ++j) {
            const f32x4v a = *(const f32x4v*)(src + 8 * lane + 512 * j), cc = *(const f32x4v*)(src + 8 * lane + 512 * j + 4);
            ss += a.x * a.x + a.y * a.y + a.z * a.z + a.w * a.w + cc.x * cc.x + cc.y * cc.y + cc.z * cc.z + cc.w * cc.w;
            *(u32x4v*)(xb + 8 * lane + 512 * j) = (u32x4v){pk2(a.x, a.y), pk2(a.z, a.w), pk2(cc.x, cc.y), pk2(cc.z, cc.w)};
        }
        ss = wave_sum(ss, lane);
        if (lane == 0) RSTD[t] = rsqrtf(ss * (1.f / DM) + EPSF);
    }
}

__device__ __forceinline__ void tp_tile(LAS float* tl, int lane, const float* src, int ld, const float* scale, float mul, bf16* dst, int Kd) {
    const int kk = lane >> 4, n4 = lane & 15;
    f32x4v v[16];
#pragma unroll
    for (int i = 0; i < 16; ++i) v[i] = *(const f32x4v*)(src + (size_t)(4 * i + kk) * ld + 4 * n4);
    if (scale) {
#pragma unroll
        for (int i = 0; i < 16; ++i) v[i] = v[i] * (scale[4 * i + kk] * mul); }
#pragma unroll
    for (int i = 0; i < 16; ++i)
#pragma unroll
        for (int e = 0; e < 4; ++e) tl[(4 * n4 + e) * 65 + 4 * i + kk] = v[i][e];
#pragma unroll
    for (int jj = 0; jj < 8; ++jj) { const int n = (lane >> 3) + 8 * jj, kc = (lane & 7) * 8; const LAS float* tp = tl + n * 65 + kc;
        *(u32x4v*)(dst + (size_t)n * Kd + kc) = (u32x4v){pk2(tp[0], tp[1]), pk2(tp[2], tp[3]), pk2(tp[4], tp[5]), pk2(tp[6], tp[7])}; }
}
template <class F, class M> __device__ __forceinline__ void transpose_tiles_map(const Ctx& c, bf16* dst, int Kd, int ntiles, const F& val, const M& map) {
    LAS float* tile = (LAS float*)c.lds + (c.tid >> 8) * (32 * 33);
    const int t2 = c.tid & 255, tx = t2 & 31, ty = t2 >> 5;
    for (int it = 2 * c.bid + (c.tid >> 8); it < ntiles; it += 2 * c.nb) {
        int k0, n0; map(it, k0, n0);
#pragma unroll
        for (int i = 0; i < 4; ++i) tile[(ty + 8 * i) * 33 + tx] = val(k0 + ty + 8 * i, n0 + tx);
        __syncthreads();
#pragma unroll
        for (int i = 0; i < 4; ++i) dst[(size_t)(n0 + ty + 8 * i) * Kd + k0 + tx] = f2bf(tile[tx * 33 + ty + 8 * i]);
        __syncthreads();
    }
}
__device__ __forceinline__ void ph_prep_w(const Ctx& c0, int ly, bf16* WIN, bf16* WOUT, bf16* WGU, bf16* WDN, bf16* WUKB, bf16* WUVT) { const Ctx c = refresh(c0);
    const float* w_in = INP(6) + (size_t)ly * DM * DIN; const float* g1 = INP(2) + (size_t)ly * DM; const float* w_uk = INP(17) + (size_t)ly * 8 * 128 * 64;
    const float* w_out = INP(19) + (size_t)ly * DM * DM; const float* ssd_norm = INP(12) + (size_t)ly * 512; const float* pool_w = INP(13) + (size_t)ly * 4 * 128 * 128;
    const float* pool_scale = INP(14) + (size_t)ly * 512; const float* w_uv = INP(18) + (size_t)ly * 8 * 128 * 64;
    const float* wg = INP(20) + (size_t)ly * DM * FF; const float* wu = INP(21) + (size_t)ly * DM * FF; const float* g3 = INP(4) + (size_t)ly * DM;
    const float* wd = INP(24) + (size_t)ly * FF * DM;
    {
        LAS float* tl = (LAS float*)c.lds + c.wave * (64 * 65);
        constexpr int N_WIN = 71 * 32, N_WGU = 176 * 32, N_WDN = 32 * 88, N_WOUT = 32 * 24, N_ALL = N_WIN + N_WGU + N_WDN + N_WOUT;
#pragma unroll 1
        for (int it0 = c.gw; it0 < N_ALL * REP_FAST; it0 += c.ngw) { const int it = it0 % N_ALL;
            int r = it; const float* src; const float* scl; bf16* dst; int ld, Kd; float mul = 1.f;
            if (r < N_WGU) { const int kt = r / 176, ct = r - kt * 176, pn = ct >> 2, up = (ct >> 1) & 1, hf = ct & 1;
                src = (up ? wu : wg) + (size_t)(64 * kt) * FF + 128 * pn + 64 * hf; ld = FF; scl = g3 + 64 * kt; dst = WGU + (size_t)(256 * pn + 128 * up + 64 * hf) * DM + 64 * kt; Kd = DM; }
            else if ((r -= N_WGU) < N_WDN) { const int kt = r >> 5, ct = r & 31;
                src = wd + (size_t)(64 * kt) * DM + 64 * ct; ld = DM; scl = nullptr; dst = WDN + (size_t)(64 * ct) * FF + 64 * kt; Kd = FF; }
            else if ((r -= N_WDN) < N_WIN) { const int kt = r / 71, ct = r - kt * 71;
                int dcol, scol;
                if (ct < 24) { dcol = 64 * ct; scol = dcol; }
                else if (ct < 32) { dcol = 64 * ct; scol = 1544 + 64 * (ct - 24); }
                else if (ct < 56) { dcol = 64 * ct; scol = 2056 + 64 * (ct - 32); if (ct < 40) mul = 0.18033688011112042f; }
                else if (ct < 64) { dcol = 64 * ct; scol = 3600 + 64 * (ct - 56); }
                else if (ct < 66) { dcol = C_DC + 64 * (ct - 64); scol = 4112 + 64 * (ct - 64); }
                else if (ct < 70) { dcol = C_QI + 64 * (ct - 66); scol = 4240 + 64 * (ct - 66); }
                else { dcol = C_KI; scol = 4496; }
                src = w_in + (size_t)(64 * kt) * DIN + scol; ld = DIN; scl = g1 + 64 * kt; dst = WIN + (size_t)dcol * DM + 64 * kt; Kd = DM; }
            else { r -= N_WIN; const int kq = r >> 5, nt = r & 31, k0 = kq < 8 ? 64 * kq : 1024 + 64 * (kq - 8);
                src = w_out + (size_t)k0 * DM + 64 * nt; ld = DM; scl = kq < 8 ? ssd_norm + k0 : nullptr; dst = WOUT + (size_t)(64 * nt) * KOUT + k0; Kd = KOUT; }
            tp_tile(tl, c.lane, src, ld, scl, mul, dst, Kd);
        }
    }
    __syncthreads();
    {   const int gt = c.bid * NTHR + c.tid, ngt = c.nb * NTHR;
        for (int it = gt; it < 8 * 128 * 64 / 2; it += ngt) { const float sc = 0.125f * 1.4426950408889634f; *(unsigned*)(WUKB + 2 * it) = pk2(w_uk[2 * it] * sc, w_uk[2 * it + 1] * sc); }
        for (int it = gt; it < 4 * 32 * 512; it += ngt) {
            const int nq = it & 511, cq = (it >> 9) & 31, gi = it >> 14, n0 = 4 * nq, c0_ = 4 * cq;
            float acc[4][4];
#pragma unroll
            for (int a = 0; a < 4; ++a)
#pragma unroll
                for (int b = 0; b < 4; ++b) acc[a][b] = 0.f;
            const float* ap = pool_w + ((size_t)gi * 128 + c0_) * 128; const float* sp = pool_scale + 128 * gi; const float* bp = w_out + (size_t)(512 + 128 * gi) * DM + n0;
#pragma unroll 2
            for (int d = 0; d < 128; d += 4) {
                f32x4v av[4], bv[4]; const f32x4v sv = *(const f32x4v*)(sp + d);
#pragma unroll
                for (int a = 0; a < 4; ++a) { av[a] = *(const f32x4v*)(ap + a * 128 + d) * sv; bv[a] = *(const f32x4v*)(bp + (size_t)(d + a) * DM); }
#pragma unroll
                for (int a = 0; a < 4; ++a)
#pragma unroll
                    for (int b = 0; b < 4; ++b) acc[a][b] += av[a][0] * bv[0][b] + av[a][1] * bv[1][b] + av[a][2] * bv[2][b] + av[a][3] * bv[3][b];
            }
#pragma unroll
            for (int b = 0; b < 4; ++b) *(u32x2v*)(WOUT + (size_t)(n0 + b) * KOUT + 512 + 128 * gi + c0_) = (u32x2v){pk2(acc[0][b], acc[1][b]), pk2(acc[2][b], acc[3][b])};
        }
        for (int it = gt; it < 8 * 64 * 128; it += ngt) { const int r = it & 127, d = (it >> 7) & 63, h = it >> 13; WUVT[it] = f2bf(w_uv[((size_t)h * 128 + r) * 64 + d]); }
    }
    transpose_tiles_map(c, WIN, DM, 2 * 64, [=](int k, int n) -> float {
            int src = -1;
            if (n < C_SM + 8) src = 1536 + (n - C_SM);
            else if (n < C_SM + 16) src = 3592 + (n - C_SM - 8);
            else if (n < C_SM + 20) src = 4560 + (n - C_SM - 16);
            return src >= 0 ? w_in[(size_t)k * DIN + src] * g1[k] : 0.f; },
        [=](int it, int& k0, int& n0) { k0 = 32 * (it & 63); n0 = C_SM + 32 * (it >> 6); });
}

__device__ __forceinline__ void ph_mixprep(const Ctx& c0, const bf16* U, const float* UF, const float* cw, const float* cb, const float* kvn, const float* dtb, bf16* XC, bf16* Y, bf16* CN, float* DT, bf16* KI) { const Ctx c = refresh(c0);
    const int gt = c.bid * NTHR + c.tid, ngt = c.nb * NTHR;
    for (int idx = gt; idx < T * 128; idx += ngt) {
        const int t = idx >> 7, c0 = (idx & 127) * 8, pos = t % L; float acc[8];
        u32x4v v[4]; f32x4v wa[4], wb[4];
#pragma unroll
        for (int k = 0; k < 4; ++k) { const bool ok = pos - 3 + k >= 0; v[k] = *(const u32x4v*)(U + (size_t)(ok ? t - 3 + k : t) * NU + C_XBC + c0);
            wa[k] = *(const f32x4v*)(cw + k * 1024 + c0); wb[k] = *(const f32x4v*)(cw + k * 1024 + c0 + 4); if (!ok) { wa[k] = (f32x4v){0.f, 0.f, 0.f, 0.f}; wb[k] = wa[k]; } }
        const f32x4v ba = *(const f32x4v*)(cb + c0), bb = *(const f32x4v*)(cb + c0 + 4);
#pragma unroll
        for (int j = 0; j < 4; ++j) { acc[j] = ba[j]; acc[4 + j] = bb[j]; }
#pragma unroll
        for (int k = 0; k < 4; ++k) { const unsigned w[4] = {v[k].x, v[k].y, v[k].z, v[k].w};
#pragma unroll
            for (int j = 0; j < 8; ++j) acc[j] += (j < 4 ? wa[k][j] : wb[k][j - 4]) * bf2f((bf16)(w[j >> 1] >> (16 * (j & 1)))); }
        *(u32x4v*)(XC + (size_t)t * 1024 + c0) = (u32x4v){pk2(siluf(acc[0]), siluf(acc[1])), pk2(siluf(acc[2]), siluf(acc[3])), pk2(siluf(acc[4]), siluf(acc[5])), pk2(siluf(acc[6]), siluf(acc[7]))};
    }
    for (int idx = gt; idx < T * 64; idx += ngt) {
        const int t = idx >> 6, c0 = (idx & 63) * 8, pos = t % L, gi = c0 >> 7, win = 2 << gi, n = min(pos + 1, win);
        float acc[8] = {0, 0, 0, 0, 0, 0, 0, 0}, self[8] = {0, 0, 0, 0, 0, 0, 0, 0};
        const bf16* up = U + (size_t)t * NU + C_POOL + c0;
#define POOL_WIN(W) { u32x4v v[W]; _Pragma("unroll") for (int i = 0; i < W; ++i) v[i] = i < n ? *(const u32x4v*)(up - (ptrdiff_t)i * NU) : (u32x4v){0u, 0u, 0u, 0u}; \
            _Pragma("unroll") for (int i = 0; i < W; ++i) { const unsigned w[4] = {v[i].x, v[i].y, v[i].z, v[i].w}; \
                _Pragma("unroll") for (int j = 0; j < 8; ++j) { const float f = bf2f((bf16)(w[j >> 1] >> (16 * (j & 1)))); acc[j] += f; if (i == 0) self[j] = f; } } }
        if (gi == 0) POOL_WIN(2) else if (gi == 1) POOL_WIN(4) else if (gi == 2) POOL_WIN(8) else POOL_WIN(16)
        const float inv = 1.f / (float)n; float o[8];
#pragma unroll
        for (int j = 0; j < 8; ++j) o[j] = acc[j] * inv - self[j];
        *(uint4*)(Y + (size_t)t * KOUT + 512 + c0) = make_uint4(pk2(o[0], o[1]), pk2(o[2], o[3]), pk2(o[4], o[5]), pk2(o[6], o[7]));
    }
    for (int t = c.gw; t < T; t += c.ngw) {
        const int lane = c.lane;
        const unsigned v = *(const unsigned*)(U + (size_t)t * NU + C_DC + 2 * lane);
        const float a = bf2f((bf16)(v & 0xffff)), cc = bf2f((bf16)(v >> 16));
        const float rs = rsqrtf(wave_sum(a * a + cc * cc, lane) * (1.f / 128.f) + EPSF);
        *(unsigned*)(CN + (size_t)t * 128 + 2 * lane) = pk2(a * rs * kvn[2 * lane], cc * rs * kvn[2 * lane + 1]);
        if (lane < 8) DT[(size_t)t * 8 + lane] = softplusf(UF[(size_t)t * 32 + lane] + dtb[lane]);
        if (lane < 32) *(unsigned*)(KI + (size_t)t * 64 + 2 * lane) = *(const unsigned*)(U + (size_t)t * NU + C_KI + 2 * lane);
    }
}
__device__ __forceinline__ void ph_fcum(const Ctx& c0, const float* UF, const float* fb, float* FCUM) { const Ctx c = refresh(c0);
    const int lane = c.lane, w = c.wave;
    LAS float* tot = (LAS float*)c.lds;
    for (int bh = c.bid; bh < 64; bh += c.nb) {
        const int b = bh >> 3, h = bh & 7; const float bias = fb[h]; float v[9]; float carry = 0.f;
#pragma unroll
        for (int i = 0; i < 9; ++i) { const int p = 576 * w + 64 * i + lane; v[i] = p < L ? logsigmoidf(UF[(size_t)(b * L + p) * 32 + 8 + h] + bias) : 0.f; }
#pragma unroll
        for (int i = 0; i < 9; ++i) { float x = v[i];
#pragma unroll
            for (int o = 1; o < 64; o <<= 1) { const float n = lane_read(x, (lane - o) & 63); if (lane >= o) x += n; }
            x += carry; v[i] = x; carry = lane_read(x, 63); }
        if (lane == 0) tot[w] = carry;
        __syncthreads();
        float off = 0.f;
#pragma unroll
        for (int ww = 0; ww < NWAVE; ++ww) off += ww < w ? tot[ww] : 0.f;
#pragma unroll
        for (int i = 0; i < 9; ++i) { const int p = 576 * w + 64 * i + lane; if (p < LKP) FCUM[(size_t)bh * LKP + p] = v[i] + off; }
        __syncthreads();
    }
}
__device__ __forceinline__ unsigned fkey(float f) { const unsigned u = __float_as_uint(f); return (u & 0x80000000u) ? ~u : (u | 0x80000000u); }
__device__ __forceinline__ int crow(int r, int hi) { return (r & 3) + 8 * (r >> 2) + 4 * hi; }
typedef short bf16x8 __attribute__((ext_vector_type(8)));
typedef float f32x16 __attribute__((ext_vector_type(16)));
typedef float f32x2v __attribute__((ext_vector_type(2)));
typedef __bf16 bf16x2v __attribute__((ext_vector_type(2)));
#define MFMA32(a, b, c) __builtin_amdgcn_mfma_f32_32x32x16_bf16((a), (b), (c), 0, 0, 0)
#define WLANE64(lo, hi, m, sel) asm volatile("s_nop 1\n\tv_writelane_b32 %0, %2, %4\n\tv_writelane_b32 %1, %3, %4" : "+v"(lo), "+v"(hi) : "s"((unsigned)(m)), "s"((unsigned)((m) >> 32)), "n"(sel))
__device__ __forceinline__ float max3f(float a, float b, float c) { float r; asm("v_max3_f32 %0, %1, %2, %3" : "=v"(r) : "v"(a), "v"(b), "v"(c)); return r; }
__device__ __forceinline__ unsigned cvtpk(float lo, float hi) { f32x2v v = {lo, hi}; bf16x2v b = __builtin_convertvector(v, bf16x2v); return __builtin_bit_cast(unsigned, b); }
__device__ __forceinline__ bf16x8 pack8(const f32x16& p, int s) {
    u32x4v r; r.x = cvtpk(p[8 * s], p[8 * s + 1]); r.y = cvtpk(p[8 * s + 2], p[8 * s + 3]); r.z = cvtpk(p[8 * s + 4], p[8 * s + 5]); r.w = cvtpk(p[8 * s + 6], p[8 * s + 7]);
    return __builtin_bit_cast(bf16x8, r);
}
constexpr int AT_KSTR = 72;
constexpr int AT_VSTR = 68;
constexpr int FOX_KB = 64 * AT_KSTR;
__device__ __forceinline__ void ph_fox(const Ctx& c0, const bf16* U, const float* FCUM, bf16* Y) {
    const Ctx c = refresh(c0);
    LAS bf16* KS = (LAS bf16*)c.lds;
    LAS bf16* VT = KS + 2 * FOX_KB;
    LAS float* FB = (LAS float*)(c.lds + 4 * FOX_KB * 2);
    const int lane = c.lane, w = c.wave, r32 = lane & 31, hi = lane >> 5, tid = c.tid;
    const float LOG2E = 1.4426950408889634f;
    typedef short s16x4v __attribute__((ext_vector_type(4)));
    for (int it = c.bid; it < 64 * 17; it += c.nb) {
        const int rnd = it >> 8, cu = it & 255, k4 = cu >> 6, bh = cu & 63, b = bh >> 3, h = bh & 7;
        const int j = rnd == 0 ? 16 - k4 : rnd == 1 ? 9 + k4 : rnd == 2 ? 8 - k4 : rnd == 3 ? 1 + k4 : 0;
        const int q0 = j == 0 ? 0 : 16 + 256 * (j - 1), qrow = q0 + 32 * w + r32, ntiles = 1 + 4 * j, qmax = q0 + 32 * w + 31;
        const bool wave_on = (j > 0) || (w == 0), row_ok = (j > 0) || (r32 < 16);
        const bf16* Ub = U + (size_t)(b * L) * NU;
        bf16x8 qf[4];
#pragma unroll
        for (int s = 0; s < 4; ++s) qf[s] = (bf16x8){0, 0, 0, 0, 0, 0, 0, 0};
        if (wave_on && row_ok) {
#pragma unroll
            for (int s = 0; s < 4; ++s) qf[s] = *(const bf16x8*)(Ub + (size_t)qrow * NU + C_FQ + 64 * h + 16 * s + 8 * hi);
        }
        f32x16 o0, o1;
#pragma unroll
        for (int r = 0; r < 16; ++r) { o0[r] = 0.f; o1[r] = 0.f; }
        float m = -1e30f, l = 0.f;
        const float* fc = FCUM + (size_t)bh * LKP;
        const bf16* kg = Ub + (size_t)(tid >> 3) * NU + C_FK + 64 * h + 8 * (tid & 7);
        const bf16* vg = Ub + (size_t)lane * NU + C_FV + 64 * h + 8 * w;
#define FOX_KB0(t) ((t) == 0 ? 0 : 16 + 64 * ((t) - 1))
#define FOX_PUT_K(buf, kr, fr) do { *(LAS u32x4v*)(KS + (buf) * FOX_KB + (tid >> 3) * AT_KSTR + 8 * (tid & 7)) = kr; if (tid < 64) FB[(buf) * 64 + tid] = fr; } while (0)
#define FOX_PUT_V(buf, vr) do { const unsigned vv_[4] = {vr.x, vr.y, vr.z, vr.w}; \
            _Pragma("unroll") for (int e = 0; e < 8; ++e) VT[(buf) * FOX_KB + (8 * w + e) * AT_VSTR + lane] = (bf16)(vv_[e >> 1] >> (16 * (e & 1))); } while (0)
#define FOX_GET_K(t, kr, fr) do { const int kb_ = FOX_KB0(t); kr = *(const u32x4v*)(kg + (size_t)kb_ * NU); if (tid < 64) fr = -fc[kb_ + tid] * LOG2E; } while (0)
#define FOX_GET_V(t, vr) do { vr = *(const u32x4v*)(vg + (size_t)FOX_KB0(t) * NU); } while (0)
#define FOX_QK(buf, P0, P1) do { const LAS float* fb_ = FB + (buf) * 64; \
            _Pragma("unroll") for (int i4 = 0; i4 < 4; ++i4) { const f32x4v f0 = *(const LAS f32x4v*)(fb_ + 8 * i4 + 4 * hi), f1 = *(const LAS f32x4v*)(fb_ + 32 + 8 * i4 + 4 * hi); \
                _Pragma("unroll") for (int e = 0; e < 4; ++e) { P0[4 * i4 + e] = f0[e]; P1[4 * i4 + e] = f1[e]; } } \
            _Pragma("unroll") for (int s = 0; s < 4; ++s) { \
                const bf16x8 a0 = *(const LAS bf16x8*)(KS + (buf) * FOX_KB + r32 * AT_KSTR + 16 * s + 8 * hi), a1 = *(const LAS bf16x8*)(KS + (buf) * FOX_KB + (32 + r32) * AT_KSTR + 16 * s + 8 * hi); \
                P0 = MFMA32(a0, qf[s], P0); P1 = MFMA32(a1, qf[s], P1); } } while (0)
        u32x4v kreg, vreg; float fbreg = 0.f;
        FOX_GET_K(0, kreg, fbreg); FOX_GET_V(0, vreg);
        FOX_PUT_K(0, kreg, fbreg); FOX_PUT_V(0, vreg);
        if (ntiles > 1) { FOX_GET_K(1, kreg, fbreg); FOX_GET_V(1, vreg); FOX_PUT_K(1, kreg, fbreg); }
        if (ntiles > 2) FOX_GET_K(2, kreg, fbreg);
        __syncthreads();
        f32x16 pc0, pc1, pn0, pn1;
#pragma unroll
        for (int r = 0; r < 16; ++r) { pc0[r] = 0.f; pc1[r] = 0.f; pn0[r] = 0.f; pn1[r] = 0.f; }
        if (wave_on) FOX_QK(0, pc0, pc1);
        __syncthreads();
        for (int i = 0; i < ntiles; ++i) {
            const int cur = i & 1, kb = FOX_KB0(i), kbn = FOX_KB0(i + 1);
            if (i + 2 < ntiles) FOX_PUT_K(cur, kreg, fbreg);
            if (i + 1 < ntiles) FOX_PUT_V(cur ^ 1, vreg);
            if (i + 3 < ntiles) FOX_GET_K(i + 3, kreg, fbreg);
            if (i + 2 < ntiles) FOX_GET_V(i + 2, vreg);
            const bool on_next = wave_on && (i + 1 < ntiles) && kbn <= qmax, on_cur = wave_on && kb <= qmax;
            if (on_next) FOX_QK(cur ^ 1, pn0, pn1);
            if (on_cur) {
                if (i == 0 || kb + 63 > q0 + 32 * w) {
                    const int klim = i == 0 ? 16 : 64;
#pragma unroll
                    for (int r = 0; r < 16; ++r) { const int k0 = crow(r, hi), k1 = 32 + k0;
                        if (!(k0 < klim && kb + k0 <= qrow)) pc0[r] = -1e30f;
                        if (!(k1 < klim && kb + k1 <= qrow)) pc1[r] = -1e30f; }
                }
                float mx = max3f(pc0[0], pc1[0], pc0[1]), mx2 = max3f(pc1[1], pc0[2], pc1[2]);
#pragma unroll
                for (int r = 3; r < 15; r += 2) { mx = max3f(mx, pc0[r], pc1[r]); mx2 = max3f(mx2, pc0[r + 1], pc1[r + 1]); }
                mx = max3f(mx, pc0[15], pc1[15]); mx = max3f(mx, mx2, mx2);
                const float mn = max3f(m, mx, lane_read(mx, lane ^ 32)), alpha = __builtin_amdgcn_exp2f(m - mn); const bool grew = __ballot(mn > m) != 0ull; m = mn;
                float sum = 0.f;
#pragma unroll
                for (int r = 0; r < 16; ++r) { pc0[r] = __builtin_amdgcn_exp2f(pc0[r] - mn); pc1[r] = __builtin_amdgcn_exp2f(pc1[r] - mn); sum += pc0[r] + pc1[r]; }
                l = l * alpha + sum;
                if (grew) {
#pragma unroll
                    for (int r = 0; r < 16; ++r) { o0[r] *= alpha; o1[r] *= alpha; } }
#pragma unroll
                for (int blk = 0; blk < 2; ++blk)
#pragma unroll
                    for (int s = 0; s < 2; ++s) {
                        const bf16x8 xs = pack8(blk == 0 ? pc0 : pc1, s);
                        const LAS bf16* vp = VT + cur * FOX_KB + r32 * AT_VSTR + 32 * blk + 16 * s + 4 * hi;
                        const s16x4v lo0 = *(const LAS s16x4v*)vp, hi0 = *(const LAS s16x4v*)(vp + 8);
                        const s16x4v lo1 = *(const LAS s16x4v*)(vp + 32 * AT_VSTR), hi1 = *(const LAS s16x4v*)(vp + 32 * AT_VSTR + 8);
                        const bf16x8 pa0 = __builtin_shufflevector(lo0, hi0, 0, 1, 2, 3, 4, 5, 6, 7), pa1 = __builtin_shufflevector(lo1, hi1, 0, 1, 2, 3, 4, 5, 6, 7);
                        o0 = MFMA32(pa0, xs, o0); o1 = MFMA32(pa1, xs, o1);
                    }
            }
            pc0 = pn0; pc1 = pn1;
            __syncthreads();
        }
        l += lane_read(l, lane ^ 32);
        if (wave_on && row_ok) {
            const float inv = 1.f / l; bf16* yr = Y + (size_t)(b * L + qrow) * KOUT + 1024 + 64 * h;
#pragma unroll
            for (int i4 = 0; i4 < 4; ++i4) {
                *(u32x2v*)(yr + 8 * i4 + 4 * hi) = (u32x2v){cvtpk(o0[4 * i4] * inv, o0[4 * i4 + 1] * inv), cvtpk(o0[4 * i4 + 2] * inv, o0[4 * i4 + 3] * inv)};
                *(u32x2v*)(yr + 32 + 8 * i4 + 4 * hi) = (u32x2v){cvtpk(o1[4 * i4] * inv, o1[4 * i4 + 1] * inv), cvtpk(o1[4 * i4 + 2] * inv, o1[4 * i4 + 3] * inv)};
            }
        }
    }
}
constexpr int DSA_LIST_OFF = 150016  , DSA_BUF_ELEMS = 17920  , DSA_SC_STR = 4160, DSA_MW_OFF = 8 * DSA_SC_STR * 4  , DSA_KSTR = 136, DSA_VT_OFF = 64 * DSA_KSTR * 2  ;
__device__ __forceinline__ void ph_dsa(const Ctx& c0, const bf16* U, const float* UF, const bf16* CN, const bf16* KI) {
    const Ctx c = refresh(c0);
    LAS unsigned* SC = (LAS unsigned*)c.lds;
    LAS u64* MW = (LAS u64*)(c.lds + DSA_MW_OFF);
    LAS bf16* KS = (LAS bf16*)c.lds;
    LAS bf16* VT = (LAS bf16*)(c.lds + DSA_VT_OFF);
    const int lane = c.lane, w = c.wave, r32 = lane & 31, hi = lane >> 5, tid = c.tid;
    const float LOG2E = 1.4426950408889634f;
    for (int it = c.bid; it < 1032; it += c.nb) {
        const int rnd = it >> 8, cu = it & 255, g16 = cu >> 4, wi16 = cu & 15;
        const int ch = rnd == 0 ? 64 - g16 : rnd == 1 ? 33 + g16 : rnd == 2 ? 32 - g16 : rnd == 3 ? 1 + g16 : 0;
        const int b = rnd == 4 ? cu : (wi16 >> 1), half = rnd == 4 ? 0 : (wi16 & 1);
        const int p0q = ch == 0 ? 0 : 16 + 64 * (ch - 1) + 32 * half, nq = ch == 0 ? 16 : 32, nadm = ch == 0 ? 16 : 16 + 64 * ch, nw = ch + 1;
        const int t0 = b * L + p0q;
        const bf16* Ub = U + (size_t)(b * L) * NU;
        if (nadm <= TOPK) {
            for (int i = tid; i < 32 * 65; i += NTHR) { const int wd = i % 65; const int lo = 64 * wd; const int nb_ = nadm - lo;
                MW[i] = (wd < nw && nb_ > 0) ? (nb_ >= 64 ? ~0ull : ((1ull << nb_) - 1ull)) : 0ull; }
            __syncthreads();
        } else {
            const int nkb = 2 * nw;
#pragma unroll 1
            for (int sb = 0; sb < 4; ++sb) {
                const int tq = t0 + 8 * sb;
                for (int rs_ = 0; rs_ < REP_SCORE; ++rs_) {
                    bf16x8 aq[4]; float wq[4][4];
#pragma unroll
                    for (int s = 0; s < 4; ++s) aq[s] = *(const bf16x8*)(U + (size_t)(tq + (r32 >> 2)) * NU + C_QI + 64 * (r32 & 3) + 32 * hi + 8 * s);
#pragma unroll
                    for (int i4 = 0; i4 < 4; ++i4) { const f32x4v t4 = *(const f32x4v*)(UF + (size_t)(tq + 2 * i4 + hi) * 32 + 16); wq[i4][0] = t4[0]; wq[i4][1] = t4[1]; wq[i4][2] = t4[2]; wq[i4][3] = t4[3]; }
                    const bf16* kib = KI + (size_t)(b * L) * 64 + (size_t)r32 * 64 + 32 * hi;
                    bf16x8 bk[4], bn[4], bm[4];
#pragma unroll
                    for (int s = 0; s < 4; ++s) { bk[s] = *(const bf16x8*)(kib + (size_t)(32 * w) * 64 + 8 * s); bn[s] = bk[s]; bm[s] = bk[s]; }
                    if (w + NWAVE < nkb) {
#pragma unroll
                        for (int s = 0; s < 4; ++s) bn[s] = *(const bf16x8*)(kib + (size_t)(32 * (w + NWAVE)) * 64 + 8 * s); }
#pragma unroll 1
                    for (int kb = w; kb < nkb; kb += NWAVE) {
                        if (kb + 2 * NWAVE < nkb) {
#pragma unroll
                            for (int s = 0; s < 4; ++s) bm[s] = *(const bf16x8*)(kib + (size_t)(32 * (kb + 2 * NWAVE)) * 64 + 8 * s); }
                        const int key = 32 * kb + r32; f32x16 acc;
#pragma unroll
                        for (int r = 0; r < 16; ++r) acc[r] = 0.f;
#pragma unroll
                        for (int s = 0; s < 4; ++s) acc = MFMA32(aq[s], bk[s], acc);
#pragma unroll
                        for (int i4 = 0; i4 < 4; ++i4) {
                            float s = wq[i4][0] * fmaxf(acc[4 * i4], 0.f) + wq[i4][1] * fmaxf(acc[4 * i4 + 1], 0.f) + wq[i4][2] * fmaxf(acc[4 * i4 + 2], 0.f) + wq[i4][3] * fmaxf(acc[4 * i4 + 3], 0.f);
                            asm("v_add_f32 %0, 0, %0" : "+v"(s));
                            unsigned kv = fkey(s); if (32 * kb + 31 >= nadm) kv = key < nadm ? kv : 0u;
                            SC[(2 * i4 + hi) * DSA_SC_STR + key] = kv;
                        }
#pragma unroll
                        for (int s = 0; s < 4; ++s) { bk[s] = bn[s]; bn[s] = bm[s]; }
                    }
                }
                __syncthreads();
                for (int rs_ = 0; rs_ < REP_SEL; ++rs_) {
                    unsigned kk[65];
#pragma unroll
                    for (int j = 0; j < 65; ++j) kk[j] = 0u;
#define DSA_BUCKETS(F) { F(0, 16) if (nw > 16) { F(16, 32) } if (nw > 32) { F(32, 48) } if (nw > 48) { F(48, 64) } if (nw > 64) { F(64, 65) } }
#define DSA_LOAD(j0, j1) _Pragma("unroll") for (int j = j0; j < j1; ++j) kk[j] = SC[w * DSA_SC_STR + 64 * j + lane];
                    DSA_BUCKETS(DSA_LOAD)
#pragma unroll
                    for (int j = 0; j < 65; ++j) if (j >= 5) kk[j] = j < nw ? kk[j] : 0u;
#define DSA_C4(a, b, c_, d) asm volatile("v_cmp_ge_u32_e64 %1, %5, %9\n\tv_cmp_ge_u32_e64 %2, %6, %9\n\tv_cmp_ge_u32_e64 %3, %7, %9\n\tv_cmp_ge_u32_e64 %4, %8, %9\n\t" \
                        "v_addc_co_u32_e64 %0, vcc, 0, %0, %1\n\tv_addc_co_u32_e64 %0, vcc, 0, %0, %2\n\tv_addc_co_u32_e64 %0, vcc, 0, %0, %3\n\tv_addc_co_u32_e64 %0, vcc, 0, %0, %4" \
                        : "+v"(nl_), "=&s"(m0_), "=&s"(m1_), "=&s"(m2_), "=&s"(m3_) : "v"(a), "v"(b), "v"(c_), "v"(d), "v"(cand_) : "vcc");
#define DSA_CNT16(j0, j1) if (j1 - j0 == 16) { DSA_C4(kk[j0], kk[j0 + 1], kk[j0 + 2], kk[j0 + 3]) DSA_C4(kk[j0 + 4], kk[j0 + 5], kk[j0 + 6], kk[j0 + 7]) DSA_C4(kk[j0 + 8], kk[j0 + 9], kk[j0 + 10], kk[j0 + 11]) DSA_C4(kk[j0 + 12], kk[j0 + 13], kk[j0 + 14], kk[j0 + 15]) } \
                        else { nl_ += kk[64] >= cand_ ? 1 : 0; }
#define DSA_COUNT(CAND, N) { const unsigned cand_ = (CAND); int nl_ = 0; u64 m0_, m1_, m2_, m3_; DSA_BUCKETS(DSA_CNT16) N = 0; \
                        _Pragma("unroll") for (int k_ = 0; k_ < 7; ++k_) N += __popcll(__ballot((nl_ >> k_) & 1)) << k_; }
                    unsigned kmax = 0u;
#define DSA_MAX(j0, j1) _Pragma("unroll") for (int j = j0; j < j1; ++j) kmax = kk[j] > kmax ? kk[j] : kmax;
                    DSA_BUCKETS(DSA_MAX)
#pragma unroll
                    for (int o = 1; o < 64; o <<= 1) { const unsigned t_ = (unsigned)lane_readi((int)kmax, lane ^ o); kmax = t_ > kmax ? t_ : kmax; }
                    kmax = (unsigned)__builtin_amdgcn_readfirstlane((int)kmax);
                    unsigned lo = 0u, hi = (kmax >> 23) + 1u, tau = 0u; int nhi = 0; bool exact = false;
                    {   unsigned step = 1u;
#pragma unroll 1
                        while (hi - lo > 1u) {
                            const unsigned e = step ? (hi - lo > step ? hi - step : lo + 1u) : lo + ((hi - lo) >> 1);
                            int n; DSA_COUNT(e << 23, n)
                            if (n == TOPK) { exact = true; tau = e << 23; break; }
                            if (n > TOPK) { lo = e; step = 0u; } else { hi = e; nhi = n; if (step) step <<= 1; }
                        }
                    }
                    int need = 0;
                    if (!exact) {
                        tau = lo << 23; unsigned width = 1u << 23;
#pragma unroll 1
                        for (int bit = 22; bit >= 20; --bit) { const unsigned cand = tau | (1u << bit); int n; DSA_COUNT(cand, n)
                            if (n == TOPK) { exact = true; tau = cand; break; }
                            if (n > TOPK) tau = cand; else nhi = n;
                            width >>= 1; }
                    }
                    if (!exact) {
                        int nin; DSA_COUNT(tau, nin)
                        const int nc = nin - nhi, needc = TOPK - nhi;
                        if (nc <= 128) {
                            LAS unsigned* lst = (LAS unsigned*)(c.lds + DSA_LIST_OFF) + w * 128; int base = 0;
#define DSA_COMPACT(j0, j1) _Pragma("unroll") for (int j = j0; j < j1; ++j) { const bool inb = (kk[j] - tau) < (1u << 20); const u64 be = __ballot(inb); \
                                if (be != 0ull) { if (inb) lst[base + __popcll(be & ((1ull << lane) - 1ull))] = kk[j]; base += __popcll(be); } }
                            DSA_BUCKETS(DSA_COMPACT)
                            const unsigned c0 = lane < nc ? lst[lane] : 0u, c1 = lane + 64 < nc ? lst[lane + 64] : 0u;
#pragma unroll 1
                            for (int bit = 19; bit >= 0; --bit) { const unsigned cand = tau | (1u << bit);
                                const int n = __popcll(__ballot(c0 >= cand)) + __popcll(__ballot(c1 >= cand));
                                if (n >= needc) tau = cand;
                                if (n == needc) { exact = true; break; } }
                            if (!exact) need = needc - (__popcll(__ballot(c0 > tau)) + __popcll(__ballot(c1 > tau)));
                        } else {
#pragma unroll 1
                            for (int bit = 19; bit >= 0; --bit) { const unsigned cand = tau | (1u << bit); int n; DSA_COUNT(cand, n)
                                if (n >= TOPK) tau = cand;
                                if (n == TOPK) { exact = true; break; } }
                            if (!exact) { int n; DSA_COUNT(tau + 1u, n) need = TOPK - n; }
                        }
                    }
                    int run = 0; unsigned mlo = 0u, mhi = 0u; u64 mine1 = 0ull; const unsigned tsel = exact ? tau : tau + 1u;
#define DSA_SEL(j0, j1) _Pragma("unroll") for (int j = j0; j < j1; ++j) { u64 bs = __ballot(kk[j] >= tsel); \
                        if (!exact) { const u64 be = __ballot(kk[j] == tau); \
                            if (be != 0ull) { const int take = need - run; if (take > 0) { const bool eq = kk[j] == tau; const int rank = __popcll(be & ((1ull << lane) - 1ull)); bs |= __ballot(eq && rank < take); } run += __popcll(be); } } \
                        if (j < 64) { WLANE64(mlo, mhi, bs, j); } else mine1 = bs; }
                    DSA_BUCKETS(DSA_SEL)
                    const u64 mine0 = ((u64)mhi << 32) | mlo;
                    MW[(8 * sb + w) * 65 + lane] = lane < nw ? mine0 : 0ull;
                    if (lane == 0) MW[(8 * sb + w) * 65 + 64] = nw > 64 ? mine1 : 0ull;
                }
                __syncthreads();
            }
        }
        for (int ra_ = 0; ra_ < REP_ATT; ++ra_) {
        bf16x8 qf[8];
        {   LAS bf16* QL = (LAS bf16*)c.lds + w * (32 * 136); const bf16* WUKB = (const bf16*)(pt_get(c, 26) + WS_FCUM + 1536 * 1024);
            bf16x8 qd[4];
#pragma unroll
            for (int s = 0; s < 4; ++s) qd[s] = *(const bf16x8*)(U + (size_t)(t0 + r32) * NU + C_DQ + 64 * w + 16 * s + 8 * hi);
#pragma unroll
            for (int rb = 0; rb < 4; ++rb) {
                f32x16 a_;
#pragma unroll
                for (int r = 0; r < 16; ++r) a_[r] = 0.f;
#pragma unroll
                for (int s = 0; s < 4; ++s) a_ = MFMA32(*(const bf16x8*)(WUKB + (size_t)(w * 128 + 32 * rb + r32) * 64 + 16 * s + 8 * hi), qd[s], a_);
#pragma unroll
                for (int i4 = 0; i4 < 4; ++i4) *(LAS u32x2v*)(QL + r32 * 136 + 32 * rb + 8 * i4 + 4 * hi) = (u32x2v){cvtpk(a_[4 * i4], a_[4 * i4 + 1]), cvtpk(a_[4 * i4 + 2], a_[4 * i4 + 3])};
            }
#pragma unroll
            for (int s = 0; s < 8; ++s) qf[s] = *(const LAS bf16x8*)(QL + r32 * 136 + 16 * s + 8 * hi);
            if (r32 >= nq) {
#pragma unroll
                for (int s = 0; s < 8; ++s) qf[s] = (bf16x8){0, 0, 0, 0, 0, 0, 0, 0}; }
        }
        __syncthreads();
        f32x16 o[4];
#pragma unroll
        for (int db = 0; db < 4; ++db)
#pragma unroll
            for (int r = 0; r < 16; ++r) o[db][r] = 0.f;
        float m = -1e4f, l = 0.f;
        const bf16* Cb = CN + (size_t)(b * L) * 128;
        u32x4v kr0, kr1, vr0, vr1;
        {   const bf16* kp = Cb + (size_t)(tid >> 3) * 128 + 16 * (tid & 7); kr0 = *(const u32x4v*)kp; kr1 = *(const u32x4v*)(kp + 8);
            const bf16* vp = Cb + (size_t)lane * 128 + 16 * w; vr0 = *(const u32x4v*)vp; vr1 = *(const u32x4v*)(vp + 8); }
#define DSA_STAGE(buf) do { LAS bf16* ks_ = KS + (buf) * DSA_BUF_ELEMS; LAS bf16* vt_ = VT + (buf) * DSA_BUF_ELEMS; \
            LAS bf16* kd = ks_ + (tid >> 3) * DSA_KSTR + 16 * (tid & 7); *(LAS u32x4v*)kd = kr0; *(LAS u32x4v*)(kd + 8) = kr1; \
            const unsigned vv[8] = {vr0.x, vr0.y, vr0.z, vr0.w, vr1.x, vr1.y, vr1.z, vr1.w}; \
            _Pragma("unroll") for (int e = 0; e < 16; ++e) vt_[(16 * w + e) * AT_VSTR + lane] = (bf16)(vv[e >> 1] >> (16 * (e & 1))); } while (0)
#define DSA_FETCH(ti) do { const bf16* kp = Cb + (size_t)(64 * (ti) + (tid >> 3)) * 128 + 16 * (tid & 7); kr0 = *(const u32x4v*)kp; kr1 = *(const u32x4v*)(kp + 8); \
            const bf16* vp = Cb + (size_t)(64 * (ti) + lane) * 128 + 16 * w; vr0 = *(const u32x4v*)vp; vr1 = *(const u32x4v*)(vp + 8); } while (0)
        DSA_STAGE(0);
        if (nw > 1) DSA_FETCH(1);
        __syncthreads();
        for (int i = 0; i < nw; ++i) {
            const int cur = i & 1;
            if (i + 1 < nw) { DSA_STAGE(cur ^ 1); if (i + 2 < nw) DSA_FETCH(i + 2); }
            const LAS bf16* ksc = KS + cur * DSA_BUF_ELEMS; const LAS bf16* vtc = VT + cur * DSA_BUF_ELEMS;
            const u64 m64 = MW[r32 * 65 + i];
            if (__ballot(m64 != 0ull) != 0ull) {
                f32x16 p0, p1;
#pragma unroll
                for (int r = 0; r < 16; ++r) { p0[r] = 0.f; p1[r] = 0.f; }
#pragma unroll
                for (int s = 0; s < 8; ++s) {
                    const bf16x8 a0 = *(const LAS bf16x8*)(ksc + r32 * DSA_KSTR + 16 * s + 8 * hi), a1 = *(const LAS bf16x8*)(ksc + (32 + r32) * DSA_KSTR + 16 * s + 8 * hi);
                    p0 = MFMA32(a0, qf[s], p0); p1 = MFMA32(a1, qf[s], p1);
                }
                const unsigned mlo_s = (unsigned)m64 >> (4 * hi), mhi_s = (unsigned)(m64 >> 32) >> (4 * hi);
                float mx = -1e30f, mx2 = -1e30f;
#pragma unroll
                for (int r = 0; r < 16; ++r) {
                    const int kb0 = (r & 3) + 8 * (r >> 2);
                    const unsigned s0 = (unsigned)__builtin_amdgcn_sbfe((int)mlo_s, kb0, 1), s1 = (unsigned)__builtin_amdgcn_sbfe((int)mhi_s, kb0, 1);
                    p0[r] = __uint_as_float((__float_as_uint(p0[r]) & s0) | (0xf149f2cau & ~s0)); p1[r] = __uint_as_float((__float_as_uint(p1[r]) & s1) | (0xf149f2cau & ~s1));
                    if (r & 1) mx = max3f(mx, p0[r], p1[r]); else mx2 = max3f(mx2, p0[r], p1[r]); }
                mx = max3f(mx, mx2, mx2);
                const float mn = max3f(m, mx, lane_read(mx, lane ^ 32)), alpha = __builtin_amdgcn_exp2f(m - mn); const bool grew = __ballot(mn > m) != 0ull; m = mn;
                float sum = 0.f;
#pragma unroll
                for (int r = 0; r < 16; ++r) { p0[r] = __builtin_amdgcn_exp2f(p0[r] - mn); p1[r] = __builtin_amdgcn_exp2f(p1[r] - mn); sum += p0[r] + p1[r]; }
                l = l * alpha + sum;
                if (grew) {
#pragma unroll
                    for (int db = 0; db < 4; ++db)
#pragma unroll
                        for (int r = 0; r < 16; ++r) o[db][r] *= alpha; }
#pragma unroll
                for (int blk = 0; blk < 2; ++blk)
#pragma unroll
                    for (int s = 0; s < 2; ++s) {
                        const bf16x8 xs = pack8(blk == 0 ? p0 : p1, s);
                        typedef short s16x4v __attribute__((ext_vector_type(4)));
                        const LAS bf16* vp = vtc + r32 * AT_VSTR + 32 * blk + 16 * s + 4 * hi;
#pragma unroll
                        for (int db = 0; db < 4; ++db) {
                            const s16x4v lo = *(const LAS s16x4v*)(vp + 32 * db * AT_VSTR), hh = *(const LAS s16x4v*)(vp + 32 * db * AT_VSTR + 8);
                            const bf16x8 pa = __builtin_shufflevector(lo, hh, 0, 1, 2, 3, 4, 5, 6, 7);
                            o[db] = MFMA32(pa, xs, o[db]);
                        }
                    }
            }
            __syncthreads();
        }
        l += lane_read(l, lane ^ 32);
        {
            const float inv = 1.f / l; f32x16 yd0, yd1; const bf16* WUVT = (const bf16*)(pt_get(c, 26) + WS_FCUM + 1792 * 1024);
#pragma unroll
            for (int r = 0; r < 16; ++r) { yd0[r] = 0.f; yd1[r] = 0.f; }
            typedef short s16x4v __attribute__((ext_vector_type(4)));
#pragma unroll
            for (int db = 0; db < 4; ++db) {
#pragma unroll
                for (int r = 0; r < 16; ++r) o[db][r] *= inv;
#pragma unroll
                for (int t = 0; t < 2; ++t) {
                    const bf16x8 xs = pack8(o[db], t);
                    const bf16* wp = WUVT + (size_t)(w * 64 + r32) * 128 + 32 * db + 16 * t + 4 * hi;
                    const s16x4v l0 = *(const s16x4v*)wp, h0 = *(const s16x4v*)(wp + 8), l1 = *(const s16x4v*)(wp + 32 * 128), h1 = *(const s16x4v*)(wp + 32 * 128 + 8);
                    yd0 = MFMA32(__builtin_shufflevector(l0, h0, 0, 1, 2, 3, 4, 5, 6, 7), xs, yd0); yd1 = MFMA32(__builtin_shufflevector(l1, h1, 0, 1, 2, 3, 4, 5, 6, 7), xs, yd1);
                }
            }
            if (r32 < nq) { bf16* yr = (bf16*)(pt_get(c, 26) + WS_Y) + (size_t)(t0 + r32) * KOUT + 1536 + 64 * w;
#pragma unroll
                for (int i4 = 0; i4 < 4; ++i4) {
                    *(u32x2v*)(yr + 8 * i4 + 4 * hi) = (u32x2v){cvtpk(yd0[4 * i4], yd0[4 * i4 + 1]), cvtpk(yd0[4 * i4 + 2], yd0[4 * i4 + 3])};
                    *(u32x2v*)(yr + 32 + 8 * i4 + 4 * hi) = (u32x2v){cvtpk(yd1[4 * i4], yd1[4 * i4 + 1]), cvtpk(yd1[4 * i4 + 2], yd1[4 * i4 + 3])}; }
            }
        }
        }
    }
}

__device__ __forceinline__ float wave_scan_incl(float v, int lane) {
#pragma unroll
    for (int o = 1; o < 64; o <<= 1) { const float n = lane_read(v, (lane - o) & 63); if (lane >= o) v += n; }
    return v;
}
__device__ __forceinline__ void ph_ssd_states(const Ctx& c0, const bf16* XC, const float* DT, const float* a_log, bf16* ST, float* CD) {
    const Ctx c = refresh(c0);
    const int lane = c.lane, w = c.wave, r32 = lane & 31, hi = lane >> 5, g = w >> 2;
    LAS bf16* XT = (LAS bf16*)c.lds + w * (64 * 72);
    LAS bf16* BT = (LAS bf16*)(c.lds + 73728);
    const float a_neg = -__expf(a_log[w]);
    for (int it = c.bid; it < NB * 65; it += c.nb) {
        const int b = it < 512 ? it >> 6 : it - 512, ch = it < 512 ? 1 + (it & 63) : 0, pseq = 64 * ch - 48 + lane;
        const bool valid = pseq >= 0; const size_t t = (size_t)(b * L + (valid ? pseq : 0));
        const float dtv = valid ? DT[t * 8 + w] : 0.f, acs = wave_scan_incl(dtv * a_neg, lane), tot = lane_read(acs, 63), scale = dtv * __expf(tot - acs);
        if (lane == 0) CD[(b * 65 + ch) * 8 + w] = __expf(tot);
        const bf16* xrow = XC + t * 1024 + 64 * w;
#pragma unroll
        for (int q = 0; q < 8; ++q) { u32x4v v = (u32x4v){0u, 0u, 0u, 0u}; if (valid) v = *(const u32x4v*)(xrow + 8 * q); const unsigned vv[4] = {v.x, v.y, v.z, v.w};
#pragma unroll
            for (int e = 0; e < 8; ++e) XT[(8 * q + e) * 72 + lane] = f2bf(bf2f((bf16)(vv[e >> 1] >> (16 * (e & 1)))) * scale); }
        const bf16* brow = XC + t * 1024 + 512 + 32 * w;
#pragma unroll
        for (int q = 0; q < 4; ++q) { u32x4v v = (u32x4v){0u, 0u, 0u, 0u}; if (valid) v = *(const u32x4v*)(brow + 8 * q); const unsigned vv[4] = {v.x, v.y, v.z, v.w};
#pragma unroll
            for (int e = 0; e < 8; ++e) BT[(32 * w + 8 * q + e) * 72 + lane] = (bf16)(vv[e >> 1] >> (16 * (e & 1))); }
        __syncthreads();
        bf16* st = ST + ((size_t)(b * 65 + ch) * 8 + w) * 8192;
#pragma unroll 1
        for (int pb = 0; pb < 2; ++pb)
#pragma unroll 1
            for (int nb = 0; nb < 4; ++nb) {
                f32x16 acc;
#pragma unroll
                for (int r = 0; r < 16; ++r) acc[r] = 0.f;
#pragma unroll
                for (int s = 0; s < 4; ++s) { const bf16x8 a = *(const LAS bf16x8*)(XT + (32 * pb + r32) * 72 + 16 * s + 8 * hi), bb = *(const LAS bf16x8*)(BT + (128 * g + 32 * nb + r32) * 72 + 16 * s + 8 * hi);
                    acc = MFMA32(a, bb, acc); }
#pragma unroll
                for (int r = 0; r < 16; ++r) st[(32 * pb + crow(r, hi)) * 128 + 32 * nb + r32] = f2bf(acc[r]);
            }
        __syncthreads();
    }
}
__device__ __forceinline__ void ph_ssd_scan(const Ctx& c0, bf16* ST, const float* CD) {
    const Ctx c = refresh(c0);
    for (int idx = c.bid * NTHR + c.tid; idx < NB * 8 * 64 * 32; idx += c.nb * NTHR) {
        const int n4 = idx & 31, p = (idx >> 5) & 63, h = (idx >> 11) & 7, b = idx >> 14;
        float h0 = 0.f, h1 = 0.f, h2 = 0.f, h3 = 0.f;
        bf16* base = ST + ((size_t)(b * 65) * 8 + h) * 8192 + p * 128 + 4 * n4; const float* cd = CD + (size_t)(b * 65) * 8 + h;
#pragma unroll 1
        for (int c5 = 0; c5 < 65; c5 += 5) {
            u32x2v v[5]; float d[5];
#pragma unroll
            for (int q = 0; q < 5; ++q) { v[q] = *(const u32x2v*)(base + (size_t)(c5 + q) * 8 * 8192); d[q] = cd[(c5 + q) * 8]; }
#pragma unroll
            for (int q = 0; q < 5; ++q) {
                *(u32x2v*)(base + (size_t)(c5 + q) * 8 * 8192) = (u32x2v){pk2(h0, h1), pk2(h2, h3)};
                h0 = d[q] * h0 + bf2f((bf16)(v[q].x & 0xffff)); h1 = d[q] * h1 + bf2f((bf16)(v[q].x >> 16)); h2 = d[q] * h2 + bf2f((bf16)(v[q].y & 0xffff)); h3 = d[q] * h3 + bf2f((bf16)(v[q].y >> 16)); }
        }
    }
}
__device__ __forceinline__ void ph_ssd_out(const Ctx& c0, const bf16* XC, const bf16* U, const float* DT, const float* a_log, const float* dsk, const bf16* ST, bf16* Y) {
    const Ctx c = refresh(c0);
    const int lane = c.lane, w = c.wave, r32 = lane & 31, hi = lane >> 5, g = w >> 2;
    LAS bf16* XT = (LAS bf16*)c.lds + w * (64 * 72);
    LAS float* ACS = (LAS float*)(c.lds + 73728) + w * 64;
    LAS float* SS = (LAS float*)(c.lds + 73728 + 2048);
    const float a_neg = -__expf(a_log[w]), Dk = dsk[w];
    typedef short s16x4v __attribute__((ext_vector_type(4)));
    for (int it = c.bid; it < NB * 65; it += c.nb) {
        const int b = it < 512 ? it >> 6 : it - 512, ch = it < 512 ? 1 + (it & 63) : 0, p0 = 64 * ch - 48, pseq = p0 + lane; const bool valid = pseq >= 0; const size_t t = (size_t)(b * L + (valid ? pseq : 0));
        const float dtv = valid ? DT[t * 8 + w] : 0.f, acs = wave_scan_incl(dtv * a_neg, lane);
        ACS[lane] = acs;
        {   const bf16* xrow = XC + t * 1024 + 64 * w;
#pragma unroll
            for (int q = 0; q < 8; ++q) { u32x4v v = (u32x4v){0u, 0u, 0u, 0u}; if (valid) v = *(const u32x4v*)(xrow + 8 * q); const unsigned vv[4] = {v.x, v.y, v.z, v.w};
#pragma unroll
                for (int e = 0; e < 8; ++e) XT[(8 * q + e) * 72 + lane] = f2bf(bf2f((bf16)(vv[e >> 1] >> (16 * (e & 1)))) * dtv); } }
        const bool vl0 = p0 + r32 >= 0, vl1 = p0 + 32 + r32 >= 0;
        const size_t tl0 = (size_t)(b * L + (vl0 ? p0 + r32 : 0)), tl1 = (size_t)(b * L + (vl1 ? p0 + 32 + r32 : 0));
        f32x16 acc[2][2];
#pragma unroll
        for (int pb = 0; pb < 2; ++pb)
#pragma unroll
            for (int lb = 0; lb < 2; ++lb)
#pragma unroll
                for (int r = 0; r < 16; ++r) acc[pb][lb][r] = 0.f;
        const bf16* hin = ST + ((size_t)(b * 65 + ch) * 8 + w) * 8192;
        if (ch != 0) {
#pragma unroll
        for (int k = 0; k < 8; ++k) {
            bf16x8 c0f = (bf16x8){0, 0, 0, 0, 0, 0, 0, 0}, c1f = c0f;
            if (vl0) c0f = *(const bf16x8*)(XC + tl0 * 1024 + 768 + 128 * g + 16 * k + 8 * hi);
            if (vl1) c1f = *(const bf16x8*)(XC + tl1 * 1024 + 768 + 128 * g + 16 * k + 8 * hi);
            const bf16x8 h0f = *(const bf16x8*)(hin + (size_t)r32 * 128 + 16 * k + 8 * hi), h1f = *(const bf16x8*)(hin + (size_t)(32 + r32) * 128 + 16 * k + 8 * hi);
            acc[0][0] = MFMA32(h0f, c0f, acc[0][0]); acc[0][1] = MFMA32(h0f, c1f, acc[0][1]); acc[1][0] = MFMA32(h1f, c0f, acc[1][0]); acc[1][1] = MFMA32(h1f, c1f, acc[1][1]);
        }
        }
        const float acl0 = ACS[r32], acl1 = ACS[32 + r32], e0 = __expf(acl0), e1 = __expf(acl1);
#pragma unroll
        for (int pb = 0; pb < 2; ++pb)
#pragma unroll
            for (int r = 0; r < 16; ++r) { acc[pb][0][r] *= e0; acc[pb][1][r] *= e1; }
#pragma unroll
        for (int sb = 0; sb < 2; ++sb)
#pragma unroll
            for (int lb = sb; lb < 2; ++lb) if (!(ch == 0 && sb == 0)) {
                f32x16 x;
#pragma unroll
                for (int r = 0; r < 16; ++r) x[r] = 0.f;
                const bool vs = p0 + 32 * sb + r32 >= 0; const size_t ts = (size_t)(b * L + (vs ? p0 + 32 * sb + r32 : 0));
                const bool vl = lb == 0 ? vl0 : vl1; const size_t tl = lb == 0 ? tl0 : tl1;
#pragma unroll
                for (int k = 0; k < 8; ++k) {
                    bf16x8 bf_ = (bf16x8){0, 0, 0, 0, 0, 0, 0, 0}, cf_ = bf_;
                    if (vs) bf_ = *(const bf16x8*)(XC + ts * 1024 + 512 + 128 * g + 16 * k + 8 * hi);
                    if (vl) cf_ = *(const bf16x8*)(XC + tl * 1024 + 768 + 128 * g + 16 * k + 8 * hi);
                    x = MFMA32(bf_, cf_, x);
                }
                const float acl = lb == 0 ? acl0 : acl1; const int lrow = 32 * lb + r32;
#pragma unroll
                for (int i4 = 0; i4 < 4; ++i4) { const f32x4v as = *(const LAS f32x4v*)(ACS + 32 * sb + 8 * i4 + 4 * hi);
#pragma unroll
                    for (int e = 0; e < 4; ++e) { const int srow = 32 * sb + 8 * i4 + 4 * hi + e; x[4 * i4 + e] = srow <= lrow ? x[4 * i4 + e] * __expf(fminf(acl - as[e], 0.f)) : 0.f; } }
#pragma unroll
                for (int ks = 0; ks < 2; ++ks) {
                    const bf16x8 xs = pack8(x, ks);
#pragma unroll
                    for (int pb = 0; pb < 2; ++pb) {
                        const LAS bf16* vp = XT + (32 * pb + r32) * 72 + 32 * sb + 16 * ks + 4 * hi;
                        const s16x4v lo = *(const LAS s16x4v*)vp, hh = *(const LAS s16x4v*)(vp + 8);
                        const bf16x8 pa = __builtin_shufflevector(lo, hh, 0, 1, 2, 3, 4, 5, 6, 7);
                        if (lb == 0) acc[pb][0] = MFMA32(pa, xs, acc[pb][0]); else acc[pb][1] = MFMA32(pa, xs, acc[pb][1]);
                    }
                }
            }
        float ssq0 = 0.f, ssq1 = 0.f;
#pragma unroll
        for (int lb = 0; lb < 2; ++lb) { const bool vl = lb == 0 ? vl0 : vl1; const size_t tl = lb == 0 ? tl0 : tl1;
#pragma unroll
            for (int pb = 0; pb < 2; ++pb)
#pragma unroll
                for (int i4 = 0; i4 < 4; ++i4) { const int pc = 64 * w + 32 * pb + 8 * i4 + 4 * hi;
                    u32x2v xv = (u32x2v){0u, 0u}, zv = xv;
                    if (vl) { xv = *(const u32x2v*)(XC + tl * 1024 + pc); zv = *(const u32x2v*)(U + tl * NU + C_Z + pc); }
                    const float xe[4] = {bf2f((bf16)(xv.x & 0xffff)), bf2f((bf16)(xv.x >> 16)), bf2f((bf16)(xv.y & 0xffff)), bf2f((bf16)(xv.y >> 16))};
                    const float ze[4] = {bf2f((bf16)(zv.x & 0xffff)), bf2f((bf16)(zv.x >> 16)), bf2f((bf16)(zv.y & 0xffff)), bf2f((bf16)(zv.y >> 16))};
#pragma unroll
                    for (int e = 0; e < 4; ++e) { const float y = acc[pb][lb][4 * i4 + e] + Dk * xe[e], gz = y * siluf(ze[e]); acc[pb][lb][4 * i4 + e] = gz; if (lb == 0) ssq0 += gz * gz; else ssq1 += gz * gz; } } }
        ssq0 += lane_read(ssq0, lane ^ 32); ssq1 += lane_read(ssq1, lane ^ 32);
        if (hi == 0) { SS[w * 64 + r32] = ssq0; SS[w * 64 + 32 + r32] = ssq1; }
        __syncthreads();
        const float tot0 = SS[(4 * g) * 64 + r32] + SS[(4 * g + 1) * 64 + r32] + SS[(4 * g + 2) * 64 + r32] + SS[(4 * g + 3) * 64 + r32];
        const float tot1 = SS[(4 * g) * 64 + 32 + r32] + SS[(4 * g + 1) * 64 + 32 + r32] + SS[(4 * g + 2) * 64 + 32 + r32] + SS[(4 * g + 3) * 64 + 32 + r32];
        const float rs0 = rsqrtf(tot0 * (1.f / 256.f) + EPSF), rs1 = rsqrtf(tot1 * (1.f / 256.f) + EPSF);
#pragma unroll
        for (int lb = 0; lb < 2; ++lb) { const bool vl = lb == 0 ? vl0 : vl1; const size_t tl = lb == 0 ? tl0 : tl1; const float rs = lb == 0 ? rs0 : rs1;
            if (vl) {
#pragma unroll
                for (int pb = 0; pb < 2; ++pb)
#pragma unroll
                    for (int i4 = 0; i4 < 4; ++i4)
                        *(u32x2v*)(Y + tl * KOUT + 64 * w + 32 * pb + 8 * i4 + 4 * hi) = (u32x2v){cvtpk(acc[pb][lb][4 * i4] * rs, acc[pb][lb][4 * i4 + 1] * rs), cvtpk(acc[pb][lb][4 * i4 + 2] * rs, acc[pb][lb][4 * i4 + 3] * rs)};
            } }
        __syncthreads();
    }
}

__device__ __forceinline__ void ph_resid(const Ctx& c0, const bf16* MIX, const float* g, bf16* XB, float* RSTD, float* dout) { const Ctx c = refresh(c0);
    const int lane = c.lane;
    for (int t = c.gw; t < T; t += c.ngw) {
        float mv[32], xv[32]; float ss = 0.f;
#pragma unroll
        for (int j = 0; j < 4; ++j) { const u32x4v v = *(const u32x4v*)(MIX + (size_t)t * DM + 8 * lane + 512 * j), xx = *(const u32x4v*)(XB + (size_t)t * DM + 8 * lane + 512 * j);
            const unsigned w[4] = {v.x, v.y, v.z, v.w}, xw[4] = {xx.x, xx.y, xx.z, xx.w};
#pragma unroll
            for (int i = 0; i < 8; ++i) { const float f = bf2f((bf16)(w[i >> 1] >> (16 * (i & 1)))); mv[8 * j + i] = f; ss += f * f; xv[8 * j + i] = bf2f((bf16)(xw[i >> 1] >> (16 * (i & 1)))); } }
        const float rs = rsqrtf(wave_sum(ss, lane) * (1.f / DM) + EPSF);
        float s2 = 0.f;
        const int b = t / L, p = t - b * L; float* orow = (dout != nullptr && p >= NMETA) ? dout + ((size_t)b * SEQ + (p - NMETA)) * DM : nullptr;
#pragma unroll
        for (int j = 0; j < 4; ++j) { const int cc = 8 * lane + 512 * j;
            const f32x4v ga = *(const f32x4v*)(g + cc), gb = *(const f32x4v*)(g + cc + 4); float a[8];
#pragma unroll
            for (int i = 0; i < 4; ++i) { a[i] = xv[8 * j + i] + mv[8 * j + i] * rs * ga[i]; a[4 + i] = xv[8 * j + 4 + i] + mv[8 * j + 4 + i] * rs * gb[i]; }
#pragma unroll
            for (int i = 0; i < 8; ++i) s2 += a[i] * a[i];
            if (orow) { *(f32x4v*)(orow + cc) = (f32x4v){a[0], a[1], a[2], a[3]}; *(f32x4v*)(orow + cc + 4) = (f32x4v){a[4], a[5], a[6], a[7]}; }
            *(u32x4v*)(XB + (size_t)t * DM + cc) = (u32x4v){pk2(a[0], a[1]), pk2(a[2], a[3]), pk2(a[4], a[5]), pk2(a[6], a[7])}; }
        s2 = wave_sum(s2, lane);
        if (lane == 0) RSTD[t] = rsqrtf(s2 * (1.f / DM) + EPSF);
    }
}

__device__ __forceinline__ void gemm_meta_rows(const Ctx& c, const bf16* A, const bf16* Bt, bf16* O, int N, int K, int ldc, const float* rs, float* UF) {
    const int lane = c.lane, r32 = lane & 31, hi = lane >> 5, w = c.wave;
    LAS float* red = (LAS float*)c.lds;
    for (int strip = c.bid; strip < N / 32; strip += c.nb) {
        const bf16* ap = A + (size_t)(r32 & 15) * K + 8 * hi; const bf16* bp = Bt + (size_t)(32 * strip + r32) * K + 8 * hi;
        f32x16 acc;
#pragma unroll
        for (int r = 0; r < 16; ++r) acc[r] = 0.f;
#pragma unroll 4
        for (int s = w; s < K / 16; s += NWAVE) acc = MFMA32(*(const bf16x8*)(ap + 16 * s), *(const bf16x8*)(bp + 16 * s), acc);
#pragma unroll
        for (int r = 0; r < 8; ++r) red[(w * 8 + r) * 64 + lane] = acc[r];
        __syncthreads();
        if (w == 0) {
            float v8[8];
#pragma unroll
            for (int r = 0; r < 8; ++r) { float t = 0.f;
#pragma unroll
                for (int ww = 0; ww < NWAVE; ++ww) t += red[(ww * 8 + r) * 64 + lane];
                v8[r] = t * (rs ? rs[crow(r, hi)] : 1.f); }
            const int n = 32 * strip + r32; const bool sm = UF != nullptr && n >= C_SM && n < C_SM + 32;
#pragma unroll 1
            for (int b = 0; b < NB; ++b) {
                bf16* ob = O + (size_t)(b * L) * ldc + n; float* ub = UF + (size_t)(b * L) * 32 + (n - C_SM);
#pragma unroll
                for (int r = 0; r < 8; ++r) { const int p = crow(r, hi); ob[(size_t)p * ldc] = f2bf(v8[r]); if (sm) ub[(size_t)p * 32] = v8[r]; }
            }
        }
        __syncthreads();
    }
}
__device__ __forceinline__ void ph_gemm_plain(const Ctx& c0, const bf16* A, const bf16* Bt, bf16* O, int N, int K, int ldc, const float* rs, float* UF) { const Ctx c = refresh(c0);
    gemm_meta_rows(c, A, Bt, O, N, K, ldc, rs, UF);
    pg8::StaticOrder S; S.init(128 * 256, N, c.nb, c.bid);
    pg8::Gemm g{A, Bt, 128 * 256, N, K, (size_t)256 * K * 2, 1};
    pg8::EpiBf16Plain E{O, ldc, rs, UF, C_SM, 1};
    pg8::gemm_phase<pg8::EpiBf16Plain, pg8::StaticOrder, true, true>(c.lds, g, S, E, c.tid);
}
__device__ __forceinline__ void ph_gemm_gateup(const Ctx& c0, const bf16* XB, const bf16* Bt, bf16* H, const float* rs, const float* cw, const float* cb) { const Ctx c = refresh(c0);
    pg8::StaticOrder S; S.init(130 * 256, NGU, c.nb, c.bid);
    pg8::Gemm g{XB - (size_t)2 * DM, Bt, 130 * 256, NGU, DM, (size_t)254 * DM * 2, 0};
    pg8::EpiGateUp E{H, rs, cw, cb, (LAS float*)(c.lds + HALO_OFF)};
    pg8::gemm_phase<pg8::EpiGateUp, pg8::StaticOrder, true, true>(c.lds, g, S, E, c.tid);
}

constexpr int REP_PREPW = 1, REP_G1 = 1, REP_G2 = 1, REP_G3 = 1, REP_G4 = 1, REP_M1 = 1, REP_SSD = 1, REP_FOX = 1, REP_DSA = 1;
__global__ void __launch_bounds__(NTHR, 2) fwd_mega(Args A) {
    extern __shared__ __attribute__((aligned(16))) unsigned char lds_raw[];
    cg::grid_group grid = cg::this_grid();
    Ctx c; c.tid = threadIdx.x; c.lane = c.tid & 63; c.wave = __builtin_amdgcn_readfirstlane(c.tid >> 6); c.bid = blockIdx.x; c.nb = gridDim.x;
    c.gw = c.bid * NWAVE + c.wave; c.ngw = c.nb * NWAVE; c.lds = (LAS unsigned char*)lds_raw;
    if (c.tid == 0) { LAS unsigned long long* PT = (LAS unsigned long long*)(c.lds + PT_OFF);
#pragma unroll
        for (int i = 0; i < 25; ++i) PT[i] = (unsigned long long)A.in[i];
        PT[25] = (unsigned long long)A.out; PT[26] = (unsigned long long)A.ws; }
    if (c.tid < 2) ((LAS unsigned*)(c.lds + MISC_OFF))[c.tid] = 0u;
    __syncthreads();
    (void)xcd_barrier_post((unsigned*)(A.ws + WS_CTL) + CW_BAR, (volatile LAS unsigned*)(c.lds + MISC_OFF), c.tid);
#define WSP(off) (pt_get(c, 26) + (off))
#define DOUT ((float*)pt_get(c, 25))
#define P_WIN ((bf16*)WSP(WS_WIN))
#define P_WOUT ((bf16*)WSP(WS_WOUT))
#define P_WGU ((bf16*)WSP(WS_WGU))
#define P_WDN ((bf16*)WSP(WS_WDN))
#define P_METAX ((float*)WSP(WS_METAX))
#define P_RSTD ((float*)WSP(WS_RSTD))
#define P_UF ((float*)WSP(WS_UF))
#define P_DT ((float*)WSP(WS_DT))
#define P_FCUM ((float*)WSP(WS_FCUM))
#define P_CN ((bf16*)WSP(WS_CN))
#define P_MASK ((u64*)WSP(WS_MASK))
#define P_KI ((bf16*)WSP(WS_MASK))
#define P_XB ((bf16*)WSP(WS_XB) + (size_t)8 * DM)
#define P_Y ((bf16*)WSP(WS_Y))
#define P_U ((bf16*)WSP(WS_R1))
#define P_XC ((bf16*)WSP(WS_XC))
#define P_H ((bf16*)WSP(WS_R1))
#define P_MIX ((bf16*)WSP(WS_R1))
#define P_MIX2 ((bf16*)WSP(WS_Y))
#define P_ST ((bf16*)WSP(WS_YA))
#define P_CD ((float*)WSP(WS_DT + 1536 * 1024))
#define P_WUV ((bf16*)WSP(WS_FCUM + 1792 * 1024))
#define P_WUK ((bf16*)WSP(WS_FCUM + 1536 * 1024))
    ph_prep_x(c, INP(0), INP(1), P_XB, P_RSTD);
    grid.sync();
#define LAYER_BODY(ly) do { \
        for (int rep = 0; rep < REP_PREPW; ++rep) ph_prep_w(c, ly, P_WIN, P_WOUT, P_WGU, P_WDN, P_WUK, P_WUV); \
        grid_barrier(c); \
        for (int rep = 0; rep < REP_G1; ++rep) ph_gemm_plain(c, P_XB, P_WIN, P_U, NU, DM, NU, P_RSTD, P_UF); \
        grid_barrier(c); \
        for (int rep = 0; rep < REP_M1; ++rep) { \
        ph_mixprep(c, P_U, P_UF, INP(7) + (size_t)ly * 4 * 1024, INP(8) + (size_t)ly * 1024, INP(16) + (size_t)ly * 128, INP(9) + (size_t)ly * 8, P_XC, P_Y, P_CN, P_DT, P_KI); \
        ph_fcum(c, P_UF, INP(15) + (size_t)ly * 8, P_FCUM); } \
        grid_barrier(c); \
        for (int rep = 0; rep < REP_SSD; ++rep) ph_ssd_states(c, P_XC, P_DT, INP(10) + (size_t)ly * 8, P_ST, P_CD); \
        for (int rep = 0; rep < REP_FOX; ++rep) ph_fox(c, P_U, P_FCUM, P_Y); \
        grid_barrier(c); \
        ph_ssd_scan(c, P_ST, P_CD); \
        for (int rep = 0; rep < REP_DSA; ++rep) ph_dsa(c, P_U, P_UF, P_CN, P_KI); \
        grid_barrier(c); \
        for (int rep = 0; rep < REP_SSD; ++rep) ph_ssd_out(c, P_XC, P_U, P_DT, INP(10) + (size_t)ly * 8, INP(11) + (size_t)ly * 8, P_ST, P_Y); \
        grid_barrier(c); \
        for (int rep = 0; rep < REP_G2; ++rep) ph_gemm_plain(c, P_Y, P_WOUT, P_MIX, DM, KOUT, DM, nullptr, nullptr); \
        grid_barrier(c); \
        ph_resid(c, P_MIX, INP(3) + (size_t)ly * DM, P_XB, P_RSTD, nullptr); \
        grid_barrier(c); \
        for (int rep = 0; rep < REP_G3; ++rep) ph_gemm_gateup(c, P_XB, P_WGU, P_H, P_RSTD, INP(22) + (size_t)ly * 3 * FF, INP(23) + (size_t)ly * FF); \
        grid_barrier(c); \
        for (int rep = 0; rep < REP_G4; ++rep) ph_gemm_plain(c, P_H, P_WDN, P_MIX2, DM, FF, DM, nullptr, nullptr); \
        grid_barrier(c); \
        ph_resid(c, P_MIX2, INP(5) + (size_t)ly * DM, P_XB, P_RSTD, (ly) == DEPTH - 1 ? DOUT : nullptr); \
        grid_barrier(c); \
    } while (0)
    LAYER_BODY(0); LAYER_BODY(1); LAYER_BODY(2); LAYER_BODY(3);
}

extern "C" void kernel_launch(void* const* d_in, const int* in_sizes, int n_in, void* d_out, int out_size, void* d_ws, size_t ws_size, hipStream_t stream) {
    static int grid_blocks = 0;
    if (grid_blocks == 0) {
        if (n_in != 25 || in_sizes[0] != NB * SEQ * DM || out_size != NB * SEQ * DM || ws_size < WS_END) { fprintf(stderr, "kernel_launch: unexpected shapes (n_in %d in0 %d out %d ws %zu)\n", n_in, n_in > 0 ? in_sizes[0] : -1, out_size, ws_size); grid_blocks = -1; return; }
        int dev = 0, cus = 0, per_cu = 0;
        (void)hipGetDevice(&dev); (void)hipDeviceGetAttribute(&cus, hipDeviceAttributeMultiprocessorCount, dev);
        if (hipFuncSetAttribute((const void*)fwd_mega, hipFuncAttributeMaxDynamicSharedMemorySize, LDS_BYTES) != hipSuccess) { fprintf(stderr, "kernel_launch: hipFuncSetAttribute failed\n"); grid_blocks = -1; return; }
        if (hipOccupancyMaxActiveBlocksPerMultiprocessor(&per_cu, (const void*)fwd_mega, NTHR, LDS_BYTES) != hipSuccess || per_cu < 1) { fprintf(stderr, "kernel_launch: occupancy query says %d blocks/CU\n", per_cu); grid_blocks = -1; return; }
        grid_blocks = cus;
        fprintf(stderr, "kernel_launch: %d CUs, %d blocks/CU by the occupancy query, grid %d\n", cus, per_cu, grid_blocks);
    }
    if (grid_blocks < 0) return;
    if (hipMemsetAsync((char*)d_ws + WS_CTL, 0, 65536, stream) != hipSuccess) { fprintf(stderr, "kernel_launch: memset failed\n"); return; }
    Args a{};
    for (int i = 0; i < 25; ++i) a.in[i] = (const float*)d_in[i];
    a.out = (float*)d_out; a.ws = (unsigned char*)d_ws;
    void* args[] = {&a};
    hipError_t e = hipLaunchCooperativeKernel((const void*)fwd_mega, dim3(grid_blocks), dim3(NTHR), args, LDS_BYTES, stream);
    if (e != hipSuccess) fprintf(stderr, "kernel_launch: cooperative launch failed: %s (grid %d)\n", hipGetErrorString(e), grid_blocks);
}
```

```cpp
#include <hip/hip_runtime.h>
#include <cstdio>
#include <cstdint>

constexpr int NB = 8, SEQ = 4096, NMETA = 16, L = SEQ + NMETA  , T = NB * L  , MP = 33024  , DM = 2048;
constexpr int NU = 4608, KOUT = 2048, FF = 5632, NGU = 2 * FF, DIN = 4564;
constexpr int C_Z = 0, C_XBC = 512, C_POOL = 1536, C_FQ = 2048, C_FK = 2560, C_FV = 3072, C_DQ = 3584, C_DC = 4096, C_QI = 4224, C_KI = 4480, C_SM = 4544;
constexpr int LKP = 4224, NMW = 66  , TOPK = 256, DEPTH = 4;
constexpr float EPSF = 1e-6f;
typedef unsigned short bf16;
typedef unsigned long long u64;

__device__ __forceinline__ float bf2f(bf16 v) { return __uint_as_float(((unsigned)v) << 16); }
__device__ __forceinline__ bf16 f2bf(float f) { unsigned u = __float_as_uint(f); return (bf16)((u + 0x7fffu + ((u >> 16) & 1u)) >> 16); }
typedef float f32x2v_ __attribute__((ext_vector_type(2)));
typedef __bf16 bf16x2v_ __attribute__((ext_vector_type(2)));
__device__ __forceinline__ unsigned pk2(float lo, float hi) { f32x2v_ v = {lo, hi}; bf16x2v_ b = __builtin_convertvector(v, bf16x2v_); return __builtin_bit_cast(unsigned, b); }
__device__ __forceinline__ float siluf(float x) { return x * __builtin_amdgcn_rcpf(1.f + __expf(-x)); }
__device__ __forceinline__ float softplusf(float x) { return fmaxf(x, 0.f) + log1pf(__expf(-fabsf(x))); }
__device__ __forceinline__ float logsigmoidf(float x) { return fminf(x, 0.f) - log1pf(__expf(-fabsf(x))); }
__device__ __forceinline__ float lane_read(float v, int src) { return __int_as_float(__builtin_amdgcn_ds_bpermute(src << 2, __float_as_int(v))); }
__device__ __forceinline__ int lane_readi(int v, int src) { return __builtin_amdgcn_ds_bpermute(src << 2, v); }
__device__ __forceinline__ float wave_sum(float v, int lane) {
#pragma unroll
    for (int o = 1; o < 64; o <<= 1) v += lane_read(v, lane ^ o);
    return v;
}
__device__ __forceinline__ float* xf_row(float* dout, float* metax, int t) {
    const int b = t / L, p = t - b * L;
    return p < NMETA ? metax + (size_t)(b * NMETA + p) * DM : dout + ((size_t)b * SEQ + (p - NMETA)) * DM;
}
namespace pg8 {
#define PG8_LAS __attribute__((address_space(3)))
typedef unsigned short bf16_t;
typedef short bf16x8 __attribute__((ext_vector_type(8)));
typedef float f32x4 __attribute__((ext_vector_type(4)));
typedef unsigned u32x4 __attribute__((ext_vector_type(4)));
constexpr int BM = 256, BK = 64, HALF = 128, HTB = HALF * BK * 2  , STAGE_BYTES = 8 * HTB, NXCD = 8, WGM = 4;

__host__ __device__ __forceinline__ int lds_byte(int r, int c) { const int st = (r >> 4) * 2 + (c >> 5), rr = r & 15, cc = c & 31, ob = rr * 64 + cc * 2; return st * 1024 + (ob ^ (((ob >> 9) & 1) << 5)); }
__host__ __device__ __forceinline__ void stage_rc(int b, int& R, int& C) { const int st = b / 1024, sb = b % 1024, swz = sb ^ (((sb >> 9) & 1) << 5); R = (st >> 1) * 16 + swz / 64; C = (st & 1) * 32 + (swz % 64) / 2; }
__host__ __device__ __forceinline__ int perm32(int rho) { const int n = rho >> 4, i = rho & 15; return 8 * (i >> 2) + 4 * n + (i & 3); }

struct Unit { int pm, pn; };
struct Gemm { const bf16_t* A; const bf16_t* Bt; int M, N, K; size_t a_tstep; int rowmap; };
__host__ __device__ __forceinline__ int tile_row0(int rowmap, int pm) { return rowmap ? (pm >> 4) * 4112 + 16 + 256 * (pm & 15) : pm * 256; }

struct StaticOrder {
    int nM, nN, nwg, G, c, wgm;
    __host__ __device__ void init(int M, int N, int G_, int c_, int wgm_ = WGM) { nM = M / BM; nN = N / BM; nwg = nM * nN; G = G_; c = c_; wgm = wgm_; }
    __host__ __device__ bool next(int i, Unit& u) const {
        const long L = (long)i * G + c; if (L >= nwg) return false;
        int wgid = (int)L; { const int q = nwg / NXCD, r = nwg % NXCD, xcd = wgid % NXCD, off = wgid / NXCD; wgid = (xcd < r ? xcd * (q + 1) : r * (q + 1) + (xcd - r) * q) + off; }
        const int nig = wgm * nN, gid = wgid / nig, fm = gid * wgm, gsz = (nM - fm) < wgm ? (nM - fm) : wgm;
        u.pm = fm + ((wgid % nig) % gsz); u.pn = (wgid % nig) / gsz; return true;
    }
    __device__ __forceinline__ void a_ready(const Unit&) const {}
    __device__ __forceinline__ void done(const Unit&) const {}
};


__device__ __forceinline__ unsigned cvt_pk_bf16(float lo, float hi) { unsigned r; asm volatile("v_cvt_pk_bf16_f32 %0, %1, %2" : "=v"(r) : "v"(lo), "v"(hi)); return r; }

struct EpiBf16Plain {
    static constexpr bool PERM = true, AFTER_DRAIN = false;
    bf16_t* O; int ldc; const float* rs; float* UF; int sm_col0; int rowmap;
    __device__ __forceinline__ void operator()(f32x4 (&acc)[2][2][4][2], const Unit& u, int wr, int wc, int fr, int fq) const {
        const int row0 = tile_row0(rowmap, u.pm) + wr * 64 + fr, col0 = u.pn * BM + wc * 32 + 8 * fq;
#pragma unroll
        for (int ai = 0; ai < 2; ++ai)
#pragma unroll
            for (int m = 0; m < 4; ++m) {
                const int row = row0 + ai * HALF + m * 16; const float s = rs ? rs[row] : 1.f; bf16_t* rowp = O + (size_t)row * ldc + col0;
#pragma unroll
                for (int bj = 0; bj < 2; ++bj) { const f32x4 v0 = acc[ai][bj][m][0] * s, v1 = acc[ai][bj][m][1] * s;
                    u32x4 w; w.x = cvt_pk_bf16(v0[0], v0[1]); w.y = cvt_pk_bf16(v0[2], v0[3]); w.z = cvt_pk_bf16(v1[0], v1[1]); w.w = cvt_pk_bf16(v1[2], v1[3]);
                    *(u32x4*)(rowp + bj * HALF) = w;
                    if (UF) { const int c = col0 + bj * HALF - sm_col0; if (c >= 0 && c < 32) { float* p = UF + (size_t)row * 32 + c; *(f32x4*)p = v0; *(f32x4*)(p + 4) = v1; } } }
            }
    }
};

struct EpiGateUp {
    static constexpr bool PERM = true, AFTER_DRAIN = false;
    bf16_t* H; const float* rs; const float* cw; const float* cb; PG8_LAS float* halo;
    float* FXG; float* FXU; float* HB;
    __device__ __forceinline__ void operator()(f32x4 (&acc)[2][2][4][2], const Unit& u, int wr, int wc, int fr, int fq) const {
        const int chl = wc * 32 + 8 * fq, ch0 = u.pn * 128 + chl, rbase = tile_row0(1, u.pm);
#pragma unroll
        for (int ai = 0; ai < 2; ++ai)
#pragma unroll
            for (int m = 0; m < 4; ++m) { const float s = rs[rbase + ai * 128 + wr * 64 + m * 16 + fr];
#pragma unroll
                for (int bj = 0; bj < 2; ++bj)
#pragma unroll
                    for (int n = 0; n < 2; ++n) acc[ai][bj][m][n] = acc[ai][bj][m][n] * s; }
        if (fr >= 14) {
#pragma unroll
            for (int ai = 0; ai < 2; ++ai)
#pragma unroll
                for (int n = 0; n < 2; ++n) *(PG8_LAS f32x4*)(halo + ((2 * ai + wr) * 2 + (fr - 14)) * 128 + chl + 4 * n) = acc[ai][0][3][n];
            if (wr == 1) {
#pragma unroll
                for (int n = 0; n < 2; ++n) *(f32x4*)(HB + ((size_t)u.pm * 2 + (fr - 14)) * FF + ch0 + 4 * n) = acc[1][0][3][n]; }
        }
        if (fr < 2 && wr == 0) {
#pragma unroll
            for (int n = 0; n < 2; ++n) { *(f32x4*)(FXG + ((size_t)u.pm * 2 + fr) * FF + ch0 + 4 * n) = acc[0][0][0][n]; *(f32x4*)(FXU + ((size_t)u.pm * 2 + fr) * FF + ch0 + 4 * n) = acc[0][1][0][n]; }
        }
        asm volatile("s_waitcnt lgkmcnt(0)" ::: "memory"); __builtin_amdgcn_s_barrier(); asm volatile("" ::: "memory");
        f32x4 w0[2], w1[2], w2[2], bb[2];
#pragma unroll
        for (int n = 0; n < 2; ++n) { w0[n] = *(const f32x4*)(cw + ch0 + 4 * n); w1[n] = *(const f32x4*)(cw + FF + ch0 + 4 * n); w2[n] = *(const f32x4*)(cw + 2 * FF + ch0 + 4 * n); bb[n] = *(const f32x4*)(cb + ch0 + 4 * n); }
#pragma unroll
        for (int ai = 0; ai < 2; ++ai)
#pragma unroll
            for (int m = 0; m < 4; ++m) {
                const int rl = ai * 128 + wr * 64 + m * 16 + fr, grow = rbase + rl, blk = 2 * ai + wr;
                unsigned pk[4];
#pragma unroll
                for (int n = 0; n < 2; ++n) {
                    const f32x4 cur = acc[ai][0][m][n]; f32x4 g1, g2;
#pragma unroll
                    for (int j = 0; j < 4; ++j) {
                        const float s1 = __int_as_float(__builtin_amdgcn_update_dpp(0, __float_as_int(cur[j]), 0x111, 0xf, 0xf, false)), s2 = __int_as_float(__builtin_amdgcn_update_dpp(0, __float_as_int(cur[j]), 0x112, 0xf, 0xf, false));
                        float p15, p14;
                        if (m > 0) { const float pv = acc[ai][0][m > 0 ? m - 1 : 0][n][j]; p15 = __int_as_float(__builtin_amdgcn_update_dpp(0, __float_as_int(pv), 0x15f, 0xf, 0xf, false)); p14 = __int_as_float(__builtin_amdgcn_update_dpp(0, __float_as_int(pv), 0x15e, 0xf, 0xf, false)); }
                        else if (blk > 0) { p14 = halo[((blk - 1) * 2 + 0) * 128 + chl + 4 * n + j]; p15 = halo[((blk - 1) * 2 + 1) * 128 + chl + 4 * n + j]; }
                        else { p14 = 0.f; p15 = 0.f; }
                        g1[j] = fr >= 1 ? s1 : p15; g2[j] = fr >= 2 ? s2 : (fr == 1 ? p15 : p14);
                    }
                    const f32x4 cv = bb[n] + w2[n] * cur + w1[n] * g1 + w0[n] * g2;
                    const f32x4 up = acc[ai][1][m][n];
                    float hv[4];
#pragma unroll
                    for (int j = 0; j < 4; ++j) hv[j] = cv[j] * __builtin_amdgcn_rcpf(1.f + __expf(-cv[j])) * up[j];
                    pk[2 * n] = cvt_pk_bf16(hv[0], hv[1]); pk[2 * n + 1] = cvt_pk_bf16(hv[2], hv[3]);
                }
                if (rl >= 2) { u32x4 w; w.x = pk[0]; w.y = pk[1]; w.z = pk[2]; w.w = pk[3]; *(u32x4*)(H + (size_t)grow * FF + ch0) = w; }
            }
    }
};
template <class Epi, class Sched, bool ALIGN_EPI = false, bool SP2 = false>
__device__ __forceinline__ void gemm_phase(PG8_LAS unsigned char* lds, const Gemm g, const Sched& S, const Epi& E, const int tid) {
    const int wid = __builtin_amdgcn_readfirstlane(tid >> 6), lane = tid & 63, wr = wid >> 2, wc = wid & 3, fr = lane & 15, fq = lane >> 4;
    const int K = g.K, nt = K / BK;
    unsigned voffA[2], voffB[2];
#pragma unroll
    for (int i = 0; i < 2; ++i) { int R, C; stage_rc(tid * 16 + i * 8192, R, C); const int Rb = Epi::PERM ? ((R & ~31) + perm32(R & 31)) : R;
        voffA[i] = (unsigned)(R * K + C) * 2u; voffB[i] = (unsigned)(Rb * K + C) * 2u; }
    const size_t kstep = (size_t)(BK * 2);
    const size_t hstep = (size_t)HALF * K * 2;
    const size_t tstep = 2 * hstep;
    const unsigned ldsw = (unsigned)wid * 1024u;
    const int aoff = lds_byte(wr * 64 + fr, fq * 8), boff = lds_byte(wc * 32 + fr, fq * 8);
#define PG8_SA(b, h) (((b) * 2 + (h)) * HTB)
#define PG8_SB(b, h) ((4 + (b) * 2 + (h)) * HTB)
#define PG8_STAGE(bufoff, gbase, voff) do { _Pragma("unroll") for (int _i = 0; _i < 2; ++_i) \
        __builtin_amdgcn_global_load_lds((const unsigned*)((const char*)(gbase) + (voff)[_i]), (PG8_LAS unsigned*)(lds + (bufoff) + ldsw + _i * 8192), 16, 0, 0); } while (0)
#define PG8_LDA(dst, b, h) do { _Pragma("unroll") for (int m = 0; m < 4; ++m) _Pragma("unroll") for (int k = 0; k < 2; ++k) dst[m][k] = *(const PG8_LAS bf16x8*)(lds + PG8_SA(b, h) + aoff + m * 2048 + k * 1024); } while (0)
#define PG8_LDB(dst, b, h) do { _Pragma("unroll") for (int n = 0; n < 2; ++n) _Pragma("unroll") for (int k = 0; k < 2; ++k) dst[n][k] = *(const PG8_LAS bf16x8*)(lds + PG8_SB(b, h) + boff + n * 2048 + k * 1024); } while (0)
#define PG8_MMA(ai, bj, At, Bt) do { __builtin_amdgcn_s_setprio(1); _Pragma("unroll") for (int m = 0; m < 4; ++m) _Pragma("unroll") for (int n = 0; n < 2; ++n) _Pragma("unroll") for (int k = 0; k < 2; ++k) \
        acc[ai][bj][m][n] = __builtin_amdgcn_mfma_f32_16x16x32_bf16(Bt[n][k], At[m][k], acc[ai][bj][m][n], 0, 0, 0); __builtin_amdgcn_s_setprio(0); } while (0)
#define PG8_WAIT_V(n) asm volatile("s_waitcnt vmcnt(" #n ")" ::: "memory")
#define PG8_WAIT_L(n) asm volatile("s_waitcnt lgkmcnt(" #n ")" ::: "memory")
#define PG8_BAR __builtin_amdgcn_s_barrier()
#define PG8_SCHED __builtin_amdgcn_sched_barrier(0)
    Unit cur, nxt; int ui = 0;
    if (!S.next(0, cur)) return;
    f32x4 acc[2][2][4][2];
#pragma unroll
    for (int a = 0; a < 2; ++a)
#pragma unroll
        for (int b = 0; b < 2; ++b)
#pragma unroll
            for (int m = 0; m < 4; ++m)
#pragma unroll
                for (int n = 0; n < 2; ++n) acc[a][b][m][n] = (f32x4){0.f, 0.f, 0.f, 0.f};
    bf16x8 At[4][2], B0[2][2], B1[2][2];
    const char* cA = (const char*)g.A + (g.rowmap ? (size_t)tile_row0(1, cur.pm) * K * 2 : (size_t)cur.pm * g.a_tstep); const char* cB = (const char*)g.Bt + (size_t)cur.pn * tstep;
    S.a_ready(cur);
    if constexpr (SP2) {
        PG8_STAGE(PG8_SB(0, 0), cB, voffB); PG8_STAGE(PG8_SB(0, 1), cB + hstep, voffB); PG8_STAGE(PG8_SA(0, 0), cA, voffA); PG8_STAGE(PG8_SA(0, 1), cA + hstep, voffA);
        if (wr == 1) PG8_BAR;
        PG8_WAIT_V(2); PG8_BAR;
        PG8_STAGE(PG8_SB(1, 0), cB + kstep, voffB); PG8_STAGE(PG8_SA(1, 0), cA + kstep, voffA); PG8_STAGE(PG8_SB(1, 1), cB + hstep + kstep, voffB);
        PG8_WAIT_V(6); PG8_BAR;
    } else {
        PG8_STAGE(PG8_SB(0, 0), cB, voffB); PG8_STAGE(PG8_SA(0, 0), cA, voffA); PG8_STAGE(PG8_SB(0, 1), cB + hstep, voffB); PG8_STAGE(PG8_SA(0, 1), cA + hstep, voffA);
        if (wr == 1) PG8_BAR;
        PG8_WAIT_V(4); PG8_BAR;
        PG8_STAGE(PG8_SB(1, 0), cB + kstep, voffB); PG8_STAGE(PG8_SA(1, 0), cA + kstep, voffA); PG8_STAGE(PG8_SB(1, 1), cB + hstep + kstep, voffB);
        PG8_WAIT_V(6); PG8_BAR;
    }
    for (;;) {
        const bool has_next = S.next(ui + 1, nxt);
        const char* nA = has_next ? (const char*)g.A + (g.rowmap ? (size_t)tile_row0(1, nxt.pm) * K * 2 : (size_t)nxt.pm * g.a_tstep) : cA; const char* nB = has_next ? (const char*)g.Bt + (size_t)nxt.pn * tstep : cB;
        for (int t = 0; t < nt; t += 2) {
            const bool last = (t == nt - 2);
            const char* a1 = cA + (size_t)(t + 1) * kstep;
            const char* a2 = last ? nA : cA + (size_t)(t + 2) * kstep; const char* b2 = last ? nB : cB + (size_t)(t + 2) * kstep;
            const char* a3 = a2 + kstep; const char* b3 = b2 + kstep;
            if (last && has_next) S.a_ready(nxt);
            if constexpr (SP2) {
            PG8_LDB(B0, 0, 0); PG8_LDB(B1, 0, 1); PG8_SCHED; PG8_LDA(At, 0, 0); PG8_STAGE(PG8_SA(1, 1), a1 + hstep, voffA);
            PG8_WAIT_V(8); PG8_WAIT_L(0); PG8_BAR; PG8_MMA(0, 0, At, B0); PG8_MMA(0, 1, At, B1); PG8_BAR; PG8_SCHED;
            PG8_LDA(At, 0, 1); PG8_STAGE(PG8_SB(0, 0), b2, voffB); PG8_STAGE(PG8_SB(0, 1), b2 + hstep, voffB); PG8_STAGE(PG8_SA(0, 0), a2, voffA);
            PG8_WAIT_V(8); PG8_WAIT_L(0); PG8_BAR; PG8_MMA(1, 0, At, B0); PG8_MMA(1, 1, At, B1); PG8_BAR; PG8_SCHED;
            PG8_LDB(B0, 1, 0); PG8_LDB(B1, 1, 1); PG8_SCHED; PG8_LDA(At, 1, 0); PG8_STAGE(PG8_SA(0, 1), a2 + hstep, voffA);
            PG8_WAIT_V(8); PG8_WAIT_L(0); PG8_BAR; PG8_MMA(0, 0, At, B0); PG8_MMA(0, 1, At, B1); PG8_BAR; PG8_SCHED;
            PG8_LDA(At, 1, 1); PG8_STAGE(PG8_SB(1, 0), b3, voffB); PG8_STAGE(PG8_SB(1, 1), b3 + hstep, voffB); PG8_STAGE(PG8_SA(1, 0), a3, voffA);
            PG8_WAIT_V(8); PG8_WAIT_L(0); PG8_BAR; PG8_MMA(1, 0, At, B0); PG8_MMA(1, 1, At, B1); PG8_BAR; PG8_SCHED;
            } else {
            PG8_LDB(B0, 0, 0); PG8_SCHED; PG8_LDA(At, 0, 0); PG8_STAGE(PG8_SA(1, 1), a1 + hstep, voffA);
            PG8_WAIT_L(8); PG8_BAR; PG8_WAIT_L(0); PG8_MMA(0, 0, At, B0); PG8_BAR; PG8_SCHED;
            PG8_LDB(B1, 0, 1); PG8_STAGE(PG8_SB(0, 0), b2, voffB);
            PG8_BAR; PG8_WAIT_L(0); PG8_MMA(0, 1, At, B1); PG8_BAR;
            PG8_LDA(At, 0, 1); PG8_STAGE(PG8_SA(0, 0), a2, voffA);
            PG8_BAR; PG8_WAIT_L(0); PG8_MMA(1, 0, At, B0); PG8_BAR; PG8_SCHED;
            PG8_STAGE(PG8_SB(0, 1), b2 + hstep, voffB);
            PG8_WAIT_V(6); PG8_BAR; PG8_MMA(1, 1, At, B1); PG8_BAR;
            PG8_LDB(B0, 1, 0); PG8_SCHED; PG8_LDA(At, 1, 0); PG8_STAGE(PG8_SA(0, 1), a2 + hstep, voffA);
            PG8_WAIT_L(8); PG8_BAR; PG8_WAIT_L(0); PG8_MMA(0, 0, At, B0); PG8_BAR; PG8_SCHED;
            PG8_LDB(B1, 1, 1); PG8_STAGE(PG8_SB(1, 0), b3, voffB);
            PG8_BAR; PG8_WAIT_L(0); PG8_MMA(0, 1, At, B1); PG8_BAR;
            PG8_LDA(At, 1, 1); PG8_STAGE(PG8_SA(1, 0), a3, voffA);
            PG8_BAR; PG8_WAIT_L(0); PG8_MMA(1, 0, At, B0); PG8_BAR; PG8_SCHED;
            PG8_STAGE(PG8_SB(1, 1), b3 + hstep, voffB);
            PG8_WAIT_V(6); PG8_BAR; PG8_MMA(1, 1, At, B1); PG8_BAR;
            }
        }
        if constexpr (ALIGN_EPI) { if (wr == 0) PG8_BAR; }
        if constexpr (!Epi::AFTER_DRAIN) { E(acc, cur, wr, wc, fr, fq); S.done(cur); }
        if (!has_next) break;
#pragma unroll
        for (int a = 0; a < 2; ++a)
#pragma unroll
            for (int b = 0; b < 2; ++b)
#pragma unroll
                for (int m = 0; m < 4; ++m)
#pragma unroll
                    for (int n = 0; n < 2; ++n) acc[a][b][m][n] = (f32x4){0.f, 0.f, 0.f, 0.f};
        cur = nxt; cA = nA; cB = nB; ++ui;
        if constexpr (ALIGN_EPI) { if (wr == 1) PG8_BAR; }
    }
    PG8_WAIT_V(0);
    if constexpr (!ALIGN_EPI) { if (wr == 0) PG8_BAR; }
    PG8_BAR;
    if constexpr (Epi::AFTER_DRAIN) { E.fused(acc, cur, wr, wc, fr, fq, lds, wid, lane); S.done(cur); }
#undef PG8_SA
#undef PG8_SB
#undef PG8_STAGE
#undef PG8_LDA
#undef PG8_LDB
#undef PG8_MMA
#undef PG8_WAIT_V
#undef PG8_WAIT_L
#undef PG8_BAR
#undef PG8_SCHED
}
}

constexpr int WGM_IN = 4, WGM_OUT = 4, WGM_GU = 4, WGM_DN = 4;
constexpr int REP_SCORE = 1, REP_SEL = 1, REP_ATT = 1, REP_SLOW = 1, REP_FAST = 1;

#include <hip/hip_cooperative_groups.h>
namespace cg = cooperative_groups;
#define LAS __attribute__((address_space(3)))
constexpr int LDS_BYTES = 163840, HALO_OFF = 133120, PT_OFF = 163328, NTHR = 512, NWAVE = 8;
constexpr size_t MiB = (size_t)1 << 20;
constexpr size_t WS_CTL = 0, WS_WIN = 1 * MiB, WS_WOUT = 21 * MiB, WS_WGU = 31 * MiB, WS_WDN = 75 * MiB, WS_METAX = 97 * MiB, WS_RSTD = 98 * MiB, WS_UF = 99 * MiB,
                 WS_DT = 104 * MiB, WS_FCUM = 106 * MiB, WS_CN = 108 * MiB, WS_MASK = 117 * MiB, WS_XB = 134 * MiB, WS_Y = 264 * MiB, WS_R1 = 426 * MiB, WS_XC = WS_R1 + 323 * MiB,
                 WS_YA = 814 * MiB, WS_FIX = 880 * MiB  , WS_END = 900 * MiB;
static_assert(WS_WIN + (size_t)NU * DM * 2 <= WS_WOUT && WS_WOUT + (size_t)DM * KOUT * 2 <= WS_WGU && WS_WGU + (size_t)NGU * DM * 2 <= WS_WDN && WS_WDN + (size_t)DM * FF * 2 <= WS_METAX, "ws weights");
static_assert(WS_UF + (size_t)MP * 32 * 4 <= WS_DT && WS_DT + (size_t)T * 8 * 4 <= WS_FCUM && WS_FCUM + (size_t)64 * LKP * 4 <= WS_CN && WS_CN + (size_t)MP * 128 * 2 <= WS_MASK && WS_MASK + (size_t)T * NMW * 8 <= WS_XB, "ws small");
static_assert(WS_XB + (size_t)(MP + 8) * DM * 2 <= WS_Y && WS_Y + (size_t)MP * KOUT * 2 <= WS_R1 && WS_R1 + (size_t)MP * NU * 2 <= WS_XC && WS_XC + (size_t)MP * 1024 * 2 <= WS_YA && WS_R1 + (size_t)MP * FF * 2 <= WS_YA && WS_YA + (size_t)T * 512 * 4 <= WS_END, "ws big");

typedef unsigned u32x4v __attribute__((ext_vector_type(4)));
typedef unsigned u32x2v __attribute__((ext_vector_type(2)));
typedef float f32x4v __attribute__((ext_vector_type(4)));
struct Args { const float* in[25]; float* out; unsigned char* ws; };

struct Ctx {
    int tid, lane, wave, gw, ngw, bid, nb;
    LAS unsigned char* lds;
};
__device__ __forceinline__ Ctx refresh(const Ctx& c0) {
    Ctx c = c0; unsigned z = 0u; int w_ = c0.wave, b_ = (int)blockIdx.x, n_ = (int)gridDim.x; asm volatile("" : "+v"(z), "+s"(w_), "+s"(b_), "+s"(n_));
    const int lane = (int)__builtin_amdgcn_mbcnt_hi(~0u, __builtin_amdgcn_mbcnt_lo(~0u, z));
    c.bid = b_; c.nb = n_; c.ngw = n_ * NWAVE; c.wave = w_; c.lane = lane; c.tid = w_ * 64 + lane; c.gw = b_ * NWAVE + w_;
    { unsigned l_ = (unsigned)(size_t)c0.lds; asm volatile("" : "+s"(l_)); c.lds = (LAS unsigned char*)(size_t)l_; }
    return c;
}
__device__ __forceinline__ unsigned char* pt_get(const Ctx& c, int i) {
    unsigned l_ = (unsigned)(size_t)c.lds; asm volatile("" : "+s"(l_));
    const LAS unsigned* p = (const LAS unsigned*)((LAS unsigned char*)(size_t)l_ + PT_OFF) + 2 * i;
    const unsigned lo = __builtin_amdgcn_readfirstlane(p[0]), hi = __builtin_amdgcn_readfirstlane(p[1]);
    __attribute__((address_space(1))) unsigned char* gp = (__attribute__((address_space(1))) unsigned char*)(((unsigned long long)hi << 32) | lo);
    return (unsigned char*)gp;
}
#define INP(i) ((const float*)pt_get(c, (i)))

#define GAS __attribute__((address_space(1)))
typedef unsigned v4u __attribute__((ext_vector_type(4)));
typedef GAS unsigned gu32;
typedef GAS unsigned long long gu64;
#define RLX_AGENT __ATOMIC_RELAXED, __HIP_MEMORY_SCOPE_AGENT
#define LDS_WAIT() asm volatile("s_waitcnt lgkmcnt(0)" ::: "memory")
#define VM_WAIT() asm volatile("s_waitcnt vmcnt(0)" ::: "memory")
__device__ __forceinline__ unsigned long long rt() { return __builtin_amdgcn_s_memrealtime(); }

#define XB_TMO      128
#define XB_XCNT(j)  (256  + 64 * (j))
#define XB_XSUB(j)  (1280 + 64 * (j))
#define XB_XGEN(j)  (2304 + 64 * (j))
#define XB_TOP      3328
#define XB_TOPGEN   3392
#define XCD_BAR_WORDS 3456
#define XB_SPIN_CAP (1u << 18)

__device__ __forceinline__ unsigned xb_ld(unsigned* p)              { return __hip_atomic_load(p, __ATOMIC_RELAXED, __HIP_MEMORY_SCOPE_AGENT); }
__device__ __forceinline__ unsigned xb_add(unsigned* p, unsigned v) { return __hip_atomic_fetch_add(p, v, __ATOMIC_RELAXED, __HIP_MEMORY_SCOPE_AGENT); }
__device__ __forceinline__ unsigned xb_xcc_id() { return (unsigned)__builtin_amdgcn_s_getreg((3 << 11) | 20) & 0xFu; }
#define XB_SPIN(cond, bar) do { unsigned _sp = 0; while (cond) { __builtin_amdgcn_s_sleep(1); \
    if ((++_sp & 255u) == 0u) { if (xb_ld(&(bar)[XB_TMO])) break; if (_sp > XB_SPIN_CAP) { atomicAdd(&(bar)[XB_TMO], 1u); break; } } } } while (0)

struct XcdBarrier {
    unsigned* bar; unsigned x;
    volatile LAS unsigned* st;
};

__device__ __forceinline__ XcdBarrier xcd_barrier_post(unsigned* bar, volatile LAS unsigned* st, int tid) {
    XcdBarrier b; b.bar = bar; b.x = xb_xcc_id(); b.st = st;
    if (tid == 0) (void)xb_add(&bar[XB_XCNT(b.x)], 1u);
    return b;
}
__device__ __forceinline__ void xcd_barrier_complete(unsigned* bar, unsigned x, unsigned& nloc, unsigned& nx) {
    const unsigned G = gridDim.x * gridDim.y * gridDim.z;
    unsigned sum, cnt, mine, sp = 0u;
    for (;;) {
        sum = 0u; cnt = 0u; mine = 0u;
#pragma unroll
        for (unsigned j = 0; j < 16; ++j) { const unsigned c = xb_ld(&bar[XB_XCNT(j)]); sum += c; cnt += (c > 0u) ? 1u : 0u; mine = (j == x) ? c : mine; }
        if (sum == G) break;
        __builtin_amdgcn_s_sleep(1);
        if ((++sp & 255u) == 0u) { if (xb_ld(&bar[XB_TMO])) break; if (sp > XB_SPIN_CAP) { atomicAdd(&bar[XB_TMO], 1u); break; } }
    }
    nloc = mine > 0u ? mine : 1u; nx = cnt > 0u ? cnt : 1u;
}

__device__ __forceinline__ void xcd_barrier(const XcdBarrier& b, int tid) {
    asm volatile("s_waitcnt vmcnt(0)" ::: "memory");
    __syncthreads();
    if (tid == 0) {
        unsigned* bar = b.bar;
        __builtin_amdgcn_s_waitcnt(0);
        unsigned nloc = b.st[0], nx = b.st[1];
        if (nloc == 0u) { xcd_barrier_complete(bar, b.x, nloc, nx); b.st[0] = nloc; b.st[1] = nx; }
        const unsigned old = xb_add(&bar[XB_XSUB(b.x)], 1u);
        const unsigned gen = old / nloc;
        if (old + 1u == (gen + 1u) * nloc) {
            __builtin_amdgcn_fence(__ATOMIC_RELEASE, "agent");
            asm volatile("s_waitcnt vmcnt(0)" ::: "memory");
            const unsigned og = xb_add(&bar[XB_TOP], 1u);
            const unsigned tg = og / nx;
            if (og + 1u == (tg + 1u) * nx) xb_add(&bar[XB_TOPGEN], 1u);
            else XB_SPIN(xb_ld(&bar[XB_TOPGEN]) == tg, bar);
            __builtin_amdgcn_fence(__ATOMIC_ACQUIRE, "agent");
            xb_add(&bar[XB_XGEN(b.x)], 1u);
            asm volatile("s_waitcnt vmcnt(0)" ::: "memory");
        } else {
            XB_SPIN(xb_ld(&bar[XB_XGEN(b.x)]) == gen, bar);
            __builtin_amdgcn_fence(__ATOMIC_ACQUIRE, "agent");
            asm volatile("s_waitcnt vmcnt(0)" ::: "memory");
        }
    }
    __syncthreads();
}

constexpr int MISC_OFF = 163072, CW_BAR = 4096;
__device__ __forceinline__ void grid_barrier(const Ctx& c0) {
    const Ctx c = refresh(c0);
    XcdBarrier b; b.bar = (unsigned*)(pt_get(c, 26) + WS_CTL) + CW_BAR; b.x = xb_xcc_id(); b.st = (volatile LAS unsigned*)(c.lds + MISC_OFF);
    xcd_barrier(b, c.tid);
}
__device__ __forceinline__ void ph_prep_x(const Ctx& c0, const float* x, const float* meta, bf16* XB, float* RSTD) { const Ctx c = refresh(c0);
    const int lane = c.lane;
    for (int w = c.gw; w < MP + 8; w += c.ngw) {
        const int t = w - 8; bf16* xb = XB + (ptrdiff_t)t * DM;
        if (t < 0 || t >= T) {
#pragma unroll
            for (int j = 0; j < 4; ++j) *(u32x4v*)(xb + 8 * lane + 512 * j) = (u32x4v){0u, 0u, 0u, 0u};
            if (t >= T && lane == 0) RSTD[t] = 0.f;
            continue;
        }
        const int b = t / L, p = t - b * L;
        const float* src = p < NMETA ? meta + (size_t)p * DM : x + ((size_t)b * SEQ + (p - NMETA)) * DM;
        float ss = 0.f;
#pragma unroll
        for (int j = 0; j < 4; ++j) {
            const f32x4v a = *(const f32x4v*)(src + 8 * lane + 512 * j), cc = *(const f32x4v*)(src + 8 * lane + 512 * j + 4);
            ss += a.x * a.x + a.y * a.y + a.z * a.z + a.w * a.w + cc.x * cc.x + cc.y * cc.y + cc.z * cc.z + cc.w * cc.w;
            *(u32x4v*)(xb + 8 * lane + 512 * j) = (u32x4v){pk2(a.x, a.y), pk2(a.z, a.w), pk2(cc.x, cc.y), pk2(cc.z, cc.w)};
        }
        ss = wave_sum(ss, lane);
        if (lane == 0) RSTD[t] = rsqrtf(ss * (1.f / DM) + EPSF);
    }
}

__device__ __forceinline__ void tp_tile(LAS float* tl, int lane, const float* src, int ld, const float* scale, float mul, bf16* dst, int Kd) {
    const int kk = lane >> 4, n4 = lane & 15;
    f32x4v v[16];
#pragma unroll
    for (int i = 0; i < 16; ++i) v[i] = *(const f32x4v*)(src + (size_t)(4 * i + kk) * ld + 4 * n4);
    if (scale) {
#pragma unroll
        for (int i = 0; i < 16; ++i) v[i] = v[i] * (scale[4 * i + kk] * mul); }
#pragma unroll
    for (int i = 0; i < 16; ++i)
#pragma unroll
        for (int e = 0; e < 4; ++e) tl[(4 * n4 + e) * 65 + 4 * i + kk] = v[i][e];
#pragma unroll
    for (int jj = 0; jj < 8; ++jj) { const int n = (lane >> 3) + 8 * jj, kc = (lane & 7) * 8; const LAS float* tp = tl + n * 65 + kc;
        *(u32x4v*)(dst + (size_t)n * Kd + kc) = (u32x4v){pk2(tp[0], tp[1]), pk2(tp[2], tp[3]), pk2(tp[4], tp[5]), pk2(tp[6], tp[7])}; }
}
template <class F, class M> __device__ __forceinline__ void transpose_tiles_map(const Ctx& c, bf16* dst, int Kd, int ntiles, const F& val, const M& map) {
    LAS float* tile = (LAS float*)c.lds + (c.tid >> 8) * (32 * 33);
    const int t2 = c.tid & 255, tx = t2 & 31, ty = t2 >> 5;
    for (int it = 2 * c.bid + (c.tid >> 8); it < ntiles; it += 2 * c.nb) {
        int k0, n0; map(it, k0, n0);
#pragma unroll
        for (int i = 0; i < 4; ++i) tile[(ty + 8 * i) * 33 + tx] = val(k0 + ty + 8 * i, n0 + tx);
        __syncthreads();
#pragma unroll
        for (int i = 0; i < 4; ++i) dst[(size_t)(n0 + ty + 8 * i) * Kd + k0 + tx] = f2bf(tile[tx * 33 + ty + 8 * i]);
        __syncthreads();
    }
}
__device__ __forceinline__ void ph_prep_w(const Ctx& c0, int ly, bf16* WIN, bf16* WOUT, bf16* WGU, bf16* WDN, bf16* WUKB, bf16* WUVT) { const Ctx c = refresh(c0);
    const float* w_in = INP(6) + (size_t)ly * DM * DIN; const float* g1 = INP(2) + (size_t)ly * DM; const float* w_uk = INP(17) + (size_t)ly * 8 * 128 * 64;
    const float* w_out = INP(19) + (size_t)ly * DM * DM; const float* ssd_norm = INP(12) + (size_t)ly * 512; const float* pool_w = INP(13) + (size_t)ly * 4 * 128 * 128;
    const float* pool_scale = INP(14) + (size_t)ly * 512; const float* w_uv = INP(18) + (size_t)ly * 8 * 128 * 64;
    const float* wg = INP(20) + (size_t)ly * DM * FF; const float* wu = INP(21) + (size_t)ly * DM * FF; const float* g3 = INP(4) + (size_t)ly * DM;
    const float* wd = INP(24) + (size_t)ly * FF * DM;
    {
        LAS float* tl = (LAS float*)c.lds + c.wave * (64 * 65);
        constexpr int N_WIN = 71 * 32, N_WGU = 176 * 32, N_WDN = 32 * 88, N_WOUT = 32 * 24, N_ALL = N_WIN + N_WGU + N_WDN + N_WOUT;
#pragma unroll 1
        for (int it0 = c.gw; it0 < N_ALL * REP_FAST; it0 += c.ngw) { const int it = it0 % N_ALL;
            int r = it; const float* src; const float* scl; bf16* dst; int ld, Kd; float mul = 1.f;
            if (r < N_WGU) { const int kt = r / 176, ct = r - kt * 176, pn = ct >> 2, up = (ct >> 1) & 1, hf = ct & 1;
                src = (up ? wu : wg) + (size_t)(64 * kt) * FF + 128 * pn + 64 * hf; ld = FF; scl = g3 + 64 * kt; dst = WGU + (size_t)(256 * pn + 128 * up + 64 * hf) * DM + 64 * kt; Kd = DM; }
            else if ((r -= N_WGU) < N_WDN) { const int kt = r >> 5, ct = r & 31;
                src = wd + (size_t)(64 * kt) * DM + 64 * ct; ld = DM; scl = nullptr; dst = WDN + (size_t)(64 * ct) * FF + 64 * kt; Kd = FF; }
            else if ((r -= N_WDN) < N_WIN) { const int kt = r / 71, ct = r - kt * 71;
                int dcol, scol;
                if (ct < 24) { dcol = 64 * ct; scol = dcol; }
                else if (ct < 32) { dcol = 64 * ct; scol = 1544 + 64 * (ct - 24); }
                else if (ct < 56) { dcol = 64 * ct; scol = 2056 + 64 * (ct - 32); if (ct < 40) mul = 0.18033688011112042f; }
                else if (ct < 64) { dcol = 64 * ct; scol = 3600 + 64 * (ct - 56); }
                else if (ct < 66) { dcol = C_DC + 64 * (ct - 64); scol = 4112 + 64 * (ct - 64); }
                else if (ct < 70) { dcol = C_QI + 64 * (ct - 66); scol = 4240 + 64 * (ct - 66); }
                else { dcol = C_KI; scol = 4496; }
                src = w_in + (size_t)(64 * kt) * DIN + scol; ld = DIN; scl = g1 + 64 * kt; dst = WIN + (size_t)dcol * DM + 64 * kt; Kd = DM; }
            else { r -= N_WIN; const int kq = r >> 5, nt = r & 31, k0 = kq < 8 ? 64 * kq : 1024 + 64 * (kq - 8);
                src = w_out + (size_t)k0 * DM + 64 * nt; ld = DM; scl = kq < 8 ? ssd_norm + k0 : nullptr; dst = WOUT + (size_t)(64 * nt) * KOUT + k0; Kd = KOUT; }
            tp_tile(tl, c.lane, src, ld, scl, mul, dst, Kd);
        }
    }
    __syncthreads();
    {   const int gt = c.bid * NTHR + c.tid, ngt = c.nb * NTHR;
        for (int it = gt; it < 8 * 128 * 64 / 2; it += ngt) { const float sc = 0.125f * 1.4426950408889634f; *(unsigned*)(WUKB + 2 * it) = pk2(w_uk[2 * it] * sc, w_uk[2 * it + 1] * sc); }
        for (int it = gt; it < 4 * 32 * 512; it += ngt) {
            const int nq = it & 511, cq = (it >> 9) & 31, gi = it >> 14, n0 = 4 * nq, c0_ = 4 * cq;
            float acc[4][4];
#pragma unroll
            for (int a = 0; a < 4; ++a)
#pragma unroll
                for (int b = 0; b < 4; ++b) acc[a][b] = 0.f;
            const float* ap = pool_w + ((size_t)gi * 128 + c0_) * 128; const float* sp = pool_scale + 128 * gi; const float* bp = w_out + (size_t)(512 + 128 * gi) * DM + n0;
#pragma unroll 2
            for (int d = 0; d < 128; d += 4) {
                f32x4v av[4], bv[4]; const f32x4v sv = *(const f32x4v*)(sp + d);
#pragma unroll
                for (int a = 0; a < 4; ++a) { av[a] = *(const f32x4v*)(ap + a * 128 + d) * sv; bv[a] = *(const f32x4v*)(bp + (size_t)(d + a) * DM); }
#pragma unroll
                for (int a = 0; a < 4; ++a)
#pragma unroll
                    for (int b = 0; b < 4; ++b) acc[a][b] += av[a][0] * bv[0][b] + av[a][1] * bv[1][b] + av[a][2] * bv[2][b] + av[a][3] * bv[3][b];
            }
#pragma unroll
            for (int b = 0; b < 4; ++b) *(u32x2v*)(WOUT + (size_t)(n0 + b) * KOUT + 512 + 128 * gi + c0_) = (u32x2v){pk2(acc[0][b], acc[1][b]), pk2(acc[2][b], acc[3][b])};
        }
        for (int it = gt; it < 8 * 64 * 128; it += ngt) { const int r = it & 127, d = (it >> 7) & 63, h = it >> 13; WUVT[it] = f2bf(w_uv[((size_t)h * 128 + r) * 64 + d]); }
    }
    transpose_tiles_map(c, WIN, DM, 2 * 64, [=](int k, int n) -> float {
            int src = -1;
            if (n < C_SM + 8) src = 1536 + (n - C_SM);
            else if (n < C_SM + 16) src = 3592 + (n - C_SM - 8);
            else if (n < C_SM + 20) src = 4560 + (n - C_SM - 16);
            return src >= 0 ? w_in[(size_t)k * DIN + src] * g1[k] : 0.f; },
        [=](int it, int& k0, int& n0) { k0 = 32 * (it & 63); n0 = C_SM + 32 * (it >> 6); });
}

__device__ __forceinline__ void ph_mixprep(const Ctx& c0, const bf16* U, const float* UF, const float* cw, const float* cb, const float* kvn, const float* dtb, bf16* XC, bf16* Y, bf16* CN, float* DT, bf16* KI) { const Ctx c = refresh(c0);
    const int gt = c.bid * NTHR + c.tid, ngt = c.nb * NTHR;
    for (int idx = gt; idx < (T / 4) * 128; idx += ngt) {
        const int t0 = (idx >> 7) * 4, c0 = (idx & 127) * 8, pos0 = t0 % L;
        u32x4v v[7];
#pragma unroll
        for (int i = 0; i < 7; ++i) v[i] = pos0 - 3 + i >= 0 ? *(const u32x4v*)(U + (size_t)(t0 - 3 + i) * NU + C_XBC + c0) : (u32x4v){0u, 0u, 0u, 0u};
        f32x4v wa[4], wb[4];
#pragma unroll
        for (int k = 0; k < 4; ++k) { wa[k] = *(const f32x4v*)(cw + k * 1024 + c0); wb[k] = *(const f32x4v*)(cw + k * 1024 + c0 + 4); }
        const f32x4v ba = *(const f32x4v*)(cb + c0), bb = *(const f32x4v*)(cb + c0 + 4);
        float x[7][8];
#pragma unroll
        for (int i = 0; i < 7; ++i) { const unsigned w_[4] = {v[i].x, v[i].y, v[i].z, v[i].w};
#pragma unroll
            for (int j = 0; j < 8; ++j) x[i][j] = bf2f((bf16)(w_[j >> 1] >> (16 * (j & 1)))); }
#pragma unroll
        for (int r = 0; r < 4; ++r) { float acc[8];
#pragma unroll
            for (int j = 0; j < 8; ++j) { acc[j] = j < 4 ? ba[j] : bb[j - 4];
#pragma unroll
                for (int k = 0; k < 4; ++k) acc[j] += (j < 4 ? wa[k][j] : wb[k][j - 4]) * x[r + k][j]; }
            *(u32x4v*)(XC + (size_t)(t0 + r) * 1024 + c0) = (u32x4v){pk2(siluf(acc[0]), siluf(acc[1])), pk2(siluf(acc[2]), siluf(acc[3])), pk2(siluf(acc[4]), siluf(acc[5])), pk2(siluf(acc[6]), siluf(acc[7]))}; }
    }
    for (int idx = gt; idx < (T / 4) * 64; idx += ngt) {
        const int t0 = (idx >> 6) * 4, c0 = (idx & 63) * 8, pos0 = t0 % L, gi = c0 >> 7;
        const bf16* up = U + (size_t)t0 * NU + C_POOL + c0;
#define POOL_BLK(W) { u32x4v v[W + 3]; _Pragma("unroll") for (int i = 0; i < W + 3; ++i) v[i] = pos0 - (W - 1) + i >= 0 ? *(const u32x4v*)(up + (ptrdiff_t)(i - (W - 1)) * NU) : (u32x4v){0u, 0u, 0u, 0u}; \
            _Pragma("unroll") for (int r = 0; r < 4; ++r) { float acc[8] = {0, 0, 0, 0, 0, 0, 0, 0}, self[8]; \
                _Pragma("unroll") for (int i = 0; i < W; ++i) { const u32x4v q_ = v[r + i]; const unsigned w_[4] = {q_.x, q_.y, q_.z, q_.w}; \
                    _Pragma("unroll") for (int j = 0; j < 8; ++j) { const float f = bf2f((bf16)(w_[j >> 1] >> (16 * (j & 1)))); acc[j] += f; if (i == W - 1) self[j] = f; } } \
                const float inv = 1.f / (float)min(pos0 + r + 1, W); \
                *(u32x4v*)(Y + (size_t)(t0 + r) * KOUT + 512 + c0) = (u32x4v){pk2(acc[0] * inv - self[0], acc[1] * inv - self[1]), pk2(acc[2] * inv - self[2], acc[3] * inv - self[3]), \
                    pk2(acc[4] * inv - self[4], acc[5] * inv - self[5]), pk2(acc[6] * inv - self[6], acc[7] * inv - self[7])}; } }
        if (gi == 0) POOL_BLK(2) else if (gi == 1) POOL_BLK(4) else if (gi == 2) POOL_BLK(8) else POOL_BLK(16)
    }
    for (int t = c.gw; t < T; t += c.ngw) {
        const int lane = c.lane;
        const unsigned v = *(const unsigned*)(U + (size_t)t * NU + C_DC + 2 * lane);
        const float a = bf2f((bf16)(v & 0xffff)), cc = bf2f((bf16)(v >> 16));
        const float rs = rsqrtf(wave_sum(a * a + cc * cc, lane) * (1.f / 128.f) + EPSF);
        *(unsigned*)(CN + (size_t)t * 128 + 2 * lane) = pk2(a * rs * kvn[2 * lane], cc * rs * kvn[2 * lane + 1]);
        if (lane < 8) DT[(size_t)t * 8 + lane] = softplusf(UF[(size_t)t * 32 + lane] + dtb[lane]);
        if (lane < 32) *(unsigned*)(KI + (size_t)t * 64 + 2 * lane) = *(const unsigned*)(U + (size_t)t * NU + C_KI + 2 * lane);
    }
}
__device__ __forceinline__ void ph_fcum(const Ctx& c0, const float* UF, const float* fb, float* FCUM) { const Ctx c = refresh(c0);
    const int lane = c.lane, w = c.wave;
    LAS float* tot = (LAS float*)c.lds;
    for (int bh = c.bid; bh < 64; bh += c.nb) {
        const int b = bh >> 3, h = bh & 7; const float bias = fb[h]; float v[9]; float carry = 0.f;
#pragma unroll
        for (int i = 0; i < 9; ++i) { const int p = 576 * w + 64 * i + lane; v[i] = p < L ? logsigmoidf(UF[(size_t)(b * L + p) * 32 + 8 + h] + bias) : 0.f; }
#pragma unroll
        for (int i = 0; i < 9; ++i) { float x = v[i];
#pragma unroll
            for (int o = 1; o < 64; o <<= 1) { const float n = lane_read(x, (lane - o) & 63); if (lane >= o) x += n; }
            x += carry; v[i] = x; carry = lane_read(x, 63); }
        if (lane == 0) tot[w] = carry;
        __syncthreads();
        float off = 0.f;
#pragma unroll
        for (int ww = 0; ww < NWAVE; ++ww) off += ww < w ? tot[ww] : 0.f;
#pragma unroll
        for (int i = 0; i < 9; ++i) { const int p = 576 * w + 64 * i + lane; if (p < LKP) FCUM[(size_t)bh * LKP + p] = v[i] + off; }
        __syncthreads();
    }
}
__device__ __forceinline__ unsigned fkey(float f) { const unsigned u = __float_as_uint(f); return (u & 0x80000000u) ? ~u : (u | 0x80000000u); }
__device__ __forceinline__ int crow(int r, int hi) { return (r & 3) + 8 * (r >> 2) + 4 * hi; }
typedef short bf16x8 __attribute__((ext_vector_type(8)));
typedef float f32x16 __attribute__((ext_vector_type(16)));
typedef float f32x2v __attribute__((ext_vector_type(2)));
typedef __bf16 bf16x2v __attribute__((ext_vector_type(2)));
#define MFMA32(a, b, c) __builtin_amdgcn_mfma_f32_32x32x16_bf16((a), (b), (c), 0, 0, 0)
#define WLANE64(lo, hi, m, sel) asm volatile("s_nop 1\n\tv_writelane_b32 %0, %2, %4\n\tv_writelane_b32 %1, %3, %4" : "+v"(lo), "+v"(hi) : "s"((unsigned)(m)), "s"((unsigned)((m) >> 32)), "n"(sel))
__device__ __forceinline__ float max3f(float a, float b, float c) { float r; asm("v_max3_f32 %0, %1, %2, %3" : "=v"(r) : "v"(a), "v"(b), "v"(c)); return r; }
__device__ __forceinline__ unsigned cvtpk(float lo, float hi) { f32x2v v = {lo, hi}; bf16x2v b = __builtin_convertvector(v, bf16x2v); return __builtin_bit_cast(unsigned, b); }
__device__ __forceinline__ bf16x8 pack8(const f32x16& p, int s) {
    u32x4v r; r.x = cvtpk(p[8 * s], p[8 * s + 1]); r.y = cvtpk(p[8 * s + 2], p[8 * s + 3]); r.z = cvtpk(p[8 * s + 4], p[8 * s + 5]); r.w = cvtpk(p[8 * s + 6], p[8 * s + 7]);
    return __builtin_bit_cast(bf16x8, r);
}
constexpr int AT_KSTR = 72;
constexpr int AT_VSTR = 68;
constexpr int FOX_KB = 64 * AT_KSTR;
__device__ __forceinline__ void ph_fox(const Ctx& c0, const bf16* U, const float* FCUM, bf16* Y) {
    const Ctx c = refresh(c0);
    LAS bf16* KS = (LAS bf16*)c.lds;
    LAS bf16* VT = KS + 2 * FOX_KB;
    LAS float* FB = (LAS float*)(c.lds + 4 * FOX_KB * 2);
    const int lane = c.lane, w = c.wave, r32 = lane & 31, hi = lane >> 5, tid = c.tid;
    const float LOG2E = 1.4426950408889634f;
    typedef short s16x4v __attribute__((ext_vector_type(4)));
    for (int it = c.bid; it < 64 * 17; it += c.nb) {
        const int rnd = it >> 8, cu = it & 255, k4 = cu >> 6, bh = cu & 63, b = bh >> 3, h = bh & 7;
        const int j = rnd == 0 ? 16 - k4 : rnd == 1 ? 9 + k4 : rnd == 2 ? 8 - k4 : rnd == 3 ? 1 + k4 : 0;
        const int q0 = j == 0 ? 0 : 16 + 256 * (j - 1), qrow = q0 + 32 * w + r32, ntiles = 1 + 4 * j, qmax = q0 + 32 * w + 31;
        const bool wave_on = (j > 0) || (w == 0), row_ok = (j > 0) || (r32 < 16);
        const bf16* Ub = U + (size_t)(b * L) * NU;
        bf16x8 qf[4];
#pragma unroll
        for (int s = 0; s < 4; ++s) qf[s] = (bf16x8){0, 0, 0, 0, 0, 0, 0, 0};
        if (wave_on && row_ok) {
#pragma unroll
            for (int s = 0; s < 4; ++s) qf[s] = *(const bf16x8*)(Ub + (size_t)qrow * NU + C_FQ + 64 * h + 16 * s + 8 * hi);
        }
        f32x16 o0, o1;
#pragma unroll
        for (int r = 0; r < 16; ++r) { o0[r] = 0.f; o1[r] = 0.f; }
        float m = -1e30f, l = 0.f;
        const float* fc = FCUM + (size_t)bh * LKP;
        const bf16* kg = Ub + (size_t)(tid >> 3) * NU + C_FK + 64 * h + 8 * (tid & 7);
        const bf16* vg = Ub + (size_t)lane * NU + C_FV + 64 * h + 8 * w;
#define FOX_KB0(t) ((t) == 0 ? 0 : 16 + 64 * ((t) - 1))
#define FOX_PUT_K(buf, kr, fr) do { *(LAS u32x4v*)(KS + (buf) * FOX_KB + (tid >> 3) * AT_KSTR + 8 * (tid & 7)) = kr; if (tid < 64) FB[(buf) * 64 + tid] = fr; } while (0)
#define FOX_PUT_V(buf, vr) do { const unsigned vv_[4] = {vr.x, vr.y, vr.z, vr.w}; \
            _Pragma("unroll") for (int e = 0; e < 8; ++e) VT[(buf) * FOX_KB + (8 * w + e) * AT_VSTR + lane] = (bf16)(vv_[e >> 1] >> (16 * (e & 1))); } while (0)
#define FOX_GET_K(t, kr, fr) do { const int kb_ = FOX_KB0(t); kr = *(const u32x4v*)(kg + (size_t)kb_ * NU); if (tid < 64) fr = -fc[kb_ + tid] * LOG2E; } while (0)
#define FOX_GET_V(t, vr) do { vr = *(const u32x4v*)(vg + (size_t)FOX_KB0(t) * NU); } while (0)
#define FOX_QK(buf, P0, P1) do { const LAS float* fb_ = FB + (buf) * 64; \
            _Pragma("unroll") for (int i4 = 0; i4 < 4; ++i4) { const f32x4v f0 = *(const LAS f32x4v*)(fb_ + 8 * i4 + 4 * hi), f1 = *(const LAS f32x4v*)(fb_ + 32 + 8 * i4 + 4 * hi); \
                _Pragma("unroll") for (int e = 0; e < 4; ++e) { P0[4 * i4 + e] = f0[e]; P1[4 * i4 + e] = f1[e]; } } \
            _Pragma("unroll") for (int s = 0; s < 4; ++s) { \
                const bf16x8 a0 = *(const LAS bf16x8*)(KS + (buf) * FOX_KB + r32 * AT_KSTR + 16 * s + 8 * hi), a1 = *(const LAS bf16x8*)(KS + (buf) * FOX_KB + (32 + r32) * AT_KSTR + 16 * s + 8 * hi); \
                P0 = MFMA32(a0, qf[s], P0); P1 = MFMA32(a1, qf[s], P1); } } while (0)
        u32x4v kreg, vreg; float fbreg = 0.f;
        FOX_GET_K(0, kreg, fbreg); FOX_GET_V(0, vreg);
        FOX_PUT_K(0, kreg, fbreg); FOX_PUT_V(0, vreg);
        if (ntiles > 1) { FOX_GET_K(1, kreg, fbreg); FOX_GET_V(1, vreg); FOX_PUT_K(1, kreg, fbreg); }
        if (ntiles > 2) FOX_GET_K(2, kreg, fbreg);
        __syncthreads();
        f32x16 pc0, pc1, pn0, pn1;
#pragma unroll
        for (int r = 0; r < 16; ++r) { pc0[r] = 0.f; pc1[r] = 0.f; pn0[r] = 0.f; pn1[r] = 0.f; }
        if (wave_on) FOX_QK(0, pc0, pc1);
        __syncthreads();
        for (int i = 0; i < ntiles; ++i) {
            const int cur = i & 1, kb = FOX_KB0(i), kbn = FOX_KB0(i + 1);
            if (i + 2 < ntiles) FOX_PUT_K(cur, kreg, fbreg);
            if (i + 1 < ntiles) FOX_PUT_V(cur ^ 1, vreg);
            if (i + 3 < ntiles) FOX_GET_K(i + 3, kreg, fbreg);
            if (i + 2 < ntiles) FOX_GET_V(i + 2, vreg);
            const bool on_next = wave_on && (i + 1 < ntiles) && kbn <= qmax, on_cur = wave_on && kb <= qmax;
            if (on_next) FOX_QK(cur ^ 1, pn0, pn1);
            if (on_cur) {
                if (i == 0 || kb + 63 > q0 + 32 * w) {
                    const int klim = i == 0 ? 16 : 64;
#pragma unroll
                    for (int r = 0; r < 16; ++r) { const int k0 = crow(r, hi), k1 = 32 + k0;
                        if (!(k0 < klim && kb + k0 <= qrow)) pc0[r] = -1e30f;
                        if (!(k1 < klim && kb + k1 <= qrow)) pc1[r] = -1e30f; }
                }
                float mx = max3f(pc0[0], pc1[0], pc0[1]), mx2 = max3f(pc1[1], pc0[2], pc1[2]);
#pragma unroll
                for (int r = 3; r < 15; r += 2) { mx = max3f(mx, pc0[r], pc1[r]); mx2 = max3f(mx2, pc0[r + 1], pc1[r + 1]); }
                mx = max3f(mx, pc0[15], pc1[15]); mx = max3f(mx, mx2, mx2);
                const float mn = max3f(m, mx, lane_read(mx, lane ^ 32)), alpha = __builtin_amdgcn_exp2f(m - mn); const bool grew = __ballot(mn > m) != 0ull; m = mn;
                float sum = 0.f;
#pragma unroll
                for (int r = 0; r < 16; ++r) { pc0[r] = __builtin_amdgcn_exp2f(pc0[r] - mn); pc1[r] = __builtin_amdgcn_exp2f(pc1[r] - mn); sum += pc0[r] + pc1[r]; }
                l = l * alpha + sum;
                if (grew) {
#pragma unroll
                    for (int r = 0; r < 16; ++r) { o0[r] *= alpha; o1[r] *= alpha; } }
#pragma unroll
                for (int blk = 0; blk < 2; ++blk)
#pragma unroll
                    for (int s = 0; s < 2; ++s) {
                        const bf16x8 xs = pack8(blk == 0 ? pc0 : pc1, s);
                        const LAS bf16* vp = VT + cur * FOX_KB + r32 * AT_VSTR + 32 * blk + 16 * s + 4 * hi;
                        const s16x4v lo0 = *(const LAS s16x4v*)vp, hi0 = *(const LAS s16x4v*)(vp + 8);
                        const s16x4v lo1 = *(const LAS s16x4v*)(vp + 32 * AT_VSTR), hi1 = *(const LAS s16x4v*)(vp + 32 * AT_VSTR + 8);
                        const bf16x8 pa0 = __builtin_shufflevector(lo0, hi0, 0, 1, 2, 3, 4, 5, 6, 7), pa1 = __builtin_shufflevector(lo1, hi1, 0, 1, 2, 3, 4, 5, 6, 7);
                        o0 = MFMA32(pa0, xs, o0); o1 = MFMA32(pa1, xs, o1);
                    }
            }
            pc0 = pn0; pc1 = pn1;
            __syncthreads();
        }
        l += lane_read(l, lane ^ 32);
        if (wave_on && row_ok) {
            const float inv = 1.f / l; bf16* yr = Y + (size_t)(b * L + qrow) * KOUT + 1024 + 64 * h;
#pragma unroll
            for (int i4 = 0; i4 < 4; ++i4) {
                *(u32x2v*)(yr + 8 * i4 + 4 * hi) = (u32x2v){cvtpk(o0[4 * i4] * inv, o0[4 * i4 + 1] * inv), cvtpk(o0[4 * i4 + 2] * inv, o0[4 * i4 + 3] * inv)};
                *(u32x2v*)(yr + 32 + 8 * i4 + 4 * hi) = (u32x2v){cvtpk(o1[4 * i4] * inv, o1[4 * i4 + 1] * inv), cvtpk(o1[4 * i4 + 2] * inv, o1[4 * i4 + 3] * inv)};
            }
        }
    }
}
constexpr int DSA_LIST_OFF = 150016  , DSA_BUF_ELEMS = 17920  , DSA_SC_STR = 4160, DSA_MW_OFF = 8 * DSA_SC_STR * 4  , DSA_KSTR = 136, DSA_VT_OFF = 64 * DSA_KSTR * 2  ;
__device__ __forceinline__ void ph_dsa(const Ctx& c0, const bf16* U, const float* UF, const bf16* CN, const bf16* KI) {
    const Ctx c = refresh(c0);
    LAS unsigned* SC = (LAS unsigned*)c.lds;
    LAS u64* MW = (LAS u64*)(c.lds + DSA_MW_OFF);
    LAS bf16* KS = (LAS bf16*)c.lds;
    LAS bf16* VT = (LAS bf16*)(c.lds + DSA_VT_OFF);
    const int lane = c.lane, w = c.wave, r32 = lane & 31, hi = lane >> 5, tid = c.tid;
    const float LOG2E = 1.4426950408889634f;
    for (int it = c.bid; it < 1032; it += c.nb) {
        const int rnd = it >> 8, cu = it & 255, g16 = cu >> 4, wi16 = cu & 15;
        const int ch = rnd == 0 ? 64 - g16 : rnd == 1 ? 33 + g16 : rnd == 2 ? 32 - g16 : rnd == 3 ? 1 + g16 : 0;
        const int b = rnd == 4 ? cu : (wi16 >> 1), half = rnd == 4 ? 0 : (wi16 & 1);
        const int p0q = ch == 0 ? 0 : 16 + 64 * (ch - 1) + 32 * half, nq = ch == 0 ? 16 : 32, nadm = ch == 0 ? 16 : 16 + 64 * ch, nw = ch + 1;
        const int t0 = b * L + p0q;
        const bf16* Ub = U + (size_t)(b * L) * NU;
        if (nadm <= TOPK) {
            for (int i = tid; i < 32 * 65; i += NTHR) { const int wd = i % 65; const int lo = 64 * wd; const int nb_ = nadm - lo;
                MW[i] = (wd < nw && nb_ > 0) ? (nb_ >= 64 ? ~0ull : ((1ull << nb_) - 1ull)) : 0ull; }
            __syncthreads();
        } else {
            const int nkb = 2 * nw;
#pragma unroll 1
            for (int sb = 0; sb < 4; ++sb) {
                const int tq = t0 + 8 * sb;
                for (int rs_ = 0; rs_ < REP_SCORE; ++rs_) {
                    bf16x8 aq[4]; float wq[4][4];
#pragma unroll
                    for (int s = 0; s < 4; ++s) aq[s] = *(const bf16x8*)(U + (size_t)(tq + (r32 >> 2)) * NU + C_QI + 64 * (r32 & 3) + 32 * hi + 8 * s);
#pragma unroll
                    for (int i4 = 0; i4 < 4; ++i4) { const f32x4v t4 = *(const f32x4v*)(UF + (size_t)(tq + 2 * i4 + hi) * 32 + 16); wq[i4][0] = t4[0]; wq[i4][1] = t4[1]; wq[i4][2] = t4[2]; wq[i4][3] = t4[3]; }
                    const bf16* kib = KI + (size_t)(b * L) * 64 + (size_t)r32 * 64 + 32 * hi;
                    bf16x8 bk[4], bn[4], bm[4];
#pragma unroll
                    for (int s = 0; s < 4; ++s) { bk[s] = *(const bf16x8*)(kib + (size_t)(32 * w) * 64 + 8 * s); bn[s] = bk[s]; bm[s] = bk[s]; }
                    if (w + NWAVE < nkb) {
#pragma unroll
                        for (int s = 0; s < 4; ++s) bn[s] = *(const bf16x8*)(kib + (size_t)(32 * (w + NWAVE)) * 64 + 8 * s); }
#pragma unroll 1
                    for (int kb = w; kb < nkb; kb += NWAVE) {
                        if (kb + 2 * NWAVE < nkb) {
#pragma unroll
                            for (int s = 0; s < 4; ++s) bm[s] = *(const bf16x8*)(kib + (size_t)(32 * (kb + 2 * NWAVE)) * 64 + 8 * s); }
                        const int key = 32 * kb + r32; f32x16 acc;
#pragma unroll
                        for (int r = 0; r < 16; ++r) acc[r] = 0.f;
#pragma unroll
                        for (int s = 0; s < 4; ++s) acc = MFMA32(aq[s], bk[s], acc);
#pragma unroll
                        for (int i4 = 0; i4 < 4; ++i4) {
                            float s = wq[i4][0] * fmaxf(acc[4 * i4], 0.f) + wq[i4][1] * fmaxf(acc[4 * i4 + 1], 0.f) + wq[i4][2] * fmaxf(acc[4 * i4 + 2], 0.f) + wq[i4][3] * fmaxf(acc[4 * i4 + 3], 0.f);
                            asm("v_add_f32 %0, 0, %0" : "+v"(s));
                            unsigned kv = fkey(s); if (32 * kb + 31 >= nadm) kv = key < nadm ? kv : 0u;
                            SC[(2 * i4 + hi) * DSA_SC_STR + key] = kv;
                        }
#pragma unroll
                        for (int s = 0; s < 4; ++s) { bk[s] = bn[s]; bn[s] = bm[s]; }
                    }
                }
                __syncthreads();
                for (int rs_ = 0; rs_ < REP_SEL; ++rs_) {
                    unsigned kk[65];
#pragma unroll
                    for (int j = 0; j < 65; ++j) kk[j] = 0u;
#define DSA_BUCKETS(F) { F(0, 16) if (nw > 16) { F(16, 32) } if (nw > 32) { F(32, 48) } if (nw > 48) { F(48, 64) } if (nw > 64) { F(64, 65) } }
#define DSA_LOAD(j0, j1) _Pragma("unroll") for (int j = j0; j < j1; ++j) kk[j] = SC[w * DSA_SC_STR + 64 * j + lane];
                    DSA_BUCKETS(DSA_LOAD)
#pragma unroll
                    for (int j = 0; j < 65; ++j) if (j >= 5) kk[j] = j < nw ? kk[j] : 0u;
#define DSA_C4(a, b, c_, d) asm volatile("v_cmp_ge_u32_e64 %1, %5, %9\n\tv_cmp_ge_u32_e64 %2, %6, %9\n\tv_cmp_ge_u32_e64 %3, %7, %9\n\tv_cmp_ge_u32_e64 %4, %8, %9\n\t" \
                        "v_addc_co_u32_e64 %0, vcc, 0, %0, %1\n\tv_addc_co_u32_e64 %0, vcc, 0, %0, %2\n\tv_addc_co_u32_e64 %0, vcc, 0, %0, %3\n\tv_addc_co_u32_e64 %0, vcc, 0, %0, %4" \
                        : "+v"(nl_), "=&s"(m0_), "=&s"(m1_), "=&s"(m2_), "=&s"(m3_) : "v"(a), "v"(b), "v"(c_), "v"(d), "v"(cand_) : "vcc");
#define DSA_CNT16(j0, j1) if (j1 - j0 == 16) { DSA_C4(kk[j0], kk[j0 + 1], kk[j0 + 2], kk[j0 + 3]) DSA_C4(kk[j0 + 4], kk[j0 + 5], kk[j0 + 6], kk[j0 + 7]) DSA_C4(kk[j0 + 8], kk[j0 + 9], kk[j0 + 10], kk[j0 + 11]) DSA_C4(kk[j0 + 12], kk[j0 + 13], kk[j0 + 14], kk[j0 + 15]) } \
                        else { nl_ += kk[64] >= cand_ ? 1 : 0; }
#define DSA_COUNT(CAND, N) { const unsigned cand_ = (CAND); int nl_ = 0; u64 m0_, m1_, m2_, m3_; DSA_BUCKETS(DSA_CNT16) N = 0; \
                        _Pragma("unroll") for (int k_ = 0; k_ < 7; ++k_) N += __popcll(__ballot((nl_ >> k_) & 1)) << k_; }
                    unsigned kmax = 0u;
#define DSA_MAX(j0, j1) _Pragma("unroll") for (int j = j0; j < j1; ++j) kmax = kk[j] > kmax ? kk[j] : kmax;
                    DSA_BUCKETS(DSA_MAX)
#pragma unroll
                    for (int o = 1; o < 64; o <<= 1) { const unsigned t_ = (unsigned)lane_readi((int)kmax, lane ^ o); kmax = t_ > kmax ? t_ : kmax; }
                    kmax = (unsigned)__builtin_amdgcn_readfirstlane((int)kmax);
                    unsigned lo = 0u, hi = (kmax >> 23) + 1u, tau = 0u; int nhi = 0; bool exact = false;
                    {   unsigned step = 1u;
#pragma unroll 1
                        while (hi - lo > 1u) {
                            const unsigned e = step ? (hi - lo > step ? hi - step : lo + 1u) : lo + ((hi - lo) >> 1);
                            int n; DSA_COUNT(e << 23, n)
                            if (n == TOPK) { exact = true; tau = e << 23; break; }
                            if (n > TOPK) { lo = e; step = 0u; } else { hi = e; nhi = n; if (step) step <<= 1; }
                        }
                    }
                    int need = 0;
                    if (!exact) {
                        tau = lo << 23; unsigned width = 1u << 23;
#pragma unroll 1
                        for (int bit = 22; bit >= 20; --bit) { const unsigned cand = tau | (1u << bit); int n; DSA_COUNT(cand, n)
                            if (n == TOPK) { exact = true; tau = cand; break; }
                            if (n > TOPK) tau = cand; else nhi = n;
                            width >>= 1; }
                    }
                    if (!exact) {
                        int nin; DSA_COUNT(tau, nin)
                        const int nc = nin - nhi, needc = TOPK - nhi;
                        if (nc <= 128) {
                            LAS unsigned* lst = (LAS unsigned*)(c.lds + DSA_LIST_OFF) + w * 128; int base = 0;
#define DSA_COMPACT(j0, j1) _Pragma("unroll") for (int j = j0; j < j1; ++j) { const bool inb = (kk[j] - tau) < (1u << 20); const u64 be = __ballot(inb); \
                                if (be != 0ull) { if (inb) lst[base + __popcll(be & ((1ull << lane) - 1ull))] = kk[j]; base += __popcll(be); } }
                            DSA_BUCKETS(DSA_COMPACT)
                            const unsigned c0 = lane < nc ? lst[lane] : 0u, c1 = lane + 64 < nc ? lst[lane + 64] : 0u;
#pragma unroll 1
                            for (int bit = 19; bit >= 0; --bit) { const unsigned cand = tau | (1u << bit);
                                const int n = __popcll(__ballot(c0 >= cand)) + __popcll(__ballot(c1 >= cand));
                                if (n >= needc) tau = cand;
                                if (n == needc) { exact = true; break; } }
                            if (!exact) need = needc - (__popcll(__ballot(c0 > tau)) + __popcll(__ballot(c1 > tau)));
                        } else {
#pragma unroll 1
                            for (int bit = 19; bit >= 0; --bit) { const unsigned cand = tau | (1u << bit); int n; DSA_COUNT(cand, n)
                                if (n >= TOPK) tau = cand;
                                if (n == TOPK) { exact = true; break; } }
                            if (!exact) { int n; DSA_COUNT(tau + 1u, n) need = TOPK - n; }
                        }
                    }
                    int run = 0; unsigned mlo = 0u, mhi = 0u; u64 mine1 = 0ull; const unsigned tsel = exact ? tau : tau + 1u;
#define DSA_SEL(j0, j1) _Pragma("unroll") for (int j = j0; j < j1; ++j) { u64 bs = __ballot(kk[j] >= tsel); \
                        if (!exact) { const u64 be = __ballot(kk[j] == tau); \
                            if (be != 0ull) { const int take = need - run; if (take > 0) { const bool eq = kk[j] == tau; const int rank = __popcll(be & ((1ull << lane) - 1ull)); bs |= __ballot(eq && rank < take); } run += __popcll(be); } } \
                        if (j < 64) { WLANE64(mlo, mhi, bs, j); } else mine1 = bs; }
                    DSA_BUCKETS(DSA_SEL)
                    const u64 mine0 = ((u64)mhi << 32) | mlo;
                    MW[(8 * sb + w) * 65 + lane] = lane < nw ? mine0 : 0ull;
                    if (lane == 0) MW[(8 * sb + w) * 65 + 64] = nw > 64 ? mine1 : 0ull;
                }
                __syncthreads();
            }
        }
        for (int ra_ = 0; ra_ < REP_ATT; ++ra_) {
        bf16x8 qf[8];
        {   LAS bf16* QL = (LAS bf16*)c.lds + w * (32 * 136); const bf16* WUKB = (const bf16*)(pt_get(c, 26) + WS_FCUM + 1536 * 1024);
            bf16x8 qd[4];
#pragma unroll
            for (int s = 0; s < 4; ++s) qd[s] = *(const bf16x8*)(U + (size_t)(t0 + r32) * NU + C_DQ + 64 * w + 16 * s + 8 * hi);
#pragma unroll
            for (int rb = 0; rb < 4; ++rb) {
                f32x16 a_;
#pragma unroll
                for (int r = 0; r < 16; ++r) a_[r] = 0.f;
#pragma unroll
                for (int s = 0; s < 4; ++s) a_ = MFMA32(*(const bf16x8*)(WUKB + (size_t)(w * 128 + 32 * rb + r32) * 64 + 16 * s + 8 * hi), qd[s], a_);
#pragma unroll
                for (int i4 = 0; i4 < 4; ++i4) *(LAS u32x2v*)(QL + r32 * 136 + 32 * rb + 8 * i4 + 4 * hi) = (u32x2v){cvtpk(a_[4 * i4], a_[4 * i4 + 1]), cvtpk(a_[4 * i4 + 2], a_[4 * i4 + 3])};
            }
#pragma unroll
            for (int s = 0; s < 8; ++s) qf[s] = *(const LAS bf16x8*)(QL + r32 * 136 + 16 * s + 8 * hi);
            if (r32 >= nq) {
#pragma unroll
                for (int s = 0; s < 8; ++s) qf[s] = (bf16x8){0, 0, 0, 0, 0, 0, 0, 0}; }
        }
        __syncthreads();
        f32x16 o[4];
#pragma unroll
        for (int db = 0; db < 4; ++db)
#pragma unroll
            for (int r = 0; r < 16; ++r) o[db][r] = 0.f;
        float m = -1e4f, l = 0.f;
        const bf16* Cb = CN + (size_t)(b * L) * 128;
        u32x4v kr0, kr1, vr0, vr1;
        {   const bf16* kp = Cb + (size_t)(tid >> 3) * 128 + 16 * (tid & 7); kr0 = *(const u32x4v*)kp; kr1 = *(const u32x4v*)(kp + 8);
            const bf16* vp = Cb + (size_t)lane * 128 + 16 * w; vr0 = *(const u32x4v*)vp; vr1 = *(const u32x4v*)(vp + 8); }
#define DSA_STAGE(buf) do { LAS bf16* ks_ = KS + (buf) * DSA_BUF_ELEMS; LAS bf16* vt_ = VT + (buf) * DSA_BUF_ELEMS; \
            LAS bf16* kd = ks_ + (tid >> 3) * DSA_KSTR + 16 * (tid & 7); *(LAS u32x4v*)kd = kr0; *(LAS u32x4v*)(kd + 8) = kr1; \
            const unsigned vv[8] = {vr0.x, vr0.y, vr0.z, vr0.w, vr1.x, vr1.y, vr1.z, vr1.w}; \
            _Pragma("unroll") for (int e = 0; e < 16; ++e) vt_[(16 * w + e) * AT_VSTR + lane] = (bf16)(vv[e >> 1] >> (16 * (e & 1))); } while (0)
#define DSA_FETCH(ti) do { const bf16* kp = Cb + (size_t)(64 * (ti) + (tid >> 3)) * 128 + 16 * (tid & 7); kr0 = *(const u32x4v*)kp; kr1 = *(const u32x4v*)(kp + 8); \
            const bf16* vp = Cb + (size_t)(64 * (ti) + lane) * 128 + 16 * w; vr0 = *(const u32x4v*)vp; vr1 = *(const u32x4v*)(vp + 8); } while (0)
        DSA_STAGE(0);
        if (nw > 1) DSA_FETCH(1);
        __syncthreads();
        for (int i = 0; i < nw; ++i) {
            const int cur = i & 1;
            if (i + 1 < nw) { DSA_STAGE(cur ^ 1); if (i + 2 < nw) DSA_FETCH(i + 2); }
            const LAS bf16* ksc = KS + cur * DSA_BUF_ELEMS; const LAS bf16* vtc = VT + cur * DSA_BUF_ELEMS;
            const u64 m64 = MW[r32 * 65 + i];
            if (__ballot(m64 != 0ull) != 0ull) {
                f32x16 p0, p1;
#pragma unroll
                for (int r = 0; r < 16; ++r) { p0[r] = 0.f; p1[r] = 0.f; }
#pragma unroll
                for (int s = 0; s < 8; ++s) {
                    const bf16x8 a0 = *(const LAS bf16x8*)(ksc + r32 * DSA_KSTR + 16 * s + 8 * hi), a1 = *(const LAS bf16x8*)(ksc + (32 + r32) * DSA_KSTR + 16 * s + 8 * hi);
                    p0 = MFMA32(a0, qf[s], p0); p1 = MFMA32(a1, qf[s], p1);
                }
                const unsigned mlo_s = (unsigned)m64 >> (4 * hi), mhi_s = (unsigned)(m64 >> 32) >> (4 * hi);
                float mx = -1e30f, mx2 = -1e30f;
#pragma unroll
                for (int r = 0; r < 16; ++r) {
                    const int kb0 = (r & 3) + 8 * (r >> 2);
                    const unsigned s0 = (unsigned)__builtin_amdgcn_sbfe((int)mlo_s, kb0, 1), s1 = (unsigned)__builtin_amdgcn_sbfe((int)mhi_s, kb0, 1);
                    p0[r] = __uint_as_float((__float_as_uint(p0[r]) & s0) | (0xf149f2cau & ~s0)); p1[r] = __uint_as_float((__float_as_uint(p1[r]) & s1) | (0xf149f2cau & ~s1));
                    if (r & 1) mx = max3f(mx, p0[r], p1[r]); else mx2 = max3f(mx2, p0[r], p1[r]); }
                mx = max3f(mx, mx2, mx2);
                const float mn = max3f(m, mx, lane_read(mx, lane ^ 32)), alpha = __builtin_amdgcn_exp2f(m - mn); const bool grew = __ballot(mn > m) != 0ull; m = mn;
                float sum = 0.f;
#pragma unroll
                for (int r = 0; r < 16; ++r) { p0[r] = __builtin_amdgcn_exp2f(p0[r] - mn); p1[r] = __builtin_amdgcn_exp2f(p1[r] - mn); sum += p0[r] + p1[r]; }
                l = l * alpha + sum;
                if (grew) {
#pragma unroll
                    for (int db = 0; db < 4; ++db)
#pragma unroll
                        for (int r = 0; r < 16; ++r) o[db][r] *= alpha; }
#pragma unroll
                for (int blk = 0; blk < 2; ++blk)
#pragma unroll
                    for (int s = 0; s < 2; ++s) {
                        const bf16x8 xs = pack8(blk == 0 ? p0 : p1, s);
                        typedef short s16x4v __attribute__((ext_vector_type(4)));
                        const LAS bf16* vp = vtc + r32 * AT_VSTR + 32 * blk + 16 * s + 4 * hi;
#pragma unroll
                        for (int db = 0; db < 4; ++db) {
                            const s16x4v lo = *(const LAS s16x4v*)(vp + 32 * db * AT_VSTR), hh = *(const LAS s16x4v*)(vp + 32 * db * AT_VSTR + 8);
                            const bf16x8 pa = __builtin_shufflevector(lo, hh, 0, 1, 2, 3, 4, 5, 6, 7);
                            o[db] = MFMA32(pa, xs, o[db]);
                        }
                    }
            }
            __syncthreads();
        }
        l += lane_read(l, lane ^ 32);
        {
            const float inv = 1.f / l; f32x16 yd0, yd1; const bf16* WUVT = (const bf16*)(pt_get(c, 26) + WS_FCUM + 1792 * 1024);
#pragma unroll
            for (int r = 0; r < 16; ++r) { yd0[r] = 0.f; yd1[r] = 0.f; }
            typedef short s16x4v __attribute__((ext_vector_type(4)));
#pragma unroll
            for (int db = 0; db < 4; ++db) {
#pragma unroll
                for (int r = 0; r < 16; ++r) o[db][r] *= inv;
#pragma unroll
                for (int t = 0; t < 2; ++t) {
                    const bf16x8 xs = pack8(o[db], t);
                    const bf16* wp = WUVT + (size_t)(w * 64 + r32) * 128 + 32 * db + 16 * t + 4 * hi;
                    const s16x4v l0 = *(const s16x4v*)wp, h0 = *(const s16x4v*)(wp + 8), l1 = *(const s16x4v*)(wp + 32 * 128), h1 = *(const s16x4v*)(wp + 32 * 128 + 8);
                    yd0 = MFMA32(__builtin_shufflevector(l0, h0, 0, 1, 2, 3, 4, 5, 6, 7), xs, yd0); yd1 = MFMA32(__builtin_shufflevector(l1, h1, 0, 1, 2, 3, 4, 5, 6, 7), xs, yd1);
                }
            }
            if (r32 < nq) { bf16* yr = (bf16*)(pt_get(c, 26) + WS_Y) + (size_t)(t0 + r32) * KOUT + 1536 + 64 * w;
#pragma unroll
                for (int i4 = 0; i4 < 4; ++i4) {
                    *(u32x2v*)(yr + 8 * i4 + 4 * hi) = (u32x2v){cvtpk(yd0[4 * i4], yd0[4 * i4 + 1]), cvtpk(yd0[4 * i4 + 2], yd0[4 * i4 + 3])};
                    *(u32x2v*)(yr + 32 + 8 * i4 + 4 * hi) = (u32x2v){cvtpk(yd1[4 * i4], yd1[4 * i4 + 1]), cvtpk(yd1[4 * i4 + 2], yd1[4 * i4 + 3])}; }
            }
        }
        }
    }
}

__device__ __forceinline__ float wave_scan_incl(float v, int lane) {
#pragma unroll
    for (int o = 1; o < 64; o <<= 1) { const float n = lane_read(v, (lane - o) & 63); if (lane >= o) v += n; }
    return v;
}
__device__ __forceinline__ void ph_ssd_states(const Ctx& c0, const bf16* XC, const float* DT, const float* a_log, bf16* ST, float* CD) {
    const Ctx c = refresh(c0);
    const int lane = c.lane, w = c.wave, r32 = lane & 31, hi = lane >> 5, g = w >> 2;
    LAS bf16* XT = (LAS bf16*)c.lds + w * (64 * 72);
    LAS bf16* BT = (LAS bf16*)(c.lds + 73728);
    const float a_neg = -__expf(a_log[w]);
    for (int it = c.bid; it < NB * 65; it += c.nb) {
        const int b = it < 512 ? it >> 6 : it - 512, ch = it < 512 ? 1 + (it & 63) : 0, pseq = 64 * ch - 48 + lane;
        const bool valid = pseq >= 0; const size_t t = (size_t)(b * L + (valid ? pseq : 0));
        const float dtv = valid ? DT[t * 8 + w] : 0.f, acs = wave_scan_incl(dtv * a_neg, lane), tot = lane_read(acs, 63), scale = dtv * __expf(tot - acs);
        if (lane == 0) CD[(b * 65 + ch) * 8 + w] = __expf(tot);
        const bf16* xrow = XC + t * 1024 + 64 * w;
#pragma unroll
        for (int q = 0; q < 8; ++q) { u32x4v v = (u32x4v){0u, 0u, 0u, 0u}; if (valid) v = *(const u32x4v*)(xrow + 8 * q); const unsigned vv[4] = {v.x, v.y, v.z, v.w};
#pragma unroll
            for (int e = 0; e < 8; ++e) XT[(8 * q + e) * 72 + lane] = f2bf(bf2f((bf16)(vv[e >> 1] >> (16 * (e & 1)))) * scale); }
        const bf16* brow = XC + t * 1024 + 512 + 32 * w;
#pragma unroll
        for (int q = 0; q < 4; ++q) { u32x4v v = (u32x4v){0u, 0u, 0u, 0u}; if (valid) v = *(const u32x4v*)(brow + 8 * q); const unsigned vv[4] = {v.x, v.y, v.z, v.w};
#pragma unroll
            for (int e = 0; e < 8; ++e) BT[(32 * w + 8 * q + e) * 72 + lane] = (bf16)(vv[e >> 1] >> (16 * (e & 1))); }
        __syncthreads();
        bf16* st = ST + ((size_t)(b * 65 + ch) * 8 + w) * 8192;
#pragma unroll 1
        for (int pb = 0; pb < 2; ++pb)
#pragma unroll 1
            for (int nb = 0; nb < 4; ++nb) {
                f32x16 acc;
#pragma unroll
                for (int r = 0; r < 16; ++r) acc[r] = 0.f;
#pragma unroll
                for (int s = 0; s < 4; ++s) { const bf16x8 a = *(const LAS bf16x8*)(XT + (32 * pb + r32) * 72 + 16 * s + 8 * hi), bb = *(const LAS bf16x8*)(BT + (128 * g + 32 * nb + r32) * 72 + 16 * s + 8 * hi);
                    acc = MFMA32(a, bb, acc); }
#pragma unroll
                for (int r = 0; r < 16; ++r) st[(32 * pb + crow(r, hi)) * 128 + 32 * nb + r32] = f2bf(acc[r]);
            }
        __syncthreads();
    }
}
__device__ __forceinline__ void ph_ssd_scan(const Ctx& c0, bf16* ST, const float* CD) {
    const Ctx c = refresh(c0);
    for (int idx = c.bid * NTHR + c.tid; idx < NB * 8 * 64 * 32; idx += c.nb * NTHR) {
        const int n4 = idx & 31, p = (idx >> 5) & 63, h = (idx >> 11) & 7, b = idx >> 14;
        float h0 = 0.f, h1 = 0.f, h2 = 0.f, h3 = 0.f;
        bf16* base = ST + ((size_t)(b * 65) * 8 + h) * 8192 + p * 128 + 4 * n4; const float* cd = CD + (size_t)(b * 65) * 8 + h;
#pragma unroll 1
        for (int c5 = 0; c5 < 65; c5 += 5) {
            u32x2v v[5]; float d[5];
#pragma unroll
            for (int q = 0; q < 5; ++q) { v[q] = *(const u32x2v*)(base + (size_t)(c5 + q) * 8 * 8192); d[q] = cd[(c5 + q) * 8]; }
#pragma unroll
            for (int q = 0; q < 5; ++q) {
                *(u32x2v*)(base + (size_t)(c5 + q) * 8 * 8192) = (u32x2v){pk2(h0, h1), pk2(h2, h3)};
                h0 = d[q] * h0 + bf2f((bf16)(v[q].x & 0xffff)); h1 = d[q] * h1 + bf2f((bf16)(v[q].x >> 16)); h2 = d[q] * h2 + bf2f((bf16)(v[q].y & 0xffff)); h3 = d[q] * h3 + bf2f((bf16)(v[q].y >> 16)); }
        }
    }
}
__device__ __forceinline__ void ph_ssd_out(const Ctx& c0, const bf16* XC, const bf16* U, const float* DT, const float* a_log, const float* dsk, const bf16* ST, bf16* Y) {
    const Ctx c = refresh(c0);
    const int lane = c.lane, w = c.wave, r32 = lane & 31, hi = lane >> 5, g = w >> 2;
    LAS bf16* XT = (LAS bf16*)c.lds + w * (64 * 72);
    LAS float* ACS = (LAS float*)(c.lds + 73728) + w * 64;
    LAS float* SS = (LAS float*)(c.lds + 73728 + 2048);
    const float a_neg = -__expf(a_log[w]), Dk = dsk[w];
    typedef short s16x4v __attribute__((ext_vector_type(4)));
    for (int it = c.bid; it < NB * 65; it += c.nb) {
        const int b = it < 512 ? it >> 6 : it - 512, ch = it < 512 ? 1 + (it & 63) : 0, p0 = 64 * ch - 48, pseq = p0 + lane; const bool valid = pseq >= 0; const size_t t = (size_t)(b * L + (valid ? pseq : 0));
        const float dtv = valid ? DT[t * 8 + w] : 0.f, acs = wave_scan_incl(dtv * a_neg, lane);
        ACS[lane] = acs;
        {   const bf16* xrow = XC + t * 1024 + 64 * w;
#pragma unroll
            for (int q = 0; q < 8; ++q) { u32x4v v = (u32x4v){0u, 0u, 0u, 0u}; if (valid) v = *(const u32x4v*)(xrow + 8 * q); const unsigned vv[4] = {v.x, v.y, v.z, v.w};
#pragma unroll
                for (int e = 0; e < 8; ++e) XT[(8 * q + e) * 72 + lane] = f2bf(bf2f((bf16)(vv[e >> 1] >> (16 * (e & 1)))) * dtv); } }
        const bool vl0 = p0 + r32 >= 0, vl1 = p0 + 32 + r32 >= 0;
        const size_t tl0 = (size_t)(b * L + (vl0 ? p0 + r32 : 0)), tl1 = (size_t)(b * L + (vl1 ? p0 + 32 + r32 : 0));
        f32x16 acc[2][2];
#pragma unroll
        for (int pb = 0; pb < 2; ++pb)
#pragma unroll
            for (int lb = 0; lb < 2; ++lb)
#pragma unroll
                for (int r = 0; r < 16; ++r) acc[pb][lb][r] = 0.f;
        const bf16* hin = ST + ((size_t)(b * 65 + ch) * 8 + w) * 8192;
        if (ch != 0) {
#pragma unroll
        for (int k = 0; k < 8; ++k) {
            bf16x8 c0f = (bf16x8){0, 0, 0, 0, 0, 0, 0, 0}, c1f = c0f;
            if (vl0) c0f = *(const bf16x8*)(XC + tl0 * 1024 + 768 + 128 * g + 16 * k + 8 * hi);
            if (vl1) c1f = *(const bf16x8*)(XC + tl1 * 1024 + 768 + 128 * g + 16 * k + 8 * hi);
            const bf16x8 h0f = *(const bf16x8*)(hin + (size_t)r32 * 128 + 16 * k + 8 * hi), h1f = *(const bf16x8*)(hin + (size_t)(32 + r32) * 128 + 16 * k + 8 * hi);
            acc[0][0] = MFMA32(h0f, c0f, acc[0][0]); acc[0][1] = MFMA32(h0f, c1f, acc[0][1]); acc[1][0] = MFMA32(h1f, c0f, acc[1][0]); acc[1][1] = MFMA32(h1f, c1f, acc[1][1]);
        }
        }
        const float acl0 = ACS[r32], acl1 = ACS[32 + r32], e0 = __expf(acl0), e1 = __expf(acl1);
#pragma unroll
        for (int pb = 0; pb < 2; ++pb)
#pragma unroll
            for (int r = 0; r < 16; ++r) { acc[pb][0][r] *= e0; acc[pb][1][r] *= e1; }
#pragma unroll
        for (int sb = 0; sb < 2; ++sb)
#pragma unroll
            for (int lb = sb; lb < 2; ++lb) if (!(ch == 0 && sb == 0)) {
                f32x16 x;
#pragma unroll
                for (int r = 0; r < 16; ++r) x[r] = 0.f;
                const bool vs = p0 + 32 * sb + r32 >= 0; const size_t ts = (size_t)(b * L + (vs ? p0 + 32 * sb + r32 : 0));
                const bool vl = lb == 0 ? vl0 : vl1; const size_t tl = lb == 0 ? tl0 : tl1;
#pragma unroll
                for (int k = 0; k < 8; ++k) {
                    bf16x8 bf_ = (bf16x8){0, 0, 0, 0, 0, 0, 0, 0}, cf_ = bf_;
                    if (vs) bf_ = *(const bf16x8*)(XC + ts * 1024 + 512 + 128 * g + 16 * k + 8 * hi);
                    if (vl) cf_ = *(const bf16x8*)(XC + tl * 1024 + 768 + 128 * g + 16 * k + 8 * hi);
                    x = MFMA32(bf_, cf_, x);
                }
                const float acl = lb == 0 ? acl0 : acl1; const int lrow = 32 * lb + r32;
#pragma unroll
                for (int i4 = 0; i4 < 4; ++i4) { const f32x4v as = *(const LAS f32x4v*)(ACS + 32 * sb + 8 * i4 + 4 * hi);
#pragma unroll
                    for (int e = 0; e < 4; ++e) { const int srow = 32 * sb + 8 * i4 + 4 * hi + e; x[4 * i4 + e] = srow <= lrow ? x[4 * i4 + e] * __expf(fminf(acl - as[e], 0.f)) : 0.f; } }
#pragma unroll
                for (int ks = 0; ks < 2; ++ks) {
                    const bf16x8 xs = pack8(x, ks);
#pragma unroll
                    for (int pb = 0; pb < 2; ++pb) {
                        const LAS bf16* vp = XT + (32 * pb + r32) * 72 + 32 * sb + 16 * ks + 4 * hi;
                        const s16x4v lo = *(const LAS s16x4v*)vp, hh = *(const LAS s16x4v*)(vp + 8);
                        const bf16x8 pa = __builtin_shufflevector(lo, hh, 0, 1, 2, 3, 4, 5, 6, 7);
                        if (lb == 0) acc[pb][0] = MFMA32(pa, xs, acc[pb][0]); else acc[pb][1] = MFMA32(pa, xs, acc[pb][1]);
                    }
                }
            }
        float ssq0 = 0.f, ssq1 = 0.f;
#pragma unroll
        for (int lb = 0; lb < 2; ++lb) { const bool vl = lb == 0 ? vl0 : vl1; const size_t tl = lb == 0 ? tl0 : tl1;
#pragma unroll
            for (int pb = 0; pb < 2; ++pb)
#pragma unroll
                for (int i4 = 0; i4 < 4; ++i4) { const int pc = 64 * w + 32 * pb + 8 * i4 + 4 * hi;
                    u32x2v xv = (u32x2v){0u, 0u}, zv = xv;
                    if (vl) { xv = *(const u32x2v*)(XC + tl * 1024 + pc); zv = *(const u32x2v*)(U + tl * NU + C_Z + pc); }
                    const float xe[4] = {bf2f((bf16)(xv.x & 0xffff)), bf2f((bf16)(xv.x >> 16)), bf2f((bf16)(xv.y & 0xffff)), bf2f((bf16)(xv.y >> 16))};
                    const float ze[4] = {bf2f((bf16)(zv.x & 0xffff)), bf2f((bf16)(zv.x >> 16)), bf2f((bf16)(zv.y & 0xffff)), bf2f((bf16)(zv.y >> 16))};
#pragma unroll
                    for (int e = 0; e < 4; ++e) { const float y = acc[pb][lb][4 * i4 + e] + Dk * xe[e], gz = y * siluf(ze[e]); acc[pb][lb][4 * i4 + e] = gz; if (lb == 0) ssq0 += gz * gz; else ssq1 += gz * gz; } } }
        ssq0 += lane_read(ssq0, lane ^ 32); ssq1 += lane_read(ssq1, lane ^ 32);
        if (hi == 0) { SS[w * 64 + r32] = ssq0; SS[w * 64 + 32 + r32] = ssq1; }
        __syncthreads();
        const float tot0 = SS[(4 * g) * 64 + r32] + SS[(4 * g + 1) * 64 + r32] + SS[(4 * g + 2) * 64 + r32] + SS[(4 * g + 3) * 64 + r32];
        const float tot1 = SS[(4 * g) * 64 + 32 + r32] + SS[(4 * g + 1) * 64 + 32 + r32] + SS[(4 * g + 2) * 64 + 32 + r32] + SS[(4 * g + 3) * 64 + 32 + r32];
        const float rs0 = rsqrtf(tot0 * (1.f / 256.f) + EPSF), rs1 = rsqrtf(tot1 * (1.f / 256.f) + EPSF);
#pragma unroll
        for (int lb = 0; lb < 2; ++lb) { const bool vl = lb == 0 ? vl0 : vl1; const size_t tl = lb == 0 ? tl0 : tl1; const float rs = lb == 0 ? rs0 : rs1;
            if (vl) {
#pragma unroll
                for (int pb = 0; pb < 2; ++pb)
#pragma unroll
                    for (int i4 = 0; i4 < 4; ++i4)
                        *(u32x2v*)(Y + tl * KOUT + 64 * w + 32 * pb + 8 * i4 + 4 * hi) = (u32x2v){cvtpk(acc[pb][lb][4 * i4] * rs, acc[pb][lb][4 * i4 + 1] * rs), cvtpk(acc[pb][lb][4 * i4 + 2] * rs, acc[pb][lb][4 * i4 + 3] * rs)};
            } }
        __syncthreads();
    }
}

__device__ __forceinline__ void ph_resid(const Ctx& c0, const bf16* MIX, const float* g, bf16* XB, float* RSTD, float* dout) { const Ctx c = refresh(c0);
    const int lane = c.lane;
    for (int t = c.gw; t < T; t += c.ngw) {
        float mv[32], xv[32]; float ss = 0.f;
#pragma unroll
        for (int j = 0; j < 4; ++j) { const u32x4v v = *(const u32x4v*)(MIX + (size_t)t * DM + 8 * lane + 512 * j), xx = *(const u32x4v*)(XB + (size_t)t * DM + 8 * lane + 512 * j);
            const unsigned w[4] = {v.x, v.y, v.z, v.w}, xw[4] = {xx.x, xx.y, xx.z, xx.w};
#pragma unroll
            for (int i = 0; i < 8; ++i) { const float f = bf2f((bf16)(w[i >> 1] >> (16 * (i & 1)))); mv[8 * j + i] = f; ss += f * f; xv[8 * j + i] = bf2f((bf16)(xw[i >> 1] >> (16 * (i & 1)))); } }
        const float rs = rsqrtf(wave_sum(ss, lane) * (1.f / DM) + EPSF);
        float s2 = 0.f;
        const int b = t / L, p = t - b * L; float* orow = (dout != nullptr && p >= NMETA) ? dout + ((size_t)b * SEQ + (p - NMETA)) * DM : nullptr;
#pragma unroll
        for (int j = 0; j < 4; ++j) { const int cc = 8 * lane + 512 * j;
            const f32x4v ga = *(const f32x4v*)(g + cc), gb = *(const f32x4v*)(g + cc + 4); float a[8];
#pragma unroll
            for (int i = 0; i < 4; ++i) { a[i] = xv[8 * j + i] + mv[8 * j + i] * rs * ga[i]; a[4 + i] = xv[8 * j + 4 + i] + mv[8 * j + 4 + i] * rs * gb[i]; }
#pragma unroll
            for (int i = 0; i < 8; ++i) s2 += a[i] * a[i];
            if (orow) { *(f32x4v*)(orow + cc) = (f32x4v){a[0], a[1], a[2], a[3]}; *(f32x4v*)(orow + cc + 4) = (f32x4v){a[4], a[5], a[6], a[7]}; }
            *(u32x4v*)(XB + (size_t)t * DM + cc) = (u32x4v){pk2(a[0], a[1]), pk2(a[2], a[3]), pk2(a[4], a[5]), pk2(a[6], a[7])}; }
        s2 = wave_sum(s2, lane);
        if (lane == 0) RSTD[t] = rsqrtf(s2 * (1.f / DM) + EPSF);
    }
}

__device__ __forceinline__ void gemm_meta_rows(const Ctx& c, const bf16* A, const bf16* Bt, bf16* O, int N, int K, int ldc, const float* rs, float* UF, float* O32 = nullptr) {
    const int lane = c.lane, r32 = lane & 31, hi = lane >> 5, w = c.wave;
    LAS float* red = (LAS float*)c.lds;
    for (int strip = c.bid; strip < N / 32; strip += c.nb) {
        const bf16* ap = A + (size_t)(r32 & 15) * K + 8 * hi; const bf16* bp = Bt + (size_t)(32 * strip + r32) * K + 8 * hi;
        f32x16 acc;
#pragma unroll
        for (int r = 0; r < 16; ++r) acc[r] = 0.f;
#pragma unroll 4
        for (int s = w; s < K / 16; s += NWAVE) acc = MFMA32(*(const bf16x8*)(ap + 16 * s), *(const bf16x8*)(bp + 16 * s), acc);
#pragma unroll
        for (int r = 0; r < 8; ++r) red[(w * 8 + r) * 64 + lane] = acc[r];
        __syncthreads();
        if (w == 0) {
            float v8[8];
#pragma unroll
            for (int r = 0; r < 8; ++r) { float t = 0.f;
#pragma unroll
                for (int ww = 0; ww < NWAVE; ++ww) t += red[(ww * 8 + r) * 64 + lane];
                v8[r] = t * (rs ? rs[crow(r, hi)] : 1.f); }
            const int n = 32 * strip + r32; const bool sm = UF != nullptr && n >= C_SM && n < C_SM + 32;
            if (O32) {
#pragma unroll
                for (int r = 0; r < 8; ++r) O32[(size_t)crow(r, hi) * N + n] = v8[r];
            } else
#pragma unroll 1
            for (int b = 0; b < NB; ++b) {
                bf16* ob = O + (size_t)(b * L) * ldc + n; float* ub = UF + (size_t)(b * L) * 32 + (n - C_SM);
#pragma unroll
                for (int r = 0; r < 8; ++r) { const int p = crow(r, hi); ob[(size_t)p * ldc] = f2bf(v8[r]); if (sm) ub[(size_t)p * 32] = v8[r]; }
            }
        }
        __syncthreads();
    }
}
__device__ __forceinline__ void ph_gemm_plain(const Ctx& c0, const bf16* A, const bf16* Bt, bf16* O, int N, int K, int ldc, const float* rs, float* UF, int wgm) { const Ctx c = refresh(c0);
    gemm_meta_rows(c, A, Bt, O, N, K, ldc, rs, UF);
    pg8::StaticOrder S; S.init(128 * 256, N, c.nb, c.bid, wgm);
    pg8::Gemm g{A, Bt, 128 * 256, N, K, (size_t)256 * K * 2, 1};
    pg8::EpiBf16Plain E{O, ldc, rs, UF, C_SM, 1};
    pg8::gemm_phase<pg8::EpiBf16Plain, pg8::StaticOrder, true, true>(c.lds, g, S, E, c.tid);
}
__device__ __forceinline__ void ph_gemm_gateup(const Ctx& c0, const bf16* XB, const bf16* Bt, bf16* H, const float* rs, const float* cw, const float* cb, float* FXG, float* FXU, float* HB, float* GUM) { const Ctx c = refresh(c0);
    gemm_meta_rows(c, XB, Bt, nullptr, NGU, DM, 0, rs, nullptr, GUM);
    pg8::StaticOrder S; S.init(128 * 256, NGU, c.nb, c.bid, WGM_GU);
    pg8::Gemm g{XB, Bt, 128 * 256, NGU, DM, (size_t)256 * DM * 2, 1};
    pg8::EpiGateUp E{H, rs, cw, cb, (LAS float*)(c.lds + HALO_OFF), FXG, FXU, HB};
    pg8::gemm_phase<pg8::EpiGateUp, pg8::StaticOrder, true, true>(c.lds, g, S, E, c.tid);
}
__device__ __forceinline__ void ph_ffn_fixup(const Ctx& c0, bf16* H, const float* cw, const float* cb, const float* FXG, const float* FXU, const float* HB, const float* GUM) { const Ctx c = refresh(c0);
    const int gt = c.bid * NTHR + c.tid, ngt = c.nb * NTHR;
    for (int idx = gt; idx < 128 * (FF / 4); idx += ngt) {
        const int pm = idx / (FF / 4), ch = (idx - pm * (FF / 4)) * 4, pn = ch >> 7, cl = ch & 127;
        const f32x4v g0 = *(const f32x4v*)(FXG + ((size_t)pm * 2) * FF + ch), g1 = *(const f32x4v*)(FXG + ((size_t)pm * 2 + 1) * FF + ch);
        const f32x4v u0 = *(const f32x4v*)(FXU + ((size_t)pm * 2) * FF + ch), u1 = *(const f32x4v*)(FXU + ((size_t)pm * 2 + 1) * FF + ch);
        f32x4v hm2, hm1;
        if ((pm & 15) == 0) { hm2 = *(const f32x4v*)(GUM + (size_t)14 * NGU + 256 * pn + cl); hm1 = *(const f32x4v*)(GUM + (size_t)15 * NGU + 256 * pn + cl); }
        else { hm2 = *(const f32x4v*)(HB + ((size_t)(pm - 1) * 2) * FF + ch); hm1 = *(const f32x4v*)(HB + ((size_t)(pm - 1) * 2 + 1) * FF + ch); }
        const f32x4v w0 = *(const f32x4v*)(cw + ch), w1 = *(const f32x4v*)(cw + FF + ch), w2 = *(const f32x4v*)(cw + 2 * FF + ch), bb = *(const f32x4v*)(cb + ch);
        const f32x4v c0v = bb + w2 * g0 + w1 * hm1 + w0 * hm2, c1v = bb + w2 * g1 + w1 * g0 + w0 * hm1;
        const size_t row = (size_t)pg8::tile_row0(1, pm);
        *(u32x2v*)(H + row * FF + ch) = (u32x2v){pk2(siluf(c0v[0]) * u0[0], siluf(c0v[1]) * u0[1]), pk2(siluf(c0v[2]) * u0[2], siluf(c0v[3]) * u0[3])};
        *(u32x2v*)(H + (row + 1) * FF + ch) = (u32x2v){pk2(siluf(c1v[0]) * u1[0], siluf(c1v[1]) * u1[1]), pk2(siluf(c1v[2]) * u1[2], siluf(c1v[3]) * u1[3])};
    }
    for (int idx = gt; idx < 16 * (FF / 4); idx += ngt) {
        const int p = idx / (FF / 4), ch = (idx - p * (FF / 4)) * 4, pn = ch >> 7, cl = ch & 127;
        const float* gr = GUM + (size_t)p * NGU + 256 * pn + cl;
        const f32x4v g = *(const f32x4v*)gr, up = *(const f32x4v*)(gr + 128);
        f32x4v gm1 = (f32x4v){0.f, 0.f, 0.f, 0.f}, gm2 = gm1;
        if (p >= 1) gm1 = *(const f32x4v*)(gr - NGU);
        if (p >= 2) gm2 = *(const f32x4v*)(gr - 2 * NGU);
        const f32x4v w0 = *(const f32x4v*)(cw + ch), w1 = *(const f32x4v*)(cw + FF + ch), w2 = *(const f32x4v*)(cw + 2 * FF + ch), bb = *(const f32x4v*)(cb + ch);
        const f32x4v cv = bb + w2 * g + w1 * gm1 + w0 * gm2;
        const u32x2v o = (u32x2v){pk2(siluf(cv[0]) * up[0], siluf(cv[1]) * up[1]), pk2(siluf(cv[2]) * up[2], siluf(cv[3]) * up[3])};
#pragma unroll
        for (int b = 0; b < NB; ++b) *(u32x2v*)(H + (size_t)(b * L + p) * FF + ch) = o;
    }
}

constexpr int REP_PREPW = 1, REP_G1 = 1, REP_G2 = 1, REP_G3 = 1, REP_G4 = 1, REP_M1 = 1, REP_SSD = 1, REP_FOX = 1, REP_DSA = 1;
__global__ void __launch_bounds__(NTHR, 2) fwd_mega(Args A) {
    extern __shared__ __attribute__((aligned(16))) unsigned char lds_raw[];
    cg::grid_group grid = cg::this_grid();
    Ctx c; c.tid = threadIdx.x; c.lane = c.tid & 63; c.wave = __builtin_amdgcn_readfirstlane(c.tid >> 6); c.bid = blockIdx.x; c.nb = gridDim.x;
    c.gw = c.bid * NWAVE + c.wave; c.ngw = c.nb * NWAVE; c.lds = (LAS unsigned char*)lds_raw;
    if (c.tid == 0) { LAS unsigned long long* PT = (LAS unsigned long long*)(c.lds + PT_OFF);
#pragma unroll
        for (int i = 0; i < 25; ++i) PT[i] = (unsigned long long)A.in[i];
        PT[25] = (unsigned long long)A.out; PT[26] = (unsigned long long)A.ws; }
    if (c.tid < 2) ((LAS unsigned*)(c.lds + MISC_OFF))[c.tid] = 0u;
    __syncthreads();
    (void)xcd_barrier_post((unsigned*)(A.ws + WS_CTL) + CW_BAR, (volatile LAS unsigned*)(c.lds + MISC_OFF), c.tid);
#define WSP(off) (pt_get(c, 26) + (off))
#define DOUT ((float*)pt_get(c, 25))
#define P_WIN ((bf16*)WSP(WS_WIN))
#define P_WOUT ((bf16*)WSP(WS_WOUT))
#define P_WGU ((bf16*)WSP(WS_WGU))
#define P_WDN ((bf16*)WSP(WS_WDN))
#define P_METAX ((float*)WSP(WS_METAX))
#define P_RSTD ((float*)WSP(WS_RSTD))
#define P_UF ((float*)WSP(WS_UF))
#define P_DT ((float*)WSP(WS_DT))
#define P_FCUM ((float*)WSP(WS_FCUM))
#define P_CN ((bf16*)WSP(WS_CN))
#define P_MASK ((u64*)WSP(WS_MASK))
#define P_KI ((bf16*)WSP(WS_MASK))
#define P_XB ((bf16*)WSP(WS_XB) + (size_t)8 * DM)
#define P_Y ((bf16*)WSP(WS_Y))
#define P_U ((bf16*)WSP(WS_R1))
#define P_XC ((bf16*)WSP(WS_XC))
#define P_H ((bf16*)WSP(WS_R1))
#define P_MIX ((bf16*)WSP(WS_R1))
#define P_MIX2 ((bf16*)WSP(WS_Y))
#define P_ST ((bf16*)WSP(WS_YA))
#define P_CD ((float*)WSP(WS_DT + 1536 * 1024))
#define P_WUV ((bf16*)WSP(WS_FCUM + 1792 * 1024))
#define P_FXG ((float*)WSP(WS_FIX))
#define P_FXU ((float*)WSP(WS_FIX + 6 * MiB))
#define P_HB ((float*)WSP(WS_FIX + 12 * MiB))
#define P_GUM ((float*)WSP(WS_FIX + 18 * MiB))
#define P_WUK ((bf16*)WSP(WS_FCUM + 1536 * 1024))
    ph_prep_x(c, INP(0), INP(1), P_XB, P_RSTD);
    ph_prep_w(c, 0, P_WIN, P_WOUT, P_WGU, P_WDN, P_WUK, P_WUV);
    grid.sync();
#define LAYER_BODY(ly) do { \
        for (int rep = 0; rep < REP_G1; ++rep) ph_gemm_plain(c, P_XB, P_WIN, P_U, NU, DM, NU, P_RSTD, P_UF, WGM_IN); \
        grid_barrier(c); \
        for (int rep = 0; rep < REP_M1; ++rep) { \
        ph_mixprep(c, P_U, P_UF, INP(7) + (size_t)ly * 4 * 1024, INP(8) + (size_t)ly * 1024, INP(16) + (size_t)ly * 128, INP(9) + (size_t)ly * 8, P_XC, P_Y, P_CN, P_DT, P_KI); \
        ph_fcum(c, P_UF, INP(15) + (size_t)ly * 8, P_FCUM); } \
        grid_barrier(c); \
        for (int rep = 0; rep < REP_SSD; ++rep) ph_ssd_states(c, P_XC, P_DT, INP(10) + (size_t)ly * 8, P_ST, P_CD); \
        for (int rep = 0; rep < REP_FOX; ++rep) ph_fox(c, P_U, P_FCUM, P_Y); \
        grid_barrier(c); \
        ph_ssd_scan(c, P_ST, P_CD); \
        for (int rep = 0; rep < REP_DSA; ++rep) ph_dsa(c, P_U, P_UF, P_CN, P_KI); \
        grid_barrier(c); \
        for (int rep = 0; rep < REP_SSD; ++rep) ph_ssd_out(c, P_XC, P_U, P_DT, INP(10) + (size_t)ly * 8, INP(11) + (size_t)ly * 8, P_ST, P_Y); \
        grid_barrier(c); \
        for (int rep = 0; rep < REP_G2; ++rep) ph_gemm_plain(c, P_Y, P_WOUT, P_MIX, DM, KOUT, DM, nullptr, nullptr, WGM_OUT); \
        grid_barrier(c); \
        ph_resid(c, P_MIX, INP(3) + (size_t)ly * DM, P_XB, P_RSTD, nullptr); \
        grid_barrier(c); \
        for (int rep = 0; rep < REP_G3; ++rep) ph_gemm_gateup(c, P_XB, P_WGU, P_H, P_RSTD, INP(22) + (size_t)ly * 3 * FF, INP(23) + (size_t)ly * FF, P_FXG, P_FXU, P_HB, P_GUM); \
        grid_barrier(c); \
        ph_ffn_fixup(c, P_H, INP(22) + (size_t)ly * 3 * FF, INP(23) + (size_t)ly * FF, P_FXG, P_FXU, P_HB, P_GUM); \
        grid_barrier(c); \
        for (int rep = 0; rep < REP_G4; ++rep) ph_gemm_plain(c, P_H, P_WDN, P_MIX2, DM, FF, DM, nullptr, nullptr, WGM_DN); \
        grid_barrier(c); \
        ph_resid(c, P_MIX2, INP(5) + (size_t)ly * DM, P_XB, P_RSTD, (ly) == DEPTH - 1 ? DOUT : nullptr); \
        if ((ly) + 1 < DEPTH) { for (int rep = 0; rep < REP_PREPW; ++rep) ph_prep_w(c, (ly) + 1, P_WIN, P_WOUT, P_WGU, P_WDN, P_WUK, P_WUV);     \
            grid_barrier(c); } \
    } while (0)
    LAYER_BODY(0); LAYER_BODY(1); LAYER_BODY(2); LAYER_BODY(3);
}

extern "C" void kernel_launch(void* const* d_in, const int* in_sizes, int n_in, void* d_out, int out_size, void* d_ws, size_t ws_size, hipStream_t stream) {
    static int grid_blocks = 0;
    if (grid_blocks == 0) {
        if (n_in != 25 || in_sizes[0] != NB * SEQ * DM || out_size != NB * SEQ * DM || ws_size < WS_END) { fprintf(stderr, "kernel_launch: unexpected shapes (n_in %d in0 %d out %d ws %zu)\n", n_in, n_in > 0 ? in_sizes[0] : -1, out_size, ws_size); grid_blocks = -1; return; }
        int dev = 0, cus = 0, per_cu = 0;
        (void)hipGetDevice(&dev); (void)hipDeviceGetAttribute(&cus, hipDeviceAttributeMultiprocessorCount, dev);
        if (hipFuncSetAttribute((const void*)fwd_mega, hipFuncAttributeMaxDynamicSharedMemorySize, LDS_BYTES) != hipSuccess) { fprintf(stderr, "kernel_launch: hipFuncSetAttribute failed\n"); grid_blocks = -1; return; }
        if (hipOccupancyMaxActiveBlocksPerMultiprocessor(&per_cu, (const void*)fwd_mega, NTHR, LDS_BYTES) != hipSuccess || per_cu < 1) { fprintf(stderr, "kernel_launch: occupancy query says %d blocks/CU\n", per_cu); grid_blocks = -1; return; }
        grid_blocks = cus;
        fprintf(stderr, "kernel_launch: %d CUs, %d blocks/CU by the occupancy query, grid %d\n", cus, per_cu, grid_blocks);
    }
    if (grid_blocks < 0) return;
    if (hipMemsetAsync((char*)d_ws + WS_CTL, 0, 65536, stream) != hipSuccess) { fprintf(stderr, "kernel_launch: memset failed\n"); return; }
    Args a{};
    for (int i = 0; i < 25; ++i) a.in[i] = (const float*)d_in[i];
    a.out = (float*)d_out; a.ws = (unsigned char*)d_ws;
    void* args[] = {&a};
    hipError_t e = hipLaunchCooperativeKernel((const void*)fwd_mega, dim3(grid_blocks), dim3(NTHR), args, LDS_BYTES, stream);
    if (e != hipSuccess) fprintf(stderr, "kernel_launch: cooperative launch failed: %s (grid %d)\n", hipGetErrorString(e), grid_blocks);
}
```

```cpp
#include <hip/hip_runtime.h>
#include <cstdio>
#include <cstdint>

constexpr int NB = 8, SEQ = 4096, NMETA = 16, L = SEQ + NMETA  , T = NB * L  , MP = 33024  , DM = 2048;
constexpr int NU = 4608, KOUT = 2048, FF = 5632, NGU = 2 * FF, DIN = 4564;
constexpr int C_Z = 0, C_XBC = 512, C_POOL = 1536, C_FQ = 2048, C_FK = 2560, C_FV = 3072, C_DQ = 3584, C_DC = 4096, C_QI = 4224, C_KI = 4480, C_SM = 4544;
constexpr int LKP = 4224, NMW = 66  , TOPK = 256, DEPTH = 4;
constexpr float EPSF = 1e-6f;
typedef unsigned short bf16;
typedef unsigned long long u64;

__device__ __forceinline__ float bf2f(bf16 v) { return __uint_as_float(((unsigned)v) << 16); }
__device__ __forceinline__ bf16 f2bf(float f) { unsigned u = __float_as_uint(f); return (bf16)((u + 0x7fffu + ((u >> 16) & 1u)) >> 16); }
typedef float f32x2v_ __attribute__((ext_vector_type(2)));
typedef __bf16 bf16x2v_ __attribute__((ext_vector_type(2)));
__device__ __forceinline__ unsigned pk2(float lo, float hi) { f32x2v_ v = {lo, hi}; bf16x2v_ b = __builtin_convertvector(v, bf16x2v_); return __builtin_bit_cast(unsigned, b); }
__device__ __forceinline__ float siluf(float x) { return x * __builtin_amdgcn_rcpf(1.f + __expf(-x)); }
__device__ __forceinline__ float softplusf(float x) { return fmaxf(x, 0.f) + log1pf(__expf(-fabsf(x))); }
__device__ __forceinline__ float logsigmoidf(float x) { return fminf(x, 0.f) - log1pf(__expf(-fabsf(x))); }
__device__ __forceinline__ float lane_read(float v, int src) { return __int_as_float(__builtin_amdgcn_ds_bpermute(src << 2, __float_as_int(v))); }
__device__ __forceinline__ int lane_readi(int v, int src) { return __builtin_amdgcn_ds_bpermute(src << 2, v); }
__device__ __forceinline__ float wave_sum(float v, int lane) {
#pragma unroll
    for (int o = 1; o < 64; o <<= 1) v += lane_read(v, lane ^ o);
    return v;
}
__device__ __forceinline__ float* xf_row(float* dout, float* metax, int t) {
    const int b = t / L, p = t - b * L;
    return p < NMETA ? metax + (size_t)(b * NMETA + p) * DM : dout + ((size_t)b * SEQ + (p - NMETA)) * DM;
}
namespace pg8 {
#define PG8_LAS __attribute__((address_space(3)))
typedef unsigned short bf16_t;
typedef short bf16x8 __attribute__((ext_vector_type(8)));
typedef float f32x4 __attribute__((ext_vector_type(4)));
typedef unsigned u32x4 __attribute__((ext_vector_type(4)));
constexpr int BM = 256, BK = 64, HALF = 128, HTB = HALF * BK * 2  , STAGE_BYTES = 8 * HTB, NXCD = 8, WGM = 4;

__host__ __device__ __forceinline__ int lds_byte(int r, int c) { const int st = (r >> 4) * 2 + (c >> 5), rr = r & 15, cc = c & 31, ob = rr * 64 + cc * 2; return st * 1024 + (ob ^ (((ob >> 9) & 1) << 5)); }
__host__ __device__ __forceinline__ void stage_rc(int b, int& R, int& C) { const int st = b / 1024, sb = b % 1024, swz = sb ^ (((sb >> 9) & 1) << 5); R = (st >> 1) * 16 + swz / 64; C = (st & 1) * 32 + (swz % 64) / 2; }
__host__ __device__ __forceinline__ int perm32(int rho) { const int n = rho >> 4, i = rho & 15; return 8 * (i >> 2) + 4 * n + (i & 3); }

struct Unit { int pm, pn; };
struct Gemm { const bf16_t* A; const bf16_t* Bt; int M, N, K; size_t a_tstep; int rowmap; };
__host__ __device__ __forceinline__ int tile_row0(int rowmap, int pm) { return rowmap ? (pm >> 4) * 4112 + 16 + 256 * (pm & 15) : pm * 256; }

struct StaticOrder {
    int nM, nN, nwg, G, c, wgm;
    __host__ __device__ void init(int M, int N, int G_, int c_, int wgm_ = WGM) { nM = M / BM; nN = N / BM; nwg = nM * nN; G = G_; c = c_; wgm = wgm_; }
    __host__ __device__ bool next(int i, Unit& u) const {
        const long L = (long)i * G + c; if (L >= nwg) return false;
        int wgid = (int)L; { const int q = nwg / NXCD, r = nwg % NXCD, xcd = wgid % NXCD, off = wgid / NXCD; wgid = (xcd < r ? xcd * (q + 1) : r * (q + 1) + (xcd - r) * q) + off; }
        const int nig = wgm * nN, gid = wgid / nig, fm = gid * wgm, gsz = (nM - fm) < wgm ? (nM - fm) : wgm;
        u.pm = fm + ((wgid % nig) % gsz); u.pn = (wgid % nig) / gsz; return true;
    }
    __device__ __forceinline__ void a_ready(const Unit&) const {}
    __device__ __forceinline__ void done(const Unit&) const {}
};


__device__ __forceinline__ unsigned cvt_pk_bf16(float lo, float hi) { return ::pk2(lo, hi); }

struct EpiBf16Plain {
    static constexpr bool PERM = true, AFTER_DRAIN = false, APERM = false;
    bf16_t* O; int ldc; const float* rs; float* UF; int sm_col0; int rowmap;
    __device__ __forceinline__ void operator()(f32x4 (&acc)[2][2][4][2], const Unit& u, int wr, int wc, int fr, int fq) const {
        const int row0 = tile_row0(rowmap, u.pm) + wr * 64 + fr, col0 = u.pn * BM + wc * 32 + 8 * fq;
#pragma unroll
        for (int ai = 0; ai < 2; ++ai)
#pragma unroll
            for (int m = 0; m < 4; ++m) {
                const int row = row0 + ai * HALF + m * 16; const float s = rs ? rs[row] : 1.f; bf16_t* rowp = O + (size_t)row * ldc + col0;
#pragma unroll
                for (int bj = 0; bj < 2; ++bj) { const f32x4 v0 = acc[ai][bj][m][0] * s, v1 = acc[ai][bj][m][1] * s;
                    u32x4 w; w.x = cvt_pk_bf16(v0[0], v0[1]); w.y = cvt_pk_bf16(v0[2], v0[3]); w.z = cvt_pk_bf16(v1[0], v1[1]); w.w = cvt_pk_bf16(v1[2], v1[3]);
                    *(u32x4*)(rowp + bj * HALF) = w;
                    if (UF) { const int c = col0 + bj * HALF - sm_col0; if (c >= 0 && c < 32) { float* p = UF + (size_t)row * 32 + c; *(f32x4*)p = v0; *(f32x4*)(p + 4) = v1; } } }
            }
    }
};

__device__ __forceinline__ float fq_sum(float x) {
#if defined(__HIP_DEVICE_COMPILE__)
    { const auto r = __builtin_amdgcn_permlane16_swap(__float_as_uint(x), __float_as_uint(x), false, false); x = __uint_as_float(r[0]) + __uint_as_float(r[1]); }
    { const auto r = __builtin_amdgcn_permlane32_swap(__float_as_uint(x), __float_as_uint(x), false, false); x = __uint_as_float(r[0]) + __uint_as_float(r[1]); }
#endif
    return x;
}
struct EpiResid {
    static constexpr bool PERM = true, AFTER_DRAIN = false, APERM = false;
    bf16_t* XB; const float* g; float* dout; float* PS; float* SS; unsigned* cnt; PG8_LAS float* sh;
    __device__ __forceinline__ void operator()(f32x4 (&acc)[2][2][4][2], const Unit& u, int wr, int wc, int fr, int fq) const {
        const int tid = (wr * 4 + wc) * 64 + fq * 16 + fr;
        const int row0 = tile_row0(1, u.pm) + wr * 64 + fr, col0 = u.pn * BM + wc * 32 + 8 * fq, rl0 = wr * 64 + fr;
        PG8_LAS float* part = sh; PG8_LAS float* rsd = sh + 1024;
        f32x4 gv[2][2];
#pragma unroll
        for (int bj = 0; bj < 2; ++bj)
#pragma unroll
            for (int n = 0; n < 2; ++n) gv[bj][n] = *(const f32x4*)(g + col0 + bj * HALF + 4 * n);
#pragma unroll
        for (int ai = 0; ai < 2; ++ai)
#pragma unroll
            for (int m = 0; m < 4; ++m) { float s = 0.f;
#pragma unroll
                for (int bj = 0; bj < 2; ++bj)
#pragma unroll
                    for (int n = 0; n < 2; ++n)
#pragma unroll
                        for (int j = 0; j < 4; ++j) s += acc[ai][bj][m][n][j] * acc[ai][bj][m][n][j];
                s = fq_sum(s);
                if (fq == 0) part[wc * 256 + ai * HALF + rl0 + m * 16] = s; }
        asm volatile("s_waitcnt lgkmcnt(0)" ::: "memory"); __builtin_amdgcn_s_barrier(); asm volatile("" ::: "memory");
        if (tid < 256) __hip_atomic_store(PS + ((size_t)u.pm * 256 + tid) * 8 + u.pn, ((part[tid] + part[256 + tid]) + part[512 + tid]) + part[768 + tid], __ATOMIC_RELAXED, __HIP_MEMORY_SCOPE_AGENT);
        asm volatile("s_waitcnt vmcnt(0)" ::: "memory"); __builtin_amdgcn_s_barrier(); asm volatile("" ::: "memory");
        if (tid == 0) { __hip_atomic_fetch_add(cnt + u.pm, 1u, __ATOMIC_RELAXED, __HIP_MEMORY_SCOPE_AGENT); unsigned sp = 0u;
            while (__hip_atomic_load(cnt + u.pm, __ATOMIC_RELAXED, __HIP_MEMORY_SCOPE_AGENT) < 8u) { __builtin_amdgcn_s_sleep(1); if (++sp > (1u << 22)) break; } }
        __builtin_amdgcn_s_barrier(); asm volatile("" ::: "memory");
        if (tid < 256) { const float* q = PS + ((size_t)u.pm * 256 + tid) * 8; float s = 0.f;
#pragma unroll
            for (int k = 0; k < 8; ++k) s += __hip_atomic_load(q + k, __ATOMIC_RELAXED, __HIP_MEMORY_SCOPE_AGENT);
            rsd[tid] = rsqrtf(s * (1.f / 2048.f) + 1e-6f); }
        asm volatile("s_waitcnt lgkmcnt(0)" ::: "memory"); __builtin_amdgcn_s_barrier(); asm volatile("" ::: "memory");
#pragma unroll
        for (int ai = 0; ai < 2; ++ai)
#pragma unroll
            for (int m = 0; m < 4; ++m) { const float r = rsd[ai * HALF + rl0 + m * 16]; const int row = row0 + ai * HALF + m * 16; float s2 = 0.f;
#pragma unroll
                for (int bj = 0; bj < 2; ++bj) { const u32x4 xv = *(const u32x4*)(XB + (size_t)row * 2048 + col0 + bj * HALF); const unsigned xw[4] = {xv.x, xv.y, xv.z, xv.w}; float a[8];
#pragma unroll
                    for (int i = 0; i < 8; ++i) { const float x = __uint_as_float((i & 1) ? (xw[i >> 1] & 0xffff0000u) : (xw[i >> 1] << 16));
                        a[i] = x + acc[ai][bj][m][i >> 2][i & 3] * r * gv[bj][i >> 2][i & 3]; s2 += a[i] * a[i]; }
                    u32x4 w; w.x = cvt_pk_bf16(a[0], a[1]); w.y = cvt_pk_bf16(a[2], a[3]); w.z = cvt_pk_bf16(a[4], a[5]); w.w = cvt_pk_bf16(a[6], a[7]);
                    *(u32x4*)(XB + (size_t)row * 2048 + col0 + bj * HALF) = w;
                    if (dout) { float* o = dout + ((size_t)u.pm * 256 + (row - tile_row0(1, u.pm))) * 2048 + col0 + bj * HALF; *(f32x4*)o = (f32x4){a[0], a[1], a[2], a[3]}; *(f32x4*)(o + 4) = (f32x4){a[4], a[5], a[6], a[7]}; } }
                s2 = fq_sum(s2);
                if (fq == 0) part[wc * 256 + ai * HALF + rl0 + m * 16] = s2; }
        asm volatile("s_waitcnt lgkmcnt(0)" ::: "memory"); __builtin_amdgcn_s_barrier(); asm volatile("" ::: "memory");
        if (tid < 256) SS[((size_t)u.pm * 256 + tid) * 8 + u.pn] = ((part[tid] + part[256 + tid]) + part[512 + tid]) + part[768 + tid];
        __builtin_amdgcn_s_barrier(); asm volatile("" ::: "memory");
    }
};

struct EpiGateUp {
    static constexpr bool PERM = true, AFTER_DRAIN = false, APERM = true;
    bf16_t* H; const float* rs; const float* cw; const float* cb; PG8_LAS float* halo;
    float* FXG; float* FXU; float* HB;
    __device__ __forceinline__ void operator()(f32x4 (&acc)[2][2][4][2], const Unit& u, int wr, int wc, int fr, int fq) const {
        const int chl = wc * 32 + 8 * fq, ch0 = u.pn * 128 + chl, rbase = tile_row0(1, u.pm);
        f32x4 w0[2], w1[2], w2[2], bb[2];
#pragma unroll
        for (int n = 0; n < 2; ++n) { w0[n] = *(const f32x4*)(cw + ch0 + 4 * n); w1[n] = *(const f32x4*)(cw + FF + ch0 + 4 * n); w2[n] = *(const f32x4*)(cw + 2 * FF + ch0 + 4 * n); bb[n] = *(const f32x4*)(cb + ch0 + 4 * n); }
#pragma unroll
        for (int ai = 0; ai < 2; ++ai) { const f32x4 s4 = *(const f32x4*)(rs + rbase + ai * 128 + wr * 64 + 4 * fr);
#pragma unroll
            for (int m = 0; m < 4; ++m)
#pragma unroll
                for (int bj = 0; bj < 2; ++bj)
#pragma unroll
                    for (int n = 0; n < 2; ++n) acc[ai][bj][m][n] = acc[ai][bj][m][n] * s4[m]; }
        if (fr == 15) {
#pragma unroll
            for (int ai = 0; ai < 2; ++ai)
#pragma unroll
                for (int n = 0; n < 2; ++n) { *(PG8_LAS f32x4*)(halo + ((2 * ai + wr) * 2 + 0) * 128 + chl + 4 * n) = acc[ai][0][2][n]; *(PG8_LAS f32x4*)(halo + ((2 * ai + wr) * 2 + 1) * 128 + chl + 4 * n) = acc[ai][0][3][n]; }
            if (wr == 1) {
#pragma unroll
                for (int n = 0; n < 2; ++n) { *(f32x4*)(HB + ((size_t)u.pm * 2 + 0) * FF + ch0 + 4 * n) = acc[1][0][2][n]; *(f32x4*)(HB + ((size_t)u.pm * 2 + 1) * FF + ch0 + 4 * n) = acc[1][0][3][n]; } }
        }
        if (fr == 0 && wr == 0) {
#pragma unroll
            for (int n = 0; n < 2; ++n) { *(f32x4*)(FXG + ((size_t)u.pm * 2 + 0) * FF + ch0 + 4 * n) = acc[0][0][0][n]; *(f32x4*)(FXG + ((size_t)u.pm * 2 + 1) * FF + ch0 + 4 * n) = acc[0][0][1][n];
                                           *(f32x4*)(FXU + ((size_t)u.pm * 2 + 0) * FF + ch0 + 4 * n) = acc[0][1][0][n]; *(f32x4*)(FXU + ((size_t)u.pm * 2 + 1) * FF + ch0 + 4 * n) = acc[0][1][1][n]; }
        }
        asm volatile("s_waitcnt lgkmcnt(0)" ::: "memory"); __builtin_amdgcn_s_barrier(); asm volatile("" ::: "memory");
#pragma unroll
        for (int ai = 0; ai < 2; ++ai) {
            const int blk = 2 * ai + wr; unsigned pk[4][4];
#pragma unroll
            for (int n = 0; n < 2; ++n) {
                f32x4 h2 = {0.f, 0.f, 0.f, 0.f}, h3 = {0.f, 0.f, 0.f, 0.f};
                if (blk > 0) { h2 = *(const PG8_LAS f32x4*)(halo + ((blk - 1) * 2 + 0) * 128 + chl + 4 * n); h3 = *(const PG8_LAS f32x4*)(halo + ((blk - 1) * 2 + 1) * 128 + chl + 4 * n); }
                f32x4 d2, d3;
#pragma unroll
                for (int j = 0; j < 4; ++j) {
                    d2[j] = __int_as_float(__builtin_amdgcn_update_dpp(__float_as_int(h2[j]), __float_as_int(acc[ai][0][2][n][j]), 0x111, 0xf, 0xf, false));
                    d3[j] = __int_as_float(__builtin_amdgcn_update_dpp(__float_as_int(h3[j]), __float_as_int(acc[ai][0][3][n][j]), 0x111, 0xf, 0xf, false)); }
#pragma unroll
                for (int m = 0; m < 4; ++m) {
                    const f32x4 cur = acc[ai][0][m][n], g1 = m == 0 ? d3 : acc[ai][0][m > 0 ? m - 1 : 0][n], g2 = m == 0 ? d2 : (m == 1 ? d3 : acc[ai][0][m > 1 ? m - 2 : 0][n]);
                    const f32x4 cv = bb[n] + w2[n] * cur + w1[n] * g1 + w0[n] * g2;
                    const f32x4 t = cv * -1.4426950408889634f; f32x4 den;
#pragma unroll
                    for (int j = 0; j < 4; ++j) den[j] = __builtin_amdgcn_exp2f(t[j]);
                    den = den + 1.f; f32x4 sg;
#pragma unroll
                    for (int j = 0; j < 4; ++j) sg[j] = __builtin_amdgcn_rcpf(den[j]);
                    const f32x4 hv = cv * sg * acc[ai][1][m][n];
                    pk[m][2 * n] = cvt_pk_bf16(hv[0], hv[1]); pk[m][2 * n + 1] = cvt_pk_bf16(hv[2], hv[3]);
                }
            }
#pragma unroll
            for (int m = 0; m < 4; ++m) { const int rl = ai * 128 + wr * 64 + 4 * fr + m;
                if (rl >= 2) { u32x4 w; w.x = pk[m][0]; w.y = pk[m][1]; w.z = pk[m][2]; w.w = pk[m][3]; *(u32x4*)(H + (size_t)(rbase + rl) * FF + ch0) = w; } }
        }
    }
};
template <class Epi, class Sched, bool ALIGN_EPI = false, bool SP2 = false>
__device__ __forceinline__ void gemm_phase(PG8_LAS unsigned char* lds, const Gemm g, const Sched& S, const Epi& E, const int tid) {
    const int wid = __builtin_amdgcn_readfirstlane(tid >> 6), lane = tid & 63, wr = wid >> 2, wc = wid & 3, fr = lane & 15, fq = lane >> 4;
    const int K = g.K, nt = K / BK;
    unsigned voffA[2], voffB[2];
#pragma unroll
    for (int i = 0; i < 2; ++i) { int R, C; stage_rc(tid * 16 + i * 8192, R, C); const int Rb = Epi::PERM ? ((R & ~31) + perm32(R & 31)) : R;
        const int Ra = Epi::APERM ? ((R & ~63) + 4 * (R & 15) + ((R & 63) >> 4)) : R;
        voffA[i] = (unsigned)(Ra * K + C) * 2u; voffB[i] = (unsigned)(Rb * K + C) * 2u; }
    const size_t kstep = (size_t)(BK * 2);
    const size_t hstep = (size_t)HALF * K * 2;
    const size_t tstep = 2 * hstep;
    const unsigned ldsw = (unsigned)wid * 1024u;
    const int aoff = lds_byte(wr * 64 + fr, fq * 8), boff = lds_byte(wc * 32 + fr, fq * 8);
#define PG8_SA(b, h) (((b) * 2 + (h)) * HTB)
#define PG8_SB(b, h) ((4 + (b) * 2 + (h)) * HTB)
#define PG8_STAGE(bufoff, gbase, voff) do { _Pragma("unroll") for (int _i = 0; _i < 2; ++_i) \
        __builtin_amdgcn_global_load_lds((const unsigned*)((const char*)(gbase) + (voff)[_i]), (PG8_LAS unsigned*)(lds + (bufoff) + ldsw + _i * 8192), 16, 0, 0); } while (0)
#define PG8_LDA(dst, b, h) do { _Pragma("unroll") for (int m = 0; m < 4; ++m) _Pragma("unroll") for (int k = 0; k < 2; ++k) dst[m][k] = *(const PG8_LAS bf16x8*)(lds + PG8_SA(b, h) + aoff + m * 2048 + k * 1024); } while (0)
#define PG8_LDB(dst, b, h) do { _Pragma("unroll") for (int n = 0; n < 2; ++n) _Pragma("unroll") for (int k = 0; k < 2; ++k) dst[n][k] = *(const PG8_LAS bf16x8*)(lds + PG8_SB(b, h) + boff + n * 2048 + k * 1024); } while (0)
#define PG8_MMA(ai, bj, At, Bt) do { __builtin_amdgcn_s_setprio(1); _Pragma("unroll") for (int m = 0; m < 4; ++m) _Pragma("unroll") for (int n = 0; n < 2; ++n) _Pragma("unroll") for (int k = 0; k < 2; ++k) \
        acc[ai][bj][m][n] = __builtin_amdgcn_mfma_f32_16x16x32_bf16(Bt[n][k], At[m][k], acc[ai][bj][m][n], 0, 0, 0); __builtin_amdgcn_s_setprio(0); } while (0)
#define PG8_WAIT_V(n) asm volatile("s_waitcnt vmcnt(" #n ")" ::: "memory")
#define PG8_WAIT_L(n) asm volatile("s_waitcnt lgkmcnt(" #n ")" ::: "memory")
#define PG8_BAR __builtin_amdgcn_s_barrier()
#define PG8_SCHED __builtin_amdgcn_sched_barrier(0)
    Unit cur, nxt; int ui = 0;
    if (!S.next(0, cur)) return;
    f32x4 acc[2][2][4][2];
#pragma unroll
    for (int a = 0; a < 2; ++a)
#pragma unroll
        for (int b = 0; b < 2; ++b)
#pragma unroll
            for (int m = 0; m < 4; ++m)
#pragma unroll
                for (int n = 0; n < 2; ++n) acc[a][b][m][n] = (f32x4){0.f, 0.f, 0.f, 0.f};
    bf16x8 At[4][2], B0[2][2], B1[2][2];
    const char* cA = (const char*)g.A + (g.rowmap ? (size_t)tile_row0(1, cur.pm) * K * 2 : (size_t)cur.pm * g.a_tstep); const char* cB = (const char*)g.Bt + (size_t)cur.pn * tstep;
    S.a_ready(cur);
    if constexpr (SP2) {
        PG8_STAGE(PG8_SB(0, 0), cB, voffB); PG8_STAGE(PG8_SB(0, 1), cB + hstep, voffB); PG8_STAGE(PG8_SA(0, 0), cA, voffA); PG8_STAGE(PG8_SA(0, 1), cA + hstep, voffA);
        if (wr == 1) PG8_BAR;
        PG8_WAIT_V(2); PG8_BAR;
        PG8_STAGE(PG8_SB(1, 0), cB + kstep, voffB); PG8_STAGE(PG8_SA(1, 0), cA + kstep, voffA); PG8_STAGE(PG8_SB(1, 1), cB + hstep + kstep, voffB);
        PG8_WAIT_V(6); PG8_BAR;
    } else {
        PG8_STAGE(PG8_SB(0, 0), cB, voffB); PG8_STAGE(PG8_SA(0, 0), cA, voffA); PG8_STAGE(PG8_SB(0, 1), cB + hstep, voffB); PG8_STAGE(PG8_SA(0, 1), cA + hstep, voffA);
        if (wr == 1) PG8_BAR;
        PG8_WAIT_V(4); PG8_BAR;
        PG8_STAGE(PG8_SB(1, 0), cB + kstep, voffB); PG8_STAGE(PG8_SA(1, 0), cA + kstep, voffA); PG8_STAGE(PG8_SB(1, 1), cB + hstep + kstep, voffB);
        PG8_WAIT_V(6); PG8_BAR;
    }
    for (;;) {
        const bool has_next = S.next(ui + 1, nxt);
        const char* nA = has_next ? (const char*)g.A + (g.rowmap ? (size_t)tile_row0(1, nxt.pm) * K * 2 : (size_t)nxt.pm * g.a_tstep) : cA; const char* nB = has_next ? (const char*)g.Bt + (size_t)nxt.pn * tstep : cB;
        for (int t = 0; t < nt; t += 2) {
            const bool last = (t == nt - 2);
            const char* a1 = cA + (size_t)(t + 1) * kstep;
            const char* a2 = last ? nA : cA + (size_t)(t + 2) * kstep; const char* b2 = last ? nB : cB + (size_t)(t + 2) * kstep;
            const char* a3 = a2 + kstep; const char* b3 = b2 + kstep;
            if (last && has_next) S.a_ready(nxt);
            if constexpr (SP2) {
            PG8_LDB(B0, 0, 0); PG8_LDB(B1, 0, 1); PG8_SCHED; PG8_LDA(At, 0, 0); PG8_STAGE(PG8_SA(1, 1), a1 + hstep, voffA);
            PG8_WAIT_V(8); PG8_WAIT_L(0); PG8_BAR; PG8_MMA(0, 0, At, B0); PG8_MMA(0, 1, At, B1); PG8_BAR; PG8_SCHED;
            PG8_LDA(At, 0, 1); PG8_STAGE(PG8_SB(0, 0), b2, voffB); PG8_STAGE(PG8_SB(0, 1), b2 + hstep, voffB); PG8_STAGE(PG8_SA(0, 0), a2, voffA);
            PG8_WAIT_V(8); PG8_WAIT_L(0); PG8_BAR; PG8_MMA(1, 0, At, B0); PG8_MMA(1, 1, At, B1); PG8_BAR; PG8_SCHED;
            PG8_LDB(B0, 1, 0); PG8_LDB(B1, 1, 1); PG8_SCHED; PG8_LDA(At, 1, 0); PG8_STAGE(PG8_SA(0, 1), a2 + hstep, voffA);
            PG8_WAIT_V(8); PG8_WAIT_L(0); PG8_BAR; PG8_MMA(0, 0, At, B0); PG8_MMA(0, 1, At, B1); PG8_BAR; PG8_SCHED;
            PG8_LDA(At, 1, 1); PG8_STAGE(PG8_SB(1, 0), b3, voffB); PG8_STAGE(PG8_SB(1, 1), b3 + hstep, voffB); PG8_STAGE(PG8_SA(1, 0), a3, voffA);
            PG8_WAIT_V(8); PG8_WAIT_L(0); PG8_BAR; PG8_MMA(1, 0, At, B0); PG8_MMA(1, 1, At, B1); PG8_BAR; PG8_SCHED;
            } else {
            PG8_LDB(B0, 0, 0); PG8_SCHED; PG8_LDA(At, 0, 0); PG8_STAGE(PG8_SA(1, 1), a1 + hstep, voffA);
            PG8_WAIT_L(8); PG8_BAR; PG8_WAIT_L(0); PG8_MMA(0, 0, At, B0); PG8_BAR; PG8_SCHED;
            PG8_LDB(B1, 0, 1); PG8_STAGE(PG8_SB(0, 0), b2, voffB);
            PG8_BAR; PG8_WAIT_L(0); PG8_MMA(0, 1, At, B1); PG8_BAR;
            PG8_LDA(At, 0, 1); PG8_STAGE(PG8_SA(0, 0), a2, voffA);
            PG8_BAR; PG8_WAIT_L(0); PG8_MMA(1, 0, At, B0); PG8_BAR; PG8_SCHED;
            PG8_STAGE(PG8_SB(0, 1), b2 + hstep, voffB);
            PG8_WAIT_V(6); PG8_BAR; PG8_MMA(1, 1, At, B1); PG8_BAR;
            PG8_LDB(B0, 1, 0); PG8_SCHED; PG8_LDA(At, 1, 0); PG8_STAGE(PG8_SA(0, 1), a2 + hstep, voffA);
            PG8_WAIT_L(8); PG8_BAR; PG8_WAIT_L(0); PG8_MMA(0, 0, At, B0); PG8_BAR; PG8_SCHED;
            PG8_LDB(B1, 1, 1); PG8_STAGE(PG8_SB(1, 0), b3, voffB);
            PG8_BAR; PG8_WAIT_L(0); PG8_MMA(0, 1, At, B1); PG8_BAR;
            PG8_LDA(At, 1, 1); PG8_STAGE(PG8_SA(1, 0), a3, voffA);
            PG8_BAR; PG8_WAIT_L(0); PG8_MMA(1, 0, At, B0); PG8_BAR; PG8_SCHED;
            PG8_STAGE(PG8_SB(1, 1), b3 + hstep, voffB);
            PG8_WAIT_V(6); PG8_BAR; PG8_MMA(1, 1, At, B1); PG8_BAR;
            }
        }
        if constexpr (ALIGN_EPI) { if (wr == 0) PG8_BAR; }
        if constexpr (!Epi::AFTER_DRAIN) { E(acc, cur, wr, wc, fr, fq); S.done(cur); }
        if (!has_next) break;
#pragma unroll
        for (int a = 0; a < 2; ++a)
#pragma unroll
            for (int b = 0; b < 2; ++b)
#pragma unroll
                for (int m = 0; m < 4; ++m)
#pragma unroll
                    for (int n = 0; n < 2; ++n) acc[a][b][m][n] = (f32x4){0.f, 0.f, 0.f, 0.f};
        cur = nxt; cA = nA; cB = nB; ++ui;
        if constexpr (ALIGN_EPI) { if (wr == 1) PG8_BAR; }
    }
    PG8_WAIT_V(0);
    if constexpr (!ALIGN_EPI) { if (wr == 0) PG8_BAR; }
    PG8_BAR;
    if constexpr (Epi::AFTER_DRAIN) { E.fused(acc, cur, wr, wc, fr, fq, lds, wid, lane); S.done(cur); }
#undef PG8_SA
#undef PG8_SB
#undef PG8_STAGE
#undef PG8_LDA
#undef PG8_LDB
#undef PG8_MMA
#undef PG8_WAIT_V
#undef PG8_WAIT_L
#undef PG8_BAR
#undef PG8_SCHED
}
}

constexpr int WGM_IN = 4, WGM_OUT = 4, WGM_GU = 4, WGM_DN = 4;
constexpr int REP_SCORE = 1, REP_SEL = 1, REP_ATT = 1, REP_SLOW = 1, REP_FAST = 1;

#include <hip/hip_cooperative_groups.h>
namespace cg = cooperative_groups;
#define LAS __attribute__((address_space(3)))
constexpr int LDS_BYTES = 163840, HALO_OFF = 133120, PT_OFF = 163328, NTHR = 512, NWAVE = 8;
constexpr size_t MiB = (size_t)1 << 20;
constexpr size_t WS_CTL = 0, WS_WIN = 1 * MiB, WS_WOUT = 21 * MiB, WS_WGU = 31 * MiB, WS_WDN = 75 * MiB, WS_METAX = 97 * MiB, WS_RSTD = 98 * MiB, WS_UF = 99 * MiB,
                 WS_DT = 104 * MiB, WS_FCUM = 106 * MiB, WS_CN = 108 * MiB, WS_MASK = 117 * MiB, WS_XB = 134 * MiB, WS_Y = 264 * MiB, WS_R1 = 426 * MiB, WS_XC = WS_R1 + 323 * MiB,
                 WS_YA = 814 * MiB, WS_FIX = 880 * MiB  , WS_END = 902 * MiB;
static_assert(WS_WIN + (size_t)NU * DM * 2 <= WS_WOUT && WS_WOUT + (size_t)DM * KOUT * 2 <= WS_WGU && WS_WGU + (size_t)NGU * DM * 2 <= WS_WDN && WS_WDN + (size_t)DM * FF * 2 <= WS_METAX, "ws weights");
static_assert(WS_UF + (size_t)MP * 32 * 4 <= WS_DT && WS_DT + (size_t)T * 8 * 4 <= WS_FCUM && WS_FCUM + (size_t)64 * LKP * 4 <= WS_CN && WS_CN + (size_t)MP * 128 * 2 <= WS_MASK && WS_MASK + (size_t)T * NMW * 8 <= WS_XB, "ws small");
static_assert(WS_XB + (size_t)(MP + 8) * DM * 2 <= WS_Y && WS_Y + (size_t)MP * KOUT * 2 <= WS_R1 && WS_R1 + (size_t)MP * NU * 2 <= WS_XC && WS_XC + (size_t)MP * 1024 * 2 <= WS_YA && WS_R1 + (size_t)MP * FF * 2 <= WS_YA && WS_YA + (size_t)T * 512 * 4 <= WS_END, "ws big");

typedef unsigned u32x4v __attribute__((ext_vector_type(4)));
typedef unsigned u32x2v __attribute__((ext_vector_type(2)));
typedef float f32x4v __attribute__((ext_vector_type(4)));
struct Args { const float* in[25]; float* out; unsigned char* ws; };

struct Ctx {
    int tid, lane, wave, gw, ngw, bid, nb;
    LAS unsigned char* lds;
};
__device__ __forceinline__ Ctx refresh(const Ctx& c0) {
    Ctx c = c0; unsigned z = 0u; int w_ = c0.wave, b_ = (int)blockIdx.x, n_ = (int)gridDim.x; asm volatile("" : "+v"(z), "+s"(w_), "+s"(b_), "+s"(n_));
    const int lane = (int)__builtin_amdgcn_mbcnt_hi(~0u, __builtin_amdgcn_mbcnt_lo(~0u, z));
    c.bid = b_; c.nb = n_; c.ngw = n_ * NWAVE; c.wave = w_; c.lane = lane; c.tid = w_ * 64 + lane; c.gw = b_ * NWAVE + w_;
    { unsigned l_ = (unsigned)(size_t)c0.lds; asm volatile("" : "+s"(l_)); c.lds = (LAS unsigned char*)(size_t)l_; }
    return c;
}
__device__ __forceinline__ unsigned char* pt_get(const Ctx& c, int i) {
    unsigned l_ = (unsigned)(size_t)c.lds; asm volatile("" : "+s"(l_));
    const LAS unsigned* p = (const LAS unsigned*)((LAS unsigned char*)(size_t)l_ + PT_OFF) + 2 * i;
    const unsigned lo = __builtin_amdgcn_readfirstlane(p[0]), hi = __builtin_amdgcn_readfirstlane(p[1]);
    __attribute__((address_space(1))) unsigned char* gp = (__attribute__((address_space(1))) unsigned char*)(((unsigned long long)hi << 32) | lo);
    return (unsigned char*)gp;
}
#define INP(i) ((const float*)pt_get(c, (i)))

#define GAS __attribute__((address_space(1)))
typedef unsigned v4u __attribute__((ext_vector_type(4)));
typedef GAS unsigned gu32;
typedef GAS unsigned long long gu64;
#define RLX_AGENT __ATOMIC_RELAXED, __HIP_MEMORY_SCOPE_AGENT
#define LDS_WAIT() asm volatile("s_waitcnt lgkmcnt(0)" ::: "memory")
#define VM_WAIT() asm volatile("s_waitcnt vmcnt(0)" ::: "memory")
__device__ __forceinline__ unsigned long long rt() { return __builtin_amdgcn_s_memrealtime(); }

#define XB_TMO      128
#define XB_XCNT(j)  (256  + 64 * (j))
#define XB_XSUB(j)  (1280 + 64 * (j))
#define XB_XGEN(j)  (2304 + 64 * (j))
#define XB_TOP      3328
#define XB_TOPGEN   3392
#define XCD_BAR_WORDS 3456
#define XB_SPIN_CAP (1u << 18)

__device__ __forceinline__ unsigned xb_ld(unsigned* p)              { return __hip_atomic_load(p, __ATOMIC_RELAXED, __HIP_MEMORY_SCOPE_AGENT); }
__device__ __forceinline__ unsigned xb_add(unsigned* p, unsigned v) { return __hip_atomic_fetch_add(p, v, __ATOMIC_RELAXED, __HIP_MEMORY_SCOPE_AGENT); }
__device__ __forceinline__ unsigned xb_xcc_id() { return (unsigned)__builtin_amdgcn_s_getreg((3 << 11) | 20) & 0xFu; }
#define XB_SPIN(cond, bar) do { unsigned _sp = 0; while (cond) { __builtin_amdgcn_s_sleep(1); \
    if ((++_sp & 255u) == 0u) { if (xb_ld(&(bar)[XB_TMO])) break; if (_sp > XB_SPIN_CAP) { atomicAdd(&(bar)[XB_TMO], 1u); break; } } } } while (0)

struct XcdBarrier {
    unsigned* bar; unsigned x;
    volatile LAS unsigned* st;
};

__device__ __forceinline__ XcdBarrier xcd_barrier_post(unsigned* bar, volatile LAS unsigned* st, int tid) {
    XcdBarrier b; b.bar = bar; b.x = xb_xcc_id(); b.st = st;
    if (tid == 0) (void)xb_add(&bar[XB_XCNT(b.x)], 1u);
    return b;
}
__device__ __forceinline__ void xcd_barrier_complete(unsigned* bar, unsigned x, unsigned& nloc, unsigned& nx) {
    const unsigned G = gridDim.x * gridDim.y * gridDim.z;
    unsigned sum, cnt, mine, sp = 0u;
    for (;;) {
        sum = 0u; cnt = 0u; mine = 0u;
#pragma unroll
        for (unsigned j = 0; j < 16; ++j) { const unsigned c = xb_ld(&bar[XB_XCNT(j)]); sum += c; cnt += (c > 0u) ? 1u : 0u; mine = (j == x) ? c : mine; }
        if (sum == G) break;
        __builtin_amdgcn_s_sleep(1);
        if ((++sp & 255u) == 0u) { if (xb_ld(&bar[XB_TMO])) break; if (sp > XB_SPIN_CAP) { atomicAdd(&bar[XB_TMO], 1u); break; } }
    }
    nloc = mine > 0u ? mine : 1u; nx = cnt > 0u ? cnt : 1u;
}

__device__ __forceinline__ void xcd_barrier(const XcdBarrier& b, int tid) {
    asm volatile("s_waitcnt vmcnt(0)" ::: "memory");
    __syncthreads();
    if (tid == 0) {
        unsigned* bar = b.bar;
        __builtin_amdgcn_s_waitcnt(0);
        unsigned nloc = b.st[0], nx = b.st[1];
        if (nloc == 0u) { xcd_barrier_complete(bar, b.x, nloc, nx); b.st[0] = nloc; b.st[1] = nx; }
        const unsigned old = xb_add(&bar[XB_XSUB(b.x)], 1u);
        const unsigned gen = old / nloc;
        if (old + 1u == (gen + 1u) * nloc) {
            __builtin_amdgcn_fence(__ATOMIC_RELEASE, "agent");
            asm volatile("s_waitcnt vmcnt(0)" ::: "memory");
            const unsigned og = xb_add(&bar[XB_TOP], 1u);
            const unsigned tg = og / nx;
            if (og + 1u == (tg + 1u) * nx) xb_add(&bar[XB_TOPGEN], 1u);
            else XB_SPIN(xb_ld(&bar[XB_TOPGEN]) == tg, bar);
            __builtin_amdgcn_fence(__ATOMIC_ACQUIRE, "agent");
            xb_add(&bar[XB_XGEN(b.x)], 1u);
            asm volatile("s_waitcnt vmcnt(0)" ::: "memory");
        } else {
            XB_SPIN(xb_ld(&bar[XB_XGEN(b.x)]) == gen, bar);
            __builtin_amdgcn_fence(__ATOMIC_ACQUIRE, "agent");
            asm volatile("s_waitcnt vmcnt(0)" ::: "memory");
        }
    }
    __syncthreads();
}

constexpr int MISC_OFF = 163072, CW_BAR = 4096;
__device__ __forceinline__ void grid_barrier(const Ctx& c0) {
    const Ctx c = refresh(c0);
    XcdBarrier b; b.bar = (unsigned*)(pt_get(c, 26) + WS_CTL) + CW_BAR; b.x = xb_xcc_id(); b.st = (volatile LAS unsigned*)(c.lds + MISC_OFF);
    xcd_barrier(b, c.tid);
}
__device__ __forceinline__ void ph_prep_x(const Ctx& c0, const float* x, const float* meta, bf16* XB, float* RSTD) { const Ctx c = refresh(c0);
    const int lane = c.lane;
    for (int w = c.gw; w < MP + 8; w += c.ngw) {
        const int t = w - 8; bf16* xb = XB + (ptrdiff_t)t * DM;
        if (t < 0 || t >= T) {
#pragma unroll
            for (int j = 0; j < 4; ++j) *(u32x4v*)(xb + 8 * lane + 512 * j) = (u32x4v){0u, 0u, 0u, 0u};
            if (t >= T && lane == 0) RSTD[t] = 0.f;
            continue;
        }
        const int b = t / L, p = t - b * L;
        const float* src = p < NMETA ? meta + (size_t)p * DM : x + ((size_t)b * SEQ + (p - NMETA)) * DM;
        float ss = 0.f;
#pragma unroll
        for (int j = 0; j < 4; ++j) {
            const f32x4v a = *(const f32x4v*)(src + 8 * lane + 512 * j), cc = *(const f32x4v*)(src + 8 * lane + 512 * j + 4);
            ss += a.x * a.x + a.y * a.y + a.z * a.z + a.w * a.w + cc.x * cc.x + cc.y * cc.y + cc.z * cc.z + cc.w * cc.w;
            *(u32x4v*)(xb + 8 * lane + 512 * j) = (u32x4v){pk2(a.x, a.y), pk2(a.z, a.w), pk2(cc.x, cc.y), pk2(cc.z, cc.w)};
        }
        ss = wave_sum(ss, lane);
        if (lane == 0) RSTD[t] = rsqrtf(ss * (1.f / DM) + EPSF);
    }
}

__device__ __forceinline__ void tp_tile(LAS float* tl, int lane, const float* src, int ld, const float* scale, float mul, bf16* dst, int Kd) {
    const int kk = lane >> 4, n4 = lane & 15;
    f32x4v v[16];
#pragma unroll
    for (int i = 0; i < 16; ++i) v[i] = *(const f32x4v*)(src + (size_t)(4 * i + kk) * ld + 4 * n4);
    if (scale) {
#pragma unroll
        for (int i = 0; i < 16; ++i) v[i] = v[i] * (scale[4 * i + kk] * mul); }
#pragma unroll
    for (int i = 0; i < 16; ++i)
#pragma unroll
        for (int e = 0; e < 4; ++e) tl[(4 * n4 + e) * 65 + 4 * i + kk] = v[i][e];
#pragma unroll
    for (int jj = 0; jj < 8; ++jj) { const int n = (lane >> 3) + 8 * jj, kc = (lane & 7) * 8; const LAS float* tp = tl + n * 65 + kc;
        *(u32x4v*)(dst + (size_t)n * Kd + kc) = (u32x4v){pk2(tp[0], tp[1]), pk2(tp[2], tp[3]), pk2(tp[4], tp[5]), pk2(tp[6], tp[7])}; }
}
template <class F, class M> __device__ __forceinline__ void transpose_tiles_map(const Ctx& c, bf16* dst, int Kd, int ntiles, const F& val, const M& map) {
    LAS float* tile = (LAS float*)c.lds + (c.tid >> 8) * (32 * 33);
    const int t2 = c.tid & 255, tx = t2 & 31, ty = t2 >> 5;
    for (int it = 2 * c.bid + (c.tid >> 8); it < ntiles; it += 2 * c.nb) {
        int k0, n0; map(it, k0, n0);
#pragma unroll
        for (int i = 0; i < 4; ++i) tile[(ty + 8 * i) * 33 + tx] = val(k0 + ty + 8 * i, n0 + tx);
        __syncthreads();
#pragma unroll
        for (int i = 0; i < 4; ++i) dst[(size_t)(n0 + ty + 8 * i) * Kd + k0 + tx] = f2bf(tile[tx * 33 + ty + 8 * i]);
        __syncthreads();
    }
}
__device__ __forceinline__ void ph_prep_w(const Ctx& c0, int ly, bf16* WIN, bf16* WOUT, bf16* WGU, bf16* WDN, bf16* WUKB, bf16* WUVT) { const Ctx c = refresh(c0);
    const float* w_in = INP(6) + (size_t)ly * DM * DIN; const float* g1 = INP(2) + (size_t)ly * DM; const float* w_uk = INP(17) + (size_t)ly * 8 * 128 * 64;
    const float* w_out = INP(19) + (size_t)ly * DM * DM; const float* ssd_norm = INP(12) + (size_t)ly * 512; const float* pool_w = INP(13) + (size_t)ly * 4 * 128 * 128;
    const float* pool_scale = INP(14) + (size_t)ly * 512; const float* w_uv = INP(18) + (size_t)ly * 8 * 128 * 64;
    const float* wg = INP(20) + (size_t)ly * DM * FF; const float* wu = INP(21) + (size_t)ly * DM * FF; const float* g3 = INP(4) + (size_t)ly * DM;
    const float* wd = INP(24) + (size_t)ly * FF * DM;
    {
        LAS float* tl = (LAS float*)c.lds + c.wave * (64 * 65);
        constexpr int N_WIN = 71 * 32, N_WGU = 176 * 32, N_WDN = 32 * 88, N_WOUT = 32 * 24, N_ALL = N_WIN + N_WGU + N_WDN + N_WOUT;
#pragma unroll 1
        for (int it0 = c.gw; it0 < N_ALL * REP_FAST; it0 += c.ngw) { const int it = it0 % N_ALL;
            int r = it; const float* src; const float* scl; bf16* dst; int ld, Kd; float mul = 1.f;
            if (r < N_WGU) { const int kt = r / 176, ct = r - kt * 176, pn = ct >> 2, up = (ct >> 1) & 1, hf = ct & 1;
                src = (up ? wu : wg) + (size_t)(64 * kt) * FF + 128 * pn + 64 * hf; ld = FF; scl = g3 + 64 * kt; dst = WGU + (size_t)(256 * pn + 128 * up + 64 * hf) * DM + 64 * kt; Kd = DM; }
            else if ((r -= N_WGU) < N_WDN) { const int kt = r >> 5, ct = r & 31;
                src = wd + (size_t)(64 * kt) * DM + 64 * ct; ld = DM; scl = nullptr; dst = WDN + (size_t)(64 * ct) * FF + 64 * kt; Kd = FF; }
            else if ((r -= N_WDN) < N_WIN) { const int kt = r / 71, ct = r - kt * 71;
                int dcol, scol;
                if (ct < 24) { dcol = 64 * ct; scol = dcol; }
                else if (ct < 32) { dcol = 64 * ct; scol = 1544 + 64 * (ct - 24); }
                else if (ct < 56) { dcol = 64 * ct; scol = 2056 + 64 * (ct - 32); if (ct < 40) mul = 0.18033688011112042f; }
                else if (ct < 64) { dcol = 64 * ct; scol = 3600 + 64 * (ct - 56); }
                else if (ct < 66) { dcol = C_DC + 64 * (ct - 64); scol = 4112 + 64 * (ct - 64); }
                else if (ct < 70) { dcol = C_QI + 64 * (ct - 66); scol = 4240 + 64 * (ct - 66); }
                else { dcol = C_KI; scol = 4496; }
                src = w_in + (size_t)(64 * kt) * DIN + scol; ld = DIN; scl = g1 + 64 * kt; dst = WIN + (size_t)dcol * DM + 64 * kt; Kd = DM; }
            else { r -= N_WIN; const int kq = r >> 5, nt = r & 31, k0 = kq < 8 ? 64 * kq : 1024 + 64 * (kq - 8);
                src = w_out + (size_t)k0 * DM + 64 * nt; ld = DM; scl = kq < 8 ? ssd_norm + k0 : nullptr; dst = WOUT + (size_t)(64 * nt) * KOUT + k0; Kd = KOUT; }
            tp_tile(tl, c.lane, src, ld, scl, mul, dst, Kd);
        }
    }
    __syncthreads();
    {   const int gt = c.bid * NTHR + c.tid, ngt = c.nb * NTHR;
        for (int it = gt; it < 8 * 128 * 64 / 2; it += ngt) { const float sc = 0.125f * 1.4426950408889634f; *(unsigned*)(WUKB + 2 * it) = pk2(w_uk[2 * it] * sc, w_uk[2 * it + 1] * sc); }
        for (int it = gt; it < 4 * 32 * 512; it += ngt) {
            const int nq = it & 511, cq = (it >> 9) & 31, gi = it >> 14, n0 = 4 * nq, c0_ = 4 * cq;
            float acc[4][4];
#pragma unroll
            for (int a = 0; a < 4; ++a)
#pragma unroll
                for (int b = 0; b < 4; ++b) acc[a][b] = 0.f;
            const float* ap = pool_w + ((size_t)gi * 128 + c0_) * 128; const float* sp = pool_scale + 128 * gi; const float* bp = w_out + (size_t)(512 + 128 * gi) * DM + n0;
#pragma unroll 2
            for (int d = 0; d < 128; d += 4) {
                f32x4v av[4], bv[4]; const f32x4v sv = *(const f32x4v*)(sp + d);
#pragma unroll
                for (int a = 0; a < 4; ++a) { av[a] = *(const f32x4v*)(ap + a * 128 + d) * sv; bv[a] = *(const f32x4v*)(bp + (size_t)(d + a) * DM); }
#pragma unroll
                for (int a = 0; a < 4; ++a)
#pragma unroll
                    for (int b = 0; b < 4; ++b) acc[a][b] += av[a][0] * bv[0][b] + av[a][1] * bv[1][b] + av[a][2] * bv[2][b] + av[a][3] * bv[3][b];
            }
#pragma unroll
            for (int b = 0; b < 4; ++b) *(u32x2v*)(WOUT + (size_t)(n0 + b) * KOUT + 512 + 128 * gi + c0_) = (u32x2v){pk2(acc[0][b], acc[1][b]), pk2(acc[2][b], acc[3][b])};
        }
        for (int it = gt; it < 8 * 64 * 128; it += ngt) { const int r = it & 127, d = (it >> 7) & 63, h = it >> 13; WUVT[it] = f2bf(w_uv[((size_t)h * 128 + r) * 64 + d]); }
    }
    transpose_tiles_map(c, WIN, DM, 2 * 64, [=](int k, int n) -> float {
            int src = -1;
            if (n < C_SM + 8) src = 1536 + (n - C_SM);
            else if (n < C_SM + 16) src = 3592 + (n - C_SM - 8);
            else if (n < C_SM + 20) src = 4560 + (n - C_SM - 16);
            return src >= 0 ? w_in[(size_t)k * DIN + src] * g1[k] : 0.f; },
        [=](int it, int& k0, int& n0) { k0 = 32 * (it & 63); n0 = C_SM + 32 * (it >> 6); });
}

__device__ __forceinline__ void ph_mixprep(const Ctx& c0, const bf16* U, const float* UF, const float* cw, const float* cb, const float* kvn, const float* dtb, bf16* XC, bf16* Y, bf16* CN, float* DT, bf16* KI) { const Ctx c = refresh(c0);
    const int gt = c.bid * NTHR + c.tid, ngt = c.nb * NTHR;
    for (int idx = gt; idx < (T / 4) * 128; idx += ngt) {
        const int t0 = (idx >> 7) * 4, c0 = (idx & 127) * 8, pos0 = t0 % L;
        u32x4v v[7];
#pragma unroll
        for (int i = 0; i < 7; ++i) v[i] = pos0 - 3 + i >= 0 ? *(const u32x4v*)(U + (size_t)(t0 - 3 + i) * NU + C_XBC + c0) : (u32x4v){0u, 0u, 0u, 0u};
        f32x4v wa[4], wb[4];
#pragma unroll
        for (int k = 0; k < 4; ++k) { wa[k] = *(const f32x4v*)(cw + k * 1024 + c0); wb[k] = *(const f32x4v*)(cw + k * 1024 + c0 + 4); }
        const f32x4v ba = *(const f32x4v*)(cb + c0), bb = *(const f32x4v*)(cb + c0 + 4);
        float x[7][8];
#pragma unroll
        for (int i = 0; i < 7; ++i) { const unsigned w_[4] = {v[i].x, v[i].y, v[i].z, v[i].w};
#pragma unroll
            for (int j = 0; j < 8; ++j) x[i][j] = bf2f((bf16)(w_[j >> 1] >> (16 * (j & 1)))); }
#pragma unroll
        for (int r = 0; r < 4; ++r) { float acc[8];
#pragma unroll
            for (int j = 0; j < 8; ++j) { acc[j] = j < 4 ? ba[j] : bb[j - 4];
#pragma unroll
                for (int k = 0; k < 4; ++k) acc[j] += (j < 4 ? wa[k][j] : wb[k][j - 4]) * x[r + k][j]; }
            *(u32x4v*)(XC + (size_t)(t0 + r) * 1024 + c0) = (u32x4v){pk2(siluf(acc[0]), siluf(acc[1])), pk2(siluf(acc[2]), siluf(acc[3])), pk2(siluf(acc[4]), siluf(acc[5])), pk2(siluf(acc[6]), siluf(acc[7]))}; }
    }
    for (int idx = gt; idx < (T / 4) * 64; idx += ngt) {
        const int t0 = (idx >> 6) * 4, c0 = (idx & 63) * 8, pos0 = t0 % L, gi = c0 >> 7;
        const bf16* up = U + (size_t)t0 * NU + C_POOL + c0;
#define POOL_BLK(W) { u32x4v v[W + 3]; _Pragma("unroll") for (int i = 0; i < W + 3; ++i) v[i] = pos0 - (W - 1) + i >= 0 ? *(const u32x4v*)(up + (ptrdiff_t)(i - (W - 1)) * NU) : (u32x4v){0u, 0u, 0u, 0u}; \
            _Pragma("unroll") for (int r = 0; r < 4; ++r) { float acc[8] = {0, 0, 0, 0, 0, 0, 0, 0}, self[8]; \
                _Pragma("unroll") for (int i = 0; i < W; ++i) { const u32x4v q_ = v[r + i]; const unsigned w_[4] = {q_.x, q_.y, q_.z, q_.w}; \
                    _Pragma("unroll") for (int j = 0; j < 8; ++j) { const float f = bf2f((bf16)(w_[j >> 1] >> (16 * (j & 1)))); acc[j] += f; if (i == W - 1) self[j] = f; } } \
                const float inv = 1.f / (float)min(pos0 + r + 1, W); \
                *(u32x4v*)(Y + (size_t)(t0 + r) * KOUT + 512 + c0) = (u32x4v){pk2(acc[0] * inv - self[0], acc[1] * inv - self[1]), pk2(acc[2] * inv - self[2], acc[3] * inv - self[3]), \
                    pk2(acc[4] * inv - self[4], acc[5] * inv - self[5]), pk2(acc[6] * inv - self[6], acc[7] * inv - self[7])}; } }
        if (gi == 0) POOL_BLK(2) else if (gi == 1) POOL_BLK(4) else if (gi == 2) POOL_BLK(8) else POOL_BLK(16)
    }
    for (int t = c.gw; t < T; t += c.ngw) {
        const int lane = c.lane;
        const unsigned v = *(const unsigned*)(U + (size_t)t * NU + C_DC + 2 * lane);
        const float a = bf2f((bf16)(v & 0xffff)), cc = bf2f((bf16)(v >> 16));
        const float rs = rsqrtf(wave_sum(a * a + cc * cc, lane) * (1.f / 128.f) + EPSF);
        *(unsigned*)(CN + (size_t)t * 128 + 2 * lane) = pk2(a * rs * kvn[2 * lane], cc * rs * kvn[2 * lane + 1]);
        if (lane < 8) DT[(size_t)t * 8 + lane] = softplusf(UF[(size_t)t * 32 + lane] + dtb[lane]);
        if (lane < 32) *(unsigned*)(KI + (size_t)t * 64 + 2 * lane) = *(const unsigned*)(U + (size_t)t * NU + C_KI + 2 * lane);
    }
}
__device__ __forceinline__ void ph_fcum(const Ctx& c0, const float* UF, const float* fb, float* FCUM) { const Ctx c = refresh(c0);
    const int lane = c.lane, w = c.wave;
    LAS float* tot = (LAS float*)c.lds;
    for (int bh = c.bid; bh < 64; bh += c.nb) {
        const int b = bh >> 3, h = bh & 7; const float bias = fb[h]; float v[9]; float carry = 0.f;
#pragma unroll
        for (int i = 0; i < 9; ++i) { const int p = 576 * w + 64 * i + lane; v[i] = p < L ? logsigmoidf(UF[(size_t)(b * L + p) * 32 + 8 + h] + bias) : 0.f; }
#pragma unroll
        for (int i = 0; i < 9; ++i) { float x = v[i];
#pragma unroll
            for (int o = 1; o < 64; o <<= 1) { const float n = lane_read(x, (lane - o) & 63); if (lane >= o) x += n; }
            x += carry; v[i] = x; carry = lane_read(x, 63); }
        if (lane == 0) tot[w] = carry;
        __syncthreads();
        float off = 0.f;
#pragma unroll
        for (int ww = 0; ww < NWAVE; ++ww) off += ww < w ? tot[ww] : 0.f;
#pragma unroll
        for (int i = 0; i < 9; ++i) { const int p = 576 * w + 64 * i + lane; if (p < L) FCUM[(size_t)bh * LKP + (p < 16 ? p : p + 48)] = -(v[i] + off) * 1.4426950408889634f; }
        if (w == 0 && lane >= 16) FCUM[(size_t)bh * LKP + lane] = -1e30f;
        __syncthreads();
    }
}
__device__ __forceinline__ unsigned fkey(float f) { const unsigned u = __float_as_uint(f); return (u & 0x80000000u) ? ~u : (u | 0x80000000u); }
__device__ __forceinline__ int crow(int r, int hi) { return (r & 3) + 8 * (r >> 2) + 4 * hi; }
typedef short bf16x8 __attribute__((ext_vector_type(8)));
typedef float f32x16 __attribute__((ext_vector_type(16)));
typedef float f32x2v __attribute__((ext_vector_type(2)));
typedef __bf16 bf16x2v __attribute__((ext_vector_type(2)));
#define MFMA32(a, b, c) __builtin_amdgcn_mfma_f32_32x32x16_bf16((a), (b), (c), 0, 0, 0)
#define WLANE64(lo, hi, m, sel) asm volatile("s_nop 1\n\tv_writelane_b32 %0, %2, %4\n\tv_writelane_b32 %1, %3, %4" : "+v"(lo), "+v"(hi) : "s"((unsigned)(m)), "s"((unsigned)((m) >> 32)), "n"(sel))
__device__ __forceinline__ float max3c(float a, float b, float c) { return __builtin_fmaxf(__builtin_fmaxf(a, b), c); }
__device__ __forceinline__ float max3f(float a, float b, float c) { float r; asm("v_max3_f32 %0, %1, %2, %3" : "=v"(r) : "v"(a), "v"(b), "v"(c)); return r; }
__device__ __forceinline__ unsigned cvtpk(float lo, float hi) { f32x2v v = {lo, hi}; bf16x2v b = __builtin_convertvector(v, bf16x2v); return __builtin_bit_cast(unsigned, b); }
__device__ __forceinline__ bf16x8 pack8(const f32x16& p, int s) {
    u32x4v r; r.x = cvtpk(p[8 * s], p[8 * s + 1]); r.y = cvtpk(p[8 * s + 2], p[8 * s + 3]); r.z = cvtpk(p[8 * s + 4], p[8 * s + 5]); r.w = cvtpk(p[8 * s + 6], p[8 * s + 7]);
    return __builtin_bit_cast(bf16x8, r);
}
constexpr int AT_KSTR = 72;
constexpr int AT_VSTR = 68;
constexpr int FOX_KB = 64 * AT_KSTR;
typedef short fx_s16x4 __attribute__((ext_vector_type(4)));
constexpr int FX_SLOTB = 8192, FX_LDS_K = 0, FX_LDS_V = 3 * FX_SLOTB, FX_LDS_B = 6 * FX_SLOTB;
#define FX_THR 8.f
#define FX_SBAR() __builtin_amdgcn_sched_barrier(0)
#define FX_PIN(x) asm volatile("" : "+v"(x))
#define FX_WAIT_BAR(N) asm volatile("s_waitcnt vmcnt(" #N ") lgkmcnt(0)\n\ts_barrier" ::: "memory")
__device__ __forceinline__ void fx_glds16(const void* g, unsigned lds_base) {
    unsigned sv; asm volatile("s_mov_b32 %0, m0\n\ts_mov_b32 m0, %2\n\ts_nop 0\n\tglobal_load_lds_dwordx4 %1, off\n\ts_mov_b32 m0, %0" : "=&s"(sv) : "v"(g), "s"(lds_base) : "memory"); }
__device__ __forceinline__ void fx_glds4(const void* g, unsigned lds_base) {
    unsigned sv; asm volatile("s_mov_b32 %0, m0\n\ts_mov_b32 m0, %2\n\ts_nop 0\n\tglobal_load_lds_dword %1, off\n\ts_mov_b32 m0, %0" : "=&s"(sv) : "v"(g), "s"(lds_base) : "memory"); }
__device__ __forceinline__ void fx_kload2(bf16x8* kf, const LAS char* kp, int d0) { kf[2 * d0] = *(const LAS bf16x8*)(kp + d0 * 2048); kf[2 * d0 + 1] = *(const LAS bf16x8*)(kp + d0 * 2048 + 512); }
__device__ __forceinline__ fx_s16x4 fx_vtr(const LAS char* p) { return __builtin_bit_cast(fx_s16x4, __builtin_amdgcn_ds_read_tr16_b64_v4i16((LAS fx_s16x4*)p)); }
__device__ __forceinline__ float fx_swapmax(float m) {
#if defined(__HIP_DEVICE_COMPILE__)
    const auto rr = __builtin_amdgcn_permlane32_swap(__float_as_uint(m), __float_as_uint(m), false, false); return max3f(__uint_as_float(rr[0]), __uint_as_float(rr[1]), __uint_as_float(rr[1]));
#else
    return m;
#endif
}
__device__ __forceinline__ float fx_swapsum(float m) {
#if defined(__HIP_DEVICE_COMPILE__)
    const auto rr = __builtin_amdgcn_permlane32_swap(__float_as_uint(m), __float_as_uint(m), false, false); return __uint_as_float(rr[0]) + __uint_as_float(rr[1]);
#else
    return m;
#endif
}
__device__ __forceinline__ float fx_rowmax(const f32x16& p0, const f32x16& p1) {
    float a = max3c(p0[0], p0[1], p1[0]), b = max3c(p0[2], p0[3], p1[1]); a = max3c(a, p1[2], p1[3]);
#pragma unroll
    for (int r = 4; r < 16; r += 4) { a = max3c(a, p0[r], p0[r + 1]); b = max3c(b, p0[r + 2], p0[r + 3]); a = max3c(a, p1[r], p1[r + 1]); b = max3c(b, p1[r + 2], p1[r + 3]); }
    return fx_swapmax(max3c(a, b, b)); }
__device__ __forceinline__ void fx_cmask(f32x16& p0, f32x16& p1, int jb, int qrel, int hi) {
    const int kb = 64 * jb + 4 * hi;
#pragma unroll
    for (int r = 0; r < 16; ++r) { const int kv = kb + (r & 3) + 8 * (r >> 2); if (kv > qrel) p0[r] = -__builtin_inff(); if (kv + 32 > qrel) p1[r] = -__builtin_inff(); } }

__device__ __forceinline__ void fox_unit(const Ctx& c, int b, int h, int j, const bf16* U, const float* BT, bf16* Y) {
    const int lane = c.lane, r32 = lane & 31, hi = lane >> 5, wid = c.wave;
    const int q0 = 16 + 256 * (j - 1), NT = 1 + 4 * j;
    const bf16* Ub = U + (size_t)(b * L) * NU;
    const unsigned lds0 = (unsigned)(size_t)c.lds;
    const bf16* ksrc = Ub + (size_t)lane * NU + C_FK + 64 * h + wid * 8;
    const bf16* vsrc = Ub + (size_t)(16 * (wid & 3) + (lane >> 2)) * NU + C_FV + 64 * h + (wid >> 2) * 32 + (lane & 3) * 8;
    const float* bsrc = BT + lane;
    const unsigned kdst = lds0 + FX_LDS_K + wid * 1024, vdst = lds0 + FX_LDS_V + wid * 1024, bdst = lds0 + FX_LDS_B + wid * 256;
#define FX_TROW(t) ((t) == 0 ? 0 : 64 * (t) - 48)
#define FX_DMA_K(t, slot) fx_glds16(ksrc + (size_t)FX_TROW(t) * NU, (unsigned)__builtin_amdgcn_readfirstlane(kdst + (slot)))
#define FX_DMA_V(t, slot) fx_glds16(vsrc + (size_t)FX_TROW(t) * NU, (unsigned)__builtin_amdgcn_readfirstlane(vdst + (slot)))
#define FX_DMA_B(t, slot) fx_glds4(bsrc + 64 * (t), (unsigned)__builtin_amdgcn_readfirstlane(bdst + ((slot) >> 2)))
    const LAS char* vp0 = (const LAS char*)c.lds + FX_LDS_V + ((lane >> 4) & 1) * 32 + (lane & 3) * 8 + (4 * hi + ((lane & 15) >> 2)) * 64;
    const LAS char* kp0 = (const LAS char*)c.lds + FX_LDS_K + hi * 1024 + r32 * 16;
    const LAS char* bp0 = (const LAS char*)c.lds + FX_LDS_B + wid * 256 + hi * 16;
    FX_DMA_K(0, 0); FX_DMA_B(0, 0); FX_DMA_V(0, 0); FX_DMA_K(1, FX_SLOTB); FX_DMA_B(1, FX_SLOTB);
    bf16x8 qr[4];
#pragma unroll
    for (int d0 = 0; d0 < 4; ++d0) qr[d0] = *(const bf16x8*)(Ub + (size_t)(q0 + 32 * wid + r32) * NU + C_FQ + 64 * h + 16 * d0 + 8 * hi);
    const float bq = BT[q0 + 32 * wid + r32 + 48];
    float mhat = 0.f, l_reg = 0.f, fsc = 1.f; f32x16 o[2];
#pragma unroll
    for (int r = 0; r < 16; ++r) { o[0][r] = 0.f; o[1][r] = 0.f; }
    const int qrel = wid * 32 + r32; bool resc = false;
    f32x16 pA0, pA1, pB0, pB1; bf16x8 kf[8]; fx_s16x4 vlo[8], vhi[8]; u32x4v pw0, pw1, pw2, pw3;
    int sl_prev = 0, sl_cur = 0, sl_next = FX_SLOTB;
#define FX_ROT() do { sl_prev = sl_cur; sl_cur = sl_next; sl_next = (sl_next == 2 * FX_SLOTB) ? 0 : sl_next + FX_SLOTB; } while (0)
#define FX_EX(v) __builtin_amdgcn_exp2f((v) + nmh)
#define FX_RESC() do { if (resc) { _Pragma("unroll") for (int d_ = 0; d_ < 2; ++d_) _Pragma("unroll") for (int r = 0; r < 16; ++r) o[d_][r] *= fsc; } } while (0)
#define FX_BIAS(X0, X1, bp, i4) do { const f32x4v f0_ = *(const LAS f32x4v*)((bp) + 32 * (i4)), f1_ = *(const LAS f32x4v*)((bp) + 128 + 32 * (i4)); \
        _Pragma("unroll") for (int e_ = 0; e_ < 4; ++e_) { X0[4 * (i4) + e_] = f0_[e_]; X1[4 * (i4) + e_] = f1_[e_]; } } while (0)
    FX_DMA_K(2, 2 * FX_SLOTB); FX_DMA_B(2, 2 * FX_SLOTB);
    FX_WAIT_BAR(4);
    _Pragma("unroll") for (int i4 = 0; i4 < 4; ++i4) FX_BIAS(pA0, pA1, bp0, i4);
    _Pragma("unroll") for (int d0 = 0; d0 < 4; ++d0) fx_kload2(kf, kp0, d0);
    pA0 = MFMA32(kf[0], qr[0], pA0); pA1 = MFMA32(kf[1], qr[0], pA1); pA0 = MFMA32(kf[2], qr[1], pA0); pA1 = MFMA32(kf[3], qr[1], pA1);
    pA0 = MFMA32(kf[4], qr[2], pA0); pA1 = MFMA32(kf[5], qr[2], pA1); pA0 = MFMA32(kf[6], qr[3], pA0); pA1 = MFMA32(kf[7], qr[3], pA1);
    { const float rm = fx_rowmax(pA0, pA1); mhat = fmaxf(rm, bq); const float nmh = -mhat;
#pragma unroll
      for (int r = 0; r < 16; ++r) { pA0[r] = FX_EX(pA0[r]); pA1[r] = FX_EX(pA1[r]); } }
    FX_WAIT_BAR(0);
    FX_DMA_K(3, 0); FX_DMA_B(3, 0); FX_DMA_V(1, FX_SLOTB); FX_ROT();
    _Pragma("unroll") for (int d0 = 0; d0 < 4; ++d0) fx_kload2(kf, kp0 + sl_cur, d0);
    _Pragma("unroll") for (int i4 = 0; i4 < 4; ++i4) FX_BIAS(pB0, pB1, bp0 + (sl_cur >> 2), i4);
    FX_WAIT_BAR(3);
#define FX_PKW(P, i) cvtpk(P[i], P[i + 1])
#define FX_PAF(k) __builtin_bit_cast(bf16x8, pw##k)
#define FX_VFR(i) (bf16x8){vlo[i][0], vlo[i][1], vlo[i][2], vlo[i][3], vhi[i][0], vhi[i][1], vhi[i][2], vhi[i][3]}
#define FX_VRD(i) do { vlo[i] = fx_vtr(vp_ + (((i) >> 2) * 4096 + ((i) & 3) * 1024)); vhi[i] = fx_vtr(vp_ + (((i) >> 2) * 4096 + ((i) & 3) * 1024 + 512)); } while (0)
#define FX_KRD(G, d0) do { if (G) { fx_kload2(kf, kp0 + sl_next, d0); FX_SBAR(); } } while (0)
#define FX_BRD(G, X0, X1, i4) do { if (G) { FX_BIAS(X0, X1, bp0 + (sl_next >> 2), i4); FX_SBAR(); } } while (0)
#define FX_GAPA(MF, a0, a1, a2, a3, W0, W1, PW) do { MF; sacc += a0; sacc += a1; sacc += a2; sacc += a3; W0; W1; FX_PIN(PW); FX_PIN(sacc); FX_SBAR(); } while (0)
#define FX_GAPB(MF, X, i) do { MF; X[i] = FX_EX(X[i]); X[i + 1] = FX_EX(X[i + 1]); X[i + 2] = FX_EX(X[i + 2]); X[i + 3] = FX_EX(X[i + 3]); FX_PIN(X); FX_SBAR(); } while (0)
#define FX_STEP(C0, C1, P0, P1, t, MASK, GK, GV, GL) do { FX_SBAR(); \
    const LAS char* vp_ = vp0 + sl_prev; \
    FX_VRD(0); FX_SBAR(); float sacc = P0[0] + P0[1]; \
                          FX_GAPA(C0 = MFMA32(kf[0], qr[0], C0), P0[2], P0[3], P0[4], P0[5],     pw0[0] = FX_PKW(P0, 0),  pw0[1] = FX_PKW(P0, 2),  pw0); \
    FX_VRD(4); FX_SBAR(); FX_GAPA(C1 = MFMA32(kf[1], qr[0], C1), P0[6], P0[7], P0[8], P0[9],     pw0[2] = FX_PKW(P0, 4),  pw0[3] = FX_PKW(P0, 6),  pw0); \
    FX_VRD(1); FX_SBAR(); FX_GAPA(C0 = MFMA32(kf[2], qr[1], C0), P0[10], P0[11], P0[12], P0[13], pw1[0] = FX_PKW(P0, 8),  pw1[1] = FX_PKW(P0, 10), pw1); \
    FX_VRD(5); FX_SBAR(); FX_GAPA(C1 = MFMA32(kf[3], qr[1], C1), P0[14], P0[15], P1[0], P1[1],   pw1[2] = FX_PKW(P0, 12), pw1[3] = FX_PKW(P0, 14), pw1); \
    FX_VRD(2); FX_SBAR(); FX_GAPA(C0 = MFMA32(kf[4], qr[2], C0), P1[2], P1[3], P1[4], P1[5],     pw2[0] = FX_PKW(P1, 0),  pw2[1] = FX_PKW(P1, 2),  pw2); \
    FX_VRD(6); FX_SBAR(); FX_GAPA(C1 = MFMA32(kf[5], qr[2], C1), P1[6], P1[7], P1[8], P1[9],     pw2[2] = FX_PKW(P1, 4),  pw2[3] = FX_PKW(P1, 6),  pw2); \
    FX_VRD(3); FX_SBAR(); FX_GAPA(C0 = MFMA32(kf[6], qr[3], C0), P1[10], P1[11], P1[12], P1[13], pw3[0] = FX_PKW(P1, 8),  pw3[1] = FX_PKW(P1, 10), pw3); \
    FX_VRD(7); FX_SBAR(); FX_GAPA(C1 = MFMA32(kf[7], qr[3], C1), P1[14], P1[15], 0.f, 0.f,       pw3[2] = FX_PKW(P1, 12), pw3[3] = FX_PKW(P1, 14), pw3); \
    l_reg += sacc; \
    if (GK) { FX_DMA_K((t) + 3, sl_cur); FX_DMA_B((t) + 3, sl_cur); } if (GV) FX_DMA_V((t) + 1, sl_next); \
    if (MASK) fx_cmask(C0, C1, (t) - (NT - 4), qrel, hi); \
    { const float rm = fx_rowmax(C0, C1) - mhat; resc = false; \
      if (__builtin_expect(__ballot(rm > FX_THR) != 0ull, 0)) { const float dl = fmaxf(rm, 0.f); mhat += dl; fsc = __builtin_amdgcn_exp2f(-dl); l_reg *= fsc; resc = true; } } \
    const float nmh = -mhat; FX_SBAR(); \
    FX_GAPB(o[0] = MFMA32(FX_VFR(0), FX_PAF(0), o[0]), C0, 0);                    FX_GAPB(o[1] = MFMA32(FX_VFR(4), FX_PAF(0), o[1]), C0, 4); \
    FX_KRD(GL, 0); FX_GAPB(o[0] = MFMA32(FX_VFR(1), FX_PAF(1), o[0]), C0, 8);     FX_KRD(GL, 1); FX_GAPB(o[1] = MFMA32(FX_VFR(5), FX_PAF(1), o[1]), C0, 12); \
    FX_KRD(GL, 2); FX_GAPB(o[0] = MFMA32(FX_VFR(2), FX_PAF(2), o[0]), C1, 0);     FX_KRD(GL, 3); FX_GAPB(o[1] = MFMA32(FX_VFR(6), FX_PAF(2), o[1]), C1, 4); \
    FX_BRD(GL, P0, P1, 0); FX_BRD(GL, P0, P1, 1); FX_GAPB(o[0] = MFMA32(FX_VFR(3), FX_PAF(3), o[0]), C1, 8); \
    FX_BRD(GL, P0, P1, 2); FX_BRD(GL, P0, P1, 3); FX_GAPB(o[1] = MFMA32(FX_VFR(7), FX_PAF(3), o[1]), C1, 12); \
    } while (0)
#define FX_ENDW(tt) do { if ((tt) + 3 < NT) { FX_WAIT_BAR(3); } else if ((tt) + 2 < NT) { FX_WAIT_BAR(1); } else { FX_WAIT_BAR(0); } } while (0)
    FX_STEP(pB0, pB1, pA0, pA1, 1, true, true, true, true); FX_ENDW(1); FX_RESC(); FX_ROT();
    int t = 2;
    for (; t + 5 < NT; t += 2) {
        FX_STEP(pA0, pA1, pB0, pB1, t, false, true, true, true);     FX_WAIT_BAR(3); FX_RESC(); FX_ROT();
        FX_STEP(pB0, pB1, pA0, pA1, t + 1, false, true, true, true); FX_WAIT_BAR(3); FX_RESC(); FX_ROT();
    }
    for (; t + 1 < NT; t += 2) {
        FX_STEP(pA0, pA1, pB0, pB1, t, true, (t + 3 < NT), (t + 1 < NT), (t + 1 < NT));         FX_ENDW(t);     FX_RESC(); FX_ROT();
        FX_STEP(pB0, pB1, pA0, pA1, t + 1, true, (t + 4 < NT), (t + 2 < NT), (t + 2 < NT));     FX_ENDW(t + 1); FX_RESC(); FX_ROT();
    }
    FX_STEP(pA0, pA1, pB0, pB1, NT - 1, true, false, false, false); FX_RESC();
    { float sacc = pA0[0] + pA0[1];
#pragma unroll
      for (int r = 2; r < 16; ++r) sacc += pA0[r];
#pragma unroll
      for (int r = 0; r < 16; ++r) sacc += pA1[r];
      l_reg += sacc;
      pw0 = (u32x4v){FX_PKW(pA0, 0), FX_PKW(pA0, 2), FX_PKW(pA0, 4), FX_PKW(pA0, 6)}; pw1 = (u32x4v){FX_PKW(pA0, 8), FX_PKW(pA0, 10), FX_PKW(pA0, 12), FX_PKW(pA0, 14)};
      pw2 = (u32x4v){FX_PKW(pA1, 0), FX_PKW(pA1, 2), FX_PKW(pA1, 4), FX_PKW(pA1, 6)}; pw3 = (u32x4v){FX_PKW(pA1, 8), FX_PKW(pA1, 10), FX_PKW(pA1, 12), FX_PKW(pA1, 14)};
      const LAS char* vp_ = vp0 + sl_cur; _Pragma("unroll") for (int i = 0; i < 8; ++i) FX_VRD(i);
      o[0] = MFMA32(FX_VFR(0), FX_PAF(0), o[0]); o[1] = MFMA32(FX_VFR(4), FX_PAF(0), o[1]); o[0] = MFMA32(FX_VFR(1), FX_PAF(1), o[0]); o[1] = MFMA32(FX_VFR(5), FX_PAF(1), o[1]);
      o[0] = MFMA32(FX_VFR(2), FX_PAF(2), o[0]); o[1] = MFMA32(FX_VFR(6), FX_PAF(2), o[1]); o[0] = MFMA32(FX_VFR(3), FX_PAF(3), o[0]); o[1] = MFMA32(FX_VFR(7), FX_PAF(3), o[1]); }
    l_reg = fx_swapsum(l_reg);
    {   const float inv = __builtin_amdgcn_rcpf(l_reg); bf16* yr = Y + (size_t)(b * L + q0 + 32 * wid + r32) * KOUT + 1024 + 64 * h;
#pragma unroll
        for (int i4 = 0; i4 < 4; ++i4) {
            *(u32x2v*)(yr + 8 * i4 + 4 * hi) = (u32x2v){cvtpk(o[0][4 * i4] * inv, o[0][4 * i4 + 1] * inv), cvtpk(o[0][4 * i4 + 2] * inv, o[0][4 * i4 + 3] * inv)};
            *(u32x2v*)(yr + 32 + 8 * i4 + 4 * hi) = (u32x2v){cvtpk(o[1][4 * i4] * inv, o[1][4 * i4 + 1] * inv), cvtpk(o[1][4 * i4 + 2] * inv, o[1][4 * i4 + 3] * inv)};
        }
    }
    asm volatile("s_waitcnt lgkmcnt(0)\n\ts_barrier" ::: "memory");
#undef FX_TROW
#undef FX_DMA_K
#undef FX_DMA_V
#undef FX_DMA_B
#undef FX_ROT
#undef FX_EX
#undef FX_RESC
#undef FX_BIAS
#undef FX_PKW
#undef FX_PAF
#undef FX_VFR
#undef FX_VRD
#undef FX_KRD
#undef FX_BRD
#undef FX_GAPA
#undef FX_GAPB
#undef FX_STEP
#undef FX_ENDW
}
__device__ __forceinline__ void ph_fox(const Ctx& c0, const bf16* U, const float* FCUM, bf16* Y) {
    const Ctx c = refresh(c0);
    LAS bf16* KS = (LAS bf16*)c.lds;
    LAS bf16* VT = KS + 2 * FOX_KB;
    LAS float* FB = (LAS float*)(c.lds + 4 * FOX_KB * 2);
    const int lane = c.lane, w = c.wave, r32 = lane & 31, hi = lane >> 5, tid = c.tid;
    const float LOG2E = 1.4426950408889634f;
    typedef short s16x4v __attribute__((ext_vector_type(4)));
    for (int it = c.bid; it < 64 * 17; it += c.nb) {
        const int rnd = it >> 8, cu = it & 255, k4 = cu >> 6, bh = cu & 63, b = bh >> 3, h = bh & 7;
        const int j = rnd == 0 ? 16 - k4 : rnd == 1 ? 9 + k4 : rnd == 2 ? 8 - k4 : rnd == 3 ? 1 + k4 : 0;
        if (j > 0) { fox_unit(c, b, h, j, U, FCUM + (size_t)bh * LKP, Y); continue; }
        const int q0 = j == 0 ? 0 : 16 + 256 * (j - 1), qrow = q0 + 32 * w + r32, ntiles = 1 + 4 * j, qmax = q0 + 32 * w + 31;
        const bool wave_on = (j > 0) || (w == 0), row_ok = (j > 0) || (r32 < 16);
        const bf16* Ub = U + (size_t)(b * L) * NU;
        bf16x8 qf[4];
#pragma unroll
        for (int s = 0; s < 4; ++s) qf[s] = (bf16x8){0, 0, 0, 0, 0, 0, 0, 0};
        if (wave_on && row_ok) {
#pragma unroll
            for (int s = 0; s < 4; ++s) qf[s] = *(const bf16x8*)(Ub + (size_t)qrow * NU + C_FQ + 64 * h + 16 * s + 8 * hi);
        }
        f32x16 o0, o1;
#pragma unroll
        for (int r = 0; r < 16; ++r) { o0[r] = 0.f; o1[r] = 0.f; }
        float m = -1e30f, l = 0.f;
        const float* fc = FCUM + (size_t)bh * LKP;
        const bf16* kg = Ub + (size_t)(tid >> 3) * NU + C_FK + 64 * h + 8 * (tid & 7);
        const bf16* vg = Ub + (size_t)lane * NU + C_FV + 64 * h + 8 * w;
#define FOX_KB0(t) ((t) == 0 ? 0 : 16 + 64 * ((t) - 1))
#define FOX_PUT_K(buf, kr, fr) do { *(LAS u32x4v*)(KS + (buf) * FOX_KB + (tid >> 3) * AT_KSTR + 8 * (tid & 7)) = kr; if (tid < 64) FB[(buf) * 64 + tid] = fr; } while (0)
#define FOX_PUT_V(buf, vr) do { const unsigned vv_[4] = {vr.x, vr.y, vr.z, vr.w}; \
            _Pragma("unroll") for (int e = 0; e < 8; ++e) VT[(buf) * FOX_KB + (8 * w + e) * AT_VSTR + lane] = (bf16)(vv_[e >> 1] >> (16 * (e & 1))); } while (0)
#define FOX_GET_K(t, kr, fr) do { const int kb_ = FOX_KB0(t); kr = *(const u32x4v*)(kg + (size_t)kb_ * NU); if (tid < 64) fr = fc[kb_ + tid]; } while (0)
#define FOX_GET_V(t, vr) do { vr = *(const u32x4v*)(vg + (size_t)FOX_KB0(t) * NU); } while (0)
#define FOX_QK(buf, P0, P1) do { const LAS float* fb_ = FB + (buf) * 64; \
            _Pragma("unroll") for (int i4 = 0; i4 < 4; ++i4) { const f32x4v f0 = *(const LAS f32x4v*)(fb_ + 8 * i4 + 4 * hi), f1 = *(const LAS f32x4v*)(fb_ + 32 + 8 * i4 + 4 * hi); \
                _Pragma("unroll") for (int e = 0; e < 4; ++e) { P0[4 * i4 + e] = f0[e]; P1[4 * i4 + e] = f1[e]; } } \
            _Pragma("unroll") for (int s = 0; s < 4; ++s) { \
                const bf16x8 a0 = *(const LAS bf16x8*)(KS + (buf) * FOX_KB + r32 * AT_KSTR + 16 * s + 8 * hi), a1 = *(const LAS bf16x8*)(KS + (buf) * FOX_KB + (32 + r32) * AT_KSTR + 16 * s + 8 * hi); \
                P0 = MFMA32(a0, qf[s], P0); P1 = MFMA32(a1, qf[s], P1); } } while (0)
        u32x4v kreg, vreg; float fbreg = 0.f;
        FOX_GET_K(0, kreg, fbreg); FOX_GET_V(0, vreg);
        FOX_PUT_K(0, kreg, fbreg); FOX_PUT_V(0, vreg);
        if (ntiles > 1) { FOX_GET_K(1, kreg, fbreg); FOX_GET_V(1, vreg); FOX_PUT_K(1, kreg, fbreg); }
        if (ntiles > 2) FOX_GET_K(2, kreg, fbreg);
        __syncthreads();
        f32x16 pc0, pc1, pn0, pn1;
#pragma unroll
        for (int r = 0; r < 16; ++r) { pc0[r] = 0.f; pc1[r] = 0.f; pn0[r] = 0.f; pn1[r] = 0.f; }
        if (wave_on) FOX_QK(0, pc0, pc1);
        __syncthreads();
        for (int i = 0; i < ntiles; ++i) {
            const int cur = i & 1, kb = FOX_KB0(i), kbn = FOX_KB0(i + 1);
            if (i + 2 < ntiles) FOX_PUT_K(cur, kreg, fbreg);
            if (i + 1 < ntiles) FOX_PUT_V(cur ^ 1, vreg);
            if (i + 3 < ntiles) FOX_GET_K(i + 3, kreg, fbreg);
            if (i + 2 < ntiles) FOX_GET_V(i + 2, vreg);
            const bool on_next = wave_on && (i + 1 < ntiles) && kbn <= qmax, on_cur = wave_on && kb <= qmax;
            if (on_next) FOX_QK(cur ^ 1, pn0, pn1);
            if (on_cur) {
                if (i == 0 || kb + 63 > q0 + 32 * w) {
                    const int klim = i == 0 ? 16 : 64;
#pragma unroll
                    for (int r = 0; r < 16; ++r) { const int k0 = crow(r, hi), k1 = 32 + k0;
                        if (!(k0 < klim && kb + k0 <= qrow)) pc0[r] = -1e30f;
                        if (!(k1 < klim && kb + k1 <= qrow)) pc1[r] = -1e30f; }
                }
                float mx = max3c(pc0[0], pc1[0], pc0[1]), mx2 = max3c(pc1[1], pc0[2], pc1[2]);
#pragma unroll
                for (int r = 3; r < 15; r += 2) { mx = max3c(mx, pc0[r], pc1[r]); mx2 = max3c(mx2, pc0[r + 1], pc1[r + 1]); }
                mx = max3c(mx, pc0[15], pc1[15]); mx = max3c(mx, mx2, mx2);
                const float mn = max3c(m, mx, lane_read(mx, lane ^ 32)), alpha = __builtin_amdgcn_exp2f(m - mn); const bool grew = __ballot(mn > m) != 0ull; m = mn;
                float sum = 0.f;
#pragma unroll
                for (int r = 0; r < 16; ++r) { pc0[r] = __builtin_amdgcn_exp2f(pc0[r] - mn); pc1[r] = __builtin_amdgcn_exp2f(pc1[r] - mn); sum += pc0[r] + pc1[r]; }
                l = l * alpha + sum;
                if (grew) {
#pragma unroll
                    for (int r = 0; r < 16; ++r) { o0[r] *= alpha; o1[r] *= alpha; } }
#pragma unroll
                for (int blk = 0; blk < 2; ++blk)
#pragma unroll
                    for (int s = 0; s < 2; ++s) {
                        const bf16x8 xs = pack8(blk == 0 ? pc0 : pc1, s);
                        const LAS bf16* vp = VT + cur * FOX_KB + r32 * AT_VSTR + 32 * blk + 16 * s + 4 * hi;
                        const s16x4v lo0 = *(const LAS s16x4v*)vp, hi0 = *(const LAS s16x4v*)(vp + 8);
                        const s16x4v lo1 = *(const LAS s16x4v*)(vp + 32 * AT_VSTR), hi1 = *(const LAS s16x4v*)(vp + 32 * AT_VSTR + 8);
                        const bf16x8 pa0 = __builtin_shufflevector(lo0, hi0, 0, 1, 2, 3, 4, 5, 6, 7), pa1 = __builtin_shufflevector(lo1, hi1, 0, 1, 2, 3, 4, 5, 6, 7);
                        o0 = MFMA32(pa0, xs, o0); o1 = MFMA32(pa1, xs, o1);
                    }
            }
            pc0 = pn0; pc1 = pn1;
            __syncthreads();
        }
        l += lane_read(l, lane ^ 32);
        if (wave_on && row_ok) {
            const float inv = 1.f / l; bf16* yr = Y + (size_t)(b * L + qrow) * KOUT + 1024 + 64 * h;
#pragma unroll
            for (int i4 = 0; i4 < 4; ++i4) {
                *(u32x2v*)(yr + 8 * i4 + 4 * hi) = (u32x2v){cvtpk(o0[4 * i4] * inv, o0[4 * i4 + 1] * inv), cvtpk(o0[4 * i4 + 2] * inv, o0[4 * i4 + 3] * inv)};
                *(u32x2v*)(yr + 32 + 8 * i4 + 4 * hi) = (u32x2v){cvtpk(o1[4 * i4] * inv, o1[4 * i4 + 1] * inv), cvtpk(o1[4 * i4 + 2] * inv, o1[4 * i4 + 3] * inv)};
            }
        }
    }
}
constexpr int DSA_LIST_OFF = 150016  , DSA_BUF_ELEMS = 17920  , DSA_SC_STR = 4160, DSA_MW_OFF = 8 * DSA_SC_STR * 4  , DSA_KSTR = 136, DSA_VT_OFF = 64 * DSA_KSTR * 2  , DSA_RING_OFF = 73728  ;
__device__ __forceinline__ void ph_dsa(const Ctx& c0, const bf16* U, const float* UF, const bf16* CN, const bf16* KI) {
    const Ctx c = refresh(c0);
    LAS unsigned* SC = (LAS unsigned*)c.lds;
    LAS u64* MW = (LAS u64*)(c.lds + DSA_MW_OFF);
    LAS bf16* KS = (LAS bf16*)c.lds;
    LAS bf16* VT = (LAS bf16*)(c.lds + DSA_VT_OFF);
    const int lane0 = c.lane, w0 = c.wave;
    const float LOG2E = 1.4426950408889634f;
    for (int it = c.bid; it < 1032; it += c.nb) {
        int w_tk = w0; asm volatile("" : "+s"(w_tk)); const int w = w_tk;
        int lane_tk = lane0; asm volatile("" : "+v"(lane_tk)); const int lane = lane_tk, r32 = lane & 31, hi = lane >> 5, tid = w * 64 + lane;
        const int rnd = it >> 8, cu = it & 255, g16 = cu >> 4, wi16 = cu & 15;
        const int ch = rnd == 0 ? 64 - g16 : rnd == 1 ? 33 + g16 : rnd == 2 ? 32 - g16 : rnd == 3 ? 1 + g16 : 0;
        const int b = rnd == 4 ? cu : (wi16 >> 1), half = rnd == 4 ? 0 : (wi16 & 1);
        const int p0q = ch == 0 ? 0 : 16 + 64 * (ch - 1) + 32 * half, nq = ch == 0 ? 16 : 32, nadm = ch == 0 ? 16 : 16 + 64 * ch, nw = ch + 1;
        const int t0 = b * L + p0q;
        const bf16* Ub = U + (size_t)(b * L) * NU;
        if (nadm <= TOPK) {
            for (int i = tid; i < 32 * 65; i += NTHR) { const int wd = i % 65; const int lo = 64 * wd; const int nb_ = nadm - lo;
                MW[i] = (wd < nw && nb_ > 0) ? (nb_ >= 64 ? ~0ull : ((1ull << nb_) - 1ull)) : 0ull; }
            __syncthreads();
        } else {
            const int nkb = 2 * nw;
#pragma unroll 1
            for (int sb = 0; sb < 4; ++sb) {
                const int tq = t0 + 8 * sb;
                for (int rs_ = 0; rs_ < REP_SCORE; ++rs_) {
                    bf16x8 aq[4]; float wq[4][4];
#pragma unroll
                    for (int s = 0; s < 4; ++s) aq[s] = *(const bf16x8*)(U + (size_t)(tq + (r32 >> 2)) * NU + C_QI + 64 * (r32 & 3) + 32 * hi + 8 * s);
#pragma unroll
                    for (int i4 = 0; i4 < 4; ++i4) { const f32x4v t4 = *(const f32x4v*)(UF + (size_t)(tq + 2 * i4 + hi) * 32 + 16); wq[i4][0] = t4[0]; wq[i4][1] = t4[1]; wq[i4][2] = t4[2]; wq[i4][3] = t4[3]; }
                    const bf16* kib = KI + (size_t)(b * L) * 64 + (size_t)r32 * 64 + 32 * hi;
                    bf16x8 bk[4], bn[4], bm[4];
#pragma unroll
                    for (int s = 0; s < 4; ++s) { bk[s] = *(const bf16x8*)(kib + (size_t)(32 * w) * 64 + 8 * s); bn[s] = bk[s]; bm[s] = bk[s]; }
                    if (w + NWAVE < nkb) {
#pragma unroll
                        for (int s = 0; s < 4; ++s) bn[s] = *(const bf16x8*)(kib + (size_t)(32 * (w + NWAVE)) * 64 + 8 * s); }
#pragma unroll 1
                    for (int kb = w; kb < nkb; kb += NWAVE) {
                        if (kb + 2 * NWAVE < nkb) {
#pragma unroll
                            for (int s = 0; s < 4; ++s) bm[s] = *(const bf16x8*)(kib + (size_t)(32 * (kb + 2 * NWAVE)) * 64 + 8 * s); }
                        const int key = 32 * kb + r32; f32x16 acc;
#pragma unroll
                        for (int r = 0; r < 16; ++r) acc[r] = 0.f;
#pragma unroll
                        for (int s = 0; s < 4; ++s) acc = MFMA32(aq[s], bk[s], acc);
#pragma unroll
                        for (int i4 = 0; i4 < 4; ++i4) {
                            float s = wq[i4][0] * fmaxf(acc[4 * i4], 0.f) + wq[i4][1] * fmaxf(acc[4 * i4 + 1], 0.f) + wq[i4][2] * fmaxf(acc[4 * i4 + 2], 0.f) + wq[i4][3] * fmaxf(acc[4 * i4 + 3], 0.f);
                            asm("v_add_f32 %0, 0, %0" : "+v"(s));
                            unsigned kv = fkey(s); if (32 * kb + 31 >= nadm) kv = key < nadm ? kv : 0u;
                            SC[(2 * i4 + hi) * DSA_SC_STR + key] = kv;
                        }
#pragma unroll
                        for (int s = 0; s < 4; ++s) { bk[s] = bn[s]; bn[s] = bm[s]; }
                    }
                }
                __syncthreads();
                for (int rs_ = 0; rs_ < REP_SEL; ++rs_) {
                    unsigned kk[65];
#pragma unroll
                    for (int j = 0; j < 65; ++j) kk[j] = 0u;
#define DSA_BUCKETS(F) { F(0, 16) if (nw > 16) { F(16, 32) } if (nw > 32) { F(32, 48) } if (nw > 48) { F(48, 64) } if (nw > 64) { F(64, 65) } }
#define DSA_LOAD(j0, j1) _Pragma("unroll") for (int j = j0; j < j1; ++j) kk[j] = SC[w * DSA_SC_STR + 64 * j + lane];
                    DSA_BUCKETS(DSA_LOAD)
#pragma unroll
                    for (int j = 0; j < 65; ++j) if (j >= 5) kk[j] = j < nw ? kk[j] : 0u;
#define DSA_C4(a, b, c_, d) asm volatile("v_cmp_ge_u32_e64 %1, %5, %9\n\tv_cmp_ge_u32_e64 %2, %6, %9\n\tv_cmp_ge_u32_e64 %3, %7, %9\n\tv_cmp_ge_u32_e64 %4, %8, %9\n\t" \
                        "v_addc_co_u32_e64 %0, vcc, 0, %0, %1\n\tv_addc_co_u32_e64 %0, vcc, 0, %0, %2\n\tv_addc_co_u32_e64 %0, vcc, 0, %0, %3\n\tv_addc_co_u32_e64 %0, vcc, 0, %0, %4" \
                        : "+v"(nl_), "=&s"(m0_), "=&s"(m1_), "=&s"(m2_), "=&s"(m3_) : "v"(a), "v"(b), "v"(c_), "v"(d), "v"(cand_) : "vcc");
#define DSA_CNT16(j0, j1) if (j1 - j0 == 16) { DSA_C4(kk[j0], kk[j0 + 1], kk[j0 + 2], kk[j0 + 3]) DSA_C4(kk[j0 + 4], kk[j0 + 5], kk[j0 + 6], kk[j0 + 7]) DSA_C4(kk[j0 + 8], kk[j0 + 9], kk[j0 + 10], kk[j0 + 11]) DSA_C4(kk[j0 + 12], kk[j0 + 13], kk[j0 + 14], kk[j0 + 15]) } \
                        else { nl_ += kk[64] >= cand_ ? 1 : 0; }
#define DSA_COUNT(CAND, N) { const unsigned cand_ = (CAND); int nl_ = 0; u64 m0_, m1_, m2_, m3_; DSA_BUCKETS(DSA_CNT16) N = 0; \
                        _Pragma("unroll") for (int k_ = 0; k_ < 7; ++k_) N += __popcll(__ballot((nl_ >> k_) & 1)) << k_; }
                    unsigned kmax = 0u;
#define DSA_MAX(j0, j1) _Pragma("unroll") for (int j = j0; j < j1; ++j) kmax = kk[j] > kmax ? kk[j] : kmax;
                    DSA_BUCKETS(DSA_MAX)
#pragma unroll
                    for (int o = 1; o < 64; o <<= 1) { const unsigned t_ = (unsigned)lane_readi((int)kmax, lane ^ o); kmax = t_ > kmax ? t_ : kmax; }
                    kmax = (unsigned)__builtin_amdgcn_readfirstlane((int)kmax);
                    unsigned lo = 0u, hi = (kmax >> 23) + 1u, tau = 0u; int nhi = 0, nlo = -1; bool exact = false;
                    {   unsigned step = 1u;
#pragma unroll 1
                        while (hi - lo > 1u) {
                            const unsigned e = step ? (hi - lo > step ? hi - step : lo + 1u) : lo + ((hi - lo) >> 1);
                            int n; DSA_COUNT(e << 23, n)
                            if (n == TOPK) { exact = true; tau = e << 23; break; }
                            if (n > TOPK) { lo = e; nlo = n; step = 0u; } else { hi = e; nhi = n; if (step) step <<= 1; }
                        }
                    }
                    int need = 0, ntau = -1, wb = 23;
                    if (!exact) {
                        tau = lo << 23; ntau = nlo;
#pragma unroll 1
                        for (int bit = 22; bit >= 20; --bit) {
                            if (ntau >= 0 && ntau - nhi <= 256) break;
                            const unsigned cand = tau | (1u << bit); int n; DSA_COUNT(cand, n)
                            if (n == TOPK) { exact = true; tau = cand; break; }
                            if (n > TOPK) { tau = cand; ntau = n; } else nhi = n;
                            wb = bit; }
                    }
                    if (!exact) {
                        int nin = ntau; if (nin < 0) { DSA_COUNT(tau, nin) }
                        const int nc = nin - nhi, needc = TOPK - nhi;
                        if (nc <= 256) {
                            LAS unsigned* lst = (LAS unsigned*)(c.lds + DSA_LIST_OFF) + w * 256; int base = 0;
#define DSA_COMPACT1(j) { const bool inb = (kk[j] - tau) < (1u << wb); const u64 be = __ballot(inb); \
                                if (be != 0ull) { if (inb) lst[base + __popcll(be & ((1ull << lane) - 1ull))] = kk[j]; base += __popcll(be); } }
#define DSA_COMPACT(j0, j1) if (j1 - j0 == 16) { _Pragma("unroll") for (int j = j0; j < j1; j += 4) { \
                                    const u64 any_ = __ballot((kk[j] - tau) < (1u << wb)) | __ballot((kk[j + 1] - tau) < (1u << wb)) | __ballot((kk[j + 2] - tau) < (1u << wb)) | __ballot((kk[j + 3] - tau) < (1u << wb)); \
                                    if (any_ != 0ull) { DSA_COMPACT1(j) DSA_COMPACT1(j + 1) DSA_COMPACT1(j + 2) DSA_COMPACT1(j + 3) } } }        \
                            else { DSA_COMPACT1(j0) }
                            DSA_BUCKETS(DSA_COMPACT)
                            const unsigned c0 = lane < nc ? lst[lane] : 0u, c1 = lane + 64 < nc ? lst[lane + 64] : 0u, c2 = lane + 128 < nc ? lst[lane + 128] : 0u, c3 = lane + 192 < nc ? lst[lane + 192] : 0u;
#pragma unroll 1
                            for (int bit = wb - 1; bit >= 0; --bit) { const unsigned cand = tau | (1u << bit);
                                const int n = (__popcll(__ballot(c0 >= cand)) + __popcll(__ballot(c1 >= cand))) + (__popcll(__ballot(c2 >= cand)) + __popcll(__ballot(c3 >= cand)));
                                if (n >= needc) tau = cand;
                                if (n == needc) { exact = true; break; } }
                            if (!exact) need = needc - ((__popcll(__ballot(c0 > tau)) + __popcll(__ballot(c1 > tau))) + (__popcll(__ballot(c2 > tau)) + __popcll(__ballot(c3 > tau))));
                        } else {
                            int n1; DSA_COUNT(tau + 1u, n1)
                            if (n1 < TOPK) need = TOPK - n1;
                            else {
#pragma unroll 1
                                for (int bit = wb - 1; bit >= 0; --bit) { const unsigned cand = tau | (1u << bit); int n; DSA_COUNT(cand, n)
                                    if (n >= TOPK) tau = cand;
                                    if (n == TOPK) { exact = true; break; } }
                                if (!exact) { int n; DSA_COUNT(tau + 1u, n) need = TOPK - n; }
                            }
                        }
                    }
                    int run = 0; unsigned mlo = 0u, mhi = 0u; u64 mine1 = 0ull; const unsigned tsel = exact ? tau : tau + 1u;
#define DSA_SEL(j0, j1) _Pragma("unroll") for (int j = j0; j < j1; ++j) { u64 bs = __ballot(kk[j] >= tsel); \
                        if (!exact) { const u64 be = __ballot(kk[j] == tau); \
                            if (be != 0ull) { const int take = need - run; if (take > 0) { const bool eq = kk[j] == tau; const int rank = __popcll(be & ((1ull << lane) - 1ull)); bs |= __ballot(eq && rank < take); } run += __popcll(be); } } \
                        if (j < 64) { WLANE64(mlo, mhi, bs, j); } else mine1 = bs; }
#define DSA_SELX(j0, j1) _Pragma("unroll") for (int j = j0; j < j1; ++j) { const u64 bs = __ballot(kk[j] >= tsel); if (j < 64) { WLANE64(mlo, mhi, bs, j); } else mine1 = bs; }
                    if (exact) { DSA_BUCKETS(DSA_SELX) } else { DSA_BUCKETS(DSA_SEL) }
                    const u64 mine0 = ((u64)mhi << 32) | mlo;
                    MW[(8 * sb + w) * 65 + lane] = lane < nw ? mine0 : 0ull;
                    if (lane == 0) MW[(8 * sb + w) * 65 + 64] = nw > 64 ? mine1 : 0ull;
                }
                __syncthreads();
            }
        }
        for (int ra_ = 0; ra_ < REP_ATT; ++ra_) {
        int w_at = w0; asm volatile("" : "+s"(w_at)); const int w = w_at;
        int lane_at = lane0; asm volatile("" : "+v"(lane_at)); const int lane = lane_at, r32 = lane & 31, hi = lane >> 5, tid = w * 64 + lane;
        const bf16* Cb = CN + (size_t)(b * L) * 128;
        const unsigned ring0 = (unsigned)(size_t)c.lds + DSA_RING_OFF;
#define DSA_SLOT(ti) ((((ti) & 3) == 3) ? (unsigned)(size_t)c.lds : ring0 + (unsigned)((ti) & 3) * 16384u)
#define DSA_DMA(ti) do { const unsigned d_ = (unsigned)__builtin_amdgcn_readfirstlane(DSA_SLOT(ti) + w * 2048); \
            int lq_ = lane0; asm volatile("" : "+v"(lq_)); const int rr0_ = 8 * w + (lq_ >> 4), rr1_ = rr0_ + 4;        \
            fx_glds16(Cb + (size_t)(64 * (ti) + rr0_) * 128 + 8 * ((lq_ & 15) ^ (((rr0_ & 3) << 2) | ((rr0_ >> 2) & 3))), d_); \
            fx_glds16(Cb + (size_t)(64 * (ti) + rr1_) * 128 + 8 * ((lq_ & 15) ^ (((rr1_ & 3) << 2) | ((rr1_ >> 2) & 3))), d_ + 1024); } while (0)
        DSA_DMA(0); if (nw > 1) DSA_DMA(1);
        bf16x8 qf[8];
        {   LAS bf16* QL = (LAS bf16*)c.lds + w * (32 * 136); const bf16* WUKB = (const bf16*)(pt_get(c, 26) + WS_FCUM + 1536 * 1024);
            bf16x8 qd[4];
#pragma unroll
            for (int s = 0; s < 4; ++s) qd[s] = *(const bf16x8*)(U + (size_t)(t0 + r32) * NU + C_DQ + 64 * w + 16 * s + 8 * hi);
#pragma unroll
            for (int rb = 0; rb < 4; ++rb) {
                f32x16 a_;
#pragma unroll
                for (int r = 0; r < 16; ++r) a_[r] = 0.f;
#pragma unroll
                for (int s = 0; s < 4; ++s) a_ = MFMA32(*(const bf16x8*)(WUKB + (size_t)(w * 128 + 32 * rb + r32) * 64 + 16 * s + 8 * hi), qd[s], a_);
#pragma unroll
                for (int i4 = 0; i4 < 4; ++i4) *(LAS u32x2v*)(QL + r32 * 136 + 32 * rb + 8 * i4 + 4 * hi) = (u32x2v){cvtpk(a_[4 * i4], a_[4 * i4 + 1]), cvtpk(a_[4 * i4 + 2], a_[4 * i4 + 3])};
            }
#pragma unroll
            for (int s = 0; s < 8; ++s) qf[s] = *(const LAS bf16x8*)(QL + r32 * 136 + 16 * s + 8 * hi);
            if (r32 >= nq) {
#pragma unroll
                for (int s = 0; s < 8; ++s) qf[s] = (bf16x8){0, 0, 0, 0, 0, 0, 0, 0}; }
        }
        f32x16 o[4];
#pragma unroll
        for (int db = 0; db < 4; ++db)
#pragma unroll
            for (int r = 0; r < 16; ++r) o[db][r] = 0.f;
        float m = -1e4f, l = 0.f;
        unsigned kb0, vb0[2];
        {   int lo_ = lane; asm volatile("" : "+v"(lo_));
            const int r32 = lo_ & 31, hi = lo_ >> 5, lane = lo_;
            const unsigned xr = ((r32 & 3) << 2) | ((r32 >> 2) & 3);
            kb0 = (256u * r32 + 16u * (hi ^ (xr & 1u))) | (16u * (xr & 14u));
            const unsigned blk_ = (lane >> 4) & 1, q_ = (lane & 15) >> 2, p_ = lane & 3;
#pragma unroll
            for (int t = 0; t < 2; ++t) vb0[t] = (256u * (4 * hi + 8 * t + q_) + 16u * ((2 * blk_ + (p_ >> 1)) ^ ((hi + 2 * t) & 3)) + 8u * (p_ & 1)) | (64u * q_);
        }
#define DSA_WAITBAR(t) do { if ((t) + 1 < nw) asm volatile("s_waitcnt vmcnt(2) lgkmcnt(0)\n\ts_barrier" ::: "memory"); else asm volatile("s_waitcnt vmcnt(0) lgkmcnt(0)\n\ts_barrier" ::: "memory"); } while (0)
#define DSA_KRD(dst, s) dst = *(const LAS bf16x8*)((const LAS char*)(size_t)(kbt ^ (32u * (s))))
#define DSA_VRD(lo_, hh_, k) do { lo_ = fx_vtr((const LAS char*)(size_t)(vpt0 ^ (64u * ((k) & 3))) + 4096 * ((k) >> 2)); hh_ = fx_vtr((const LAS char*)(size_t)(vpt1 ^ (64u * ((k) & 3))) + 4096 * ((k) >> 2)); } while (0)
#define DSA_VF(lo_, hh_) __builtin_shufflevector(lo_, hh_, 0, 1, 2, 3, 4, 5, 6, 7)
#define DSA_PVAL(P, i) (P)[i] = __builtin_amdgcn_exp2f((P)[i]); sacc += (P)[i]
#define DSA_INIT(C, r) do { const unsigned s0_ = (unsigned)__builtin_amdgcn_sbfe((int)msk_s, ((r) & 3) + 8 * ((r) >> 2), 1); \
            C[r] = __uint_as_float((negm_b & s0_) | (0xf149f2cau & ~s0_)); } while (0)
#define DSA_DECIDE(C) do { const float rm_ = max3c(mx, fx_swapmax(mx), mx); \
            if (__builtin_expect(__ballot(rm_ > FX_THR) != 0ull, 0)) { const float dl_ = fmaxf(rm_, 0.f), alpha_ = __builtin_amdgcn_exp2f(-dl_); m += dl_; l *= alpha_; \
                _Pragma("unroll") for (int r = 0; r < 16; ++r) C[r] -= dl_; \
                _Pragma("unroll") for (int db = 0; db < 4; ++db) _Pragma("unroll") for (int r = 0; r < 16; ++r) o[db][r] *= alpha_; } } while (0)
#define DSA_GA(C, P, s, f) { \
            C = MFMA32(f, qf[s], C); DSA_PVAL(P, 2 * (s)); DSA_PVAL(P, 2 * (s) + 1); \
            if ((s) < 4) { pwa[(s) & 3] = cvtpk((P)[2 * (s)], (P)[2 * (s) + 1]); FX_PIN(pwa); } else { pwb[(s) & 3] = cvtpk((P)[2 * (s)], (P)[2 * (s) + 1]); FX_PIN(pwb); } FX_PIN(sacc); FX_SBAR(); \
            if ((s) + 2 < 8) { DSA_KRD(f, (s) + 2); FX_SBAR(); } }
#define DSA_GB(C, k, f0, f1, n0, n1) { \
            if ((k) + 1 < 8) { DSA_VRD(n0, n1, 4 * ksb + (k) + 1); FX_SBAR(); } \
            o[(k) & 3] = MFMA32(DSA_VF(f0, f1), __builtin_bit_cast(bf16x8, (k) < 4 ? pwa : pwb), o[(k) & 3]); \
            mx = max3c(mx, C[2 * (k)], C[2 * (k) + 1]); FX_PIN(mx); FX_SBAR(); }
#define DSA_HSTEP(C, P, t, hf, tp) do { \
            const unsigned kbt = DSA_SLOT(t) + kb0 + 8192u * (hf), vpt0 = DSA_SLOT(tp) + vb0[0], vpt1 = DSA_SLOT(tp) + vb0[1]; constexpr int ksb = 2 * (1 - (hf)); \
            const u64 m64 = MW[r32 * 65 + (t)]; const unsigned msk_s = (unsigned)((hf) ? (m64 >> 32) : m64) >> (4 * hi); \
            bf16x8 ka, kc; float sacc = 0.f, mx = -1e30f; u32x4v pwa, pwb; fx_s16x4 va0, va1, vb0_, vb1_; \
            DSA_KRD(ka, 0); DSA_KRD(kc, 1); FX_SBAR(); \
            { const unsigned negm_b = __float_as_uint(-m); _Pragma("unroll") for (int r = 0; r < 16; ++r) DSA_INIT(C, r); } \
            DSA_GA(C, P, 0, ka) DSA_GA(C, P, 1, kc) DSA_GA(C, P, 2, ka) DSA_GA(C, P, 3, kc) DSA_GA(C, P, 4, ka) DSA_GA(C, P, 5, kc) DSA_GA(C, P, 6, ka) DSA_GA(C, P, 7, kc) \
            l += sacc; \
            DSA_VRD(va0, va1, 4 * ksb); FX_SBAR(); \
            DSA_GB(C, 0, va0, va1, vb0_, vb1_) DSA_GB(C, 1, vb0_, vb1_, va0, va1) DSA_GB(C, 2, va0, va1, vb0_, vb1_) DSA_GB(C, 3, vb0_, vb1_, va0, va1) \
            DSA_GB(C, 4, va0, va1, vb0_, vb1_) DSA_GB(C, 5, vb0_, vb1_, va0, va1) DSA_GB(C, 6, va0, va1, vb0_, vb1_) DSA_GB(C, 7, vb0_, vb1_, va0, va1) \
            DSA_DECIDE(C); } while (0)
        f32x16 pA, pB;
        DSA_WAITBAR(0); if (2 < nw) DSA_DMA(2);
        {   const unsigned kbt = DSA_SLOT(0) + kb0; const u64 m64 = MW[r32 * 65]; const unsigned msk_s = (unsigned)m64 >> (4 * hi), negm_b = 0u; float mx = -1e30f;
#pragma unroll
            for (int r = 0; r < 16; ++r) DSA_INIT(pA, r);
#pragma unroll
            for (int s = 0; s < 8; ++s) { bf16x8 kf_; DSA_KRD(kf_, s); pA = MFMA32(kf_, qf[s], pA); }
#pragma unroll
            for (int r = 0; r < 16; ++r) mx = max3c(mx, pA[r], pA[r]);
            m = max3c(mx, fx_swapmax(mx), -1e4f);
#pragma unroll
            for (int r = 0; r < 16; ++r) pA[r] -= m;
        }
        DSA_HSTEP(pB, pA, 0, 1, 0);
        for (int t = 1; t < nw; ++t) {
            DSA_WAITBAR(t); if (t + 2 < nw) DSA_DMA(t + 2);
            DSA_HSTEP(pA, pB, t, 0, t - 1);
            DSA_HSTEP(pB, pA, t, 1, t);
        }
        {   float sacc = 0.f;
#pragma unroll
            for (int r = 0; r < 16; ++r) { DSA_PVAL(pB, r); }
            l += sacc;
            const unsigned vpt0 = DSA_SLOT(nw - 1) + vb0[0], vpt1 = DSA_SLOT(nw - 1) + vb0[1];
#pragma unroll
            for (int s = 0; s < 2; ++s) { const bf16x8 x1 = pack8(pB, s);
#pragma unroll
                for (int db = 0; db < 4; ++db) { fx_s16x4 a_, b_; DSA_VRD(a_, b_, 4 * (2 + s) + db); o[db] = MFMA32(DSA_VF(a_, b_), x1, o[db]); } }
        }
        __syncthreads();
        l += lane_read(l, lane ^ 32);
        {
            const float inv = 1.f / l; f32x16 yd0, yd1; const bf16* WUVT = (const bf16*)(pt_get(c, 26) + WS_FCUM + 1792 * 1024);
#pragma unroll
            for (int r = 0; r < 16; ++r) { yd0[r] = 0.f; yd1[r] = 0.f; }
            typedef short s16x4v __attribute__((ext_vector_type(4)));
#pragma unroll
            for (int db = 0; db < 4; ++db) {
#pragma unroll
                for (int r = 0; r < 16; ++r) o[db][r] *= inv;
#pragma unroll
                for (int t = 0; t < 2; ++t) {
                    const bf16x8 xs = pack8(o[db], t);
                    const bf16* wp = WUVT + (size_t)(w * 64 + r32) * 128 + 32 * db + 16 * t + 4 * hi;
                    const s16x4v l0 = *(const s16x4v*)wp, h0 = *(const s16x4v*)(wp + 8), l1 = *(const s16x4v*)(wp + 32 * 128), h1 = *(const s16x4v*)(wp + 32 * 128 + 8);
                    yd0 = MFMA32(__builtin_shufflevector(l0, h0, 0, 1, 2, 3, 4, 5, 6, 7), xs, yd0); yd1 = MFMA32(__builtin_shufflevector(l1, h1, 0, 1, 2, 3, 4, 5, 6, 7), xs, yd1);
                }
            }
            if (r32 < nq) { bf16* yr = (bf16*)(pt_get(c, 26) + WS_Y) + (size_t)(t0 + r32) * KOUT + 1536 + 64 * w;
#pragma unroll
                for (int i4 = 0; i4 < 4; ++i4) {
                    *(u32x2v*)(yr + 8 * i4 + 4 * hi) = (u32x2v){cvtpk(yd0[4 * i4], yd0[4 * i4 + 1]), cvtpk(yd0[4 * i4 + 2], yd0[4 * i4 + 3])};
                    *(u32x2v*)(yr + 32 + 8 * i4 + 4 * hi) = (u32x2v){cvtpk(yd1[4 * i4], yd1[4 * i4 + 1]), cvtpk(yd1[4 * i4 + 2], yd1[4 * i4 + 3])}; }
            }
        }
        }
    }
}

__device__ __forceinline__ float wave_scan_incl(float v, int lane) {
#pragma unroll
    for (int o = 1; o < 64; o <<= 1) { const float n = lane_read(v, (lane - o) & 63); if (lane >= o) v += n; }
    return v;
}
__device__ __forceinline__ void ph_ssd_states(const Ctx& c0, const bf16* XC, const float* DT, const float* a_log, bf16* ST, float* CD) {
    const Ctx c = refresh(c0);
    const int lane = c.lane, w = c.wave, r32 = lane & 31, hi = lane >> 5, g = w >> 2;
    LAS bf16* XT = (LAS bf16*)c.lds + w * (64 * 72);
    LAS bf16* BT = (LAS bf16*)(c.lds + 73728);
    const float a_neg = -__expf(a_log[w]);
    for (int it = c.bid; it < NB * 65; it += c.nb) {
        const int b = it < 512 ? it >> 6 : it - 512, ch = it < 512 ? 1 + (it & 63) : 0, pseq = 64 * ch - 48 + lane;
        const bool valid = pseq >= 0; const size_t t = (size_t)(b * L + (valid ? pseq : 0));
        const float dtv = valid ? DT[t * 8 + w] : 0.f, acs = wave_scan_incl(dtv * a_neg, lane), tot = lane_read(acs, 63), scale = dtv * __expf(tot - acs);
        if (lane == 0) CD[(b * 65 + ch) * 8 + w] = __expf(tot);
        const bf16* xrow = XC + t * 1024 + 64 * w;
#pragma unroll
        for (int q = 0; q < 8; ++q) { u32x4v v = (u32x4v){0u, 0u, 0u, 0u}; if (valid) v = *(const u32x4v*)(xrow + 8 * q); const unsigned vv[4] = {v.x, v.y, v.z, v.w};
#pragma unroll
            for (int e = 0; e < 8; ++e) XT[(8 * q + e) * 72 + lane] = f2bf(bf2f((bf16)(vv[e >> 1] >> (16 * (e & 1)))) * scale); }
        const bf16* brow = XC + t * 1024 + 512 + 32 * w;
#pragma unroll
        for (int q = 0; q < 4; ++q) { u32x4v v = (u32x4v){0u, 0u, 0u, 0u}; if (valid) v = *(const u32x4v*)(brow + 8 * q); const unsigned vv[4] = {v.x, v.y, v.z, v.w};
#pragma unroll
            for (int e = 0; e < 8; ++e) BT[(32 * w + 8 * q + e) * 72 + lane] = (bf16)(vv[e >> 1] >> (16 * (e & 1))); }
        __syncthreads();
        bf16* st = ST + ((size_t)(b * 65 + ch) * 8 + w) * 8192;
#pragma unroll 1
        for (int pb = 0; pb < 2; ++pb)
#pragma unroll 1
            for (int nb = 0; nb < 4; ++nb) {
                f32x16 acc;
#pragma unroll
                for (int r = 0; r < 16; ++r) acc[r] = 0.f;
#pragma unroll
                for (int s = 0; s < 4; ++s) { const bf16x8 a = *(const LAS bf16x8*)(XT + (32 * pb + r32) * 72 + 16 * s + 8 * hi), bb = *(const LAS bf16x8*)(BT + (128 * g + 32 * nb + r32) * 72 + 16 * s + 8 * hi);
                    acc = MFMA32(a, bb, acc); }
#pragma unroll
                for (int r = 0; r < 16; ++r) st[(32 * pb + crow(r, hi)) * 128 + 32 * nb + r32] = f2bf(acc[r]);
            }
        __syncthreads();
    }
}
__device__ __forceinline__ void ph_ssd_scan(const Ctx& c0, bf16* ST, const float* CD) {
    const Ctx c = refresh(c0);
    for (int idx = c.bid * NTHR + c.tid; idx < NB * 8 * 64 * 32; idx += c.nb * NTHR) {
        const int n4 = idx & 31, p = (idx >> 5) & 63, h = (idx >> 11) & 7, b = idx >> 14;
        float h0 = 0.f, h1 = 0.f, h2 = 0.f, h3 = 0.f;
        bf16* base = ST + ((size_t)(b * 65) * 8 + h) * 8192 + p * 128 + 4 * n4; const float* cd = CD + (size_t)(b * 65) * 8 + h;
#pragma unroll 1
        for (int c5 = 0; c5 < 65; c5 += 5) {
            u32x2v v[5]; float d[5];
#pragma unroll
            for (int q = 0; q < 5; ++q) { v[q] = *(const u32x2v*)(base + (size_t)(c5 + q) * 8 * 8192); d[q] = cd[(c5 + q) * 8]; }
#pragma unroll
            for (int q = 0; q < 5; ++q) {
                *(u32x2v*)(base + (size_t)(c5 + q) * 8 * 8192) = (u32x2v){pk2(h0, h1), pk2(h2, h3)};
                h0 = d[q] * h0 + bf2f((bf16)(v[q].x & 0xffff)); h1 = d[q] * h1 + bf2f((bf16)(v[q].x >> 16)); h2 = d[q] * h2 + bf2f((bf16)(v[q].y & 0xffff)); h3 = d[q] * h3 + bf2f((bf16)(v[q].y >> 16)); }
        }
    }
}
__device__ __forceinline__ void ph_ssd_out(const Ctx& c0, const bf16* XC, const bf16* U, const float* DT, const float* a_log, const float* dsk, const bf16* ST, bf16* Y) {
    const Ctx c = refresh(c0);
    const int lane = c.lane, w = c.wave, r32 = lane & 31, hi = lane >> 5, g = w >> 2;
    LAS bf16* XT = (LAS bf16*)c.lds + w * (64 * 72);
    LAS float* ACS = (LAS float*)(c.lds + 73728) + w * 64;
    LAS float* SS = (LAS float*)(c.lds + 73728 + 2048);
    const float a_neg = -__expf(a_log[w]), Dk = dsk[w];
    typedef short s16x4v __attribute__((ext_vector_type(4)));
    for (int it = c.bid; it < NB * 65; it += c.nb) {
        const int b = it < 512 ? it >> 6 : it - 512, ch = it < 512 ? 1 + (it & 63) : 0, p0 = 64 * ch - 48, pseq = p0 + lane; const bool valid = pseq >= 0; const size_t t = (size_t)(b * L + (valid ? pseq : 0));
        const float dtv = valid ? DT[t * 8 + w] : 0.f, acs = wave_scan_incl(dtv * a_neg, lane);
        ACS[lane] = acs;
        {   const bf16* xrow = XC + t * 1024 + 64 * w;
#pragma unroll
            for (int q = 0; q < 8; ++q) { u32x4v v = (u32x4v){0u, 0u, 0u, 0u}; if (valid) v = *(const u32x4v*)(xrow + 8 * q); const unsigned vv[4] = {v.x, v.y, v.z, v.w};
#pragma unroll
                for (int e = 0; e < 8; ++e) XT[(8 * q + e) * 72 + lane] = f2bf(bf2f((bf16)(vv[e >> 1] >> (16 * (e & 1)))) * dtv); } }
        const bool vl0 = p0 + r32 >= 0, vl1 = p0 + 32 + r32 >= 0;
        const size_t tl0 = (size_t)(b * L + (vl0 ? p0 + r32 : 0)), tl1 = (size_t)(b * L + (vl1 ? p0 + 32 + r32 : 0));
        f32x16 acc[2][2];
#pragma unroll
        for (int pb = 0; pb < 2; ++pb)
#pragma unroll
            for (int lb = 0; lb < 2; ++lb)
#pragma unroll
                for (int r = 0; r < 16; ++r) acc[pb][lb][r] = 0.f;
        const bf16* hin = ST + ((size_t)(b * 65 + ch) * 8 + w) * 8192;
        if (ch != 0) {
#pragma unroll
        for (int k = 0; k < 8; ++k) {
            bf16x8 c0f = (bf16x8){0, 0, 0, 0, 0, 0, 0, 0}, c1f = c0f;
            if (vl0) c0f = *(const bf16x8*)(XC + tl0 * 1024 + 768 + 128 * g + 16 * k + 8 * hi);
            if (vl1) c1f = *(const bf16x8*)(XC + tl1 * 1024 + 768 + 128 * g + 16 * k + 8 * hi);
            const bf16x8 h0f = *(const bf16x8*)(hin + (size_t)r32 * 128 + 16 * k + 8 * hi), h1f = *(const bf16x8*)(hin + (size_t)(32 + r32) * 128 + 16 * k + 8 * hi);
            acc[0][0] = MFMA32(h0f, c0f, acc[0][0]); acc[0][1] = MFMA32(h0f, c1f, acc[0][1]); acc[1][0] = MFMA32(h1f, c0f, acc[1][0]); acc[1][1] = MFMA32(h1f, c1f, acc[1][1]);
        }
        }
        const float acl0 = ACS[r32], acl1 = ACS[32 + r32], e0 = __expf(acl0), e1 = __expf(acl1);
#pragma unroll
        for (int pb = 0; pb < 2; ++pb)
#pragma unroll
            for (int r = 0; r < 16; ++r) { acc[pb][0][r] *= e0; acc[pb][1][r] *= e1; }
#pragma unroll
        for (int sb = 0; sb < 2; ++sb)
#pragma unroll
            for (int lb = sb; lb < 2; ++lb) if (!(ch == 0 && sb == 0)) {
                f32x16 x;
#pragma unroll
                for (int r = 0; r < 16; ++r) x[r] = 0.f;
                const bool vs = p0 + 32 * sb + r32 >= 0; const size_t ts = (size_t)(b * L + (vs ? p0 + 32 * sb + r32 : 0));
                const bool vl = lb == 0 ? vl0 : vl1; const size_t tl = lb == 0 ? tl0 : tl1;
#pragma unroll
                for (int k = 0; k < 8; ++k) {
                    bf16x8 bf_ = (bf16x8){0, 0, 0, 0, 0, 0, 0, 0}, cf_ = bf_;
                    if (vs) bf_ = *(const bf16x8*)(XC + ts * 1024 + 512 + 128 * g + 16 * k + 8 * hi);
                    if (vl) cf_ = *(const bf16x8*)(XC + tl * 1024 + 768 + 128 * g + 16 * k + 8 * hi);
                    x = MFMA32(bf_, cf_, x);
                }
                const float acl = lb == 0 ? acl0 : acl1; const int lrow = 32 * lb + r32;
#pragma unroll
                for (int i4 = 0; i4 < 4; ++i4) { const f32x4v as = *(const LAS f32x4v*)(ACS + 32 * sb + 8 * i4 + 4 * hi);
#pragma unroll
                    for (int e = 0; e < 4; ++e) { const int srow = 32 * sb + 8 * i4 + 4 * hi + e; x[4 * i4 + e] = srow <= lrow ? x[4 * i4 + e] * __expf(fminf(acl - as[e], 0.f)) : 0.f; } }
#pragma unroll
                for (int ks = 0; ks < 2; ++ks) {
                    const bf16x8 xs = pack8(x, ks);
#pragma unroll
                    for (int pb = 0; pb < 2; ++pb) {
                        const LAS bf16* vp = XT + (32 * pb + r32) * 72 + 32 * sb + 16 * ks + 4 * hi;
                        const s16x4v lo = *(const LAS s16x4v*)vp, hh = *(const LAS s16x4v*)(vp + 8);
                        const bf16x8 pa = __builtin_shufflevector(lo, hh, 0, 1, 2, 3, 4, 5, 6, 7);
                        if (lb == 0) acc[pb][0] = MFMA32(pa, xs, acc[pb][0]); else acc[pb][1] = MFMA32(pa, xs, acc[pb][1]);
                    }
                }
            }
        float ssq0 = 0.f, ssq1 = 0.f;
#pragma unroll
        for (int lb = 0; lb < 2; ++lb) { const bool vl = lb == 0 ? vl0 : vl1; const size_t tl = lb == 0 ? tl0 : tl1;
#pragma unroll
            for (int pb = 0; pb < 2; ++pb)
#pragma unroll
                for (int i4 = 0; i4 < 4; ++i4) { const int pc = 64 * w + 32 * pb + 8 * i4 + 4 * hi;
                    u32x2v xv = (u32x2v){0u, 0u}, zv = xv;
                    if (vl) { xv = *(const u32x2v*)(XC + tl * 1024 + pc); zv = *(const u32x2v*)(U + tl * NU + C_Z + pc); }
                    const float xe[4] = {bf2f((bf16)(xv.x & 0xffff)), bf2f((bf16)(xv.x >> 16)), bf2f((bf16)(xv.y & 0xffff)), bf2f((bf16)(xv.y >> 16))};
                    const float ze[4] = {bf2f((bf16)(zv.x & 0xffff)), bf2f((bf16)(zv.x >> 16)), bf2f((bf16)(zv.y & 0xffff)), bf2f((bf16)(zv.y >> 16))};
#pragma unroll
                    for (int e = 0; e < 4; ++e) { const float y = acc[pb][lb][4 * i4 + e] + Dk * xe[e], gz = y * siluf(ze[e]); acc[pb][lb][4 * i4 + e] = gz; if (lb == 0) ssq0 += gz * gz; else ssq1 += gz * gz; } } }
        ssq0 += lane_read(ssq0, lane ^ 32); ssq1 += lane_read(ssq1, lane ^ 32);
        if (hi == 0) { SS[w * 64 + r32] = ssq0; SS[w * 64 + 32 + r32] = ssq1; }
        __syncthreads();
        const float tot0 = SS[(4 * g) * 64 + r32] + SS[(4 * g + 1) * 64 + r32] + SS[(4 * g + 2) * 64 + r32] + SS[(4 * g + 3) * 64 + r32];
        const float tot1 = SS[(4 * g) * 64 + 32 + r32] + SS[(4 * g + 1) * 64 + 32 + r32] + SS[(4 * g + 2) * 64 + 32 + r32] + SS[(4 * g + 3) * 64 + 32 + r32];
        const float rs0 = rsqrtf(tot0 * (1.f / 256.f) + EPSF), rs1 = rsqrtf(tot1 * (1.f / 256.f) + EPSF);
#pragma unroll
        for (int lb = 0; lb < 2; ++lb) { const bool vl = lb == 0 ? vl0 : vl1; const size_t tl = lb == 0 ? tl0 : tl1; const float rs = lb == 0 ? rs0 : rs1;
            if (vl) {
#pragma unroll
                for (int pb = 0; pb < 2; ++pb)
#pragma unroll
                    for (int i4 = 0; i4 < 4; ++i4)
                        *(u32x2v*)(Y + tl * KOUT + 64 * w + 32 * pb + 8 * i4 + 4 * hi) = (u32x2v){cvtpk(acc[pb][lb][4 * i4] * rs, acc[pb][lb][4 * i4 + 1] * rs), cvtpk(acc[pb][lb][4 * i4 + 2] * rs, acc[pb][lb][4 * i4 + 3] * rs)};
            } }
        __syncthreads();
    }
}

__device__ __forceinline__ void ph_resid(const Ctx& c0, const bf16* MIX, const float* g, bf16* XB, float* RSTD, float* dout, const float* SSslot = nullptr) { const Ctx c = refresh(c0);
    const int lane = c.lane;
    if (SSslot) {
        for (int idx = c.bid * NTHR + c.tid; idx < 128 * 256; idx += c.nb * NTHR) { const float* q = SSslot + (size_t)idx * 8; float sm = 0.f;
#pragma unroll
            for (int k = 0; k < 8; ++k) sm += q[k];
            RSTD[pg8::tile_row0(1, idx >> 8) + (idx & 255)] = rsqrtf(sm * (1.f / DM) + EPSF); } }
    const bool reord = c.ngw == 2048;
    for (int it = SSslot ? 16 : 0; it < (reord ? 17 : (T + c.ngw - 1) / c.ngw); ++it) {
        int t;
        if (reord) {
            if (it < 16) { const int q = 3 - (it >> 2), j = it & 3, i8 = c.gw >> 8; t = (2 * j + (i8 >> 2)) * L + 16 + 256 * (4 * q + (i8 & 3)) + (c.gw & 255); }
            else { if (c.gw >= 128) break; t = (c.gw >> 4) * L + (c.gw & 15); }
        } else { t = c.gw + it * c.ngw; if (t >= T) break; }
        float mv[32], xv[32]; float ss = 0.f;
#pragma unroll
        for (int j = 0; j < 4; ++j) { const u32x4v v = *(const u32x4v*)(MIX + (size_t)t * DM + 8 * lane + 512 * j), xx = *(const u32x4v*)(XB + (size_t)t * DM + 8 * lane + 512 * j);
            const unsigned w[4] = {v.x, v.y, v.z, v.w}, xw[4] = {xx.x, xx.y, xx.z, xx.w};
#pragma unroll
            for (int i = 0; i < 8; ++i) { const float f = bf2f((bf16)(w[i >> 1] >> (16 * (i & 1)))); mv[8 * j + i] = f; ss += f * f; xv[8 * j + i] = bf2f((bf16)(xw[i >> 1] >> (16 * (i & 1)))); } }
        const float rs = rsqrtf(wave_sum(ss, lane) * (1.f / DM) + EPSF);
        float s2 = 0.f;
        const int b = t / L, p = t - b * L; float* orow = (dout != nullptr && p >= NMETA) ? dout + ((size_t)b * SEQ + (p - NMETA)) * DM : nullptr;
#pragma unroll
        for (int j = 0; j < 4; ++j) { const int cc = 8 * lane + 512 * j;
            const f32x4v ga = *(const f32x4v*)(g + cc), gb = *(const f32x4v*)(g + cc + 4); float a[8];
#pragma unroll
            for (int i = 0; i < 4; ++i) { a[i] = xv[8 * j + i] + mv[8 * j + i] * rs * ga[i]; a[4 + i] = xv[8 * j + 4 + i] + mv[8 * j + 4 + i] * rs * gb[i]; }
#pragma unroll
            for (int i = 0; i < 8; ++i) s2 += a[i] * a[i];
            if (orow) { *(f32x4v*)(orow + cc) = (f32x4v){a[0], a[1], a[2], a[3]}; *(f32x4v*)(orow + cc + 4) = (f32x4v){a[4], a[5], a[6], a[7]}; }
            *(u32x4v*)(XB + (size_t)t * DM + cc) = (u32x4v){pk2(a[0], a[1]), pk2(a[2], a[3]), pk2(a[4], a[5]), pk2(a[6], a[7])}; }
        s2 = wave_sum(s2, lane);
        if (lane == 0) RSTD[t] = rsqrtf(s2 * (1.f / DM) + EPSF);
    }
}

__device__ __forceinline__ void gemm_meta_rows(const Ctx& c, const bf16* A, const bf16* Bt, bf16* O, int N, int K, int ldc, const float* rs, float* UF, float* O32 = nullptr) {
    const int lane = c.lane, r32 = lane & 31, hi = lane >> 5, w = c.wave;
    LAS float* red = (LAS float*)c.lds;
    for (int strip = c.bid; strip < N / 32; strip += c.nb) {
        const bf16* ap = A + (size_t)(r32 & 15) * K + 8 * hi; const bf16* bp = Bt + (size_t)(32 * strip + r32) * K + 8 * hi;
        f32x16 acc;
#pragma unroll
        for (int r = 0; r < 16; ++r) acc[r] = 0.f;
#pragma unroll 1
        for (int s0 = w; s0 < K / 16; s0 += 16 * NWAVE) {
            bf16x8 fa[16], fb[16];
#pragma unroll
            for (int u = 0; u < 16; ++u) { const int s = s0 + u * NWAVE; const bool ok = s < K / 16; const int sc = ok ? s : w;
                fa[u] = *(const bf16x8*)(ap + 16 * sc); fb[u] = *(const bf16x8*)(bp + 16 * sc); if (!ok) fa[u] = (bf16x8){0, 0, 0, 0, 0, 0, 0, 0}; }
#pragma unroll
            for (int u = 0; u < 16; ++u) acc = MFMA32(fa[u], fb[u], acc);
        }
#pragma unroll
        for (int r = 0; r < 8; ++r) red[(w * 8 + r) * 64 + lane] = acc[r];
        __syncthreads();
        if (w == 0) {
            float v8[8];
#pragma unroll
            for (int r = 0; r < 8; ++r) { float t = 0.f;
#pragma unroll
                for (int ww = 0; ww < NWAVE; ++ww) t += red[(ww * 8 + r) * 64 + lane];
                v8[r] = t * (rs ? rs[crow(r, hi)] : 1.f); }
            const int n = 32 * strip + r32; const bool sm = UF != nullptr && n >= C_SM && n < C_SM + 32;
            if (O32) {
#pragma unroll
                for (int r = 0; r < 8; ++r) O32[(size_t)crow(r, hi) * N + n] = v8[r];
            } else
#pragma unroll 1
            for (int b = 0; b < NB; ++b) {
                bf16* ob = O + (size_t)(b * L) * ldc + n; float* ub = UF + (size_t)(b * L) * 32 + (n - C_SM);
#pragma unroll
                for (int r = 0; r < 8; ++r) { const int p = crow(r, hi); ob[(size_t)p * ldc] = f2bf(v8[r]); if (sm) ub[(size_t)p * 32] = v8[r]; }
            }
        }
        __syncthreads();
    }
}
__device__ __forceinline__ void ph_gemm_plain(const Ctx& c0, const bf16* A, const bf16* Bt, bf16* O, int N, int K, int ldc, const float* rs, float* UF, int wgm) { const Ctx c = refresh(c0);
    gemm_meta_rows(c, A, Bt, O, N, K, ldc, rs, UF);
    pg8::StaticOrder S; S.init(128 * 256, N, c.nb, c.bid, wgm);
    pg8::Gemm g{A, Bt, 128 * 256, N, K, (size_t)256 * K * 2, 1};
    pg8::EpiBf16Plain E{O, ldc, rs, UF, C_SM, 1};
    pg8::gemm_phase<pg8::EpiBf16Plain, pg8::StaticOrder, true, true>(c.lds, g, S, E, c.tid);
}
__device__ __forceinline__ void ph_gemm_resid(const Ctx& c0, const bf16* A, const bf16* Bt, bf16* O, int K, bf16* XB, const float* g, float* dout, float* PS, float* SS, unsigned* cnt) { const Ctx c = refresh(c0);
    pg8::StaticOrder S; S.init(128 * 256, DM, c.nb, c.bid, 4);
    pg8::Gemm g_{A, Bt, 128 * 256, DM, K, (size_t)256 * K * 2, 1};
    pg8::EpiResid E{XB, g, dout, PS, SS, cnt, (LAS float*)(c.lds + HALO_OFF)};
    pg8::gemm_phase<pg8::EpiResid, pg8::StaticOrder, true, true>(c.lds, g_, S, E, c.tid);
    gemm_meta_rows(c, A, Bt, O, DM, K, DM, nullptr, nullptr);
}
__device__ __forceinline__ void ph_gemm_gateup(const Ctx& c0, const bf16* XB, const bf16* Bt, bf16* H, const float* rs, const float* cw, const float* cb, float* FXG, float* FXU, float* HB, float* GUM) { const Ctx c = refresh(c0);
    gemm_meta_rows(c, XB, Bt, nullptr, NGU, DM, 0, rs, nullptr, GUM);
    pg8::StaticOrder S; S.init(128 * 256, NGU, c.nb, c.bid, WGM_GU);
    pg8::Gemm g{XB, Bt, 128 * 256, NGU, DM, (size_t)256 * DM * 2, 1};
    pg8::EpiGateUp E{H, rs, cw, cb, (LAS float*)(c.lds + HALO_OFF), FXG, FXU, HB};
    pg8::gemm_phase<pg8::EpiGateUp, pg8::StaticOrder, true, true>(c.lds, g, S, E, c.tid);
}
__device__ __forceinline__ void ph_ffn_fixup(const Ctx& c0, bf16* H, const float* cw, const float* cb, const float* FXG, const float* FXU, const float* HB, const float* GUM) { const Ctx c = refresh(c0);
    const int gt = c.bid * NTHR + c.tid, ngt = c.nb * NTHR;
    for (int idx = gt; idx < 128 * (FF / 4); idx += ngt) {
        const int pm = idx / (FF / 4), ch = (idx - pm * (FF / 4)) * 4, pn = ch >> 7, cl = ch & 127;
        const f32x4v g0 = *(const f32x4v*)(FXG + ((size_t)pm * 2) * FF + ch), g1 = *(const f32x4v*)(FXG + ((size_t)pm * 2 + 1) * FF + ch);
        const f32x4v u0 = *(const f32x4v*)(FXU + ((size_t)pm * 2) * FF + ch), u1 = *(const f32x4v*)(FXU + ((size_t)pm * 2 + 1) * FF + ch);
        f32x4v hm2, hm1;
        if ((pm & 15) == 0) { hm2 = *(const f32x4v*)(GUM + (size_t)14 * NGU + 256 * pn + cl); hm1 = *(const f32x4v*)(GUM + (size_t)15 * NGU + 256 * pn + cl); }
        else { hm2 = *(const f32x4v*)(HB + ((size_t)(pm - 1) * 2) * FF + ch); hm1 = *(const f32x4v*)(HB + ((size_t)(pm - 1) * 2 + 1) * FF + ch); }
        const f32x4v w0 = *(const f32x4v*)(cw + ch), w1 = *(const f32x4v*)(cw + FF + ch), w2 = *(const f32x4v*)(cw + 2 * FF + ch), bb = *(const f32x4v*)(cb + ch);
        const f32x4v c0v = bb + w2 * g0 + w1 * hm1 + w0 * hm2, c1v = bb + w2 * g1 + w1 * g0 + w0 * hm1;
        const size_t row = (size_t)pg8::tile_row0(1, pm);
        *(u32x2v*)(H + row * FF + ch) = (u32x2v){pk2(siluf(c0v[0]) * u0[0], siluf(c0v[1]) * u0[1]), pk2(siluf(c0v[2]) * u0[2], siluf(c0v[3]) * u0[3])};
        *(u32x2v*)(H + (row + 1) * FF + ch) = (u32x2v){pk2(siluf(c1v[0]) * u1[0], siluf(c1v[1]) * u1[1]), pk2(siluf(c1v[2]) * u1[2], siluf(c1v[3]) * u1[3])};
    }
    for (int idx = gt; idx < 16 * (FF / 4); idx += ngt) {
        const int p = idx / (FF / 4), ch = (idx - p * (FF / 4)) * 4, pn = ch >> 7, cl = ch & 127;
        const float* gr = GUM + (size_t)p * NGU + 256 * pn + cl;
        const f32x4v g = *(const f32x4v*)gr, up = *(const f32x4v*)(gr + 128);
        f32x4v gm1 = (f32x4v){0.f, 0.f, 0.f, 0.f}, gm2 = gm1;
        if (p >= 1) gm1 = *(const f32x4v*)(gr - NGU);
        if (p >= 2) gm2 = *(const f32x4v*)(gr - 2 * NGU);
        const f32x4v w0 = *(const f32x4v*)(cw + ch), w1 = *(const f32x4v*)(cw + FF + ch), w2 = *(const f32x4v*)(cw + 2 * FF + ch), bb = *(const f32x4v*)(cb + ch);
        const f32x4v cv = bb + w2 * g + w1 * gm1 + w0 * gm2;
        const u32x2v o = (u32x2v){pk2(siluf(cv[0]) * up[0], siluf(cv[1]) * up[1]), pk2(siluf(cv[2]) * up[2], siluf(cv[3]) * up[3])};
#pragma unroll
        for (int b = 0; b < NB; ++b) *(u32x2v*)(H + (size_t)(b * L + p) * FF + ch) = o;
    }
}

constexpr int REP_PREPW = 1, REP_G1 = 1, REP_G2 = 1, REP_G3 = 1, REP_G4 = 1, REP_M1 = 1, REP_SSD = 1, REP_FOX = 1, REP_DSA = 1;
__global__ void __launch_bounds__(NTHR, 2) fwd_mega(Args A) {
    extern __shared__ __attribute__((aligned(16))) unsigned char lds_raw[];
    cg::grid_group grid = cg::this_grid();
    Ctx c; c.tid = threadIdx.x; c.lane = c.tid & 63; c.wave = __builtin_amdgcn_readfirstlane(c.tid >> 6); c.bid = blockIdx.x; c.nb = gridDim.x;
    c.gw = c.bid * NWAVE + c.wave; c.ngw = c.nb * NWAVE; c.lds = (LAS unsigned char*)lds_raw;
    if (c.tid == 0) { LAS unsigned long long* PT = (LAS unsigned long long*)(c.lds + PT_OFF);
#pragma unroll
        for (int i = 0; i < 25; ++i) PT[i] = (unsigned long long)A.in[i];
        PT[25] = (unsigned long long)A.out; PT[26] = (unsigned long long)A.ws; }
    if (c.tid < 2) ((LAS unsigned*)(c.lds + MISC_OFF))[c.tid] = 0u;
    __syncthreads();
    (void)xcd_barrier_post((unsigned*)(A.ws + WS_CTL) + CW_BAR, (volatile LAS unsigned*)(c.lds + MISC_OFF), c.tid);
#define WSP(off) (pt_get(c, 26) + (off))
#define DOUT ((float*)pt_get(c, 25))
#define P_WIN ((bf16*)WSP(WS_WIN))
#define P_WOUT ((bf16*)WSP(WS_WOUT))
#define P_WGU ((bf16*)WSP(WS_WGU))
#define P_WDN ((bf16*)WSP(WS_WDN))
#define P_METAX ((float*)WSP(WS_METAX))
#define P_RSTD ((float*)WSP(WS_RSTD))
#define P_UF ((float*)WSP(WS_UF))
#define P_DT ((float*)WSP(WS_DT))
#define P_FCUM ((float*)WSP(WS_FCUM))
#define P_CN ((bf16*)WSP(WS_CN))
#define P_MASK ((u64*)WSP(WS_MASK))
#define P_KI ((bf16*)WSP(WS_MASK))
#define P_XB ((bf16*)WSP(WS_XB) + (size_t)8 * DM)
#define P_Y ((bf16*)WSP(WS_Y))
#define P_U ((bf16*)WSP(WS_R1))
#define P_XC ((bf16*)WSP(WS_XC))
#define P_H ((bf16*)WSP(WS_R1))
#define P_MIX ((bf16*)WSP(WS_R1))
#define P_MIX2 ((bf16*)WSP(WS_Y))
#define P_ST ((bf16*)WSP(WS_YA))
#define P_CD ((float*)WSP(WS_DT + 1536 * 1024))
#define P_WUV ((bf16*)WSP(WS_FCUM + 1792 * 1024))
#define P_FXG ((float*)WSP(WS_FIX))
#define P_FXU ((float*)WSP(WS_FIX + 6 * MiB))
#define P_HB ((float*)WSP(WS_FIX + 12 * MiB))
#define P_GUM ((float*)WSP(WS_FIX + 18 * MiB))
#define P_PS ((float*)WSP(WS_FIX + 19 * MiB))
#define P_SS ((float*)WSP(WS_FIX + 20 * MiB))
#define P_CNT ((unsigned*)WSP(WS_CTL) + 8192)
#define P_WUK ((bf16*)WSP(WS_FCUM + 1536 * 1024))
    ph_prep_x(c, INP(0), INP(1), P_XB, P_RSTD);
    ph_prep_w(c, 0, P_WIN, P_WOUT, P_WGU, P_WDN, P_WUK, P_WUV);
    grid.sync();
#define LAYER_BODY(ly) do { \
        for (int rep = 0; rep < REP_G1; ++rep) ph_gemm_plain(c, P_XB, P_WIN, P_U, NU, DM, NU, P_RSTD, P_UF, WGM_IN); \
        grid_barrier(c); \
        for (int rep = 0; rep < REP_M1; ++rep) { \
        ph_mixprep(c, P_U, P_UF, INP(7) + (size_t)ly * 4 * 1024, INP(8) + (size_t)ly * 1024, INP(16) + (size_t)ly * 128, INP(9) + (size_t)ly * 8, P_XC, P_Y, P_CN, P_DT, P_KI); \
        ph_fcum(c, P_UF, INP(15) + (size_t)ly * 8, P_FCUM); } \
        grid_barrier(c); \
        for (int rep = 0; rep < REP_SSD; ++rep) ph_ssd_states(c, P_XC, P_DT, INP(10) + (size_t)ly * 8, P_ST, P_CD); \
        for (int rep = 0; rep < REP_FOX; ++rep) ph_fox(c, P_U, P_FCUM, P_Y); \
        grid_barrier(c); \
        ph_ssd_scan(c, P_ST, P_CD); \
        for (int rep = 0; rep < REP_DSA; ++rep) ph_dsa(c, P_U, P_UF, P_CN, P_KI); \
        grid_barrier(c); \
        for (int rep = 0; rep < REP_SSD; ++rep) ph_ssd_out(c, P_XC, P_U, P_DT, INP(10) + (size_t)ly * 8, INP(11) + (size_t)ly * 8, P_ST, P_Y); \
        grid_barrier(c); \
        if (fused) { ph_gemm_resid(c, P_Y, P_WOUT, P_MIX, KOUT, P_XB, INP(3) + (size_t)ly * DM, nullptr, P_PS, P_SS, P_CNT + (2 * (ly)) * 128); \
            grid_barrier(c); \
            ph_resid(c, P_MIX, INP(3) + (size_t)ly * DM, P_XB, P_RSTD, nullptr, P_SS); } \
        else { for (int rep = 0; rep < REP_G2; ++rep) ph_gemm_plain(c, P_Y, P_WOUT, P_MIX, DM, KOUT, DM, nullptr, nullptr, WGM_OUT); \
            grid_barrier(c); \
            ph_resid(c, P_MIX, INP(3) + (size_t)ly * DM, P_XB, P_RSTD, nullptr); } \
        grid_barrier(c); \
        for (int rep = 0; rep < REP_G3; ++rep) ph_gemm_gateup(c, P_XB, P_WGU, P_H, P_RSTD, INP(22) + (size_t)ly * 3 * FF, INP(23) + (size_t)ly * FF, P_FXG, P_FXU, P_HB, P_GUM); \
        grid_barrier(c); \
        ph_ffn_fixup(c, P_H, INP(22) + (size_t)ly * 3 * FF, INP(23) + (size_t)ly * FF, P_FXG, P_FXU, P_HB, P_GUM); \
        grid_barrier(c); \
        if (fused) { ph_gemm_resid(c, P_H, P_WDN, P_MIX2, FF, P_XB, INP(5) + (size_t)ly * DM, (ly) == DEPTH - 1 ? DOUT : nullptr, P_PS, P_SS, P_CNT + (2 * (ly) + 1) * 128); \
            grid_barrier(c); \
            ph_resid(c, P_MIX2, INP(5) + (size_t)ly * DM, P_XB, P_RSTD, nullptr, P_SS); } \
        else { for (int rep = 0; rep < REP_G4; ++rep) ph_gemm_plain(c, P_H, P_WDN, P_MIX2, DM, FF, DM, nullptr, nullptr, WGM_DN); \
            grid_barrier(c); \
            ph_resid(c, P_MIX2, INP(5) + (size_t)ly * DM, P_XB, P_RSTD, (ly) == DEPTH - 1 ? DOUT : nullptr); } \
        if ((ly) + 1 < DEPTH) { for (int rep = 0; rep < REP_PREPW; ++rep) ph_prep_w(c, (ly) + 1, P_WIN, P_WOUT, P_WGU, P_WDN, P_WUK, P_WUV);     \
            grid_barrier(c); } \
    } while (0)
    const bool fused = c.nb == 256;
    LAYER_BODY(0); LAYER_BODY(1); LAYER_BODY(2); LAYER_BODY(3);
}

extern "C" void kernel_launch(void* const* d_in, const int* in_sizes, int n_in, void* d_out, int out_size, void* d_ws, size_t ws_size, hipStream_t stream) {
    static int grid_blocks = 0;
    if (grid_blocks == 0) {
        if (n_in != 25 || in_sizes[0] != NB * SEQ * DM || out_size != NB * SEQ * DM || ws_size < WS_END) { fprintf(stderr, "kernel_launch: unexpected shapes (n_in %d in0 %d out %d ws %zu)\n", n_in, n_in > 0 ? in_sizes[0] : -1, out_size, ws_size); grid_blocks = -1; return; }
        int dev = 0, cus = 0, per_cu = 0;
        (void)hipGetDevice(&dev); (void)hipDeviceGetAttribute(&cus, hipDeviceAttributeMultiprocessorCount, dev);
        if (hipFuncSetAttribute((const void*)fwd_mega, hipFuncAttributeMaxDynamicSharedMemorySize, LDS_BYTES) != hipSuccess) { fprintf(stderr, "kernel_launch: hipFuncSetAttribute failed\n"); grid_blocks = -1; return; }
        if (hipOccupancyMaxActiveBlocksPerMultiprocessor(&per_cu, (const void*)fwd_mega, NTHR, LDS_BYTES) != hipSuccess || per_cu < 1) { fprintf(stderr, "kernel_launch: occupancy query says %d blocks/CU\n", per_cu); grid_blocks = -1; return; }
        grid_blocks = cus;
        fprintf(stderr, "kernel_launch: %d CUs, %d blocks/CU by the occupancy query, grid %d\n", cus, per_cu, grid_blocks);
    }
    if (grid_blocks < 0) return;
    if (hipMemsetAsync((char*)d_ws + WS_CTL, 0, 65536, stream) != hipSuccess) { fprintf(stderr, "kernel_launch: memset failed\n"); return; }
    Args a{};
    for (int i = 0; i < 25; ++i) a.in[i] = (const float*)d_in[i];
    a.out = (float*)d_out; a.ws = (unsigned char*)d_ws;
    void* args[] = {&a};
    hipError_t e = hipLaunchCooperativeKernel((const void*)fwd_mega, dim3(grid_blocks), dim3(NTHR), args, LDS_BYTES, stream);
    if (e != hipSuccess) fprintf(stderr, "kernel_launch: cooperative launch failed: %s (grid %d)\n", hipGetErrorString(e), grid_blocks);
}
```

```cpp
#include <hip/hip_runtime.h>
#include <cstdio>
#include <cstdint>

constexpr int NB = 8, SEQ = 4096, NMETA = 16, L = SEQ + NMETA  , T = NB * L  , MP = 33024  , DM = 2048;
constexpr int NU = 4608, KOUT = 2048, FF = 5632, NGU = 2 * FF, DIN = 4564;
constexpr int C_Z = 0, C_XBC = 512, C_POOL = 1536, C_FQ = 2048, C_FK = 2560, C_FV = 3072, C_DQ = 3584, C_DC = 4096, C_QI = 4224, C_KI = 4480, C_SM = 4544;
constexpr int LKP = 4224, NMW = 66  , TOPK = 256, DEPTH = 4;
constexpr float EPSF = 1e-6f;
typedef unsigned short bf16;
typedef unsigned long long u64;

__device__ __forceinline__ float bf2f(bf16 v) { return __uint_as_float(((unsigned)v) << 16); }
__device__ __forceinline__ bf16 f2bf(float f) { unsigned u = __float_as_uint(f); return (bf16)((u + 0x7fffu + ((u >> 16) & 1u)) >> 16); }
typedef float f32x2v_ __attribute__((ext_vector_type(2)));
typedef __bf16 bf16x2v_ __attribute__((ext_vector_type(2)));
__device__ __forceinline__ unsigned pk2(float lo, float hi) { f32x2v_ v = {lo, hi}; bf16x2v_ b = __builtin_convertvector(v, bf16x2v_); return __builtin_bit_cast(unsigned, b); }
__device__ __forceinline__ float siluf(float x) { return x * __builtin_amdgcn_rcpf(1.f + __expf(-x)); }
__device__ __forceinline__ float softplusf(float x) { return fmaxf(x, 0.f) + log1pf(__expf(-fabsf(x))); }
__device__ __forceinline__ float logsigmoidf(float x) { return fminf(x, 0.f) - log1pf(__expf(-fabsf(x))); }
__device__ __forceinline__ float lane_read(float v, int src) { return __int_as_float(__builtin_amdgcn_ds_bpermute(src << 2, __float_as_int(v))); }
__device__ __forceinline__ int lane_readi(int v, int src) { return __builtin_amdgcn_ds_bpermute(src << 2, v); }
__device__ __forceinline__ float wave_sum(float v, int lane) {
#pragma unroll
    for (int o = 1; o < 64; o <<= 1) v += lane_read(v, lane ^ o);
    return v;
}
__device__ __forceinline__ float* xf_row(float* dout, float* metax, int t) {
    const int b = t / L, p = t - b * L;
    return p < NMETA ? metax + (size_t)(b * NMETA + p) * DM : dout + ((size_t)b * SEQ + (p - NMETA)) * DM;
}
namespace pg8 {
#define PG8_LAS __attribute__((address_space(3)))
typedef unsigned short bf16_t;
typedef short bf16x8 __attribute__((ext_vector_type(8)));
typedef float f32x4 __attribute__((ext_vector_type(4)));
typedef unsigned u32x4 __attribute__((ext_vector_type(4)));
constexpr int BM = 256, BK = 64, HALF = 128, HTB = HALF * BK * 2  , STAGE_BYTES = 8 * HTB, NXCD = 8, WGM = 4;

__host__ __device__ __forceinline__ int lds_byte(int r, int c) { const int st = (r >> 4) * 2 + (c >> 5), rr = r & 15, cc = c & 31, ob = rr * 64 + cc * 2; return st * 1024 + (ob ^ (((ob >> 9) & 1) << 5)); }
__host__ __device__ __forceinline__ void stage_rc(int b, int& R, int& C) { const int st = b / 1024, sb = b % 1024, swz = sb ^ (((sb >> 9) & 1) << 5); R = (st >> 1) * 16 + swz / 64; C = (st & 1) * 32 + (swz % 64) / 2; }
__host__ __device__ __forceinline__ int perm32(int rho) { const int n = rho >> 4, i = rho & 15; return 8 * (i >> 2) + 4 * n + (i & 3); }

struct Unit { int pm, pn; };
struct Gemm { const bf16_t* A; const bf16_t* Bt; int M, N, K; size_t a_tstep; int rowmap; };
__host__ __device__ __forceinline__ int tile_row0(int rowmap, int pm) { return rowmap ? (pm >> 4) * 4112 + 16 + 256 * (pm & 15) : pm * 256; }

struct StaticOrder {
    int nM, nN, nwg, G, c, wgm;
    __host__ __device__ void init(int M, int N, int G_, int c_, int wgm_ = WGM) { nM = M / BM; nN = N / BM; nwg = nM * nN; G = G_; c = c_; wgm = wgm_; }
    __host__ __device__ bool next(int i, Unit& u) const {
        const long L = (long)i * G + c; if (L >= nwg) return false;
        int wgid = (int)L; { const int q = nwg / NXCD, r = nwg % NXCD, xcd = wgid % NXCD, off = wgid / NXCD; wgid = (xcd < r ? xcd * (q + 1) : r * (q + 1) + (xcd - r) * q) + off; }
        const int nig = wgm * nN, gid = wgid / nig, fm = gid * wgm, gsz = (nM - fm) < wgm ? (nM - fm) : wgm;
        u.pm = fm + ((wgid % nig) % gsz); u.pn = (wgid % nig) / gsz; return true;
    }
    __device__ __forceinline__ void a_ready(const Unit&) const {}
    __device__ __forceinline__ void done(const Unit&) const {}
};


__device__ __forceinline__ unsigned cvt_pk_bf16(float lo, float hi) { return ::pk2(lo, hi); }

struct EpiBf16Plain {
    static constexpr bool PERM = true, AFTER_DRAIN = false, APERM = false;
    bf16_t* O; int ldc; const float* rs; float* UF; int sm_col0; int rowmap;
    __device__ __forceinline__ void operator()(f32x4 (&acc)[2][2][4][2], const Unit& u, int wr, int wc, int fr, int fq) const {
        const int row0 = tile_row0(rowmap, u.pm) + wr * 64 + fr, col0 = u.pn * BM + wc * 32 + 8 * fq;
#pragma unroll
        for (int ai = 0; ai < 2; ++ai)
#pragma unroll
            for (int m = 0; m < 4; ++m) {
                const int row = row0 + ai * HALF + m * 16; const float s = rs ? rs[row] : 1.f; bf16_t* rowp = O + (size_t)row * ldc + col0;
#pragma unroll
                for (int bj = 0; bj < 2; ++bj) { const f32x4 v0 = acc[ai][bj][m][0] * s, v1 = acc[ai][bj][m][1] * s;
                    u32x4 w; w.x = cvt_pk_bf16(v0[0], v0[1]); w.y = cvt_pk_bf16(v0[2], v0[3]); w.z = cvt_pk_bf16(v1[0], v1[1]); w.w = cvt_pk_bf16(v1[2], v1[3]);
                    *(u32x4*)(rowp + bj * HALF) = w;
                    if (UF) { const int c = col0 + bj * HALF - sm_col0; if (c >= 0 && c < 32) { float* p = UF + (size_t)row * 32 + c; *(f32x4*)p = v0; *(f32x4*)(p + 4) = v1; } } }
            }
    }
};

__device__ __forceinline__ float fq_sum(float x) {
#if defined(__HIP_DEVICE_COMPILE__)
    { const auto r = __builtin_amdgcn_permlane16_swap(__float_as_uint(x), __float_as_uint(x), false, false); x = __uint_as_float(r[0]) + __uint_as_float(r[1]); }
    { const auto r = __builtin_amdgcn_permlane32_swap(__float_as_uint(x), __float_as_uint(x), false, false); x = __uint_as_float(r[0]) + __uint_as_float(r[1]); }
#endif
    return x;
}
struct EpiResid {
    static constexpr bool PERM = true, AFTER_DRAIN = false, APERM = false;
    bf16_t* XB; const float* g; float* dout; float* PS; float* SS; unsigned* cnt; PG8_LAS float* sh;
    __device__ __forceinline__ void operator()(f32x4 (&acc)[2][2][4][2], const Unit& u, int wr, int wc, int fr, int fq) const {
        const int tid = (wr * 4 + wc) * 64 + fq * 16 + fr;
        const int row0 = tile_row0(1, u.pm) + wr * 64 + fr, col0 = u.pn * BM + wc * 32 + 8 * fq, rl0 = wr * 64 + fr;
        PG8_LAS float* part = sh; PG8_LAS float* rsd = sh + 1024;
        f32x4 gv[2][2];
#pragma unroll
        for (int bj = 0; bj < 2; ++bj)
#pragma unroll
            for (int n = 0; n < 2; ++n) gv[bj][n] = *(const f32x4*)(g + col0 + bj * HALF + 4 * n);
#pragma unroll
        for (int ai = 0; ai < 2; ++ai)
#pragma unroll
            for (int m = 0; m < 4; ++m) { float s = 0.f;
#pragma unroll
                for (int bj = 0; bj < 2; ++bj)
#pragma unroll
                    for (int n = 0; n < 2; ++n)
#pragma unroll
                        for (int j = 0; j < 4; ++j) s += acc[ai][bj][m][n][j] * acc[ai][bj][m][n][j];
                s = fq_sum(s);
                if (fq == 0) part[wc * 256 + ai * HALF + rl0 + m * 16] = s; }
        asm volatile("s_waitcnt lgkmcnt(0)" ::: "memory"); __builtin_amdgcn_s_barrier(); asm volatile("" ::: "memory");
        if (tid < 256) __hip_atomic_store(PS + ((size_t)u.pm * 256 + tid) * 8 + u.pn, ((part[tid] + part[256 + tid]) + part[512 + tid]) + part[768 + tid], __ATOMIC_RELAXED, __HIP_MEMORY_SCOPE_AGENT);
        asm volatile("s_waitcnt vmcnt(0)" ::: "memory"); __builtin_amdgcn_s_barrier(); asm volatile("" ::: "memory");
        if (tid == 0) { __hip_atomic_fetch_add(cnt + u.pm, 1u, __ATOMIC_RELAXED, __HIP_MEMORY_SCOPE_AGENT); unsigned sp = 0u;
            while (__hip_atomic_load(cnt + u.pm, __ATOMIC_RELAXED, __HIP_MEMORY_SCOPE_AGENT) < 8u) { __builtin_amdgcn_s_sleep(1); if (++sp > (1u << 22)) break; } }
        __builtin_amdgcn_s_barrier(); asm volatile("" ::: "memory");
        if (tid < 256) { const float* q = PS + ((size_t)u.pm * 256 + tid) * 8; float s = 0.f;
#pragma unroll
            for (int k = 0; k < 8; ++k) s += __hip_atomic_load(q + k, __ATOMIC_RELAXED, __HIP_MEMORY_SCOPE_AGENT);
            rsd[tid] = rsqrtf(s * (1.f / 2048.f) + 1e-6f); }
        asm volatile("s_waitcnt lgkmcnt(0)" ::: "memory"); __builtin_amdgcn_s_barrier(); asm volatile("" ::: "memory");
#pragma unroll
        for (int ai = 0; ai < 2; ++ai)
#pragma unroll
            for (int m = 0; m < 4; ++m) { const float r = rsd[ai * HALF + rl0 + m * 16]; const int row = row0 + ai * HALF + m * 16; float s2 = 0.f;
#pragma unroll
                for (int bj = 0; bj < 2; ++bj) { const u32x4 xv = *(const u32x4*)(XB + (size_t)row * 2048 + col0 + bj * HALF); const unsigned xw[4] = {xv.x, xv.y, xv.z, xv.w}; float a[8];
#pragma unroll
                    for (int i = 0; i < 8; ++i) { const float x = __uint_as_float((i & 1) ? (xw[i >> 1] & 0xffff0000u) : (xw[i >> 1] << 16));
                        a[i] = x + acc[ai][bj][m][i >> 2][i & 3] * r * gv[bj][i >> 2][i & 3]; s2 += a[i] * a[i]; }
                    u32x4 w; w.x = cvt_pk_bf16(a[0], a[1]); w.y = cvt_pk_bf16(a[2], a[3]); w.z = cvt_pk_bf16(a[4], a[5]); w.w = cvt_pk_bf16(a[6], a[7]);
                    *(u32x4*)(XB + (size_t)row * 2048 + col0 + bj * HALF) = w;
                    if (dout) { float* o = dout + ((size_t)u.pm * 256 + (row - tile_row0(1, u.pm))) * 2048 + col0 + bj * HALF; *(f32x4*)o = (f32x4){a[0], a[1], a[2], a[3]}; *(f32x4*)(o + 4) = (f32x4){a[4], a[5], a[6], a[7]}; } }
                s2 = fq_sum(s2);
                if (fq == 0) part[wc * 256 + ai * HALF + rl0 + m * 16] = s2; }
        asm volatile("s_waitcnt lgkmcnt(0)" ::: "memory"); __builtin_amdgcn_s_barrier(); asm volatile("" ::: "memory");
        if (tid < 256) SS[((size_t)u.pm * 256 + tid) * 8 + u.pn] = ((part[tid] + part[256 + tid]) + part[512 + tid]) + part[768 + tid];
        __builtin_amdgcn_s_barrier(); asm volatile("" ::: "memory");
    }
};

struct EpiGateUp {
    static constexpr bool PERM = true, AFTER_DRAIN = false, APERM = true;
    bf16_t* H; const float* rs; const float* cw; const float* cb; PG8_LAS float* halo;
    float* FXG; float* FXU; float* HB;
    __device__ __forceinline__ void operator()(f32x4 (&acc)[2][2][4][2], const Unit& u, int wr, int wc, int fr, int fq) const {
        const int chl = wc * 32 + 8 * fq, ch0 = u.pn * 128 + chl, rbase = tile_row0(1, u.pm);
        f32x4 w0[2], w1[2], w2[2], bb[2];
#pragma unroll
        for (int n = 0; n < 2; ++n) { w0[n] = *(const f32x4*)(cw + ch0 + 4 * n); w1[n] = *(const f32x4*)(cw + FF + ch0 + 4 * n); w2[n] = *(const f32x4*)(cw + 2 * FF + ch0 + 4 * n); bb[n] = *(const f32x4*)(cb + ch0 + 4 * n); }
#pragma unroll
        for (int ai = 0; ai < 2; ++ai) { const f32x4 s4 = *(const f32x4*)(rs + rbase + ai * 128 + wr * 64 + 4 * fr);
#pragma unroll
            for (int m = 0; m < 4; ++m)
#pragma unroll
                for (int bj = 0; bj < 2; ++bj)
#pragma unroll
                    for (int n = 0; n < 2; ++n) acc[ai][bj][m][n] = acc[ai][bj][m][n] * s4[m]; }
        if (fr == 15) {
#pragma unroll
            for (int ai = 0; ai < 2; ++ai)
#pragma unroll
                for (int n = 0; n < 2; ++n) { *(PG8_LAS f32x4*)(halo + ((2 * ai + wr) * 2 + 0) * 128 + chl + 4 * n) = acc[ai][0][2][n]; *(PG8_LAS f32x4*)(halo + ((2 * ai + wr) * 2 + 1) * 128 + chl + 4 * n) = acc[ai][0][3][n]; }
            if (wr == 1) {
#pragma unroll
                for (int n = 0; n < 2; ++n) { *(f32x4*)(HB + ((size_t)u.pm * 2 + 0) * FF + ch0 + 4 * n) = acc[1][0][2][n]; *(f32x4*)(HB + ((size_t)u.pm * 2 + 1) * FF + ch0 + 4 * n) = acc[1][0][3][n]; } }
        }
        if (fr == 0 && wr == 0) {
#pragma unroll
            for (int n = 0; n < 2; ++n) { *(f32x4*)(FXG + ((size_t)u.pm * 2 + 0) * FF + ch0 + 4 * n) = acc[0][0][0][n]; *(f32x4*)(FXG + ((size_t)u.pm * 2 + 1) * FF + ch0 + 4 * n) = acc[0][0][1][n];
                                           *(f32x4*)(FXU + ((size_t)u.pm * 2 + 0) * FF + ch0 + 4 * n) = acc[0][1][0][n]; *(f32x4*)(FXU + ((size_t)u.pm * 2 + 1) * FF + ch0 + 4 * n) = acc[0][1][1][n]; }
        }
        asm volatile("s_waitcnt lgkmcnt(0)" ::: "memory"); __builtin_amdgcn_s_barrier(); asm volatile("" ::: "memory");
#pragma unroll
        for (int ai = 0; ai < 2; ++ai) {
            const int blk = 2 * ai + wr; unsigned pk[4][4];
#pragma unroll
            for (int n = 0; n < 2; ++n) {
                f32x4 h2 = {0.f, 0.f, 0.f, 0.f}, h3 = {0.f, 0.f, 0.f, 0.f};
                if (blk > 0) { h2 = *(const PG8_LAS f32x4*)(halo + ((blk - 1) * 2 + 0) * 128 + chl + 4 * n); h3 = *(const PG8_LAS f32x4*)(halo + ((blk - 1) * 2 + 1) * 128 + chl + 4 * n); }
                f32x4 d2, d3;
#pragma unroll
                for (int j = 0; j < 4; ++j) {
                    d2[j] = __int_as_float(__builtin_amdgcn_update_dpp(__float_as_int(h2[j]), __float_as_int(acc[ai][0][2][n][j]), 0x111, 0xf, 0xf, false));
                    d3[j] = __int_as_float(__builtin_amdgcn_update_dpp(__float_as_int(h3[j]), __float_as_int(acc[ai][0][3][n][j]), 0x111, 0xf, 0xf, false)); }
#pragma unroll
                for (int m = 0; m < 4; ++m) {
                    const f32x4 cur = acc[ai][0][m][n], g1 = m == 0 ? d3 : acc[ai][0][m > 0 ? m - 1 : 0][n], g2 = m == 0 ? d2 : (m == 1 ? d3 : acc[ai][0][m > 1 ? m - 2 : 0][n]);
                    const f32x4 cv = bb[n] + w2[n] * cur + w1[n] * g1 + w0[n] * g2;
                    const f32x4 t = cv * -1.4426950408889634f; f32x4 den;
#pragma unroll
                    for (int j = 0; j < 4; ++j) den[j] = __builtin_amdgcn_exp2f(t[j]);
                    den = den + 1.f; f32x4 sg;
#pragma unroll
                    for (int j = 0; j < 4; ++j) sg[j] = __builtin_amdgcn_rcpf(den[j]);
                    const f32x4 hv = cv * sg * acc[ai][1][m][n];
                    pk[m][2 * n] = cvt_pk_bf16(hv[0], hv[1]); pk[m][2 * n + 1] = cvt_pk_bf16(hv[2], hv[3]);
                }
            }
#pragma unroll
            for (int m = 0; m < 4; ++m) { const int rl = ai * 128 + wr * 64 + 4 * fr + m;
                if (rl >= 2) { u32x4 w; w.x = pk[m][0]; w.y = pk[m][1]; w.z = pk[m][2]; w.w = pk[m][3]; *(u32x4*)(H + (size_t)(rbase + rl) * FF + ch0) = w; } }
        }
    }
};
template <class Epi, class Sched, bool ALIGN_EPI = false, bool SP2 = false>
__device__ __forceinline__ void gemm_phase(PG8_LAS unsigned char* lds, const Gemm g, const Sched& S, const Epi& E, const int tid) {
    const int wid = __builtin_amdgcn_readfirstlane(tid >> 6), lane = tid & 63, wr = wid >> 2, wc = wid & 3, fr = lane & 15, fq = lane >> 4;
    const int K = g.K, nt = K / BK;
    unsigned voffA[2], voffB[2];
#pragma unroll
    for (int i = 0; i < 2; ++i) { int R, C; stage_rc(tid * 16 + i * 8192, R, C); const int Rb = Epi::PERM ? ((R & ~31) + perm32(R & 31)) : R;
        const int Ra = Epi::APERM ? ((R & ~63) + 4 * (R & 15) + ((R & 63) >> 4)) : R;
        voffA[i] = (unsigned)(Ra * K + C) * 2u; voffB[i] = (unsigned)(Rb * K + C) * 2u; }
    const size_t kstep = (size_t)(BK * 2);
    const size_t hstep = (size_t)HALF * K * 2;
    const size_t tstep = 2 * hstep;
    const unsigned ldsw = (unsigned)wid * 1024u;
    const int aoff = lds_byte(wr * 64 + fr, fq * 8), boff = lds_byte(wc * 32 + fr, fq * 8);
#define PG8_SA(b, h) (((b) * 2 + (h)) * HTB)
#define PG8_SB(b, h) ((4 + (b) * 2 + (h)) * HTB)
#define PG8_STAGE(bufoff, gbase, voff) do { _Pragma("unroll") for (int _i = 0; _i < 2; ++_i) \
        __builtin_amdgcn_global_load_lds((const unsigned*)((const char*)(gbase) + (voff)[_i]), (PG8_LAS unsigned*)(lds + (bufoff) + ldsw + _i * 8192), 16, 0, 0); } while (0)
#define PG8_LDA(dst, b, h) do { _Pragma("unroll") for (int m = 0; m < 4; ++m) _Pragma("unroll") for (int k = 0; k < 2; ++k) dst[m][k] = *(const PG8_LAS bf16x8*)(lds + PG8_SA(b, h) + aoff + m * 2048 + k * 1024); } while (0)
#define PG8_LDB(dst, b, h) do { _Pragma("unroll") for (int n = 0; n < 2; ++n) _Pragma("unroll") for (int k = 0; k < 2; ++k) dst[n][k] = *(const PG8_LAS bf16x8*)(lds + PG8_SB(b, h) + boff + n * 2048 + k * 1024); } while (0)
#define PG8_MMA(ai, bj, At, Bt) do { __builtin_amdgcn_s_setprio(1); _Pragma("unroll") for (int m = 0; m < 4; ++m) _Pragma("unroll") for (int n = 0; n < 2; ++n) _Pragma("unroll") for (int k = 0; k < 2; ++k) \
        acc[ai][bj][m][n] = __builtin_amdgcn_mfma_f32_16x16x32_bf16(Bt[n][k], At[m][k], acc[ai][bj][m][n], 0, 0, 0); __builtin_amdgcn_s_setprio(0); } while (0)
#define PG8_WAIT_V(n) asm volatile("s_waitcnt vmcnt(" #n ")" ::: "memory")
#define PG8_WAIT_L(n) asm volatile("s_waitcnt lgkmcnt(" #n ")" ::: "memory")
#define PG8_BAR __builtin_amdgcn_s_barrier()
#define PG8_SCHED __builtin_amdgcn_sched_barrier(0)
    Unit cur, nxt; int ui = 0;
    if (!S.next(0, cur)) return;
    f32x4 acc[2][2][4][2];
#pragma unroll
    for (int a = 0; a < 2; ++a)
#pragma unroll
        for (int b = 0; b < 2; ++b)
#pragma unroll
            for (int m = 0; m < 4; ++m)
#pragma unroll
                for (int n = 0; n < 2; ++n) acc[a][b][m][n] = (f32x4){0.f, 0.f, 0.f, 0.f};
    bf16x8 At[4][2], B0[2][2], B1[2][2];
    const char* cA = (const char*)g.A + (g.rowmap ? (size_t)tile_row0(1, cur.pm) * K * 2 : (size_t)cur.pm * g.a_tstep); const char* cB = (const char*)g.Bt + (size_t)cur.pn * tstep;
    S.a_ready(cur);
    if constexpr (SP2) {
        PG8_STAGE(PG8_SB(0, 0), cB, voffB); PG8_STAGE(PG8_SB(0, 1), cB + hstep, voffB); PG8_STAGE(PG8_SA(0, 0), cA, voffA); PG8_STAGE(PG8_SA(0, 1), cA + hstep, voffA);
        if (wr == 1) PG8_BAR;
        PG8_WAIT_V(2); PG8_BAR;
        PG8_STAGE(PG8_SB(1, 0), cB + kstep, voffB); PG8_STAGE(PG8_SA(1, 0), cA + kstep, voffA); PG8_STAGE(PG8_SB(1, 1), cB + hstep + kstep, voffB);
        PG8_WAIT_V(6); PG8_BAR;
    } else {
        PG8_STAGE(PG8_SB(0, 0), cB, voffB); PG8_STAGE(PG8_SA(0, 0), cA, voffA); PG8_STAGE(PG8_SB(0, 1), cB + hstep, voffB); PG8_STAGE(PG8_SA(0, 1), cA + hstep, voffA);
        if (wr == 1) PG8_BAR;
        PG8_WAIT_V(4); PG8_BAR;
        PG8_STAGE(PG8_SB(1, 0), cB + kstep, voffB); PG8_STAGE(PG8_SA(1, 0), cA + kstep, voffA); PG8_STAGE(PG8_SB(1, 1), cB + hstep + kstep, voffB);
        PG8_WAIT_V(6); PG8_BAR;
    }
    for (;;) {
        const bool has_next = S.next(ui + 1, nxt);
        const char* nA = has_next ? (const char*)g.A + (g.rowmap ? (size_t)tile_row0(1, nxt.pm) * K * 2 : (size_t)nxt.pm * g.a_tstep) : cA; const char* nB = has_next ? (const char*)g.Bt + (size_t)nxt.pn * tstep : cB;
        for (int t = 0; t < nt; t += 2) {
            const bool last = (t == nt - 2);
            const char* a1 = cA + (size_t)(t + 1) * kstep;
            const char* a2 = last ? nA : cA + (size_t)(t + 2) * kstep; const char* b2 = last ? nB : cB + (size_t)(t + 2) * kstep;
            const char* a3 = a2 + kstep; const char* b3 = b2 + kstep;
            if (last && has_next) S.a_ready(nxt);
            if constexpr (SP2) {
            PG8_LDB(B0, 0, 0); PG8_LDB(B1, 0, 1); PG8_SCHED; PG8_LDA(At, 0, 0); PG8_STAGE(PG8_SA(1, 1), a1 + hstep, voffA);
            PG8_WAIT_V(8); PG8_WAIT_L(0); PG8_BAR; PG8_MMA(0, 0, At, B0); PG8_MMA(0, 1, At, B1); PG8_BAR; PG8_SCHED;
            PG8_LDA(At, 0, 1); PG8_STAGE(PG8_SB(0, 0), b2, voffB); PG8_STAGE(PG8_SB(0, 1), b2 + hstep, voffB); PG8_STAGE(PG8_SA(0, 0), a2, voffA);
            PG8_WAIT_V(8); PG8_WAIT_L(0); PG8_BAR; PG8_MMA(1, 0, At, B0); PG8_MMA(1, 1, At, B1); PG8_BAR; PG8_SCHED;
            PG8_LDB(B0, 1, 0); PG8_LDB(B1, 1, 1); PG8_SCHED; PG8_LDA(At, 1, 0); PG8_STAGE(PG8_SA(0, 1), a2 + hstep, voffA);
            PG8_WAIT_V(8); PG8_WAIT_L(0); PG8_BAR; PG8_MMA(0, 0, At, B0); PG8_MMA(0, 1, At, B1); PG8_BAR; PG8_SCHED;
            PG8_LDA(At, 1, 1); PG8_STAGE(PG8_SB(1, 0), b3, voffB); PG8_STAGE(PG8_SB(1, 1), b3 + hstep, voffB); PG8_STAGE(PG8_SA(1, 0), a3, voffA);
            PG8_WAIT_V(8); PG8_WAIT_L(0); PG8_BAR; PG8_MMA(1, 0, At, B0); PG8_MMA(1, 1, At, B1); PG8_BAR; PG8_SCHED;
            } else {
            PG8_LDB(B0, 0, 0); PG8_SCHED; PG8_LDA(At, 0, 0); PG8_STAGE(PG8_SA(1, 1), a1 + hstep, voffA);
            PG8_WAIT_L(8); PG8_BAR; PG8_WAIT_L(0); PG8_MMA(0, 0, At, B0); PG8_BAR; PG8_SCHED;
            PG8_LDB(B1, 0, 1); PG8_STAGE(PG8_SB(0, 0), b2, voffB);
            PG8_BAR; PG8_WAIT_L(0); PG8_MMA(0, 1, At, B1); PG8_BAR;
            PG8_LDA(At, 0, 1); PG8_STAGE(PG8_SA(0, 0), a2, voffA);
            PG8_BAR; PG8_WAIT_L(0); PG8_MMA(1, 0, At, B0); PG8_BAR; PG8_SCHED;
            PG8_STAGE(PG8_SB(0, 1), b2 + hstep, voffB);
            PG8_WAIT_V(6); PG8_BAR; PG8_MMA(1, 1, At, B1); PG8_BAR;
            PG8_LDB(B0, 1, 0); PG8_SCHED; PG8_LDA(At, 1, 0); PG8_STAGE(PG8_SA(0, 1), a2 + hstep, voffA);
            PG8_WAIT_L(8); PG8_BAR; PG8_WAIT_L(0); PG8_MMA(0, 0, At, B0); PG8_BAR; PG8_SCHED;
            PG8_LDB(B1, 1, 1); PG8_STAGE(PG8_SB(1, 0), b3, voffB);
            PG8_BAR; PG8_WAIT_L(0); PG8_MMA(0, 1, At, B1); PG8_BAR;
            PG8_LDA(At, 1, 1); PG8_STAGE(PG8_SA(1, 0), a3, voffA);
            PG8_BAR; PG8_WAIT_L(0); PG8_MMA(1, 0, At, B0); PG8_BAR; PG8_SCHED;
            PG8_STAGE(PG8_SB(1, 1), b3 + hstep, voffB);
            PG8_WAIT_V(6); PG8_BAR; PG8_MMA(1, 1, At, B1); PG8_BAR;
            }
        }
        if constexpr (ALIGN_EPI) { if (wr == 0) PG8_BAR; }
        if constexpr (!Epi::AFTER_DRAIN) { E(acc, cur, wr, wc, fr, fq); S.done(cur); }
        if (!has_next) break;
#pragma unroll
        for (int a = 0; a < 2; ++a)
#pragma unroll
            for (int b = 0; b < 2; ++b)
#pragma unroll
                for (int m = 0; m < 4; ++m)
#pragma unroll
                    for (int n = 0; n < 2; ++n) acc[a][b][m][n] = (f32x4){0.f, 0.f, 0.f, 0.f};
        cur = nxt; cA = nA; cB = nB; ++ui;
        if constexpr (ALIGN_EPI) { if (wr == 1) PG8_BAR; }
    }
    PG8_WAIT_V(0);
    if constexpr (!ALIGN_EPI) { if (wr == 0) PG8_BAR; }
    PG8_BAR;
    if constexpr (Epi::AFTER_DRAIN) { E.fused(acc, cur, wr, wc, fr, fq, lds, wid, lane); S.done(cur); }
#undef PG8_SA
#undef PG8_SB
#undef PG8_STAGE
#undef PG8_LDA
#undef PG8_LDB
#undef PG8_MMA
#undef PG8_WAIT_V
#undef PG8_WAIT_L
#undef PG8_BAR
#undef PG8_SCHED
}
}

constexpr int WGM_IN = 4, WGM_OUT = 4, WGM_GU = 4, WGM_DN = 4;
constexpr int REP_SCORE = 1, REP_SEL = 1, REP_ATT = 1, REP_SLOW = 1, REP_FAST = 1;

#include <hip/hip_cooperative_groups.h>
namespace cg = cooperative_groups;
#define LAS __attribute__((address_space(3)))
constexpr int LDS_BYTES = 163840, HALO_OFF = 133120, PT_OFF = 163328, NTHR = 512, NWAVE = 8;
constexpr size_t MiB = (size_t)1 << 20;
constexpr size_t WS_CTL = 0, WS_WIN = 1 * MiB, WS_WOUT = 21 * MiB, WS_WGU = 31 * MiB, WS_WDN = 75 * MiB, WS_METAX = 97 * MiB, WS_RSTD = 98 * MiB, WS_UF = 99 * MiB,
                 WS_DT = 104 * MiB, WS_FCUM = 106 * MiB, WS_CN = 108 * MiB, WS_MASK = 117 * MiB, WS_XB = 134 * MiB, WS_Y = 264 * MiB, WS_R1 = 426 * MiB, WS_XC = WS_R1 + 323 * MiB,
                 WS_YA = 814 * MiB, WS_FIX = 880 * MiB  , WS_END = 902 * MiB;
static_assert(WS_WIN + (size_t)NU * DM * 2 <= WS_WOUT && WS_WOUT + (size_t)DM * KOUT * 2 <= WS_WGU && WS_WGU + (size_t)NGU * DM * 2 <= WS_WDN && WS_WDN + (size_t)DM * FF * 2 <= WS_METAX, "ws weights");
static_assert(WS_UF + (size_t)MP * 32 * 4 <= WS_DT && WS_DT + (size_t)T * 8 * 4 <= WS_FCUM && WS_FCUM + (size_t)64 * LKP * 4 <= WS_CN && WS_CN + (size_t)MP * 128 * 2 <= WS_MASK && WS_MASK + (size_t)T * NMW * 8 <= WS_XB, "ws small");
static_assert(WS_XB + (size_t)(MP + 8) * DM * 2 <= WS_Y && WS_Y + (size_t)MP * KOUT * 2 <= WS_R1 && WS_R1 + (size_t)MP * NU * 2 <= WS_XC && WS_XC + (size_t)MP * 1024 * 2 <= WS_YA && WS_R1 + (size_t)MP * FF * 2 <= WS_YA && WS_YA + (size_t)T * 512 * 4 <= WS_END, "ws big");

typedef unsigned u32x4v __attribute__((ext_vector_type(4)));
typedef unsigned u32x2v __attribute__((ext_vector_type(2)));
typedef float f32x4v __attribute__((ext_vector_type(4)));
struct Args { const float* in[25]; float* out; unsigned char* ws; };

struct Ctx {
    int tid, lane, wave, gw, ngw, bid, nb;
    LAS unsigned char* lds;
};
__device__ __forceinline__ Ctx refresh(const Ctx& c0) {
    Ctx c = c0; unsigned z = 0u; int w_ = c0.wave, b_ = (int)blockIdx.x, n_ = (int)gridDim.x; asm volatile("" : "+v"(z), "+s"(w_), "+s"(b_), "+s"(n_));
    const int lane = (int)__builtin_amdgcn_mbcnt_hi(~0u, __builtin_amdgcn_mbcnt_lo(~0u, z));
    c.bid = b_; c.nb = n_; c.ngw = n_ * NWAVE; c.wave = w_; c.lane = lane; c.tid = w_ * 64 + lane; c.gw = b_ * NWAVE + w_;
    { unsigned l_ = (unsigned)(size_t)c0.lds; asm volatile("" : "+s"(l_)); c.lds = (LAS unsigned char*)(size_t)l_; }
    return c;
}
__device__ __forceinline__ unsigned char* pt_get(const Ctx& c, int i) {
    unsigned l_ = (unsigned)(size_t)c.lds; asm volatile("" : "+s"(l_));
    const LAS unsigned* p = (const LAS unsigned*)((LAS unsigned char*)(size_t)l_ + PT_OFF) + 2 * i;
    const unsigned lo = __builtin_amdgcn_readfirstlane(p[0]), hi = __builtin_amdgcn_readfirstlane(p[1]);
    __attribute__((address_space(1))) unsigned char* gp = (__attribute__((address_space(1))) unsigned char*)(((unsigned long long)hi << 32) | lo);
    return (unsigned char*)gp;
}
#define INP(i) ((const float*)pt_get(c, (i)))

#define GAS __attribute__((address_space(1)))
typedef unsigned v4u __attribute__((ext_vector_type(4)));
typedef GAS unsigned gu32;
typedef GAS unsigned long long gu64;
#define RLX_AGENT __ATOMIC_RELAXED, __HIP_MEMORY_SCOPE_AGENT
#define LDS_WAIT() asm volatile("s_waitcnt lgkmcnt(0)" ::: "memory")
#define VM_WAIT() asm volatile("s_waitcnt vmcnt(0)" ::: "memory")
__device__ __forceinline__ unsigned long long rt() { return __builtin_amdgcn_s_memrealtime(); }

#define XB_TMO      128
#define XB_XCNT(j)  (256  + 64 * (j))
#define XB_XSUB(j)  (1280 + 64 * (j))
#define XB_XGEN(j)  (2304 + 64 * (j))
#define XB_TOP      3328
#define XB_TOPGEN   3392
#define XCD_BAR_WORDS 3456
#define XB_SPIN_CAP (1u << 18)

__device__ __forceinline__ unsigned xb_ld(unsigned* p)              { return __hip_atomic_load(p, __ATOMIC_RELAXED, __HIP_MEMORY_SCOPE_AGENT); }
__device__ __forceinline__ unsigned xb_add(unsigned* p, unsigned v) { return __hip_atomic_fetch_add(p, v, __ATOMIC_RELAXED, __HIP_MEMORY_SCOPE_AGENT); }
__device__ __forceinline__ unsigned xb_xcc_id() { return (unsigned)__builtin_amdgcn_s_getreg((3 << 11) | 20) & 0xFu; }
#define XB_SPIN(cond, bar) do { unsigned _sp = 0; while (cond) { __builtin_amdgcn_s_sleep(1); \
    if ((++_sp & 255u) == 0u) { if (xb_ld(&(bar)[XB_TMO])) break; if (_sp > XB_SPIN_CAP) { atomicAdd(&(bar)[XB_TMO], 1u); break; } } } } while (0)

struct XcdBarrier {
    unsigned* bar; unsigned x;
    volatile LAS unsigned* st;
};

__device__ __forceinline__ XcdBarrier xcd_barrier_post(unsigned* bar, volatile LAS unsigned* st, int tid) {
    XcdBarrier b; b.bar = bar; b.x = xb_xcc_id(); b.st = st;
    if (tid == 0) (void)xb_add(&bar[XB_XCNT(b.x)], 1u);
    return b;
}
__device__ __forceinline__ void xcd_barrier_complete(unsigned* bar, unsigned x, unsigned& nloc, unsigned& nx) {
    const unsigned G = gridDim.x * gridDim.y * gridDim.z;
    unsigned sum, cnt, mine, sp = 0u;
    for (;;) {
        sum = 0u; cnt = 0u; mine = 0u;
#pragma unroll
        for (unsigned j = 0; j < 16; ++j) { const unsigned c = xb_ld(&bar[XB_XCNT(j)]); sum += c; cnt += (c > 0u) ? 1u : 0u; mine = (j == x) ? c : mine; }
        if (sum == G) break;
        __builtin_amdgcn_s_sleep(1);
        if ((++sp & 255u) == 0u) { if (xb_ld(&bar[XB_TMO])) break; if (sp > XB_SPIN_CAP) { atomicAdd(&bar[XB_TMO], 1u); break; } }
    }
    nloc = mine > 0u ? mine : 1u; nx = cnt > 0u ? cnt : 1u;
}

__device__ __forceinline__ void xcd_barrier(const XcdBarrier& b, int tid) {
    asm volatile("s_waitcnt vmcnt(0)" ::: "memory");
    __syncthreads();
    if (tid == 0) {
        unsigned* bar = b.bar;
        __builtin_amdgcn_s_waitcnt(0);
        unsigned nloc = b.st[0], nx = b.st[1];
        if (nloc == 0u) { xcd_barrier_complete(bar, b.x, nloc, nx); b.st[0] = nloc; b.st[1] = nx; }
        const unsigned old = xb_add(&bar[XB_XSUB(b.x)], 1u);
        const unsigned gen = old / nloc;
        if (old + 1u == (gen + 1u) * nloc) {
            __builtin_amdgcn_fence(__ATOMIC_RELEASE, "agent");
            asm volatile("s_waitcnt vmcnt(0)" ::: "memory");
            const unsigned og = xb_add(&bar[XB_TOP], 1u);
            const unsigned tg = og / nx;
            if (og + 1u == (tg + 1u) * nx) xb_add(&bar[XB_TOPGEN], 1u);
            else XB_SPIN(xb_ld(&bar[XB_TOPGEN]) == tg, bar);
            __builtin_amdgcn_fence(__ATOMIC_ACQUIRE, "agent");
            xb_add(&bar[XB_XGEN(b.x)], 1u);
            asm volatile("s_waitcnt vmcnt(0)" ::: "memory");
        } else {
            XB_SPIN(xb_ld(&bar[XB_XGEN(b.x)]) == gen, bar);
            __builtin_amdgcn_fence(__ATOMIC_ACQUIRE, "agent");
            asm volatile("s_waitcnt vmcnt(0)" ::: "memory");
        }
    }
    __syncthreads();
}

constexpr int MISC_OFF = 163072, CW_BAR = 4096;
__device__ __forceinline__ void grid_barrier(const Ctx& c0) {
    const Ctx c = refresh(c0);
    XcdBarrier b; b.bar = (unsigned*)(pt_get(c, 26) + WS_CTL) + CW_BAR; b.x = xb_xcc_id(); b.st = (volatile LAS unsigned*)(c.lds + MISC_OFF);
    xcd_barrier(b, c.tid);
}
__device__ __forceinline__ void ph_prep_x(const Ctx& c0, const float* x, const float* meta, bf16* XB, float* RSTD) { const Ctx c = refresh(c0);
    const int lane = c.lane;
    for (int w = c.gw; w < MP + 8; w += c.ngw) {
        const int t = w - 8; bf16* xb = XB + (ptrdiff_t)t * DM;
        if (t < 0 || t >= T) {
#pragma unroll
            for (int j = 0; j < 4; ++j) *(u32x4v*)(xb + 8 * lane + 512 * j) = (u32x4v){0u, 0u, 0u, 0u};
            if (t >= T && lane == 0) RSTD[t] = 0.f;
            continue;
        }
        const int b = t / L, p = t - b * L;
        const float* src = p < NMETA ? meta + (size_t)p * DM : x + ((size_t)b * SEQ + (p - NMETA)) * DM;
        float ss = 0.f;
#pragma unroll
        for (int j = 0; j < 4; ++j) {
            const f32x4v a = *(const f32x4v*)(src + 8 * lane + 512 * j), cc = *(const f32x4v*)(src + 8 * lane + 512 * j + 4);
            ss += a.x * a.x + a.y * a.y + a.z * a.z + a.w * a.w + cc.x * cc.x + cc.y * cc.y + cc.z * cc.z + cc.w * cc.w;
            *(u32x4v*)(xb + 8 * lane + 512 * j) = (u32x4v){pk2(a.x, a.y), pk2(a.z, a.w), pk2(cc.x, cc.y), pk2(cc.z, cc.w)};
        }
        ss = wave_sum(ss, lane);
        if (lane == 0) RSTD[t] = rsqrtf(ss * (1.f / DM) + EPSF);
    }
}

__device__ __forceinline__ void tp_tile(LAS float* tl, int lane, const float* src, int ld, const float* scale, float mul, bf16* dst, int Kd) {
    const int kk = lane >> 4, n4 = lane & 15;
    f32x4v v[16];
#pragma unroll
    for (int i = 0; i < 16; ++i) v[i] = *(const f32x4v*)(src + (size_t)(4 * i + kk) * ld + 4 * n4);
    if (scale) {
#pragma unroll
        for (int i = 0; i < 16; ++i) v[i] = v[i] * (scale[4 * i + kk] * mul); }
#pragma unroll
    for (int i = 0; i < 16; ++i)
#pragma unroll
        for (int e = 0; e < 4; ++e) tl[(4 * n4 + e) * 65 + 4 * i + kk] = v[i][e];
#pragma unroll
    for (int jj = 0; jj < 8; ++jj) { const int n = (lane >> 3) + 8 * jj, kc = (lane & 7) * 8; const LAS float* tp = tl + n * 65 + kc;
        *(u32x4v*)(dst + (size_t)n * Kd + kc) = (u32x4v){pk2(tp[0], tp[1]), pk2(tp[2], tp[3]), pk2(tp[4], tp[5]), pk2(tp[6], tp[7])}; }
}
template <class F, class M> __device__ __forceinline__ void transpose_tiles_map(const Ctx& c, bf16* dst, int Kd, int ntiles, const F& val, const M& map) {
    LAS float* tile = (LAS float*)c.lds + (c.tid >> 8) * (32 * 33);
    const int t2 = c.tid & 255, tx = t2 & 31, ty = t2 >> 5;
    for (int it = 2 * c.bid + (c.tid >> 8); it < ntiles; it += 2 * c.nb) {
        int k0, n0; map(it, k0, n0);
#pragma unroll
        for (int i = 0; i < 4; ++i) tile[(ty + 8 * i) * 33 + tx] = val(k0 + ty + 8 * i, n0 + tx);
        __syncthreads();
#pragma unroll
        for (int i = 0; i < 4; ++i) dst[(size_t)(n0 + ty + 8 * i) * Kd + k0 + tx] = f2bf(tile[tx * 33 + ty + 8 * i]);
        __syncthreads();
    }
}
__device__ __forceinline__ void ph_prep_w(const Ctx& c0, int ly, bf16* WIN, bf16* WOUT, bf16* WGU, bf16* WDN, bf16* WUKB, bf16* WUVT) { const Ctx c = refresh(c0);
    const float* w_in = INP(6) + (size_t)ly * DM * DIN; const float* g1 = INP(2) + (size_t)ly * DM; const float* w_uk = INP(17) + (size_t)ly * 8 * 128 * 64;
    const float* w_out = INP(19) + (size_t)ly * DM * DM; const float* ssd_norm = INP(12) + (size_t)ly * 512; const float* pool_w = INP(13) + (size_t)ly * 4 * 128 * 128;
    const float* pool_scale = INP(14) + (size_t)ly * 512; const float* w_uv = INP(18) + (size_t)ly * 8 * 128 * 64;
    const float* wg = INP(20) + (size_t)ly * DM * FF; const float* wu = INP(21) + (size_t)ly * DM * FF; const float* g3 = INP(4) + (size_t)ly * DM;
    const float* wd = INP(24) + (size_t)ly * FF * DM;
    {
        LAS float* tl = (LAS float*)c.lds + c.wave * (64 * 65);
        constexpr int N_WIN = 71 * 32, N_WGU = 176 * 32, N_WDN = 32 * 88, N_WOUT = 32 * 24, N_ALL = N_WIN + N_WGU + N_WDN + N_WOUT;
#pragma unroll 1
        for (int it0 = c.gw; it0 < N_ALL * REP_FAST; it0 += c.ngw) { const int it = it0 % N_ALL;
            int r = it; const float* src; const float* scl; bf16* dst; int ld, Kd; float mul = 1.f;
            if (r < N_WGU) { const int kt = r / 176, ct = r - kt * 176, pn = ct >> 2, up = (ct >> 1) & 1, hf = ct & 1;
                src = (up ? wu : wg) + (size_t)(64 * kt) * FF + 128 * pn + 64 * hf; ld = FF; scl = g3 + 64 * kt; dst = WGU + (size_t)(256 * pn + 128 * up + 64 * hf) * DM + 64 * kt; Kd = DM; }
            else if ((r -= N_WGU) < N_WDN) { const int kt = r >> 5, ct = r & 31;
                src = wd + (size_t)(64 * kt) * DM + 64 * ct; ld = DM; scl = nullptr; dst = WDN + (size_t)(64 * ct) * FF + 64 * kt; Kd = FF; }
            else if ((r -= N_WDN) < N_WIN) { const int kt = r / 71, ct = r - kt * 71;
                int dcol, scol;
                if (ct < 24) { dcol = 64 * ct; scol = dcol; }
                else if (ct < 32) { dcol = 64 * ct; scol = 1544 + 64 * (ct - 24); }
                else if (ct < 56) { dcol = 64 * ct; scol = 2056 + 64 * (ct - 32); if (ct < 40) mul = 0.18033688011112042f; }
                else if (ct < 64) { dcol = 64 * ct; scol = 3600 + 64 * (ct - 56); }
                else if (ct < 66) { dcol = C_DC + 64 * (ct - 64); scol = 4112 + 64 * (ct - 64); }
                else if (ct < 70) { dcol = C_QI + 64 * (ct - 66); scol = 4240 + 64 * (ct - 66); }
                else { dcol = C_KI; scol = 4496; }
                src = w_in + (size_t)(64 * kt) * DIN + scol; ld = DIN; scl = g1 + 64 * kt; dst = WIN + (size_t)dcol * DM + 64 * kt; Kd = DM; }
            else { r -= N_WIN; const int kq = r >> 5, nt = r & 31, k0 = kq < 8 ? 64 * kq : 1024 + 64 * (kq - 8);
                src = w_out + (size_t)k0 * DM + 64 * nt; ld = DM; scl = kq < 8 ? ssd_norm + k0 : nullptr; dst = WOUT + (size_t)(64 * nt) * KOUT + k0; Kd = KOUT; }
            tp_tile(tl, c.lane, src, ld, scl, mul, dst, Kd);
        }
    }
    __syncthreads();
    {   const int gt = c.bid * NTHR + c.tid, ngt = c.nb * NTHR;
        for (int it = gt; it < 8 * 128 * 64 / 2; it += ngt) { const float sc = 0.125f * 1.4426950408889634f; *(unsigned*)(WUKB + 2 * it) = pk2(w_uk[2 * it] * sc, w_uk[2 * it + 1] * sc); }
        for (int it = gt; it < 4 * 32 * 512; it += ngt) {
            const int nq = it & 511, cq = (it >> 9) & 31, gi = it >> 14, n0 = 4 * nq, c0_ = 4 * cq;
            float acc[4][4];
#pragma unroll
            for (int a = 0; a < 4; ++a)
#pragma unroll
                for (int b = 0; b < 4; ++b) acc[a][b] = 0.f;
            const float* ap = pool_w + ((size_t)gi * 128 + c0_) * 128; const float* sp = pool_scale + 128 * gi; const float* bp = w_out + (size_t)(512 + 128 * gi) * DM + n0;
#pragma unroll 2
            for (int d = 0; d < 128; d += 4) {
                f32x4v av[4], bv[4]; const f32x4v sv = *(const f32x4v*)(sp + d);
#pragma unroll
                for (int a = 0; a < 4; ++a) { av[a] = *(const f32x4v*)(ap + a * 128 + d) * sv; bv[a] = *(const f32x4v*)(bp + (size_t)(d + a) * DM); }
#pragma unroll
                for (int a = 0; a < 4; ++a)
#pragma unroll
                    for (int b = 0; b < 4; ++b) acc[a][b] += av[a][0] * bv[0][b] + av[a][1] * bv[1][b] + av[a][2] * bv[2][b] + av[a][3] * bv[3][b];
            }
#pragma unroll
            for (int b = 0; b < 4; ++b) *(u32x2v*)(WOUT + (size_t)(n0 + b) * KOUT + 512 + 128 * gi + c0_) = (u32x2v){pk2(acc[0][b], acc[1][b]), pk2(acc[2][b], acc[3][b])};
        }
        for (int it = gt; it < 8 * 64 * 128; it += ngt) { const int r = it & 127, d = (it >> 7) & 63, h = it >> 13; WUVT[it] = f2bf(w_uv[((size_t)h * 128 + r) * 64 + d]); }
    }
    transpose_tiles_map(c, WIN, DM, 2 * 64, [=](int k, int n) -> float {
            int src = -1;
            if (n < C_SM + 8) src = 1536 + (n - C_SM);
            else if (n < C_SM + 16) src = 3592 + (n - C_SM - 8);
            else if (n < C_SM + 20) src = 4560 + (n - C_SM - 16);
            return src >= 0 ? w_in[(size_t)k * DIN + src] * g1[k] : 0.f; },
        [=](int it, int& k0, int& n0) { k0 = 32 * (it & 63); n0 = C_SM + 32 * (it >> 6); });
}

__device__ __forceinline__ void ph_mixprep(const Ctx& c0, const bf16* U, const float* UF, const float* cw, const float* cb, const float* kvn, const float* dtb, bf16* XC, bf16* Y, bf16* CN, float* DT, bf16* KI) { const Ctx c = refresh(c0);
    const int gt = c.bid * NTHR + c.tid, ngt = c.nb * NTHR;
    for (int idx = gt; idx < (T / 4) * 128; idx += ngt) {
        const int t0 = (idx >> 7) * 4, c0 = (idx & 127) * 8, pos0 = t0 % L;
        u32x4v v[7];
#pragma unroll
        for (int i = 0; i < 7; ++i) v[i] = pos0 - 3 + i >= 0 ? *(const u32x4v*)(U + (size_t)(t0 - 3 + i) * NU + C_XBC + c0) : (u32x4v){0u, 0u, 0u, 0u};
        f32x4v wa[4], wb[4];
#pragma unroll
        for (int k = 0; k < 4; ++k) { wa[k] = *(const f32x4v*)(cw + k * 1024 + c0); wb[k] = *(const f32x4v*)(cw + k * 1024 + c0 + 4); }
        const f32x4v ba = *(const f32x4v*)(cb + c0), bb = *(const f32x4v*)(cb + c0 + 4);
        float x[7][8];
#pragma unroll
        for (int i = 0; i < 7; ++i) { const unsigned w_[4] = {v[i].x, v[i].y, v[i].z, v[i].w};
#pragma unroll
            for (int j = 0; j < 8; ++j) x[i][j] = bf2f((bf16)(w_[j >> 1] >> (16 * (j & 1)))); }
#pragma unroll
        for (int r = 0; r < 4; ++r) { float acc[8];
#pragma unroll
            for (int j = 0; j < 8; ++j) { acc[j] = j < 4 ? ba[j] : bb[j - 4];
#pragma unroll
                for (int k = 0; k < 4; ++k) acc[j] += (j < 4 ? wa[k][j] : wb[k][j - 4]) * x[r + k][j]; }
            *(u32x4v*)(XC + (size_t)(t0 + r) * 1024 + c0) = (u32x4v){pk2(siluf(acc[0]), siluf(acc[1])), pk2(siluf(acc[2]), siluf(acc[3])), pk2(siluf(acc[4]), siluf(acc[5])), pk2(siluf(acc[6]), siluf(acc[7]))}; }
    }
    for (int idx = gt; idx < (T / 4) * 64; idx += ngt) {
        const int t0 = (idx >> 6) * 4, c0 = (idx & 63) * 8, pos0 = t0 % L, gi = c0 >> 7;
        const bf16* up = U + (size_t)t0 * NU + C_POOL + c0;
#define POOL_BLK(W) { u32x4v v[W + 3]; _Pragma("unroll") for (int i = 0; i < W + 3; ++i) v[i] = pos0 - (W - 1) + i >= 0 ? *(const u32x4v*)(up + (ptrdiff_t)(i - (W - 1)) * NU) : (u32x4v){0u, 0u, 0u, 0u}; \
            _Pragma("unroll") for (int r = 0; r < 4; ++r) { float acc[8] = {0, 0, 0, 0, 0, 0, 0, 0}, self[8]; \
                _Pragma("unroll") for (int i = 0; i < W; ++i) { const u32x4v q_ = v[r + i]; const unsigned w_[4] = {q_.x, q_.y, q_.z, q_.w}; \
                    _Pragma("unroll") for (int j = 0; j < 8; ++j) { const float f = bf2f((bf16)(w_[j >> 1] >> (16 * (j & 1)))); acc[j] += f; if (i == W - 1) self[j] = f; } } \
                const float inv = 1.f / (float)min(pos0 + r + 1, W); \
                *(u32x4v*)(Y + (size_t)(t0 + r) * KOUT + 512 + c0) = (u32x4v){pk2(acc[0] * inv - self[0], acc[1] * inv - self[1]), pk2(acc[2] * inv - self[2], acc[3] * inv - self[3]), \
                    pk2(acc[4] * inv - self[4], acc[5] * inv - self[5]), pk2(acc[6] * inv - self[6], acc[7] * inv - self[7])}; } }
        if (gi == 0) POOL_BLK(2) else if (gi == 1) POOL_BLK(4) else if (gi == 2) POOL_BLK(8) else POOL_BLK(16)
    }
    for (int t = c.gw; t < T; t += c.ngw) {
        const int lane = c.lane;
        const unsigned v = *(const unsigned*)(U + (size_t)t * NU + C_DC + 2 * lane);
        const float a = bf2f((bf16)(v & 0xffff)), cc = bf2f((bf16)(v >> 16));
        const float rs = rsqrtf(wave_sum(a * a + cc * cc, lane) * (1.f / 128.f) + EPSF);
        *(unsigned*)(CN + (size_t)t * 128 + 2 * lane) = pk2(a * rs * kvn[2 * lane], cc * rs * kvn[2 * lane + 1]);
        if (lane < 8) DT[(size_t)t * 8 + lane] = softplusf(UF[(size_t)t * 32 + lane] + dtb[lane]);
        if (lane < 32) *(unsigned*)(KI + (size_t)t * 64 + 2 * lane) = *(const unsigned*)(U + (size_t)t * NU + C_KI + 2 * lane);
    }
}
__device__ __forceinline__ void ph_fcum(const Ctx& c0, const float* UF, const float* fb, float* FCUM) { const Ctx c = refresh(c0);
    const int lane = c.lane, w = c.wave;
    LAS float* tot = (LAS float*)c.lds;
    for (int bh = c.bid; bh < 64; bh += c.nb) {
        const int b = bh >> 3, h = bh & 7; const float bias = fb[h]; float v[9]; float carry = 0.f;
#pragma unroll
        for (int i = 0; i < 9; ++i) { const int p = 576 * w + 64 * i + lane; v[i] = p < L ? logsigmoidf(UF[(size_t)(b * L + p) * 32 + 8 + h] + bias) : 0.f; }
#pragma unroll
        for (int i = 0; i < 9; ++i) { float x = v[i];
#pragma unroll
            for (int o = 1; o < 64; o <<= 1) { const float n = lane_read(x, (lane - o) & 63); if (lane >= o) x += n; }
            x += carry; v[i] = x; carry = lane_read(x, 63); }
        if (lane == 0) tot[w] = carry;
        __syncthreads();
        float off = 0.f;
#pragma unroll
        for (int ww = 0; ww < NWAVE; ++ww) off += ww < w ? tot[ww] : 0.f;
#pragma unroll
        for (int i = 0; i < 9; ++i) { const int p = 576 * w + 64 * i + lane; if (p < L) FCUM[(size_t)bh * LKP + (p < 16 ? p : p + 48)] = -(v[i] + off) * 1.4426950408889634f; }
        if (w == 0 && lane >= 16) FCUM[(size_t)bh * LKP + lane] = -1e30f;
        __syncthreads();
    }
}
__device__ __forceinline__ unsigned fkey(float f) { const unsigned u = __float_as_uint(f); return (u & 0x80000000u) ? ~u : (u | 0x80000000u); }
__device__ __forceinline__ int crow(int r, int hi) { return (r & 3) + 8 * (r >> 2) + 4 * hi; }
typedef short bf16x8 __attribute__((ext_vector_type(8)));
typedef float f32x16 __attribute__((ext_vector_type(16)));
typedef float f32x2v __attribute__((ext_vector_type(2)));
typedef __bf16 bf16x2v __attribute__((ext_vector_type(2)));
#define MFMA32(a, b, c) __builtin_amdgcn_mfma_f32_32x32x16_bf16((a), (b), (c), 0, 0, 0)
#define WLANE64(lo, hi, m, sel) asm volatile("s_nop 1\n\tv_writelane_b32 %0, %2, %4\n\tv_writelane_b32 %1, %3, %4" : "+v"(lo), "+v"(hi) : "s"((unsigned)(m)), "s"((unsigned)((m) >> 32)), "n"(sel))
__device__ __forceinline__ float max3c(float a, float b, float c) { return __builtin_fmaxf(__builtin_fmaxf(a, b), c); }
__device__ __forceinline__ float max3f(float a, float b, float c) { float r; asm("v_max3_f32 %0, %1, %2, %3" : "=v"(r) : "v"(a), "v"(b), "v"(c)); return r; }
__device__ __forceinline__ unsigned cvtpk(float lo, float hi) { f32x2v v = {lo, hi}; bf16x2v b = __builtin_convertvector(v, bf16x2v); return __builtin_bit_cast(unsigned, b); }
__device__ __forceinline__ bf16x8 pack8(const f32x16& p, int s) {
    u32x4v r; r.x = cvtpk(p[8 * s], p[8 * s + 1]); r.y = cvtpk(p[8 * s + 2], p[8 * s + 3]); r.z = cvtpk(p[8 * s + 4], p[8 * s + 5]); r.w = cvtpk(p[8 * s + 6], p[8 * s + 7]);
    return __builtin_bit_cast(bf16x8, r);
}
constexpr int AT_KSTR = 72;
constexpr int AT_VSTR = 68;
constexpr int FOX_KB = 64 * AT_KSTR;
typedef short fx_s16x4 __attribute__((ext_vector_type(4)));
constexpr int FX_SLOTB = 8192, FX_LDS_K = 0, FX_LDS_V = 3 * FX_SLOTB, FX_LDS_B = 6 * FX_SLOTB;
#define FX_THR 8.f
#define FX_SBAR() __builtin_amdgcn_sched_barrier(0)
#define FX_PIN(x) asm volatile("" : "+v"(x))
#define FX_WAIT_BAR(N) asm volatile("s_waitcnt vmcnt(" #N ") lgkmcnt(0)\n\ts_barrier" ::: "memory")
__device__ __forceinline__ void fx_glds16(const void* g, unsigned lds_base) {
    unsigned sv; asm volatile("s_mov_b32 %0, m0\n\ts_mov_b32 m0, %2\n\ts_nop 0\n\tglobal_load_lds_dwordx4 %1, off\n\ts_mov_b32 m0, %0" : "=&s"(sv) : "v"(g), "s"(lds_base) : "memory"); }
__device__ __forceinline__ void fx_glds4(const void* g, unsigned lds_base) {
    unsigned sv; asm volatile("s_mov_b32 %0, m0\n\ts_mov_b32 m0, %2\n\ts_nop 0\n\tglobal_load_lds_dword %1, off\n\ts_mov_b32 m0, %0" : "=&s"(sv) : "v"(g), "s"(lds_base) : "memory"); }
__device__ __forceinline__ void fx_kload2(bf16x8* kf, const LAS char* kp, int d0) { kf[2 * d0] = *(const LAS bf16x8*)(kp + d0 * 2048); kf[2 * d0 + 1] = *(const LAS bf16x8*)(kp + d0 * 2048 + 512); }
__device__ __forceinline__ fx_s16x4 fx_vtr(const LAS char* p) { return __builtin_bit_cast(fx_s16x4, __builtin_amdgcn_ds_read_tr16_b64_v4i16((LAS fx_s16x4*)p)); }
__device__ __forceinline__ float fx_swapmax(float m) {
#if defined(__HIP_DEVICE_COMPILE__)
    const auto rr = __builtin_amdgcn_permlane32_swap(__float_as_uint(m), __float_as_uint(m), false, false); return max3f(__uint_as_float(rr[0]), __uint_as_float(rr[1]), __uint_as_float(rr[1]));
#else
    return m;
#endif
}
__device__ __forceinline__ float fx_swapsum(float m) {
#if defined(__HIP_DEVICE_COMPILE__)
    const auto rr = __builtin_amdgcn_permlane32_swap(__float_as_uint(m), __float_as_uint(m), false, false); return __uint_as_float(rr[0]) + __uint_as_float(rr[1]);
#else
    return m;
#endif
}
__device__ __forceinline__ float fx_rowmax(const f32x16& p0, const f32x16& p1) {
    float a = max3c(p0[0], p0[1], p1[0]), b = max3c(p0[2], p0[3], p1[1]); a = max3c(a, p1[2], p1[3]);
#pragma unroll
    for (int r = 4; r < 16; r += 4) { a = max3c(a, p0[r], p0[r + 1]); b = max3c(b, p0[r + 2], p0[r + 3]); a = max3c(a, p1[r], p1[r + 1]); b = max3c(b, p1[r + 2], p1[r + 3]); }
    return fx_swapmax(max3c(a, b, b)); }
__device__ __forceinline__ void fx_cmask(f32x16& p0, f32x16& p1, int jb, int qrel, int hi) {
    const int kb = 64 * jb + 4 * hi;
#pragma unroll
    for (int r = 0; r < 16; ++r) { const int kv = kb + (r & 3) + 8 * (r >> 2); if (kv > qrel) p0[r] = -__builtin_inff(); if (kv + 32 > qrel) p1[r] = -__builtin_inff(); } }

__device__ __forceinline__ void fox_unit(const Ctx& c, int b, int h, int j, const bf16* U, const float* BT, bf16* Y) {
    const int lane = c.lane, r32 = lane & 31, hi = lane >> 5, wid = c.wave;
    const int q0 = 16 + 256 * (j - 1), NT = 1 + 4 * j;
    const bf16* Ub = U + (size_t)(b * L) * NU;
    const unsigned lds0 = (unsigned)(size_t)c.lds;
    const bf16* ksrc = Ub + (size_t)lane * NU + C_FK + 64 * h + wid * 8;
    const bf16* vsrc = Ub + (size_t)(16 * (wid & 3) + (lane >> 2)) * NU + C_FV + 64 * h + (wid >> 2) * 32 + (lane & 3) * 8;
    const float* bsrc = BT + lane;
    const unsigned kdst = lds0 + FX_LDS_K + wid * 1024, vdst = lds0 + FX_LDS_V + wid * 1024, bdst = lds0 + FX_LDS_B + wid * 256;
#define FX_TROW(t) ((t) == 0 ? 0 : 64 * (t) - 48)
#define FX_DMA_K(t, slot) fx_glds16(ksrc + (size_t)FX_TROW(t) * NU, (unsigned)__builtin_amdgcn_readfirstlane(kdst + (slot)))
#define FX_DMA_V(t, slot) fx_glds16(vsrc + (size_t)FX_TROW(t) * NU, (unsigned)__builtin_amdgcn_readfirstlane(vdst + (slot)))
#define FX_DMA_B(t, slot) fx_glds4(bsrc + 64 * (t), (unsigned)__builtin_amdgcn_readfirstlane(bdst + ((slot) >> 2)))
    const LAS char* vp0 = (const LAS char*)c.lds + FX_LDS_V + ((lane >> 4) & 1) * 32 + (lane & 3) * 8 + (4 * hi + ((lane & 15) >> 2)) * 64;
    const LAS char* kp0 = (const LAS char*)c.lds + FX_LDS_K + hi * 1024 + r32 * 16;
    const LAS char* bp0 = (const LAS char*)c.lds + FX_LDS_B + wid * 256 + hi * 16;
    FX_DMA_K(0, 0); FX_DMA_B(0, 0); FX_DMA_V(0, 0); FX_DMA_K(1, FX_SLOTB); FX_DMA_B(1, FX_SLOTB);
    bf16x8 qr[4];
#pragma unroll
    for (int d0 = 0; d0 < 4; ++d0) qr[d0] = *(const bf16x8*)(Ub + (size_t)(q0 + 32 * wid + r32) * NU + C_FQ + 64 * h + 16 * d0 + 8 * hi);
    const float bq = BT[q0 + 32 * wid + r32 + 48];
    float mhat = 0.f, l_reg = 0.f, fsc = 1.f; f32x16 o[2];
#pragma unroll
    for (int r = 0; r < 16; ++r) { o[0][r] = 0.f; o[1][r] = 0.f; }
    const int qrel = wid * 32 + r32; bool resc = false;
    f32x16 pA0, pA1, pB0, pB1; bf16x8 kf[8]; fx_s16x4 vlo[8], vhi[8]; u32x4v pw0, pw1, pw2, pw3;
    int sl_prev = 0, sl_cur = 0, sl_next = FX_SLOTB;
#define FX_ROT() do { sl_prev = sl_cur; sl_cur = sl_next; sl_next = (sl_next == 2 * FX_SLOTB) ? 0 : sl_next + FX_SLOTB; } while (0)
#define FX_EX(v) __builtin_amdgcn_exp2f((v) + nmh)
#define FX_RESC() do { if (resc) { _Pragma("unroll") for (int d_ = 0; d_ < 2; ++d_) _Pragma("unroll") for (int r = 0; r < 16; ++r) o[d_][r] *= fsc; } } while (0)
#define FX_BIAS(X0, X1, bp, i4) do { const f32x4v f0_ = *(const LAS f32x4v*)((bp) + 32 * (i4)), f1_ = *(const LAS f32x4v*)((bp) + 128 + 32 * (i4)); \
        _Pragma("unroll") for (int e_ = 0; e_ < 4; ++e_) { X0[4 * (i4) + e_] = f0_[e_]; X1[4 * (i4) + e_] = f1_[e_]; } } while (0)
    FX_DMA_K(2, 2 * FX_SLOTB); FX_DMA_B(2, 2 * FX_SLOTB);
    FX_WAIT_BAR(4);
    _Pragma("unroll") for (int i4 = 0; i4 < 4; ++i4) FX_BIAS(pA0, pA1, bp0, i4);
    _Pragma("unroll") for (int d0 = 0; d0 < 4; ++d0) fx_kload2(kf, kp0, d0);
    pA0 = MFMA32(kf[0], qr[0], pA0); pA1 = MFMA32(kf[1], qr[0], pA1); pA0 = MFMA32(kf[2], qr[1], pA0); pA1 = MFMA32(kf[3], qr[1], pA1);
    pA0 = MFMA32(kf[4], qr[2], pA0); pA1 = MFMA32(kf[5], qr[2], pA1); pA0 = MFMA32(kf[6], qr[3], pA0); pA1 = MFMA32(kf[7], qr[3], pA1);
    { const float rm = fx_rowmax(pA0, pA1); mhat = fmaxf(rm, bq); const float nmh = -mhat;
#pragma unroll
      for (int r = 0; r < 16; ++r) { pA0[r] = FX_EX(pA0[r]); pA1[r] = FX_EX(pA1[r]); } }
    FX_WAIT_BAR(0);
    FX_DMA_K(3, 0); FX_DMA_B(3, 0); FX_DMA_V(1, FX_SLOTB); FX_ROT();
    _Pragma("unroll") for (int d0 = 0; d0 < 4; ++d0) fx_kload2(kf, kp0 + sl_cur, d0);
    _Pragma("unroll") for (int i4 = 0; i4 < 4; ++i4) FX_BIAS(pB0, pB1, bp0 + (sl_cur >> 2), i4);
    FX_WAIT_BAR(3);
#define FX_PKW(P, i) cvtpk(P[i], P[i + 1])
#define FX_PAF(k) __builtin_bit_cast(bf16x8, pw##k)
#define FX_VFR(i) (bf16x8){vlo[i][0], vlo[i][1], vlo[i][2], vlo[i][3], vhi[i][0], vhi[i][1], vhi[i][2], vhi[i][3]}
#define FX_VRD(i) do { vlo[i] = fx_vtr(vp_ + (((i) >> 2) * 4096 + ((i) & 3) * 1024)); vhi[i] = fx_vtr(vp_ + (((i) >> 2) * 4096 + ((i) & 3) * 1024 + 512)); } while (0)
#define FX_KRD(G, d0) do { if (G) { fx_kload2(kf, kp0 + sl_next, d0); FX_SBAR(); } } while (0)
#define FX_BRD(G, X0, X1, i4) do { if (G) { FX_BIAS(X0, X1, bp0 + (sl_next >> 2), i4); FX_SBAR(); } } while (0)
#define FX_GAPA(MF, a0, a1, a2, a3, W0, W1, PW) do { MF; sacc += a0; sacc += a1; sacc += a2; sacc += a3; W0; W1; FX_PIN(PW); FX_PIN(sacc); FX_SBAR(); } while (0)
#define FX_GAPB(MF, X, i) do { MF; X[i] = FX_EX(X[i]); X[i + 1] = FX_EX(X[i + 1]); X[i + 2] = FX_EX(X[i + 2]); X[i + 3] = FX_EX(X[i + 3]); FX_PIN(X); FX_SBAR(); } while (0)
#define FX_STEP(C0, C1, P0, P1, t, MASK, GK, GV, GL) do { FX_SBAR(); \
    const LAS char* vp_ = vp0 + sl_prev; \
    FX_VRD(0); FX_SBAR(); float sacc = P0[0] + P0[1]; \
                          FX_GAPA(C0 = MFMA32(kf[0], qr[0], C0), P0[2], P0[3], P0[4], P0[5],     pw0[0] = FX_PKW(P0, 0),  pw0[1] = FX_PKW(P0, 2),  pw0); \
    FX_VRD(4); FX_SBAR(); FX_GAPA(C1 = MFMA32(kf[1], qr[0], C1), P0[6], P0[7], P0[8], P0[9],     pw0[2] = FX_PKW(P0, 4),  pw0[3] = FX_PKW(P0, 6),  pw0); \
    FX_VRD(1); FX_SBAR(); FX_GAPA(C0 = MFMA32(kf[2], qr[1], C0), P0[10], P0[11], P0[12], P0[13], pw1[0] = FX_PKW(P0, 8),  pw1[1] = FX_PKW(P0, 10), pw1); \
    FX_VRD(5); FX_SBAR(); FX_GAPA(C1 = MFMA32(kf[3], qr[1], C1), P0[14], P0[15], P1[0], P1[1],   pw1[2] = FX_PKW(P0, 12), pw1[3] = FX_PKW(P0, 14), pw1); \
    FX_VRD(2); FX_SBAR(); FX_GAPA(C0 = MFMA32(kf[4], qr[2], C0), P1[2], P1[3], P1[4], P1[5],     pw2[0] = FX_PKW(P1, 0),  pw2[1] = FX_PKW(P1, 2),  pw2); \
    FX_VRD(6); FX_SBAR(); FX_GAPA(C1 = MFMA32(kf[5], qr[2], C1), P1[6], P1[7], P1[8], P1[9],     pw2[2] = FX_PKW(P1, 4),  pw2[3] = FX_PKW(P1, 6),  pw2); \
    FX_VRD(3); FX_SBAR(); FX_GAPA(C0 = MFMA32(kf[6], qr[3], C0), P1[10], P1[11], P1[12], P1[13], pw3[0] = FX_PKW(P1, 8),  pw3[1] = FX_PKW(P1, 10), pw3); \
    FX_VRD(7); FX_SBAR(); FX_GAPA(C1 = MFMA32(kf[7], qr[3], C1), P1[14], P1[15], 0.f, 0.f,       pw3[2] = FX_PKW(P1, 12), pw3[3] = FX_PKW(P1, 14), pw3); \
    l_reg += sacc; \
    if (GK) { FX_DMA_K((t) + 3, sl_cur); FX_DMA_B((t) + 3, sl_cur); } if (GV) FX_DMA_V((t) + 1, sl_next); \
    if (MASK) fx_cmask(C0, C1, (t) - (NT - 4), qrel, hi); \
    { const float rm = fx_rowmax(C0, C1) - mhat; resc = false; \
      if (__builtin_expect(__ballot(rm > FX_THR) != 0ull, 0)) { const float dl = fmaxf(rm, 0.f); mhat += dl; fsc = __builtin_amdgcn_exp2f(-dl); l_reg *= fsc; resc = true; } } \
    const float nmh = -mhat; FX_SBAR(); \
    FX_GAPB(o[0] = MFMA32(FX_VFR(0), FX_PAF(0), o[0]), C0, 0);                    FX_GAPB(o[1] = MFMA32(FX_VFR(4), FX_PAF(0), o[1]), C0, 4); \
    FX_KRD(GL, 0); FX_GAPB(o[0] = MFMA32(FX_VFR(1), FX_PAF(1), o[0]), C0, 8);     FX_KRD(GL, 1); FX_GAPB(o[1] = MFMA32(FX_VFR(5), FX_PAF(1), o[1]), C0, 12); \
    FX_KRD(GL, 2); FX_GAPB(o[0] = MFMA32(FX_VFR(2), FX_PAF(2), o[0]), C1, 0);     FX_KRD(GL, 3); FX_GAPB(o[1] = MFMA32(FX_VFR(6), FX_PAF(2), o[1]), C1, 4); \
    FX_BRD(GL, P0, P1, 0); FX_BRD(GL, P0, P1, 1); FX_GAPB(o[0] = MFMA32(FX_VFR(3), FX_PAF(3), o[0]), C1, 8); \
    FX_BRD(GL, P0, P1, 2); FX_BRD(GL, P0, P1, 3); FX_GAPB(o[1] = MFMA32(FX_VFR(7), FX_PAF(3), o[1]), C1, 12); \
    } while (0)
#define FX_ENDW(tt) do { if ((tt) + 3 < NT) { FX_WAIT_BAR(3); } else if ((tt) + 2 < NT) { FX_WAIT_BAR(1); } else { FX_WAIT_BAR(0); } } while (0)
    FX_STEP(pB0, pB1, pA0, pA1, 1, true, true, true, true); FX_ENDW(1); FX_RESC(); FX_ROT();
    int t = 2;
    for (; t + 5 < NT; t += 2) {
        FX_STEP(pA0, pA1, pB0, pB1, t, false, true, true, true);     FX_WAIT_BAR(3); FX_RESC(); FX_ROT();
        FX_STEP(pB0, pB1, pA0, pA1, t + 1, false, true, true, true); FX_WAIT_BAR(3); FX_RESC(); FX_ROT();
    }
    for (; t + 1 < NT; t += 2) {
        FX_STEP(pA0, pA1, pB0, pB1, t, true, (t + 3 < NT), (t + 1 < NT), (t + 1 < NT));         FX_ENDW(t);     FX_RESC(); FX_ROT();
        FX_STEP(pB0, pB1, pA0, pA1, t + 1, true, (t + 4 < NT), (t + 2 < NT), (t + 2 < NT));     FX_ENDW(t + 1); FX_RESC(); FX_ROT();
    }
    FX_STEP(pA0, pA1, pB0, pB1, NT - 1, true, false, false, false); FX_RESC();
    { float sacc = pA0[0] + pA0[1];
#pragma unroll
      for (int r = 2; r < 16; ++r) sacc += pA0[r];
#pragma unroll
      for (int r = 0; r < 16; ++r) sacc += pA1[r];
      l_reg += sacc;
      pw0 = (u32x4v){FX_PKW(pA0, 0), FX_PKW(pA0, 2), FX_PKW(pA0, 4), FX_PKW(pA0, 6)}; pw1 = (u32x4v){FX_PKW(pA0, 8), FX_PKW(pA0, 10), FX_PKW(pA0, 12), FX_PKW(pA0, 14)};
      pw2 = (u32x4v){FX_PKW(pA1, 0), FX_PKW(pA1, 2), FX_PKW(pA1, 4), FX_PKW(pA1, 6)}; pw3 = (u32x4v){FX_PKW(pA1, 8), FX_PKW(pA1, 10), FX_PKW(pA1, 12), FX_PKW(pA1, 14)};
      const LAS char* vp_ = vp0 + sl_cur; _Pragma("unroll") for (int i = 0; i < 8; ++i) FX_VRD(i);
      o[0] = MFMA32(FX_VFR(0), FX_PAF(0), o[0]); o[1] = MFMA32(FX_VFR(4), FX_PAF(0), o[1]); o[0] = MFMA32(FX_VFR(1), FX_PAF(1), o[0]); o[1] = MFMA32(FX_VFR(5), FX_PAF(1), o[1]);
      o[0] = MFMA32(FX_VFR(2), FX_PAF(2), o[0]); o[1] = MFMA32(FX_VFR(6), FX_PAF(2), o[1]); o[0] = MFMA32(FX_VFR(3), FX_PAF(3), o[0]); o[1] = MFMA32(FX_VFR(7), FX_PAF(3), o[1]); }
    l_reg = fx_swapsum(l_reg);
    {   const float inv = __builtin_amdgcn_rcpf(l_reg); bf16* yr = Y + (size_t)(b * L + q0 + 32 * wid + r32) * KOUT + 1024 + 64 * h;
#pragma unroll
        for (int i4 = 0; i4 < 4; ++i4) {
            *(u32x2v*)(yr + 8 * i4 + 4 * hi) = (u32x2v){cvtpk(o[0][4 * i4] * inv, o[0][4 * i4 + 1] * inv), cvtpk(o[0][4 * i4 + 2] * inv, o[0][4 * i4 + 3] * inv)};
            *(u32x2v*)(yr + 32 + 8 * i4 + 4 * hi) = (u32x2v){cvtpk(o[1][4 * i4] * inv, o[1][4 * i4 + 1] * inv), cvtpk(o[1][4 * i4 + 2] * inv, o[1][4 * i4 + 3] * inv)};
        }
    }
    asm volatile("s_waitcnt lgkmcnt(0)\n\ts_barrier" ::: "memory");
#undef FX_TROW
#undef FX_DMA_K
#undef FX_DMA_V
#undef FX_DMA_B
#undef FX_ROT
#undef FX_EX
#undef FX_RESC
#undef FX_BIAS
#undef FX_PKW
#undef FX_PAF
#undef FX_VFR
#undef FX_VRD
#undef FX_KRD
#undef FX_BRD
#undef FX_GAPA
#undef FX_GAPB
#undef FX_STEP
#undef FX_ENDW
}
__device__ __forceinline__ void ph_fox(const Ctx& c0, const bf16* U, const float* FCUM, bf16* Y) {
    const Ctx c = refresh(c0);
    LAS bf16* KS = (LAS bf16*)c.lds;
    LAS bf16* VT = KS + 2 * FOX_KB;
    LAS float* FB = (LAS float*)(c.lds + 4 * FOX_KB * 2);
    const int lane = c.lane, w = c.wave, r32 = lane & 31, hi = lane >> 5, tid = c.tid;
    const float LOG2E = 1.4426950408889634f;
    typedef short s16x4v __attribute__((ext_vector_type(4)));
    for (int it = c.bid; it < 64 * 17; it += c.nb) {
        const int rnd = it >> 8, cu = it & 255, k4 = cu >> 6, bh = cu & 63, b = bh >> 3, h = bh & 7;
        const int j = rnd == 0 ? 16 - k4 : rnd == 1 ? 9 + k4 : rnd == 2 ? 8 - k4 : rnd == 3 ? 1 + k4 : 0;
        if (j > 0) { fox_unit(c, b, h, j, U, FCUM + (size_t)bh * LKP, Y); continue; }
        const int q0 = j == 0 ? 0 : 16 + 256 * (j - 1), qrow = q0 + 32 * w + r32, ntiles = 1 + 4 * j, qmax = q0 + 32 * w + 31;
        const bool wave_on = (j > 0) || (w == 0), row_ok = (j > 0) || (r32 < 16);
        const bf16* Ub = U + (size_t)(b * L) * NU;
        bf16x8 qf[4];
#pragma unroll
        for (int s = 0; s < 4; ++s) qf[s] = (bf16x8){0, 0, 0, 0, 0, 0, 0, 0};
        if (wave_on && row_ok) {
#pragma unroll
            for (int s = 0; s < 4; ++s) qf[s] = *(const bf16x8*)(Ub + (size_t)qrow * NU + C_FQ + 64 * h + 16 * s + 8 * hi);
        }
        f32x16 o0, o1;
#pragma unroll
        for (int r = 0; r < 16; ++r) { o0[r] = 0.f; o1[r] = 0.f; }
        float m = -1e30f, l = 0.f;
        const float* fc = FCUM + (size_t)bh * LKP;
        const bf16* kg = Ub + (size_t)(tid >> 3) * NU + C_FK + 64 * h + 8 * (tid & 7);
        const bf16* vg = Ub + (size_t)lane * NU + C_FV + 64 * h + 8 * w;
#define FOX_KB0(t) ((t) == 0 ? 0 : 16 + 64 * ((t) - 1))
#define FOX_PUT_K(buf, kr, fr) do { *(LAS u32x4v*)(KS + (buf) * FOX_KB + (tid >> 3) * AT_KSTR + 8 * (tid & 7)) = kr; if (tid < 64) FB[(buf) * 64 + tid] = fr; } while (0)
#define FOX_PUT_V(buf, vr) do { const unsigned vv_[4] = {vr.x, vr.y, vr.z, vr.w}; \
            _Pragma("unroll") for (int e = 0; e < 8; ++e) VT[(buf) * FOX_KB + (8 * w + e) * AT_VSTR + lane] = (bf16)(vv_[e >> 1] >> (16 * (e & 1))); } while (0)
#define FOX_GET_K(t, kr, fr) do { const int kb_ = FOX_KB0(t); kr = *(const u32x4v*)(kg + (size_t)kb_ * NU); if (tid < 64) fr = fc[kb_ + tid]; } while (0)
#define FOX_GET_V(t, vr) do { vr = *(const u32x4v*)(vg + (size_t)FOX_KB0(t) * NU); } while (0)
#define FOX_QK(buf, P0, P1) do { const LAS float* fb_ = FB + (buf) * 64; \
            _Pragma("unroll") for (int i4 = 0; i4 < 4; ++i4) { const f32x4v f0 = *(const LAS f32x4v*)(fb_ + 8 * i4 + 4 * hi), f1 = *(const LAS f32x4v*)(fb_ + 32 + 8 * i4 + 4 * hi); \
                _Pragma("unroll") for (int e = 0; e < 4; ++e) { P0[4 * i4 + e] = f0[e]; P1[4 * i4 + e] = f1[e]; } } \
            _Pragma("unroll") for (int s = 0; s < 4; ++s) { \
                const bf16x8 a0 = *(const LAS bf16x8*)(KS + (buf) * FOX_KB + r32 * AT_KSTR + 16 * s + 8 * hi), a1 = *(const LAS bf16x8*)(KS + (buf) * FOX_KB + (32 + r32) * AT_KSTR + 16 * s + 8 * hi); \
                P0 = MFMA32(a0, qf[s], P0); P1 = MFMA32(a1, qf[s], P1); } } while (0)
        u32x4v kreg, vreg; float fbreg = 0.f;
        FOX_GET_K(0, kreg, fbreg); FOX_GET_V(0, vreg);
        FOX_PUT_K(0, kreg, fbreg); FOX_PUT_V(0, vreg);
        if (ntiles > 1) { FOX_GET_K(1, kreg, fbreg); FOX_GET_V(1, vreg); FOX_PUT_K(1, kreg, fbreg); }
        if (ntiles > 2) FOX_GET_K(2, kreg, fbreg);
        __syncthreads();
        f32x16 pc0, pc1, pn0, pn1;
#pragma unroll
        for (int r = 0; r < 16; ++r) { pc0[r] = 0.f; pc1[r] = 0.f; pn0[r] = 0.f; pn1[r] = 0.f; }
        if (wave_on) FOX_QK(0, pc0, pc1);
        __syncthreads();
        for (int i = 0; i < ntiles; ++i) {
            const int cur = i & 1, kb = FOX_KB0(i), kbn = FOX_KB0(i + 1);
            if (i + 2 < ntiles) FOX_PUT_K(cur, kreg, fbreg);
            if (i + 1 < ntiles) FOX_PUT_V(cur ^ 1, vreg);
            if (i + 3 < ntiles) FOX_GET_K(i + 3, kreg, fbreg);
            if (i + 2 < ntiles) FOX_GET_V(i + 2, vreg);
            const bool on_next = wave_on && (i + 1 < ntiles) && kbn <= qmax, on_cur = wave_on && kb <= qmax;
            if (on_next) FOX_QK(cur ^ 1, pn0, pn1);
            if (on_cur) {
                if (i == 0 || kb + 63 > q0 + 32 * w) {
                    const int klim = i == 0 ? 16 : 64;
#pragma unroll
                    for (int r = 0; r < 16; ++r) { const int k0 = crow(r, hi), k1 = 32 + k0;
                        if (!(k0 < klim && kb + k0 <= qrow)) pc0[r] = -1e30f;
                        if (!(k1 < klim && kb + k1 <= qrow)) pc1[r] = -1e30f; }
                }
                float mx = max3c(pc0[0], pc1[0], pc0[1]), mx2 = max3c(pc1[1], pc0[2], pc1[2]);
#pragma unroll
                for (int r = 3; r < 15; r += 2) { mx = max3c(mx, pc0[r], pc1[r]); mx2 = max3c(mx2, pc0[r + 1], pc1[r + 1]); }
                mx = max3c(mx, pc0[15], pc1[15]); mx = max3c(mx, mx2, mx2);
                const float mn = max3c(m, mx, lane_read(mx, lane ^ 32)), alpha = __builtin_amdgcn_exp2f(m - mn); const bool grew = __ballot(mn > m) != 0ull; m = mn;
                float sum = 0.f;
#pragma unroll
                for (int r = 0; r < 16; ++r) { pc0[r] = __builtin_amdgcn_exp2f(pc0[r] - mn); pc1[r] = __builtin_amdgcn_exp2f(pc1[r] - mn); sum += pc0[r] + pc1[r]; }
                l = l * alpha + sum;
                if (grew) {
#pragma unroll
                    for (int r = 0; r < 16; ++r) { o0[r] *= alpha; o1[r] *= alpha; } }
#pragma unroll
                for (int blk = 0; blk < 2; ++blk)
#pragma unroll
                    for (int s = 0; s < 2; ++s) {
                        const bf16x8 xs = pack8(blk == 0 ? pc0 : pc1, s);
                        const LAS bf16* vp = VT + cur * FOX_KB + r32 * AT_VSTR + 32 * blk + 16 * s + 4 * hi;
                        const s16x4v lo0 = *(const LAS s16x4v*)vp, hi0 = *(const LAS s16x4v*)(vp + 8);
                        const s16x4v lo1 = *(const LAS s16x4v*)(vp + 32 * AT_VSTR), hi1 = *(const LAS s16x4v*)(vp + 32 * AT_VSTR + 8);
                        const bf16x8 pa0 = __builtin_shufflevector(lo0, hi0, 0, 1, 2, 3, 4, 5, 6, 7), pa1 = __builtin_shufflevector(lo1, hi1, 0, 1, 2, 3, 4, 5, 6, 7);
                        o0 = MFMA32(pa0, xs, o0); o1 = MFMA32(pa1, xs, o1);
                    }
            }
            pc0 = pn0; pc1 = pn1;
            __syncthreads();
        }
        l += lane_read(l, lane ^ 32);
        if (wave_on && row_ok) {
            const float inv = 1.f / l; bf16* yr = Y + (size_t)(b * L + qrow) * KOUT + 1024 + 64 * h;
#pragma unroll
            for (int i4 = 0; i4 < 4; ++i4) {
                *(u32x2v*)(yr + 8 * i4 + 4 * hi) = (u32x2v){cvtpk(o0[4 * i4] * inv, o0[4 * i4 + 1] * inv), cvtpk(o0[4 * i4 + 2] * inv, o0[4 * i4 + 3] * inv)};
                *(u32x2v*)(yr + 32 + 8 * i4 + 4 * hi) = (u32x2v){cvtpk(o1[4 * i4] * inv, o1[4 * i4 + 1] * inv), cvtpk(o1[4 * i4 + 2] * inv, o1[4 * i4 + 3] * inv)};
            }
        }
    }
}
constexpr int DSA_LIST_OFF = 150016  , DSA_BUF_ELEMS = 17920  , DSA_SC_STR = 4160, DSA_MW_OFF = 8 * DSA_SC_STR * 4  , DSA_KSTR = 136, DSA_VT_OFF = 64 * DSA_KSTR * 2  , DSA_RING_OFF = 73728  ;
__device__ __forceinline__ void ph_dsa(const Ctx& c0, const bf16* U, const float* UF, const bf16* CN, const bf16* KI) {
    const Ctx c = refresh(c0);
    LAS unsigned* SC = (LAS unsigned*)c.lds;
    LAS u64* MW = (LAS u64*)(c.lds + DSA_MW_OFF);
    LAS bf16* KS = (LAS bf16*)c.lds;
    LAS bf16* VT = (LAS bf16*)(c.lds + DSA_VT_OFF);
    const int lane0 = c.lane, w0 = c.wave;
    const float LOG2E = 1.4426950408889634f;
    for (int it = c.bid; it < 1032; it += c.nb) {
        int w_tk = w0; asm volatile("" : "+s"(w_tk)); const int w = w_tk;
        int lane_tk = lane0; asm volatile("" : "+v"(lane_tk)); const int lane = lane_tk, r32 = lane & 31, hi = lane >> 5, tid = w * 64 + lane;
        const int rnd = it >> 8, cu = it & 255, g16 = cu >> 4, wi16 = cu & 15;
        const int ch = rnd == 0 ? 64 - g16 : rnd == 1 ? 33 + g16 : rnd == 2 ? 32 - g16 : rnd == 3 ? 1 + g16 : 0;
        const int b = rnd == 4 ? cu : (wi16 >> 1), half = rnd == 4 ? 0 : (wi16 & 1);
        const int p0q = ch == 0 ? 0 : 16 + 64 * (ch - 1) + 32 * half, nq = ch == 0 ? 16 : 32, nadm = ch == 0 ? 16 : 16 + 64 * ch, nw = ch + 1;
        const int t0 = b * L + p0q;
        const bf16* Ub = U + (size_t)(b * L) * NU;
        if (nadm <= TOPK) {
            for (int i = tid; i < 32 * 65; i += NTHR) { const int wd = i % 65; const int lo = 64 * wd; const int nb_ = nadm - lo;
                MW[i] = (wd < nw && nb_ > 0) ? (nb_ >= 64 ? ~0ull : ((1ull << nb_) - 1ull)) : 0ull; }
            __syncthreads();
        } else {
            const int nkb = 2 * nw;
#pragma unroll 1
            for (int sb = 0; sb < 4; ++sb) {
                const int tq = t0 + 8 * sb;
                for (int rs_ = 0; rs_ < REP_SCORE; ++rs_) {
                    bf16x8 aq[4]; float wq[4][4];
#pragma unroll
                    for (int s = 0; s < 4; ++s) aq[s] = *(const bf16x8*)(U + (size_t)(tq + (r32 >> 2)) * NU + C_QI + 64 * (r32 & 3) + 32 * hi + 8 * s);
#pragma unroll
                    for (int i4 = 0; i4 < 4; ++i4) { const f32x4v t4 = *(const f32x4v*)(UF + (size_t)(tq + 2 * i4 + hi) * 32 + 16); wq[i4][0] = t4[0]; wq[i4][1] = t4[1]; wq[i4][2] = t4[2]; wq[i4][3] = t4[3]; }
                    const bf16* kib = KI + (size_t)(b * L) * 64 + (size_t)r32 * 64 + 32 * hi;
                    bf16x8 bk[4], bn[4], bm[4];
#pragma unroll
                    for (int s = 0; s < 4; ++s) { bk[s] = *(const bf16x8*)(kib + (size_t)(32 * w) * 64 + 8 * s); bn[s] = bk[s]; bm[s] = bk[s]; }
                    if (w + NWAVE < nkb) {
#pragma unroll
                        for (int s = 0; s < 4; ++s) bn[s] = *(const bf16x8*)(kib + (size_t)(32 * (w + NWAVE)) * 64 + 8 * s); }
#pragma unroll 1
                    for (int kb = w; kb < nkb; kb += NWAVE) {
                        if (kb + 2 * NWAVE < nkb) {
#pragma unroll
                            for (int s = 0; s < 4; ++s) bm[s] = *(const bf16x8*)(kib + (size_t)(32 * (kb + 2 * NWAVE)) * 64 + 8 * s); }
                        const int key = 32 * kb + r32; f32x16 acc;
#pragma unroll
                        for (int r = 0; r < 16; ++r) acc[r] = 0.f;
#pragma unroll
                        for (int s = 0; s < 4; ++s) acc = MFMA32(aq[s], bk[s], acc);
#pragma unroll
                        for (int i4 = 0; i4 < 4; ++i4) {
                            float s = wq[i4][0] * fmaxf(acc[4 * i4], 0.f) + wq[i4][1] * fmaxf(acc[4 * i4 + 1], 0.f) + wq[i4][2] * fmaxf(acc[4 * i4 + 2], 0.f) + wq[i4][3] * fmaxf(acc[4 * i4 + 3], 0.f);
                            asm("v_add_f32 %0, 0, %0" : "+v"(s));
                            unsigned kv = fkey(s); if (32 * kb + 31 >= nadm) kv = key < nadm ? kv : 0u;
                            SC[(2 * i4 + hi) * DSA_SC_STR + key] = kv;
                        }
#pragma unroll
                        for (int s = 0; s < 4; ++s) { bk[s] = bn[s]; bn[s] = bm[s]; }
                    }
                }
                __syncthreads();
                for (int rs_ = 0; rs_ < REP_SEL; ++rs_) {
                    unsigned kk[65];
#pragma unroll
                    for (int j = 0; j < 65; ++j) kk[j] = 0u;
#define DSA_BUCKETS(F) { F(0, 16) if (nw > 16) { F(16, 32) } if (nw > 32) { F(32, 48) } if (nw > 48) { F(48, 64) } if (nw > 64) { F(64, 65) } }
#define DSA_LOAD(j0, j1) _Pragma("unroll") for (int j = j0; j < j1; ++j) kk[j] = SC[w * DSA_SC_STR + 64 * j + lane];
                    DSA_BUCKETS(DSA_LOAD)
#pragma unroll
                    for (int j = 0; j < 65; ++j) if (j >= 5) kk[j] = j < nw ? kk[j] : 0u;
#define DSA_C4(a, b, c_, d) asm volatile("v_cmp_ge_u32_e64 %1, %5, %9\n\tv_cmp_ge_u32_e64 %2, %6, %9\n\tv_cmp_ge_u32_e64 %3, %7, %9\n\tv_cmp_ge_u32_e64 %4, %8, %9\n\t" \
                        "v_addc_co_u32_e64 %0, vcc, 0, %0, %1\n\tv_addc_co_u32_e64 %0, vcc, 0, %0, %2\n\tv_addc_co_u32_e64 %0, vcc, 0, %0, %3\n\tv_addc_co_u32_e64 %0, vcc, 0, %0, %4" \
                        : "+v"(nl_), "=&s"(m0_), "=&s"(m1_), "=&s"(m2_), "=&s"(m3_) : "v"(a), "v"(b), "v"(c_), "v"(d), "v"(cand_) : "vcc");
#define DSA_CNT16(j0, j1) if (j1 - j0 == 16) { DSA_C4(kk[j0], kk[j0 + 1], kk[j0 + 2], kk[j0 + 3]) DSA_C4(kk[j0 + 4], kk[j0 + 5], kk[j0 + 6], kk[j0 + 7]) DSA_C4(kk[j0 + 8], kk[j0 + 9], kk[j0 + 10], kk[j0 + 11]) DSA_C4(kk[j0 + 12], kk[j0 + 13], kk[j0 + 14], kk[j0 + 15]) } \
                        else { nl_ += kk[64] >= cand_ ? 1 : 0; }
#define DSA_COUNT(CAND, N) { const unsigned cand_ = (CAND); int nl_ = 0; u64 m0_, m1_, m2_, m3_; DSA_BUCKETS(DSA_CNT16) N = 0; \
                        _Pragma("unroll") for (int k_ = 0; k_ < 7; ++k_) N += __popcll(__ballot((nl_ >> k_) & 1)) << k_; }
                    unsigned kmax = 0u;
#define DSA_MAX(j0, j1) _Pragma("unroll") for (int j = j0; j < j1; ++j) kmax = kk[j] > kmax ? kk[j] : kmax;
                    DSA_BUCKETS(DSA_MAX)
#pragma unroll
                    for (int o = 1; o < 64; o <<= 1) { const unsigned t_ = (unsigned)lane_readi((int)kmax, lane ^ o); kmax = t_ > kmax ? t_ : kmax; }
                    kmax = (unsigned)__builtin_amdgcn_readfirstlane((int)kmax);
                    unsigned lo = 0u, hi = (kmax >> 23) + 1u, tau = 0u; int nhi = 0, nlo = -1; bool exact = false;
                    {   unsigned step = 1u;
#pragma unroll 1
                        while (hi - lo > 1u) {
                            const unsigned e = step ? (hi - lo > step ? hi - step : lo + 1u) : lo + ((hi - lo) >> 1);
                            int n; DSA_COUNT(e << 23, n)
                            if (n == TOPK) { exact = true; tau = e << 23; break; }
                            if (n > TOPK) { lo = e; nlo = n; step = 0u; } else { hi = e; nhi = n; if (step) step <<= 1; }
                        }
                    }
                    int need = 0, ntau = -1, wb = 23;
                    if (!exact) {
                        tau = lo << 23; ntau = nlo;
#pragma unroll 1
                        for (int bit = 22; bit >= 20; --bit) {
                            if (ntau >= 0 && ntau - nhi <= 256) break;
                            const unsigned cand = tau | (1u << bit); int n; DSA_COUNT(cand, n)
                            if (n == TOPK) { exact = true; tau = cand; break; }
                            if (n > TOPK) { tau = cand; ntau = n; } else nhi = n;
                            wb = bit; }
                    }
                    if (!exact) {
                        int nin = ntau; if (nin < 0) { DSA_COUNT(tau, nin) }
                        const int nc = nin - nhi, needc = TOPK - nhi;
                        if (nc <= 256) {
                            LAS unsigned* lst = (LAS unsigned*)(c.lds + DSA_LIST_OFF) + w * 256; int base = 0;
#define DSA_COMPACT1(j) { const bool inb = (kk[j] - tau) < (1u << wb); const u64 be = __ballot(inb); \
                                if (be != 0ull) { if (inb) lst[base + __popcll(be & ((1ull << lane) - 1ull))] = kk[j]; base += __popcll(be); } }
#define DSA_COMPACT(j0, j1) if (j1 - j0 == 16) { _Pragma("unroll") for (int j = j0; j < j1; j += 4) { \
                                    const u64 any_ = __ballot((kk[j] - tau) < (1u << wb)) | __ballot((kk[j + 1] - tau) < (1u << wb)) | __ballot((kk[j + 2] - tau) < (1u << wb)) | __ballot((kk[j + 3] - tau) < (1u << wb)); \
                                    if (any_ != 0ull) { DSA_COMPACT1(j) DSA_COMPACT1(j + 1) DSA_COMPACT1(j + 2) DSA_COMPACT1(j + 3) } } }        \
                            else { DSA_COMPACT1(j0) }
                            DSA_BUCKETS(DSA_COMPACT)
                            const unsigned c0 = lane < nc ? lst[lane] : 0u, c1 = lane + 64 < nc ? lst[lane + 64] : 0u, c2 = lane + 128 < nc ? lst[lane + 128] : 0u, c3 = lane + 192 < nc ? lst[lane + 192] : 0u;
#pragma unroll 1
                            for (int bit = wb - 1; bit >= 0; --bit) { const unsigned cand = tau | (1u << bit);
                                const int n = (__popcll(__ballot(c0 >= cand)) + __popcll(__ballot(c1 >= cand))) + (__popcll(__ballot(c2 >= cand)) + __popcll(__ballot(c3 >= cand)));
                                if (n >= needc) tau = cand;
                                if (n == needc) { exact = true; break; } }
                            if (!exact) need = needc - ((__popcll(__ballot(c0 > tau)) + __popcll(__ballot(c1 > tau))) + (__popcll(__ballot(c2 > tau)) + __popcll(__ballot(c3 > tau))));
                        } else {
                            int n1; DSA_COUNT(tau + 1u, n1)
                            if (n1 < TOPK) need = TOPK - n1;
                            else {
#pragma unroll 1
                                for (int bit = wb - 1; bit >= 0; --bit) { const unsigned cand = tau | (1u << bit); int n; DSA_COUNT(cand, n)
                                    if (n >= TOPK) tau = cand;
                                    if (n == TOPK) { exact = true; break; } }
                                if (!exact) { int n; DSA_COUNT(tau + 1u, n) need = TOPK - n; }
                            }
                        }
                    }
                    int run = 0; unsigned mlo = 0u, mhi = 0u; u64 mine1 = 0ull; const unsigned tsel = exact ? tau : tau + 1u;
#define DSA_SEL(j0, j1) _Pragma("unroll") for (int j = j0; j < j1; ++j) { u64 bs = __ballot(kk[j] >= tsel); \
                        if (!exact) { const u64 be = __ballot(kk[j] == tau); \
                            if (be != 0ull) { const int take = need - run; if (take > 0) { const bool eq = kk[j] == tau; const int rank = __popcll(be & ((1ull << lane) - 1ull)); bs |= __ballot(eq && rank < take); } run += __popcll(be); } } \
                        if (j < 64) { WLANE64(mlo, mhi, bs, j); } else mine1 = bs; }
#define DSA_SELX(j0, j1) _Pragma("unroll") for (int j = j0; j < j1; ++j) { const u64 bs = __ballot(kk[j] >= tsel); if (j < 64) { WLANE64(mlo, mhi, bs, j); } else mine1 = bs; }
                    if (exact) { DSA_BUCKETS(DSA_SELX) } else { DSA_BUCKETS(DSA_SEL) }
                    const u64 mine0 = ((u64)mhi << 32) | mlo;
                    MW[(8 * sb + w) * 65 + lane] = lane < nw ? mine0 : 0ull;
                    if (lane == 0) MW[(8 * sb + w) * 65 + 64] = nw > 64 ? mine1 : 0ull;
                }
                __syncthreads();
            }
        }
        for (int ra_ = 0; ra_ < REP_ATT; ++ra_) {
        int w_at = w0; asm volatile("" : "+s"(w_at)); const int w = w_at;
        int lane_at = lane0; asm volatile("" : "+v"(lane_at)); const int lane = lane_at, r32 = lane & 31, hi = lane >> 5, tid = w * 64 + lane;
        const bf16* Cb = CN + (size_t)(b * L) * 128;
        const unsigned ring0 = (unsigned)(size_t)c.lds + DSA_RING_OFF;
#define DSA_SLOT(ti) ((((ti) & 3) == 3) ? (unsigned)(size_t)c.lds : ring0 + (unsigned)((ti) & 3) * 16384u)
#define DSA_DMA(ti) do { const unsigned d_ = (unsigned)__builtin_amdgcn_readfirstlane(DSA_SLOT(ti) + w * 2048); \
            int lq_ = lane0; asm volatile("" : "+v"(lq_)); const int rr0_ = 8 * w + (lq_ >> 4), rr1_ = rr0_ + 4;        \
            fx_glds16(Cb + (size_t)(64 * (ti) + rr0_) * 128 + 8 * ((lq_ & 15) ^ (((rr0_ & 3) << 2) | ((rr0_ >> 2) & 3))), d_); \
            fx_glds16(Cb + (size_t)(64 * (ti) + rr1_) * 128 + 8 * ((lq_ & 15) ^ (((rr1_ & 3) << 2) | ((rr1_ >> 2) & 3))), d_ + 1024); } while (0)
        DSA_DMA(0); if (nw > 1) DSA_DMA(1);
        bf16x8 qf[8];
        {   LAS bf16* QL = (LAS bf16*)c.lds + w * (32 * 136); const bf16* WUKB = (const bf16*)(pt_get(c, 26) + WS_FCUM + 1536 * 1024);
            bf16x8 qd[4];
#pragma unroll
            for (int s = 0; s < 4; ++s) qd[s] = *(const bf16x8*)(U + (size_t)(t0 + r32) * NU + C_DQ + 64 * w + 16 * s + 8 * hi);
#pragma unroll
            for (int rb = 0; rb < 4; ++rb) {
                f32x16 a_;
#pragma unroll
                for (int r = 0; r < 16; ++r) a_[r] = 0.f;
#pragma unroll
                for (int s = 0; s < 4; ++s) a_ = MFMA32(*(const bf16x8*)(WUKB + (size_t)(w * 128 + 32 * rb + r32) * 64 + 16 * s + 8 * hi), qd[s], a_);
#pragma unroll
                for (int i4 = 0; i4 < 4; ++i4) *(LAS u32x2v*)(QL + r32 * 136 + 32 * rb + 8 * i4 + 4 * hi) = (u32x2v){cvtpk(a_[4 * i4], a_[4 * i4 + 1]), cvtpk(a_[4 * i4 + 2], a_[4 * i4 + 3])};
            }
#pragma unroll
            for (int s = 0; s < 8; ++s) qf[s] = *(const LAS bf16x8*)(QL + r32 * 136 + 16 * s + 8 * hi);
            if (r32 >= nq) {
#pragma unroll
                for (int s = 0; s < 8; ++s) qf[s] = (bf16x8){0, 0, 0, 0, 0, 0, 0, 0}; }
        }
        f32x16 o[4];
#pragma unroll
        for (int db = 0; db < 4; ++db)
#pragma unroll
            for (int r = 0; r < 16; ++r) o[db][r] = 0.f;
        float m = -1e4f, l = 0.f;
        unsigned kb0, vb0[2];
        {   int lo_ = lane; asm volatile("" : "+v"(lo_));
            const int r32 = lo_ & 31, hi = lo_ >> 5, lane = lo_;
            const unsigned xr = ((r32 & 3) << 2) | ((r32 >> 2) & 3);
            kb0 = (256u * r32 + 16u * (hi ^ (xr & 1u))) | (16u * (xr & 14u));
            const unsigned blk_ = (lane >> 4) & 1, q_ = (lane & 15) >> 2, p_ = lane & 3;
#pragma unroll
            for (int t = 0; t < 2; ++t) vb0[t] = (256u * (4 * hi + 8 * t + q_) + 16u * ((2 * blk_ + (p_ >> 1)) ^ ((hi + 2 * t) & 3)) + 8u * (p_ & 1)) | (64u * q_);
        }
#define DSA_WAITBAR(t) do { if ((t) + 1 < nw) asm volatile("s_waitcnt vmcnt(2) lgkmcnt(0)\n\ts_barrier" ::: "memory"); else asm volatile("s_waitcnt vmcnt(0) lgkmcnt(0)\n\ts_barrier" ::: "memory"); } while (0)
#define DSA_KRD(dst, s) dst = *(const LAS bf16x8*)((const LAS char*)(size_t)(kbt ^ (32u * (s))))
#define DSA_VRD(lo_, hh_, k) do { lo_ = fx_vtr((const LAS char*)(size_t)(vpt0 ^ (64u * ((k) & 3))) + 4096 * ((k) >> 2)); hh_ = fx_vtr((const LAS char*)(size_t)(vpt1 ^ (64u * ((k) & 3))) + 4096 * ((k) >> 2)); } while (0)
#define DSA_VF(lo_, hh_) __builtin_shufflevector(lo_, hh_, 0, 1, 2, 3, 4, 5, 6, 7)
#define DSA_PVAL(P, i) (P)[i] = __builtin_amdgcn_exp2f((P)[i]); sacc += (P)[i]
#define DSA_INIT(C, r) do { const unsigned s0_ = (unsigned)__builtin_amdgcn_sbfe((int)msk_s, ((r) & 3) + 8 * ((r) >> 2), 1); \
            C[r] = __uint_as_float((negm_b & s0_) | (0xf149f2cau & ~s0_)); } while (0)
#define DSA_DECIDE(C) do { const float rm_ = max3c(mx, fx_swapmax(mx), mx); \
            if (__builtin_expect(__ballot(rm_ > FX_THR) != 0ull, 0)) { const float dl_ = fmaxf(rm_, 0.f), alpha_ = __builtin_amdgcn_exp2f(-dl_); m += dl_; l *= alpha_; \
                _Pragma("unroll") for (int r = 0; r < 16; ++r) C[r] -= dl_; \
                _Pragma("unroll") for (int db = 0; db < 4; ++db) _Pragma("unroll") for (int r = 0; r < 16; ++r) o[db][r] *= alpha_; } } while (0)
#define DSA_GA(C, P, s, f) { \
            C = MFMA32(f, qf[s], C); DSA_PVAL(P, 2 * (s)); DSA_PVAL(P, 2 * (s) + 1); \
            if ((s) < 4) { pwa[(s) & 3] = cvtpk((P)[2 * (s)], (P)[2 * (s) + 1]); FX_PIN(pwa); } else { pwb[(s) & 3] = cvtpk((P)[2 * (s)], (P)[2 * (s) + 1]); FX_PIN(pwb); } FX_PIN(sacc); FX_SBAR(); \
            if ((s) + 2 < 8) { DSA_KRD(f, (s) + 2); FX_SBAR(); } }
#define DSA_GB(C, k, f0, f1, n0, n1) { \
            if ((k) + 1 < 8) { DSA_VRD(n0, n1, 4 * ksb + (k) + 1); FX_SBAR(); } \
            o[(k) & 3] = MFMA32(DSA_VF(f0, f1), __builtin_bit_cast(bf16x8, (k) < 4 ? pwa : pwb), o[(k) & 3]); \
            mx = max3c(mx, C[2 * (k)], C[2 * (k) + 1]); FX_PIN(mx); FX_SBAR(); }
#define DSA_HSTEP(C, P, t, hf, tp) do { \
            const unsigned kbt = DSA_SLOT(t) + kb0 + 8192u * (hf), vpt0 = DSA_SLOT(tp) + vb0[0], vpt1 = DSA_SLOT(tp) + vb0[1]; constexpr int ksb = 2 * (1 - (hf)); \
            const u64 m64 = MW[r32 * 65 + (t)]; const unsigned msk_s = (unsigned)((hf) ? (m64 >> 32) : m64) >> (4 * hi); \
            bf16x8 ka, kc; float sacc = 0.f, mx = -1e30f; u32x4v pwa, pwb; fx_s16x4 va0, va1, vb0_, vb1_; \
            DSA_KRD(ka, 0); DSA_KRD(kc, 1); FX_SBAR(); \
            { const unsigned negm_b = __float_as_uint(-m); _Pragma("unroll") for (int r = 0; r < 16; ++r) DSA_INIT(C, r); } \
            DSA_GA(C, P, 0, ka) DSA_GA(C, P, 1, kc) DSA_GA(C, P, 2, ka) DSA_GA(C, P, 3, kc) DSA_GA(C, P, 4, ka) DSA_GA(C, P, 5, kc) DSA_GA(C, P, 6, ka) DSA_GA(C, P, 7, kc) \
            l += sacc; \
            DSA_VRD(va0, va1, 4 * ksb); FX_SBAR(); \
            DSA_GB(C, 0, va0, va1, vb0_, vb1_) DSA_GB(C, 1, vb0_, vb1_, va0, va1) DSA_GB(C, 2, va0, va1, vb0_, vb1_) DSA_GB(C, 3, vb0_, vb1_, va0, va1) \
            DSA_GB(C, 4, va0, va1, vb0_, vb1_) DSA_GB(C, 5, vb0_, vb1_, va0, va1) DSA_GB(C, 6, va0, va1, vb0_, vb1_) DSA_GB(C, 7, vb0_, vb1_, va0, va1) \
            DSA_DECIDE(C); } while (0)
        f32x16 pA, pB;
        DSA_WAITBAR(0); if (2 < nw) DSA_DMA(2);
        {   const unsigned kbt = DSA_SLOT(0) + kb0; const u64 m64 = MW[r32 * 65]; const unsigned msk_s = (unsigned)m64 >> (4 * hi), negm_b = 0u; float mx = -1e30f;
#pragma unroll
            for (int r = 0; r < 16; ++r) DSA_INIT(pA, r);
#pragma unroll
            for (int s = 0; s < 8; ++s) { bf16x8 kf_; DSA_KRD(kf_, s); pA = MFMA32(kf_, qf[s], pA); }
#pragma unroll
            for (int r = 0; r < 16; ++r) mx = max3c(mx, pA[r], pA[r]);
            m = max3c(mx, fx_swapmax(mx), -1e4f);
#pragma unroll
            for (int r = 0; r < 16; ++r) pA[r] -= m;
        }
        DSA_HSTEP(pB, pA, 0, 1, 0);
        for (int t = 1; t < nw; ++t) {
            DSA_WAITBAR(t); if (t + 2 < nw) DSA_DMA(t + 2);
            DSA_HSTEP(pA, pB, t, 0, t - 1);
            DSA_HSTEP(pB, pA, t, 1, t);
        }
        {   float sacc = 0.f;
#pragma unroll
            for (int r = 0; r < 16; ++r) { DSA_PVAL(pB, r); }
            l += sacc;
            const unsigned vpt0 = DSA_SLOT(nw - 1) + vb0[0], vpt1 = DSA_SLOT(nw - 1) + vb0[1];
#pragma unroll
            for (int s = 0; s < 2; ++s) { const bf16x8 x1 = pack8(pB, s);
#pragma unroll
                for (int db = 0; db < 4; ++db) { fx_s16x4 a_, b_; DSA_VRD(a_, b_, 4 * (2 + s) + db); o[db] = MFMA32(DSA_VF(a_, b_), x1, o[db]); } }
        }
        __syncthreads();
        l += lane_read(l, lane ^ 32);
        {
            const float inv = 1.f / l; f32x16 yd0, yd1; const bf16* WUVT = (const bf16*)(pt_get(c, 26) + WS_FCUM + 1792 * 1024);
#pragma unroll
            for (int r = 0; r < 16; ++r) { yd0[r] = 0.f; yd1[r] = 0.f; }
            typedef short s16x4v __attribute__((ext_vector_type(4)));
#pragma unroll
            for (int db = 0; db < 4; ++db) {
#pragma unroll
                for (int r = 0; r < 16; ++r) o[db][r] *= inv;
#pragma unroll
                for (int t = 0; t < 2; ++t) {
                    const bf16x8 xs = pack8(o[db], t);
                    const bf16* wp = WUVT + (size_t)(w * 64 + r32) * 128 + 32 * db + 16 * t + 4 * hi;
                    const s16x4v l0 = *(const s16x4v*)wp, h0 = *(const s16x4v*)(wp + 8), l1 = *(const s16x4v*)(wp + 32 * 128), h1 = *(const s16x4v*)(wp + 32 * 128 + 8);
                    yd0 = MFMA32(__builtin_shufflevector(l0, h0, 0, 1, 2, 3, 4, 5, 6, 7), xs, yd0); yd1 = MFMA32(__builtin_shufflevector(l1, h1, 0, 1, 2, 3, 4, 5, 6, 7), xs, yd1);
                }
            }
            if (r32 < nq) { bf16* yr = (bf16*)(pt_get(c, 26) + WS_Y) + (size_t)(t0 + r32) * KOUT + 1536 + 64 * w;
#pragma unroll
                for (int i4 = 0; i4 < 4; ++i4) {
                    *(u32x2v*)(yr + 8 * i4 + 4 * hi) = (u32x2v){cvtpk(yd0[4 * i4], yd0[4 * i4 + 1]), cvtpk(yd0[4 * i4 + 2], yd0[4 * i4 + 3])};
                    *(u32x2v*)(yr + 32 + 8 * i4 + 4 * hi) = (u32x2v){cvtpk(yd1[4 * i4], yd1[4 * i4 + 1]), cvtpk(yd1[4 * i4 + 2], yd1[4 * i4 + 3])}; }
            }
        }
        }
    }
}

__device__ __forceinline__ float wave_scan_incl(float v, int lane) {
#pragma unroll
    for (int o = 1; o < 64; o <<= 1) { const float n = lane_read(v, (lane - o) & 63); if (lane >= o) v += n; }
    return v;
}
__device__ __forceinline__ void ph_ssd_states(const Ctx& c0, const bf16* XC, const float* DT, const float* a_log, bf16* ST, float* CD) {
    const Ctx c = refresh(c0);
    const int lane = c.lane, w = c.wave, r32 = lane & 31, hi = lane >> 5, g = w >> 2;
    LAS bf16* XT = (LAS bf16*)c.lds + w * (64 * 72);
    LAS bf16* BT = (LAS bf16*)(c.lds + 73728);
    const float a_neg = -__expf(a_log[w]);
    for (int it = c.bid; it < NB * 65; it += c.nb) {
        const int b = it < 512 ? it >> 6 : it - 512, ch = it < 512 ? 1 + (it & 63) : 0, pseq = 64 * ch - 48 + lane;
        const bool valid = pseq >= 0; const size_t t = (size_t)(b * L + (valid ? pseq : 0));
        const float dtv = valid ? DT[t * 8 + w] : 0.f, acs = wave_scan_incl(dtv * a_neg, lane), tot = lane_read(acs, 63), scale = dtv * __expf(tot - acs);
        if (lane == 0) CD[(b * 65 + ch) * 8 + w] = __expf(tot);
        const bf16* xrow = XC + t * 1024 + 64 * w;
#pragma unroll
        for (int q = 0; q < 8; ++q) { u32x4v v = (u32x4v){0u, 0u, 0u, 0u}; if (valid) v = *(const u32x4v*)(xrow + 8 * q); const unsigned vv[4] = {v.x, v.y, v.z, v.w};
#pragma unroll
            for (int e = 0; e < 8; ++e) XT[(8 * q + e) * 72 + lane] = f2bf(bf2f((bf16)(vv[e >> 1] >> (16 * (e & 1)))) * scale); }
        const bf16* brow = XC + t * 1024 + 512 + 32 * w;
#pragma unroll
        for (int q = 0; q < 4; ++q) { u32x4v v = (u32x4v){0u, 0u, 0u, 0u}; if (valid) v = *(const u32x4v*)(brow + 8 * q); const unsigned vv[4] = {v.x, v.y, v.z, v.w};
#pragma unroll
            for (int e = 0; e < 8; ++e) BT[(32 * w + 8 * q + e) * 72 + lane] = (bf16)(vv[e >> 1] >> (16 * (e & 1))); }
        __syncthreads();
        bf16* st = ST + ((size_t)(b * 65 + ch) * 8 + w) * 8192;
#pragma unroll 1
        for (int pb = 0; pb < 2; ++pb)
#pragma unroll 1
            for (int nb = 0; nb < 4; ++nb) {
                f32x16 acc;
#pragma unroll
                for (int r = 0; r < 16; ++r) acc[r] = 0.f;
#pragma unroll
                for (int s = 0; s < 4; ++s) { const bf16x8 a = *(const LAS bf16x8*)(XT + (32 * pb + r32) * 72 + 16 * s + 8 * hi), bb = *(const LAS bf16x8*)(BT + (128 * g + 32 * nb + r32) * 72 + 16 * s + 8 * hi);
                    acc = MFMA32(a, bb, acc); }
#pragma unroll
                for (int r = 0; r < 16; ++r) st[(32 * pb + crow(r, hi)) * 128 + 32 * nb + r32] = f2bf(acc[r]);
            }
        __syncthreads();
    }
}
__device__ __forceinline__ void ph_ssd_scan(const Ctx& c0, bf16* ST, const float* CD) {
    const Ctx c = refresh(c0);
    for (int idx = c.bid * NTHR + c.tid; idx < NB * 8 * 64 * 32; idx += c.nb * NTHR) {
        const int n4 = idx & 31, p = (idx >> 5) & 63, h = (idx >> 11) & 7, b = idx >> 14;
        float h0 = 0.f, h1 = 0.f, h2 = 0.f, h3 = 0.f;
        bf16* base = ST + ((size_t)(b * 65) * 8 + h) * 8192 + p * 128 + 4 * n4; const float* cd = CD + (size_t)(b * 65) * 8 + h;
#pragma unroll 1
        for (int c5 = 0; c5 < 65; c5 += 5) {
            u32x2v v[5]; float d[5];
#pragma unroll
            for (int q = 0; q < 5; ++q) { v[q] = *(const u32x2v*)(base + (size_t)(c5 + q) * 8 * 8192); d[q] = cd[(c5 + q) * 8]; }
#pragma unroll
            for (int q = 0; q < 5; ++q) {
                *(u32x2v*)(base + (size_t)(c5 + q) * 8 * 8192) = (u32x2v){pk2(h0, h1), pk2(h2, h3)};
                h0 = d[q] * h0 + bf2f((bf16)(v[q].x & 0xffff)); h1 = d[q] * h1 + bf2f((bf16)(v[q].x >> 16)); h2 = d[q] * h2 + bf2f((bf16)(v[q].y & 0xffff)); h3 = d[q] * h3 + bf2f((bf16)(v[q].y >> 16)); }
        }
    }
}
__device__ __forceinline__ void ph_ssd_out(const Ctx& c0, const bf16* XC, const bf16* U, const float* DT, const float* a_log, const float* dsk, const bf16* ST, bf16* Y) {
    const Ctx c = refresh(c0);
    const int lane = c.lane, w = c.wave, r32 = lane & 31, hi = lane >> 5, g = w >> 2;
    LAS bf16* XT = (LAS bf16*)c.lds + w * (64 * 72);
    LAS float* ACS = (LAS float*)(c.lds + 73728) + w * 64;
    LAS float* SS = (LAS float*)(c.lds + 73728 + 2048);
    const float a_neg = -__expf(a_log[w]), Dk = dsk[w];
    typedef short s16x4v __attribute__((ext_vector_type(4)));
    for (int it = c.bid; it < NB * 65; it += c.nb) {
        const int b = it < 512 ? it >> 6 : it - 512, ch = it < 512 ? 1 + (it & 63) : 0, p0 = 64 * ch - 48, pseq = p0 + lane; const bool valid = pseq >= 0; const size_t t = (size_t)(b * L + (valid ? pseq : 0));
        const float dtv = valid ? DT[t * 8 + w] : 0.f, acs = wave_scan_incl(dtv * a_neg, lane);
        ACS[lane] = acs;
        {   const bf16* xrow = XC + t * 1024 + 64 * w;
#pragma unroll
            for (int q = 0; q < 8; ++q) { u32x4v v = (u32x4v){0u, 0u, 0u, 0u}; if (valid) v = *(const u32x4v*)(xrow + 8 * q); const unsigned vv[4] = {v.x, v.y, v.z, v.w};
#pragma unroll
                for (int e = 0; e < 8; ++e) XT[(8 * q + e) * 72 + lane] = f2bf(bf2f((bf16)(vv[e >> 1] >> (16 * (e & 1)))) * dtv); } }
        const bool vl0 = p0 + r32 >= 0, vl1 = p0 + 32 + r32 >= 0;
        const size_t tl0 = (size_t)(b * L + (vl0 ? p0 + r32 : 0)), tl1 = (size_t)(b * L + (vl1 ? p0 + 32 + r32 : 0));
        f32x16 acc[2][2];
#pragma unroll
        for (int pb = 0; pb < 2; ++pb)
#pragma unroll
            for (int lb = 0; lb < 2; ++lb)
#pragma unroll
                for (int r = 0; r < 16; ++r) acc[pb][lb][r] = 0.f;
        const bf16* hin = ST + ((size_t)(b * 65 + ch) * 8 + w) * 8192;
        if (ch != 0) {
#pragma unroll
        for (int k = 0; k < 8; ++k) {
            bf16x8 c0f = (bf16x8){0, 0, 0, 0, 0, 0, 0, 0}, c1f = c0f;
            if (vl0) c0f = *(const bf16x8*)(XC + tl0 * 1024 + 768 + 128 * g + 16 * k + 8 * hi);
            if (vl1) c1f = *(const bf16x8*)(XC + tl1 * 1024 + 768 + 128 * g + 16 * k + 8 * hi);
            const bf16x8 h0f = *(const bf16x8*)(hin + (size_t)r32 * 128 + 16 * k + 8 * hi), h1f = *(const bf16x8*)(hin + (size_t)(32 + r32) * 128 + 16 * k + 8 * hi);
            acc[0][0] = MFMA32(h0f, c0f, acc[0][0]); acc[0][1] = MFMA32(h0f, c1f, acc[0][1]); acc[1][0] = MFMA32(h1f, c0f, acc[1][0]); acc[1][1] = MFMA32(h1f, c1f, acc[1][1]);
        }
        }
        const float acl0 = ACS[r32], acl1 = ACS[32 + r32], e0 = __expf(acl0), e1 = __expf(acl1);
#pragma unroll
        for (int pb = 0; pb < 2; ++pb)
#pragma unroll
            for (int r = 0; r < 16; ++r) { acc[pb][0][r] *= e0; acc[pb][1][r] *= e1; }
#pragma unroll
        for (int sb = 0; sb < 2; ++sb)
#pragma unroll
            for (int lb = sb; lb < 2; ++lb) if (!(ch == 0 && sb == 0)) {
                f32x16 x;
#pragma unroll
                for (int r = 0; r < 16; ++r) x[r] = 0.f;
                const bool vs = p0 + 32 * sb + r32 >= 0; const size_t ts = (size_t)(b * L + (vs ? p0 + 32 * sb + r32 : 0));
                const bool vl = lb == 0 ? vl0 : vl1; const size_t tl = lb == 0 ? tl0 : tl1;
#pragma unroll
                for (int k = 0; k < 8; ++k) {
                    bf16x8 bf_ = (bf16x8){0, 0, 0, 0, 0, 0, 0, 0}, cf_ = bf_;
                    if (vs) bf_ = *(const bf16x8*)(XC + ts * 1024 + 512 + 128 * g + 16 * k + 8 * hi);
                    if (vl) cf_ = *(const bf16x8*)(XC + tl * 1024 + 768 + 128 * g + 16 * k + 8 * hi);
                    x = MFMA32(bf_, cf_, x);
                }
                const float acl = lb == 0 ? acl0 : acl1; const int lrow = 32 * lb + r32;
#pragma unroll
                for (int i4 = 0; i4 < 4; ++i4) { const f32x4v as = *(const LAS f32x4v*)(ACS + 32 * sb + 8 * i4 + 4 * hi);
#pragma unroll
                    for (int e = 0; e < 4; ++e) { const int srow = 32 * sb + 8 * i4 + 4 * hi + e; x[4 * i4 + e] = srow <= lrow ? x[4 * i4 + e] * __expf(fminf(acl - as[e], 0.f)) : 0.f; } }
#pragma unroll
                for (int ks = 0; ks < 2; ++ks) {
                    const bf16x8 xs = pack8(x, ks);
#pragma unroll
                    for (int pb = 0; pb < 2; ++pb) {
                        const LAS bf16* vp = XT + (32 * pb + r32) * 72 + 32 * sb + 16 * ks + 4 * hi;
                        const s16x4v lo = *(const LAS s16x4v*)vp, hh = *(const LAS s16x4v*)(vp + 8);
                        const bf16x8 pa = __builtin_shufflevector(lo, hh, 0, 1, 2, 3, 4, 5, 6, 7);
                        if (lb == 0) acc[pb][0] = MFMA32(pa, xs, acc[pb][0]); else acc[pb][1] = MFMA32(pa, xs, acc[pb][1]);
                    }
                }
            }
        float ssq0 = 0.f, ssq1 = 0.f;
#pragma unroll
        for (int lb = 0; lb < 2; ++lb) { const bool vl = lb == 0 ? vl0 : vl1; const size_t tl = lb == 0 ? tl0 : tl1;
#pragma unroll
            for (int pb = 0; pb < 2; ++pb)
#pragma unroll
                for (int i4 = 0; i4 < 4; ++i4) { const int pc = 64 * w + 32 * pb + 8 * i4 + 4 * hi;
                    u32x2v xv = (u32x2v){0u, 0u}, zv = xv;
                    if (vl) { xv = *(const u32x2v*)(XC + tl * 1024 + pc); zv = *(const u32x2v*)(U + tl * NU + C_Z + pc); }
                    const float xe[4] = {bf2f((bf16)(xv.x & 0xffff)), bf2f((bf16)(xv.x >> 16)), bf2f((bf16)(xv.y & 0xffff)), bf2f((bf16)(xv.y >> 16))};
                    const float ze[4] = {bf2f((bf16)(zv.x & 0xffff)), bf2f((bf16)(zv.x >> 16)), bf2f((bf16)(zv.y & 0xffff)), bf2f((bf16)(zv.y >> 16))};
#pragma unroll
                    for (int e = 0; e < 4; ++e) { const float y = acc[pb][lb][4 * i4 + e] + Dk * xe[e], gz = y * siluf(ze[e]); acc[pb][lb][4 * i4 + e] = gz; if (lb == 0) ssq0 += gz * gz; else ssq1 += gz * gz; } } }
        ssq0 += lane_read(ssq0, lane ^ 32); ssq1 += lane_read(ssq1, lane ^ 32);
        if (hi == 0) { SS[w * 64 + r32] = ssq0; SS[w * 64 + 32 + r32] = ssq1; }
        __syncthreads();
        const float tot0 = SS[(4 * g) * 64 + r32] + SS[(4 * g + 1) * 64 + r32] + SS[(4 * g + 2) * 64 + r32] + SS[(4 * g + 3) * 64 + r32];
        const float tot1 = SS[(4 * g) * 64 + 32 + r32] + SS[(4 * g + 1) * 64 + 32 + r32] + SS[(4 * g + 2) * 64 + 32 + r32] + SS[(4 * g + 3) * 64 + 32 + r32];
        const float rs0 = rsqrtf(tot0 * (1.f / 256.f) + EPSF), rs1 = rsqrtf(tot1 * (1.f / 256.f) + EPSF);
#pragma unroll
        for (int lb = 0; lb < 2; ++lb) { const bool vl = lb == 0 ? vl0 : vl1; const size_t tl = lb == 0 ? tl0 : tl1; const float rs = lb == 0 ? rs0 : rs1;
            if (vl) {
#pragma unroll
                for (int pb = 0; pb < 2; ++pb)
#pragma unroll
                    for (int i4 = 0; i4 < 4; ++i4)
                        *(u32x2v*)(Y + tl * KOUT + 64 * w + 32 * pb + 8 * i4 + 4 * hi) = (u32x2v){cvtpk(acc[pb][lb][4 * i4] * rs, acc[pb][lb][4 * i4 + 1] * rs), cvtpk(acc[pb][lb][4 * i4 + 2] * rs, acc[pb][lb][4 * i4 + 3] * rs)};
            } }
        __syncthreads();
    }
}

__device__ __forceinline__ void ph_resid(const Ctx& c0, const bf16* MIX, const float* g, bf16* XB, float* RSTD, float* dout, const float* SSslot = nullptr) { const Ctx c = refresh(c0);
    const int lane = c.lane;
    if (SSslot) {
        for (int idx = c.bid * NTHR + c.tid; idx < 128 * 256; idx += c.nb * NTHR) { const float* q = SSslot + (size_t)idx * 8; float sm = 0.f;
#pragma unroll
            for (int k = 0; k < 8; ++k) sm += q[k];
            RSTD[pg8::tile_row0(1, idx >> 8) + (idx & 255)] = rsqrtf(sm * (1.f / DM) + EPSF); } }
    const bool reord = c.ngw == 2048;
    for (int it = SSslot ? 16 : 0; it < (reord ? 17 : (T + c.ngw - 1) / c.ngw); ++it) {
        int t;
        if (reord) {
            if (it < 16) { const int q = 3 - (it >> 2), j = it & 3, i8 = c.gw >> 8; t = (2 * j + (i8 >> 2)) * L + 16 + 256 * (4 * q + (i8 & 3)) + (c.gw & 255); }
            else { if (c.gw >= 128) break; t = (c.gw >> 4) * L + (c.gw & 15); }
        } else { t = c.gw + it * c.ngw; if (t >= T) break; }
        float mv[32], xv[32]; float ss = 0.f;
#pragma unroll
        for (int j = 0; j < 4; ++j) { const u32x4v v = *(const u32x4v*)(MIX + (size_t)t * DM + 8 * lane + 512 * j), xx = *(const u32x4v*)(XB + (size_t)t * DM + 8 * lane + 512 * j);
            const unsigned w[4] = {v.x, v.y, v.z, v.w}, xw[4] = {xx.x, xx.y, xx.z, xx.w};
#pragma unroll
            for (int i = 0; i < 8; ++i) { const float f = bf2f((bf16)(w[i >> 1] >> (16 * (i & 1)))); mv[8 * j + i] = f; ss += f * f; xv[8 * j + i] = bf2f((bf16)(xw[i >> 1] >> (16 * (i & 1)))); } }
        const float rs = rsqrtf(wave_sum(ss, lane) * (1.f / DM) + EPSF);
        float s2 = 0.f;
        const int b = t / L, p = t - b * L; float* orow = (dout != nullptr && p >= NMETA) ? dout + ((size_t)b * SEQ + (p - NMETA)) * DM : nullptr;
#pragma unroll
        for (int j = 0; j < 4; ++j) { const int cc = 8 * lane + 512 * j;
            const f32x4v ga = *(const f32x4v*)(g + cc), gb = *(const f32x4v*)(g + cc + 4); float a[8];
#pragma unroll
            for (int i = 0; i < 4; ++i) { a[i] = xv[8 * j + i] + mv[8 * j + i] * rs * ga[i]; a[4 + i] = xv[8 * j + 4 + i] + mv[8 * j + 4 + i] * rs * gb[i]; }
#pragma unroll
            for (int i = 0; i < 8; ++i) s2 += a[i] * a[i];
            if (orow) { *(f32x4v*)(orow + cc) = (f32x4v){a[0], a[1], a[2], a[3]}; *(f32x4v*)(orow + cc + 4) = (f32x4v){a[4], a[5], a[6], a[7]}; }
            *(u32x4v*)(XB + (size_t)t * DM + cc) = (u32x4v){pk2(a[0], a[1]), pk2(a[2], a[3]), pk2(a[4], a[5]), pk2(a[6], a[7])}; }
        s2 = wave_sum(s2, lane);
        if (lane == 0) RSTD[t] = rsqrtf(s2 * (1.f / DM) + EPSF);
    }
}

__device__ __forceinline__ void gemm_meta_rows(const Ctx& c, const bf16* A, const bf16* Bt, bf16* O, int N, int K, int ldc, const float* rs, float* UF, float* O32 = nullptr) {
    const int lane = c.lane, r32 = lane & 31, hi = lane >> 5, w = c.wave;
    LAS float* red = (LAS float*)c.lds;
    for (int strip = c.bid; strip < N / 32; strip += c.nb) {
        const bf16* ap = A + (size_t)(r32 & 15) * K + 8 * hi; const bf16* bp = Bt + (size_t)(32 * strip + r32) * K + 8 * hi;
        f32x16 acc;
#pragma unroll
        for (int r = 0; r < 16; ++r) acc[r] = 0.f;
#pragma unroll 1
        for (int s0 = w; s0 < K / 16; s0 += 16 * NWAVE) {
            bf16x8 fa[16], fb[16];
#pragma unroll
            for (int u = 0; u < 16; ++u) { const int s = s0 + u * NWAVE; const bool ok = s < K / 16; const int sc = ok ? s : w;
                fa[u] = *(const bf16x8*)(ap + 16 * sc); fb[u] = *(const bf16x8*)(bp + 16 * sc); if (!ok) fa[u] = (bf16x8){0, 0, 0, 0, 0, 0, 0, 0}; }
#pragma unroll
            for (int u = 0; u < 16; ++u) acc = MFMA32(fa[u], fb[u], acc);
        }
#pragma unroll
        for (int r = 0; r < 8; ++r) red[(w * 8 + r) * 64 + lane] = acc[r];
        __syncthreads();
        if (w == 0) {
            float v8[8];
#pragma unroll
            for (int r = 0; r < 8; ++r) { float t = 0.f;
#pragma unroll
                for (int ww = 0; ww < NWAVE; ++ww) t += red[(ww * 8 + r) * 64 + lane];
                v8[r] = t * (rs ? rs[crow(r, hi)] : 1.f); }
            const int n = 32 * strip + r32; const bool sm = UF != nullptr && n >= C_SM && n < C_SM + 32;
            if (O32) {
#pragma unroll
                for (int r = 0; r < 8; ++r) O32[(size_t)crow(r, hi) * N + n] = v8[r];
            } else
#pragma unroll 1
            for (int b = 0; b < NB; ++b) {
                bf16* ob = O + (size_t)(b * L) * ldc + n; float* ub = UF + (size_t)(b * L) * 32 + (n - C_SM);
#pragma unroll
                for (int r = 0; r < 8; ++r) { const int p = crow(r, hi); ob[(size_t)p * ldc] = f2bf(v8[r]); if (sm) ub[(size_t)p * 32] = v8[r]; }
            }
        }
        __syncthreads();
    }
}
__device__ __forceinline__ void ph_gemm_plain(const Ctx& c0, const bf16* A, const bf16* Bt, bf16* O, int N, int K, int ldc, const float* rs, float* UF, int wgm) { const Ctx c = refresh(c0);
    gemm_meta_rows(c, A, Bt, O, N, K, ldc, rs, UF);
    pg8::StaticOrder S; S.init(128 * 256, N, c.nb, c.bid, wgm);
    pg8::Gemm g{A, Bt, 128 * 256, N, K, (size_t)256 * K * 2, 1};
    pg8::EpiBf16Plain E{O, ldc, rs, UF, C_SM, 1};
    pg8::gemm_phase<pg8::EpiBf16Plain, pg8::StaticOrder, true, true>(c.lds, g, S, E, c.tid);
}
__device__ __forceinline__ void ph_gemm_resid(const Ctx& c0, const bf16* A, const bf16* Bt, bf16* O, int K, bf16* XB, const float* g, float* dout, float* PS, float* SS, unsigned* cnt) { const Ctx c = refresh(c0);
    gemm_meta_rows(c, A, Bt, O, DM, K, DM, nullptr, nullptr);
    pg8::StaticOrder S; S.init(128 * 256, DM, c.nb, c.bid, 4);
    pg8::Gemm g_{A, Bt, 128 * 256, DM, K, (size_t)256 * K * 2, 1};
    pg8::EpiResid E{XB, g, dout, PS, SS, cnt, (LAS float*)(c.lds + HALO_OFF)};
    pg8::gemm_phase<pg8::EpiResid, pg8::StaticOrder, true, true>(c.lds, g_, S, E, c.tid);
}
__device__ __forceinline__ void ph_gemm_gateup(const Ctx& c0, const bf16* XB, const bf16* Bt, bf16* H, const float* rs, const float* cw, const float* cb, float* FXG, float* FXU, float* HB, float* GUM) { const Ctx c = refresh(c0);
    gemm_meta_rows(c, XB, Bt, nullptr, NGU, DM, 0, rs, nullptr, GUM);
    pg8::StaticOrder S; S.init(128 * 256, NGU, c.nb, c.bid, WGM_GU);
    pg8::Gemm g{XB, Bt, 128 * 256, NGU, DM, (size_t)256 * DM * 2, 1};
    pg8::EpiGateUp E{H, rs, cw, cb, (LAS float*)(c.lds + HALO_OFF), FXG, FXU, HB};
    pg8::gemm_phase<pg8::EpiGateUp, pg8::StaticOrder, true, true>(c.lds, g, S, E, c.tid);
}
__device__ __forceinline__ void ph_ffn_fixup(const Ctx& c0, bf16* H, const float* cw, const float* cb, const float* FXG, const float* FXU, const float* HB, const float* GUM) { const Ctx c = refresh(c0);
    const int gt = c.bid * NTHR + c.tid, ngt = c.nb * NTHR;
    for (int idx = gt; idx < 128 * (FF / 4); idx += ngt) {
        const int pm = idx / (FF / 4), ch = (idx - pm * (FF / 4)) * 4, pn = ch >> 7, cl = ch & 127;
        const f32x4v g0 = *(const f32x4v*)(FXG + ((size_t)pm * 2) * FF + ch), g1 = *(const f32x4v*)(FXG + ((size_t)pm * 2 + 1) * FF + ch);
        const f32x4v u0 = *(const f32x4v*)(FXU + ((size_t)pm * 2) * FF + ch), u1 = *(const f32x4v*)(FXU + ((size_t)pm * 2 + 1) * FF + ch);
        f32x4v hm2, hm1;
        if ((pm & 15) == 0) { hm2 = *(const f32x4v*)(GUM + (size_t)14 * NGU + 256 * pn + cl); hm1 = *(const f32x4v*)(GUM + (size_t)15 * NGU + 256 * pn + cl); }
        else { hm2 = *(const f32x4v*)(HB + ((size_t)(pm - 1) * 2) * FF + ch); hm1 = *(const f32x4v*)(HB + ((size_t)(pm - 1) * 2 + 1) * FF + ch); }
        const f32x4v w0 = *(const f32x4v*)(cw + ch), w1 = *(const f32x4v*)(cw + FF + ch), w2 = *(const f32x4v*)(cw + 2 * FF + ch), bb = *(const f32x4v*)(cb + ch);
        const f32x4v c0v = bb + w2 * g0 + w1 * hm1 + w0 * hm2, c1v = bb + w2 * g1 + w1 * g0 + w0 * hm1;
        const size_t row = (size_t)pg8::tile_row0(1, pm);
        *(u32x2v*)(H + row * FF + ch) = (u32x2v){pk2(siluf(c0v[0]) * u0[0], siluf(c0v[1]) * u0[1]), pk2(siluf(c0v[2]) * u0[2], siluf(c0v[3]) * u0[3])};
        *(u32x2v*)(H + (row + 1) * FF + ch) = (u32x2v){pk2(siluf(c1v[0]) * u1[0], siluf(c1v[1]) * u1[1]), pk2(siluf(c1v[2]) * u1[2], siluf(c1v[3]) * u1[3])};
    }
    for (int idx = gt; idx < 16 * (FF / 4); idx += ngt) {
        const int p = idx / (FF / 4), ch = (idx - p * (FF / 4)) * 4, pn = ch >> 7, cl = ch & 127;
        const float* gr = GUM + (size_t)p * NGU + 256 * pn + cl;
        const f32x4v g = *(const f32x4v*)gr, up = *(const f32x4v*)(gr + 128);
        f32x4v gm1 = (f32x4v){0.f, 0.f, 0.f, 0.f}, gm2 = gm1;
        if (p >= 1) gm1 = *(const f32x4v*)(gr - NGU);
        if (p >= 2) gm2 = *(const f32x4v*)(gr - 2 * NGU);
        const f32x4v w0 = *(const f32x4v*)(cw + ch), w1 = *(const f32x4v*)(cw + FF + ch), w2 = *(const f32x4v*)(cw + 2 * FF + ch), bb = *(const f32x4v*)(cb + ch);
        const f32x4v cv = bb + w2 * g + w1 * gm1 + w0 * gm2;
        const u32x2v o = (u32x2v){pk2(siluf(cv[0]) * up[0], siluf(cv[1]) * up[1]), pk2(siluf(cv[2]) * up[2], siluf(cv[3]) * up[3])};
#pragma unroll
        for (int b = 0; b < NB; ++b) *(u32x2v*)(H + (size_t)(b * L + p) * FF + ch) = o;
    }
}

constexpr int REP_PREPW = 1, REP_G1 = 1, REP_G2 = 1, REP_G3 = 1, REP_G4 = 1, REP_M1 = 1, REP_SSD = 1, REP_FOX = 1, REP_DSA = 1;
__global__ void __launch_bounds__(NTHR, 2) fwd_mega(Args A) {
    extern __shared__ __attribute__((aligned(16))) unsigned char lds_raw[];
    cg::grid_group grid = cg::this_grid();
    Ctx c; c.tid = threadIdx.x; c.lane = c.tid & 63; c.wave = __builtin_amdgcn_readfirstlane(c.tid >> 6); c.bid = blockIdx.x; c.nb = gridDim.x;
    c.gw = c.bid * NWAVE + c.wave; c.ngw = c.nb * NWAVE; c.lds = (LAS unsigned char*)lds_raw;
    if (c.tid == 0) { LAS unsigned long long* PT = (LAS unsigned long long*)(c.lds + PT_OFF);
#pragma unroll
        for (int i = 0; i < 25; ++i) PT[i] = (unsigned long long)A.in[i];
        PT[25] = (unsigned long long)A.out; PT[26] = (unsigned long long)A.ws; }
    if (c.tid < 2) ((LAS unsigned*)(c.lds + MISC_OFF))[c.tid] = 0u;
    __syncthreads();
    (void)xcd_barrier_post((unsigned*)(A.ws + WS_CTL) + CW_BAR, (volatile LAS unsigned*)(c.lds + MISC_OFF), c.tid);
#define WSP(off) (pt_get(c, 26) + (off))
#define DOUT ((float*)pt_get(c, 25))
#define P_WIN ((bf16*)WSP(WS_WIN))
#define P_WOUT ((bf16*)WSP(WS_WOUT))
#define P_WGU ((bf16*)WSP(WS_WGU))
#define P_WDN ((bf16*)WSP(WS_WDN))
#define P_METAX ((float*)WSP(WS_METAX))
#define P_RSTD ((float*)WSP(WS_RSTD))
#define P_UF ((float*)WSP(WS_UF))
#define P_DT ((float*)WSP(WS_DT))
#define P_FCUM ((float*)WSP(WS_FCUM))
#define P_CN ((bf16*)WSP(WS_CN))
#define P_MASK ((u64*)WSP(WS_MASK))
#define P_KI ((bf16*)WSP(WS_MASK))
#define P_XB ((bf16*)WSP(WS_XB) + (size_t)8 * DM)
#define P_Y ((bf16*)WSP(WS_Y))
#define P_U ((bf16*)WSP(WS_R1))
#define P_XC ((bf16*)WSP(WS_XC))
#define P_H ((bf16*)WSP(WS_R1))
#define P_MIX ((bf16*)WSP(WS_R1))
#define P_MIX2 ((bf16*)WSP(WS_Y))
#define P_ST ((bf16*)WSP(WS_YA))
#define P_CD ((float*)WSP(WS_DT + 1536 * 1024))
#define P_WUV ((bf16*)WSP(WS_FCUM + 1792 * 1024))
#define P_FXG ((float*)WSP(WS_FIX))
#define P_FXU ((float*)WSP(WS_FIX + 6 * MiB))
#define P_HB ((float*)WSP(WS_FIX + 12 * MiB))
#define P_GUM ((float*)WSP(WS_FIX + 18 * MiB))
#define P_PS ((float*)WSP(WS_FIX + 19 * MiB))
#define P_SS ((float*)WSP(WS_FIX + 20 * MiB))
#define P_CNT ((unsigned*)WSP(WS_CTL) + 8192)
#define P_WUK ((bf16*)WSP(WS_FCUM + 1536 * 1024))
    ph_prep_x(c, INP(0), INP(1), P_XB, P_RSTD);
    ph_prep_w(c, 0, P_WIN, P_WOUT, P_WGU, P_WDN, P_WUK, P_WUV);
    grid.sync();
#define LAYER_BODY(ly) do { \
        for (int rep = 0; rep < REP_G1; ++rep) ph_gemm_plain(c, P_XB, P_WIN, P_U, NU, DM, NU, P_RSTD, P_UF, WGM_IN); \
        grid_barrier(c); \
        for (int rep = 0; rep < REP_M1; ++rep) { \
        ph_mixprep(c, P_U, P_UF, INP(7) + (size_t)ly * 4 * 1024, INP(8) + (size_t)ly * 1024, INP(16) + (size_t)ly * 128, INP(9) + (size_t)ly * 8, P_XC, P_Y, P_CN, P_DT, P_KI); \
        ph_fcum(c, P_UF, INP(15) + (size_t)ly * 8, P_FCUM); } \
        grid_barrier(c); \
        for (int rep = 0; rep < REP_SSD; ++rep) ph_ssd_states(c, P_XC, P_DT, INP(10) + (size_t)ly * 8, P_ST, P_CD); \
        for (int rep = 0; rep < REP_FOX; ++rep) ph_fox(c, P_U, P_FCUM, P_Y); \
        grid_barrier(c); \
        ph_ssd_scan(c, P_ST, P_CD); \
        for (int rep = 0; rep < REP_DSA; ++rep) ph_dsa(c, P_U, P_UF, P_CN, P_KI); \
        grid_barrier(c); \
        for (int rep = 0; rep < REP_SSD; ++rep) ph_ssd_out(c, P_XC, P_U, P_DT, INP(10) + (size_t)ly * 8, INP(11) + (size_t)ly * 8, P_ST, P_Y); \
        grid_barrier(c); \
        if (fused) { ph_gemm_resid(c, P_Y, P_WOUT, P_MIX, KOUT, P_XB, INP(3) + (size_t)ly * DM, nullptr, P_PS, P_SS, P_CNT + (2 * (ly)) * 128); \
            grid_barrier(c); \
            ph_resid(c, P_MIX, INP(3) + (size_t)ly * DM, P_XB, P_RSTD, nullptr, P_SS); } \
        else { for (int rep = 0; rep < REP_G2; ++rep) ph_gemm_plain(c, P_Y, P_WOUT, P_MIX, DM, KOUT, DM, nullptr, nullptr, WGM_OUT); \
            grid_barrier(c); \
            ph_resid(c, P_MIX, INP(3) + (size_t)ly * DM, P_XB, P_RSTD, nullptr); } \
        grid_barrier(c); \
        for (int rep = 0; rep < REP_G3; ++rep) ph_gemm_gateup(c, P_XB, P_WGU, P_H, P_RSTD, INP(22) + (size_t)ly * 3 * FF, INP(23) + (size_t)ly * FF, P_FXG, P_FXU, P_HB, P_GUM); \
        grid_barrier(c); \
        ph_ffn_fixup(c, P_H, INP(22) + (size_t)ly * 3 * FF, INP(23) + (size_t)ly * FF, P_FXG, P_FXU, P_HB, P_GUM); \
        grid_barrier(c); \
        if (fused) { ph_gemm_resid(c, P_H, P_WDN, P_MIX2, FF, P_XB, INP(5) + (size_t)ly * DM, (ly) == DEPTH - 1 ? DOUT : nullptr, P_PS, P_SS, P_CNT + (2 * (ly) + 1) * 128); \
            grid_barrier(c); \
            ph_resid(c, P_MIX2, INP(5) + (size_t)ly * DM, P_XB, P_RSTD, nullptr, P_SS); } \
        else { for (int rep = 0; rep < REP_G4; ++rep) ph_gemm_plain(c, P_H, P_WDN, P_MIX2, DM, FF, DM, nullptr, nullptr, WGM_DN); \
            grid_barrier(c); \
            ph_resid(c, P_MIX2, INP(5) + (size_t)ly * DM, P_XB, P_RSTD, (ly) == DEPTH - 1 ? DOUT : nullptr); } \
        if ((ly) + 1 < DEPTH) { for (int rep = 0; rep < REP_PREPW; ++rep) ph_prep_w(c, (ly) + 1, P_WIN, P_WOUT, P_WGU, P_WDN, P_WUK, P_WUV);     \
            grid_barrier(c); } \
    } while (0)
    const bool fused = c.nb == 256;
    LAYER_BODY(0); LAYER_BODY(1); LAYER_BODY(2); LAYER_BODY(3);
}

extern "C" void kernel_launch(void* const* d_in, const int* in_sizes, int n_in, void* d_out, int out_size, void* d_ws, size_t ws_size, hipStream_t stream) {
    static int grid_blocks = 0;
    if (grid_blocks == 0) {
        if (n_in != 25 || in_sizes[0] != NB * SEQ * DM || out_size != NB * SEQ * DM || ws_size < WS_END) { fprintf(stderr, "kernel_launch: unexpected shapes (n_in %d in0 %d out %d ws %zu)\n", n_in, n_in > 0 ? in_sizes[0] : -1, out_size, ws_size); grid_blocks = -1; return; }
        int dev = 0, cus = 0, per_cu = 0;
        (void)hipGetDevice(&dev); (void)hipDeviceGetAttribute(&cus, hipDeviceAttributeMultiprocessorCount, dev);
        if (hipFuncSetAttribute((const void*)fwd_mega, hipFuncAttributeMaxDynamicSharedMemorySize, LDS_BYTES) != hipSuccess) { fprintf(stderr, "kernel_launch: hipFuncSetAttribute failed\n"); grid_blocks = -1; return; }
        if (hipOccupancyMaxActiveBlocksPerMultiprocessor(&per_cu, (const void*)fwd_mega, NTHR, LDS_BYTES) != hipSuccess || per_cu < 1) { fprintf(stderr, "kernel_launch: occupancy query says %d blocks/CU\n", per_cu); grid_blocks = -1; return; }
        grid_blocks = cus;
        fprintf(stderr, "kernel_launch: %d CUs, %d blocks/CU by the occupancy query, grid %d\n", cus, per_cu, grid_blocks);
    }
    if (grid_blocks < 0) return;
    if (hipMemsetAsync((char*)d_ws + WS_CTL, 0, 65536, stream) != hipSuccess) { fprintf(stderr, "kernel_launch: memset failed\n"); return; }
    Args a{};
    for (int i = 0; i < 25; ++i) a.in[i] = (const float*)d_in[i];
    a.out = (float*)d_out; a.ws = (unsigned char*)d_ws;
    void* args[] = {&a};
    hipError_t e = hipLaunchCooperativeKernel((const void*)fwd_mega, dim3(grid_blocks), dim3(NTHR), args, LDS_BYTES, stream);
    if (e != hipSuccess) fprintf(stderr, "kernel_launch: cooperative launch failed: %s (grid %d)\n", hipGetErrorString(e), grid_blocks);
}
```

```cpp
#include <hip/hip_runtime.h>
#include <cstdio>
#include <cstdint>

constexpr int NB = 8, SEQ = 4096, NMETA = 16, L = SEQ + NMETA  , T = NB * L  , MP = 33024  , DM = 2048;
constexpr int NU = 4608, KOUT = 2048, FF = 5632, NGU = 2 * FF, DIN = 4564;
constexpr int C_Z = 0, C_XBC = 512, C_POOL = 1536, C_FQ = 2048, C_FK = 2560, C_FV = 3072, C_DQ = 3584, C_DC = 4096, C_QI = 4224, C_KI = 4480, C_SM = 4544;
constexpr int LKP = 4224, NMW = 66  , TOPK = 256, DEPTH = 4;
constexpr float EPSF = 1e-6f;
typedef unsigned short bf16;
typedef unsigned long long u64;

__device__ __forceinline__ float bf2f(bf16 v) { return __uint_as_float(((unsigned)v) << 16); }
__device__ __forceinline__ bf16 f2bf(float f) { unsigned u = __float_as_uint(f); return (bf16)((u + 0x7fffu + ((u >> 16) & 1u)) >> 16); }
typedef float f32x2v_ __attribute__((ext_vector_type(2)));
typedef __bf16 bf16x2v_ __attribute__((ext_vector_type(2)));
__device__ __forceinline__ unsigned pk2(float lo, float hi) { f32x2v_ v = {lo, hi}; bf16x2v_ b = __builtin_convertvector(v, bf16x2v_); return __builtin_bit_cast(unsigned, b); }
__device__ __forceinline__ float siluf(float x) { return x * __builtin_amdgcn_rcpf(1.f + __expf(-x)); }
__device__ __forceinline__ float softplusf(float x) { return fmaxf(x, 0.f) + log1pf(__expf(-fabsf(x))); }
__device__ __forceinline__ float logsigmoidf(float x) { return fminf(x, 0.f) - log1pf(__expf(-fabsf(x))); }
__device__ __forceinline__ float lane_read(float v, int src) { return __int_as_float(__builtin_amdgcn_ds_bpermute(src << 2, __float_as_int(v))); }
__device__ __forceinline__ int lane_readi(int v, int src) { return __builtin_amdgcn_ds_bpermute(src << 2, v); }
__device__ __forceinline__ float wave_sum(float v, int lane) {
#pragma unroll
    for (int o = 1; o < 64; o <<= 1) v += lane_read(v, lane ^ o);
    return v;
}
__device__ __forceinline__ float* xf_row(float* dout, float* metax, int t) {
    const int b = t / L, p = t - b * L;
    return p < NMETA ? metax + (size_t)(b * NMETA + p) * DM : dout + ((size_t)b * SEQ + (p - NMETA)) * DM;
}
namespace pg8 {
#define PG8_LAS __attribute__((address_space(3)))
typedef unsigned short bf16_t;
typedef short bf16x8 __attribute__((ext_vector_type(8)));
typedef float f32x4 __attribute__((ext_vector_type(4)));
typedef unsigned u32x4 __attribute__((ext_vector_type(4)));
constexpr int BM = 256, BK = 64, HALF = 128, HTB = HALF * BK * 2  , STAGE_BYTES = 8 * HTB, NXCD = 8, WGM = 4;

__host__ __device__ __forceinline__ int lds_byte(int r, int c) { const int st = (r >> 4) * 2 + (c >> 5), rr = r & 15, cc = c & 31, ob = rr * 64 + cc * 2; return st * 1024 + (ob ^ (((ob >> 9) & 1) << 5)); }
__host__ __device__ __forceinline__ void stage_rc(int b, int& R, int& C) { const int st = b / 1024, sb = b % 1024, swz = sb ^ (((sb >> 9) & 1) << 5); R = (st >> 1) * 16 + swz / 64; C = (st & 1) * 32 + (swz % 64) / 2; }
__host__ __device__ __forceinline__ int perm32(int rho) { const int n = rho >> 4, i = rho & 15; return 8 * (i >> 2) + 4 * n + (i & 3); }

struct Unit { int pm, pn; };
struct Gemm { const bf16_t* A; const bf16_t* Bt; int M, N, K; size_t a_tstep; int rowmap; };
__host__ __device__ __forceinline__ int tile_row0(int rowmap, int pm) { return rowmap ? (pm >> 4) * 4112 + 16 + 256 * (pm & 15) : pm * 256; }

struct StaticOrder {
    int nM, nN, nwg, G, c, wgm;
    __host__ __device__ void init(int M, int N, int G_, int c_, int wgm_ = WGM) { nM = M / BM; nN = N / BM; nwg = nM * nN; G = G_; c = c_; wgm = wgm_; }
    __host__ __device__ bool next(int i, Unit& u) const {
        const long L = (long)i * G + c; if (L >= nwg) return false;
        int wgid = (int)L; { const int q = nwg / NXCD, r = nwg % NXCD, xcd = wgid % NXCD, off = wgid / NXCD; wgid = (xcd < r ? xcd * (q + 1) : r * (q + 1) + (xcd - r) * q) + off; }
        const int nig = wgm * nN, gid = wgid / nig, fm = gid * wgm, gsz = (nM - fm) < wgm ? (nM - fm) : wgm;
        u.pm = fm + ((wgid % nig) % gsz); u.pn = (wgid % nig) / gsz; return true;
    }
    __device__ __forceinline__ void a_ready(const Unit&) const {}
    __device__ __forceinline__ void done(const Unit&) const {}
};


__device__ __forceinline__ unsigned cvt_pk_bf16(float lo, float hi) { return ::pk2(lo, hi); }

struct EpiBf16Plain {
    static constexpr bool PERM = true, AFTER_DRAIN = false, APERM = false;
    bf16_t* O; int ldc; const float* rs; float* UF; int sm_col0; int rowmap;
    __device__ __forceinline__ void operator()(f32x4 (&acc)[2][2][4][2], const Unit& u, int wr, int wc, int fr, int fq) const {
        const int row0 = tile_row0(rowmap, u.pm) + wr * 64 + fr, col0 = u.pn * BM + wc * 32 + 8 * fq;
#pragma unroll
        for (int ai = 0; ai < 2; ++ai)
#pragma unroll
            for (int m = 0; m < 4; ++m) {
                const int row = row0 + ai * HALF + m * 16; const float s = rs ? rs[row] : 1.f; bf16_t* rowp = O + (size_t)row * ldc + col0;
#pragma unroll
                for (int bj = 0; bj < 2; ++bj) { const f32x4 v0 = acc[ai][bj][m][0] * s, v1 = acc[ai][bj][m][1] * s;
                    u32x4 w; w.x = cvt_pk_bf16(v0[0], v0[1]); w.y = cvt_pk_bf16(v0[2], v0[3]); w.z = cvt_pk_bf16(v1[0], v1[1]); w.w = cvt_pk_bf16(v1[2], v1[3]);
                    *(u32x4*)(rowp + bj * HALF) = w;
                    if (UF) { const int c = col0 + bj * HALF - sm_col0; if (c >= 0 && c < 32) { float* p = UF + (size_t)row * 32 + c; *(f32x4*)p = v0; *(f32x4*)(p + 4) = v1; } } }
            }
    }
};

__device__ __forceinline__ float fq_sum(float x) {
#if defined(__HIP_DEVICE_COMPILE__)
    { const auto r = __builtin_amdgcn_permlane16_swap(__float_as_uint(x), __float_as_uint(x), false, false); x = __uint_as_float(r[0]) + __uint_as_float(r[1]); }
    { const auto r = __builtin_amdgcn_permlane32_swap(__float_as_uint(x), __float_as_uint(x), false, false); x = __uint_as_float(r[0]) + __uint_as_float(r[1]); }
#endif
    return x;
}
struct EpiResid {
    static constexpr bool PERM = true, AFTER_DRAIN = false, APERM = false;
    bf16_t* XB; const float* g; float* dout; float* PS; float* SS; unsigned* cnt; PG8_LAS float* sh;
    __device__ __forceinline__ void operator()(f32x4 (&acc)[2][2][4][2], const Unit& u, int wr, int wc, int fr, int fq) const {
        const int tid = (wr * 4 + wc) * 64 + fq * 16 + fr;
        const int row0 = tile_row0(1, u.pm) + wr * 64 + fr, col0 = u.pn * BM + wc * 32 + 8 * fq, rl0 = wr * 64 + fr;
        PG8_LAS float* part = sh; PG8_LAS float* rsd = sh + 1024;
        f32x4 gv[2][2];
#pragma unroll
        for (int bj = 0; bj < 2; ++bj)
#pragma unroll
            for (int n = 0; n < 2; ++n) gv[bj][n] = *(const f32x4*)(g + col0 + bj * HALF + 4 * n);
#pragma unroll
        for (int ai = 0; ai < 2; ++ai)
#pragma unroll
            for (int m = 0; m < 4; ++m) { float s = 0.f;
#pragma unroll
                for (int bj = 0; bj < 2; ++bj)
#pragma unroll
                    for (int n = 0; n < 2; ++n)
#pragma unroll
                        for (int j = 0; j < 4; ++j) s += acc[ai][bj][m][n][j] * acc[ai][bj][m][n][j];
                s = fq_sum(s);
                if (fq == 0) part[wc * 256 + ai * HALF + rl0 + m * 16] = s; }
        asm volatile("s_waitcnt lgkmcnt(0)" ::: "memory"); __builtin_amdgcn_s_barrier(); asm volatile("" ::: "memory");
        if (tid < 256) __hip_atomic_store(PS + ((size_t)u.pm * 256 + tid) * 8 + u.pn, ((part[tid] + part[256 + tid]) + part[512 + tid]) + part[768 + tid], __ATOMIC_RELAXED, __HIP_MEMORY_SCOPE_AGENT);
        asm volatile("s_waitcnt vmcnt(0)" ::: "memory"); __builtin_amdgcn_s_barrier(); asm volatile("" ::: "memory");
        if (tid == 0) { __hip_atomic_fetch_add(cnt + u.pm, 1u, __ATOMIC_RELAXED, __HIP_MEMORY_SCOPE_AGENT); unsigned sp = 0u;
            while (__hip_atomic_load(cnt + u.pm, __ATOMIC_RELAXED, __HIP_MEMORY_SCOPE_AGENT) < 8u) { __builtin_amdgcn_s_sleep(1); if (++sp > (1u << 22)) break; } }
        __builtin_amdgcn_s_barrier(); asm volatile("" ::: "memory");
        if (tid < 256) { const float* q = PS + ((size_t)u.pm * 256 + tid) * 8; float s = 0.f;
#pragma unroll
            for (int k = 0; k < 8; ++k) s += __hip_atomic_load(q + k, __ATOMIC_RELAXED, __HIP_MEMORY_SCOPE_AGENT);
            rsd[tid] = rsqrtf(s * (1.f / 2048.f) + 1e-6f); }
        asm volatile("s_waitcnt lgkmcnt(0)" ::: "memory"); __builtin_amdgcn_s_barrier(); asm volatile("" ::: "memory");
#pragma unroll
        for (int ai = 0; ai < 2; ++ai)
#pragma unroll
            for (int m = 0; m < 4; ++m) { const float r = rsd[ai * HALF + rl0 + m * 16]; const int row = row0 + ai * HALF + m * 16; float s2 = 0.f;
#pragma unroll
                for (int bj = 0; bj < 2; ++bj) { const u32x4 xv = *(const u32x4*)(XB + (size_t)row * 2048 + col0 + bj * HALF); const unsigned xw[4] = {xv.x, xv.y, xv.z, xv.w}; float a[8];
#pragma unroll
                    for (int i = 0; i < 8; ++i) { const float x = __uint_as_float((i & 1) ? (xw[i >> 1] & 0xffff0000u) : (xw[i >> 1] << 16));
                        a[i] = x + acc[ai][bj][m][i >> 2][i & 3] * r * gv[bj][i >> 2][i & 3]; s2 += a[i] * a[i]; }
                    u32x4 w; w.x = cvt_pk_bf16(a[0], a[1]); w.y = cvt_pk_bf16(a[2], a[3]); w.z = cvt_pk_bf16(a[4], a[5]); w.w = cvt_pk_bf16(a[6], a[7]);
                    if (!dout) *(u32x4*)(XB + (size_t)row * 2048 + col0 + bj * HALF) = w;
                    if (dout) { float* o = dout + ((size_t)u.pm * 256 + (row - tile_row0(1, u.pm))) * 2048 + col0 + bj * HALF; *(f32x4*)o = (f32x4){a[0], a[1], a[2], a[3]}; *(f32x4*)(o + 4) = (f32x4){a[4], a[5], a[6], a[7]}; } }
                s2 = fq_sum(s2);
                if (fq == 0) part[wc * 256 + ai * HALF + rl0 + m * 16] = s2; }
        if (dout) return;
        asm volatile("s_waitcnt lgkmcnt(0)" ::: "memory"); __builtin_amdgcn_s_barrier(); asm volatile("" ::: "memory");
        if (tid < 256) SS[((size_t)u.pm * 256 + tid) * 8 + u.pn] = ((part[tid] + part[256 + tid]) + part[512 + tid]) + part[768 + tid];
        __builtin_amdgcn_s_barrier(); asm volatile("" ::: "memory");
    }
};

struct EpiGateUp {
    static constexpr bool PERM = true, AFTER_DRAIN = false, APERM = true;
    bf16_t* H; const float* rs; const float* cw; const float* cb; PG8_LAS float* halo;
    float* FXG; float* FXU; float* HB;
    __device__ __forceinline__ void operator()(f32x4 (&acc)[2][2][4][2], const Unit& u, int wr, int wc, int fr, int fq) const {
        const int chl = wc * 32 + 8 * fq, ch0 = u.pn * 128 + chl, rbase = tile_row0(1, u.pm);
        f32x4 w0[2], w1[2], w2[2], bb[2];
#pragma unroll
        for (int n = 0; n < 2; ++n) { w0[n] = *(const f32x4*)(cw + ch0 + 4 * n); w1[n] = *(const f32x4*)(cw + FF + ch0 + 4 * n); w2[n] = *(const f32x4*)(cw + 2 * FF + ch0 + 4 * n); bb[n] = *(const f32x4*)(cb + ch0 + 4 * n); }
#pragma unroll
        for (int ai = 0; ai < 2; ++ai) { const f32x4 s4 = *(const f32x4*)(rs + rbase + ai * 128 + wr * 64 + 4 * fr);
#pragma unroll
            for (int m = 0; m < 4; ++m)
#pragma unroll
                for (int bj = 0; bj < 2; ++bj)
#pragma unroll
                    for (int n = 0; n < 2; ++n) acc[ai][bj][m][n] = acc[ai][bj][m][n] * s4[m]; }
        if (fr == 15) {
#pragma unroll
            for (int ai = 0; ai < 2; ++ai)
#pragma unroll
                for (int n = 0; n < 2; ++n) { *(PG8_LAS f32x4*)(halo + ((2 * ai + wr) * 2 + 0) * 128 + chl + 4 * n) = acc[ai][0][2][n]; *(PG8_LAS f32x4*)(halo + ((2 * ai + wr) * 2 + 1) * 128 + chl + 4 * n) = acc[ai][0][3][n]; }
            if (wr == 1) {
#pragma unroll
                for (int n = 0; n < 2; ++n) { *(f32x4*)(HB + ((size_t)u.pm * 2 + 0) * FF + ch0 + 4 * n) = acc[1][0][2][n]; *(f32x4*)(HB + ((size_t)u.pm * 2 + 1) * FF + ch0 + 4 * n) = acc[1][0][3][n]; } }
        }
        if (fr == 0 && wr == 0) {
#pragma unroll
            for (int n = 0; n < 2; ++n) { *(f32x4*)(FXG + ((size_t)u.pm * 2 + 0) * FF + ch0 + 4 * n) = acc[0][0][0][n]; *(f32x4*)(FXG + ((size_t)u.pm * 2 + 1) * FF + ch0 + 4 * n) = acc[0][0][1][n];
                                           *(f32x4*)(FXU + ((size_t)u.pm * 2 + 0) * FF + ch0 + 4 * n) = acc[0][1][0][n]; *(f32x4*)(FXU + ((size_t)u.pm * 2 + 1) * FF + ch0 + 4 * n) = acc[0][1][1][n]; }
        }
        asm volatile("s_waitcnt lgkmcnt(0)" ::: "memory"); __builtin_amdgcn_s_barrier(); asm volatile("" ::: "memory");
#pragma unroll
        for (int ai = 0; ai < 2; ++ai) {
            const int blk = 2 * ai + wr; unsigned pk[4][4];
#pragma unroll
            for (int n = 0; n < 2; ++n) {
                f32x4 h2 = {0.f, 0.f, 0.f, 0.f}, h3 = {0.f, 0.f, 0.f, 0.f};
                if (blk > 0) { h2 = *(const PG8_LAS f32x4*)(halo + ((blk - 1) * 2 + 0) * 128 + chl + 4 * n); h3 = *(const PG8_LAS f32x4*)(halo + ((blk - 1) * 2 + 1) * 128 + chl + 4 * n); }
                f32x4 d2, d3;
#pragma unroll
                for (int j = 0; j < 4; ++j) {
                    d2[j] = __int_as_float(__builtin_amdgcn_update_dpp(__float_as_int(h2[j]), __float_as_int(acc[ai][0][2][n][j]), 0x111, 0xf, 0xf, false));
                    d3[j] = __int_as_float(__builtin_amdgcn_update_dpp(__float_as_int(h3[j]), __float_as_int(acc[ai][0][3][n][j]), 0x111, 0xf, 0xf, false)); }
#pragma unroll
                for (int m = 0; m < 4; ++m) {
                    const f32x4 cur = acc[ai][0][m][n], g1 = m == 0 ? d3 : acc[ai][0][m > 0 ? m - 1 : 0][n], g2 = m == 0 ? d2 : (m == 1 ? d3 : acc[ai][0][m > 1 ? m - 2 : 0][n]);
                    const f32x4 cv = bb[n] + w2[n] * cur + w1[n] * g1 + w0[n] * g2;
                    const f32x4 t = cv * -1.4426950408889634f; f32x4 den;
#pragma unroll
                    for (int j = 0; j < 4; ++j) den[j] = __builtin_amdgcn_exp2f(t[j]);
                    den = den + 1.f; f32x4 sg;
#pragma unroll
                    for (int j = 0; j < 4; ++j) sg[j] = __builtin_amdgcn_rcpf(den[j]);
                    const f32x4 hv = cv * sg * acc[ai][1][m][n];
                    pk[m][2 * n] = cvt_pk_bf16(hv[0], hv[1]); pk[m][2 * n + 1] = cvt_pk_bf16(hv[2], hv[3]);
                }
            }
#pragma unroll
            for (int m = 0; m < 4; ++m) { const int rl = ai * 128 + wr * 64 + 4 * fr + m;
                if (rl >= 2) { u32x4 w; w.x = pk[m][0]; w.y = pk[m][1]; w.z = pk[m][2]; w.w = pk[m][3]; *(u32x4*)(H + (size_t)(rbase + rl) * FF + ch0) = w; } }
        }
    }
};
template <class Epi, class Sched, bool ALIGN_EPI = false, bool SP2 = false>
__device__ __forceinline__ void gemm_phase(PG8_LAS unsigned char* lds, const Gemm g, const Sched& S, const Epi& E, const int tid) {
    const int wid = __builtin_amdgcn_readfirstlane(tid >> 6), lane = tid & 63, wr = wid >> 2, wc = wid & 3, fr = lane & 15, fq = lane >> 4;
    const int K = g.K, nt = K / BK;
    unsigned voffA[2], voffB[2];
#pragma unroll
    for (int i = 0; i < 2; ++i) { int R, C; stage_rc(tid * 16 + i * 8192, R, C); const int Rb = Epi::PERM ? ((R & ~31) + perm32(R & 31)) : R;
        const int Ra = Epi::APERM ? ((R & ~63) + 4 * (R & 15) + ((R & 63) >> 4)) : R;
        voffA[i] = (unsigned)(Ra * K + C) * 2u; voffB[i] = (unsigned)(Rb * K + C) * 2u; }
    const size_t kstep = (size_t)(BK * 2);
    const size_t hstep = (size_t)HALF * K * 2;
    const size_t tstep = 2 * hstep;
    const unsigned ldsw = (unsigned)wid * 1024u;
    const int aoff = lds_byte(wr * 64 + fr, fq * 8), boff = lds_byte(wc * 32 + fr, fq * 8);
#define PG8_SA(b, h) (((b) * 2 + (h)) * HTB)
#define PG8_SB(b, h) ((4 + (b) * 2 + (h)) * HTB)
#define PG8_STAGE(bufoff, gbase, voff) do { _Pragma("unroll") for (int _i = 0; _i < 2; ++_i) \
        __builtin_amdgcn_global_load_lds((const unsigned*)((const char*)(gbase) + (voff)[_i]), (PG8_LAS unsigned*)(lds + (bufoff) + ldsw + _i * 8192), 16, 0, 0); } while (0)
#define PG8_LDA(dst, b, h) do { _Pragma("unroll") for (int m = 0; m < 4; ++m) _Pragma("unroll") for (int k = 0; k < 2; ++k) dst[m][k] = *(const PG8_LAS bf16x8*)(lds + PG8_SA(b, h) + aoff + m * 2048 + k * 1024); } while (0)
#define PG8_LDB(dst, b, h) do { _Pragma("unroll") for (int n = 0; n < 2; ++n) _Pragma("unroll") for (int k = 0; k < 2; ++k) dst[n][k] = *(const PG8_LAS bf16x8*)(lds + PG8_SB(b, h) + boff + n * 2048 + k * 1024); } while (0)
#define PG8_MMA(ai, bj, At, Bt) do { __builtin_amdgcn_s_setprio(1); _Pragma("unroll") for (int m = 0; m < 4; ++m) _Pragma("unroll") for (int n = 0; n < 2; ++n) _Pragma("unroll") for (int k = 0; k < 2; ++k) \
        acc[ai][bj][m][n] = __builtin_amdgcn_mfma_f32_16x16x32_bf16(Bt[n][k], At[m][k], acc[ai][bj][m][n], 0, 0, 0); __builtin_amdgcn_s_setprio(0); } while (0)
#define PG8_WAIT_V(n) asm volatile("s_waitcnt vmcnt(" #n ")" ::: "memory")
#define PG8_WAIT_L(n) asm volatile("s_waitcnt lgkmcnt(" #n ")" ::: "memory")
#define PG8_BAR __builtin_amdgcn_s_barrier()
#define PG8_SCHED __builtin_amdgcn_sched_barrier(0)
    Unit cur, nxt; int ui = 0;
    if (!S.next(0, cur)) return;
    f32x4 acc[2][2][4][2];
#pragma unroll
    for (int a = 0; a < 2; ++a)
#pragma unroll
        for (int b = 0; b < 2; ++b)
#pragma unroll
            for (int m = 0; m < 4; ++m)
#pragma unroll
                for (int n = 0; n < 2; ++n) acc[a][b][m][n] = (f32x4){0.f, 0.f, 0.f, 0.f};
    bf16x8 At[4][2], B0[2][2], B1[2][2];
    const char* cA = (const char*)g.A + (g.rowmap ? (size_t)tile_row0(1, cur.pm) * K * 2 : (size_t)cur.pm * g.a_tstep); const char* cB = (const char*)g.Bt + (size_t)cur.pn * tstep;
    S.a_ready(cur);
    if constexpr (SP2) {
        PG8_STAGE(PG8_SB(0, 0), cB, voffB); PG8_STAGE(PG8_SB(0, 1), cB + hstep, voffB); PG8_STAGE(PG8_SA(0, 0), cA, voffA); PG8_STAGE(PG8_SA(0, 1), cA + hstep, voffA);
        if (wr == 1) PG8_BAR;
        PG8_WAIT_V(2); PG8_BAR;
        PG8_STAGE(PG8_SB(1, 0), cB + kstep, voffB); PG8_STAGE(PG8_SA(1, 0), cA + kstep, voffA); PG8_STAGE(PG8_SB(1, 1), cB + hstep + kstep, voffB);
        PG8_WAIT_V(6); PG8_BAR;
    } else {
        PG8_STAGE(PG8_SB(0, 0), cB, voffB); PG8_STAGE(PG8_SA(0, 0), cA, voffA); PG8_STAGE(PG8_SB(0, 1), cB + hstep, voffB); PG8_STAGE(PG8_SA(0, 1), cA + hstep, voffA);
        if (wr == 1) PG8_BAR;
        PG8_WAIT_V(4); PG8_BAR;
        PG8_STAGE(PG8_SB(1, 0), cB + kstep, voffB); PG8_STAGE(PG8_SA(1, 0), cA + kstep, voffA); PG8_STAGE(PG8_SB(1, 1), cB + hstep + kstep, voffB);
        PG8_WAIT_V(6); PG8_BAR;
    }
    for (;;) {
        const bool has_next = S.next(ui + 1, nxt);
        const char* nA = has_next ? (const char*)g.A + (g.rowmap ? (size_t)tile_row0(1, nxt.pm) * K * 2 : (size_t)nxt.pm * g.a_tstep) : cA; const char* nB = has_next ? (const char*)g.Bt + (size_t)nxt.pn * tstep : cB;
        for (int t = 0; t < nt; t += 2) {
            const bool last = (t == nt - 2);
            const char* a1 = cA + (size_t)(t + 1) * kstep;
            const char* a2 = last ? nA : cA + (size_t)(t + 2) * kstep; const char* b2 = last ? nB : cB + (size_t)(t + 2) * kstep;
            const char* a3 = a2 + kstep; const char* b3 = b2 + kstep;
            if (last && has_next) S.a_ready(nxt);
            if constexpr (SP2) {
            PG8_LDB(B0, 0, 0); PG8_LDB(B1, 0, 1); PG8_SCHED; PG8_LDA(At, 0, 0); PG8_STAGE(PG8_SA(1, 1), a1 + hstep, voffA);
            PG8_WAIT_V(8); PG8_WAIT_L(0); PG8_BAR; PG8_MMA(0, 0, At, B0); PG8_MMA(0, 1, At, B1); PG8_BAR; PG8_SCHED;
            PG8_LDA(At, 0, 1); PG8_STAGE(PG8_SB(0, 0), b2, voffB); PG8_STAGE(PG8_SB(0, 1), b2 + hstep, voffB); PG8_STAGE(PG8_SA(0, 0), a2, voffA);
            PG8_WAIT_V(8); PG8_WAIT_L(0); PG8_BAR; PG8_MMA(1, 0, At, B0); PG8_MMA(1, 1, At, B1); PG8_BAR; PG8_SCHED;
            PG8_LDB(B0, 1, 0); PG8_LDB(B1, 1, 1); PG8_SCHED; PG8_LDA(At, 1, 0); PG8_STAGE(PG8_SA(0, 1), a2 + hstep, voffA);
            PG8_WAIT_V(8); PG8_WAIT_L(0); PG8_BAR; PG8_MMA(0, 0, At, B0); PG8_MMA(0, 1, At, B1); PG8_BAR; PG8_SCHED;
            PG8_LDA(At, 1, 1); PG8_STAGE(PG8_SB(1, 0), b3, voffB); PG8_STAGE(PG8_SB(1, 1), b3 + hstep, voffB); PG8_STAGE(PG8_SA(1, 0), a3, voffA);
            PG8_WAIT_V(8); PG8_WAIT_L(0); PG8_BAR; PG8_MMA(1, 0, At, B0); PG8_MMA(1, 1, At, B1); PG8_BAR; PG8_SCHED;
            } else {
            PG8_LDB(B0, 0, 0); PG8_SCHED; PG8_LDA(At, 0, 0); PG8_STAGE(PG8_SA(1, 1), a1 + hstep, voffA);
            PG8_WAIT_L(8); PG8_BAR; PG8_WAIT_L(0); PG8_MMA(0, 0, At, B0); PG8_BAR; PG8_SCHED;
            PG8_LDB(B1, 0, 1); PG8_STAGE(PG8_SB(0, 0), b2, voffB);
            PG8_BAR; PG8_WAIT_L(0); PG8_MMA(0, 1, At, B1); PG8_BAR;
            PG8_LDA(At, 0, 1); PG8_STAGE(PG8_SA(0, 0), a2, voffA);
            PG8_BAR; PG8_WAIT_L(0); PG8_MMA(1, 0, At, B0); PG8_BAR; PG8_SCHED;
            PG8_STAGE(PG8_SB(0, 1), b2 + hstep, voffB);
            PG8_WAIT_V(6); PG8_BAR; PG8_MMA(1, 1, At, B1); PG8_BAR;
            PG8_LDB(B0, 1, 0); PG8_SCHED; PG8_LDA(At, 1, 0); PG8_STAGE(PG8_SA(0, 1), a2 + hstep, voffA);
            PG8_WAIT_L(8); PG8_BAR; PG8_WAIT_L(0); PG8_MMA(0, 0, At, B0); PG8_BAR; PG8_SCHED;
            PG8_LDB(B1, 1, 1); PG8_STAGE(PG8_SB(1, 0), b3, voffB);
            PG8_BAR; PG8_WAIT_L(0); PG8_MMA(0, 1, At, B1); PG8_BAR;
            PG8_LDA(At, 1, 1); PG8_STAGE(PG8_SA(1, 0), a3, voffA);
            PG8_BAR; PG8_WAIT_L(0); PG8_MMA(1, 0, At, B0); PG8_BAR; PG8_SCHED;
            PG8_STAGE(PG8_SB(1, 1), b3 + hstep, voffB);
            PG8_WAIT_V(6); PG8_BAR; PG8_MMA(1, 1, At, B1); PG8_BAR;
            }
        }
        if constexpr (ALIGN_EPI) { if (wr == 0) PG8_BAR; }
        if constexpr (!Epi::AFTER_DRAIN) { E(acc, cur, wr, wc, fr, fq); S.done(cur); }
        if (!has_next) break;
#pragma unroll
        for (int a = 0; a < 2; ++a)
#pragma unroll
            for (int b = 0; b < 2; ++b)
#pragma unroll
                for (int m = 0; m < 4; ++m)
#pragma unroll
                    for (int n = 0; n < 2; ++n) acc[a][b][m][n] = (f32x4){0.f, 0.f, 0.f, 0.f};
        cur = nxt; cA = nA; cB = nB; ++ui;
        if constexpr (ALIGN_EPI) { if (wr == 1) PG8_BAR; }
    }
    PG8_WAIT_V(0);
    if constexpr (!ALIGN_EPI) { if (wr == 0) PG8_BAR; }
    PG8_BAR;
    if constexpr (Epi::AFTER_DRAIN) { E.fused(acc, cur, wr, wc, fr, fq, lds, wid, lane); S.done(cur); }
#undef PG8_SA
#undef PG8_SB
#undef PG8_STAGE
#undef PG8_LDA
#undef PG8_LDB
#undef PG8_MMA
#undef PG8_WAIT_V
#undef PG8_WAIT_L
#undef PG8_BAR
#undef PG8_SCHED
}
}

constexpr int WGM_IN = 4, WGM_OUT = 4, WGM_GU = 4, WGM_DN = 4;
constexpr int REP_SCORE = 1, REP_SEL = 1, REP_ATT = 1, REP_SLOW = 1, REP_FAST = 1;

#include <hip/hip_cooperative_groups.h>
namespace cg = cooperative_groups;
#define LAS __attribute__((address_space(3)))
constexpr int LDS_BYTES = 163840, HALO_OFF = 133120, PT_OFF = 163328, NTHR = 512, NWAVE = 8;
constexpr size_t MiB = (size_t)1 << 20;
constexpr size_t WS_CTL = 0, WS_WIN = 1 * MiB, WS_WOUT = 21 * MiB, WS_WGU = 31 * MiB, WS_WDN = 75 * MiB, WS_METAX = 97 * MiB, WS_RSTD = 98 * MiB, WS_UF = 99 * MiB,
                 WS_DT = 104 * MiB, WS_FCUM = 106 * MiB, WS_CN = 108 * MiB, WS_MASK = 117 * MiB, WS_XB = 134 * MiB, WS_Y = 264 * MiB, WS_R1 = 426 * MiB, WS_XC = WS_R1 + 323 * MiB,
                 WS_YA = 814 * MiB, WS_FIX = 880 * MiB  , WS_END = 902 * MiB;
static_assert(WS_WIN + (size_t)NU * DM * 2 <= WS_WOUT && WS_WOUT + (size_t)DM * KOUT * 2 <= WS_WGU && WS_WGU + (size_t)NGU * DM * 2 <= WS_WDN && WS_WDN + (size_t)DM * FF * 2 <= WS_METAX, "ws weights");
static_assert(WS_UF + (size_t)MP * 32 * 4 <= WS_DT && WS_DT + (size_t)T * 8 * 4 <= WS_FCUM && WS_FCUM + (size_t)64 * LKP * 4 <= WS_CN && WS_CN + (size_t)MP * 128 * 2 <= WS_MASK && WS_MASK + (size_t)T * NMW * 8 <= WS_XB, "ws small");
static_assert(WS_XB + (size_t)(MP + 8) * DM * 2 <= WS_Y && WS_Y + (size_t)MP * KOUT * 2 <= WS_R1 && WS_R1 + (size_t)MP * NU * 2 <= WS_XC && WS_XC + (size_t)MP * 1024 * 2 <= WS_YA && WS_R1 + (size_t)MP * FF * 2 <= WS_YA && WS_YA + (size_t)T * 512 * 4 <= WS_END, "ws big");

typedef unsigned u32x4v __attribute__((ext_vector_type(4)));
typedef unsigned u32x2v __attribute__((ext_vector_type(2)));
typedef float f32x4v __attribute__((ext_vector_type(4)));
struct Args { const float* in[25]; float* out; unsigned char* ws; };

struct Ctx {
    int tid, lane, wave, gw, ngw, bid, nb;
    LAS unsigned char* lds;
};
__device__ __forceinline__ Ctx refresh(const Ctx& c0) {
    Ctx c = c0; unsigned z = 0u; int w_ = c0.wave, b_ = (int)blockIdx.x, n_ = (int)gridDim.x; asm volatile("" : "+v"(z), "+s"(w_), "+s"(b_), "+s"(n_));
    const int lane = (int)__builtin_amdgcn_mbcnt_hi(~0u, __builtin_amdgcn_mbcnt_lo(~0u, z));
    c.bid = b_; c.nb = n_; c.ngw = n_ * NWAVE; c.wave = w_; c.lane = lane; c.tid = w_ * 64 + lane; c.gw = b_ * NWAVE + w_;
    { unsigned l_ = (unsigned)(size_t)c0.lds; asm volatile("" : "+s"(l_)); c.lds = (LAS unsigned char*)(size_t)l_; }
    return c;
}
__device__ __forceinline__ unsigned char* pt_get(const Ctx& c, int i) {
    unsigned l_ = (unsigned)(size_t)c.lds; asm volatile("" : "+s"(l_));
    const LAS unsigned* p = (const LAS unsigned*)((LAS unsigned char*)(size_t)l_ + PT_OFF) + 2 * i;
    const unsigned lo = __builtin_amdgcn_readfirstlane(p[0]), hi = __builtin_amdgcn_readfirstlane(p[1]);
    __attribute__((address_space(1))) unsigned char* gp = (__attribute__((address_space(1))) unsigned char*)(((unsigned long long)hi << 32) | lo);
    return (unsigned char*)gp;
}
#define INP(i) ((const float*)pt_get(c, (i)))

#define GAS __attribute__((address_space(1)))
typedef unsigned v4u __attribute__((ext_vector_type(4)));
typedef GAS unsigned gu32;
typedef GAS unsigned long long gu64;
#define RLX_AGENT __ATOMIC_RELAXED, __HIP_MEMORY_SCOPE_AGENT
#define LDS_WAIT() asm volatile("s_waitcnt lgkmcnt(0)" ::: "memory")
#define VM_WAIT() asm volatile("s_waitcnt vmcnt(0)" ::: "memory")
__device__ __forceinline__ unsigned long long rt() { return __builtin_amdgcn_s_memrealtime(); }

#define XB_TMO      128
#define XB_XCNT(j)  (256  + 64 * (j))
#define XB_XSUB(j)  (1280 + 64 * (j))
#define XB_XGEN(j)  (2304 + 64 * (j))
#define XB_TOP      3328
#define XB_TOPGEN   3392
#define XCD_BAR_WORDS 3456
#define XB_SPIN_CAP (1u << 18)

__device__ __forceinline__ unsigned xb_ld(unsigned* p)              { return __hip_atomic_load(p, __ATOMIC_RELAXED, __HIP_MEMORY_SCOPE_AGENT); }
__device__ __forceinline__ unsigned xb_add(unsigned* p, unsigned v) { return __hip_atomic_fetch_add(p, v, __ATOMIC_RELAXED, __HIP_MEMORY_SCOPE_AGENT); }
__device__ __forceinline__ unsigned xb_xcc_id() { return (unsigned)__builtin_amdgcn_s_getreg((3 << 11) | 20) & 0xFu; }
#define XB_SPIN(cond, bar) do { unsigned _sp = 0; while (cond) { __builtin_amdgcn_s_sleep(1); \
    if ((++_sp & 255u) == 0u) { if (xb_ld(&(bar)[XB_TMO])) break; if (_sp > XB_SPIN_CAP) { atomicAdd(&(bar)[XB_TMO], 1u); break; } } } } while (0)

struct XcdBarrier {
    unsigned* bar; unsigned x;
    volatile LAS unsigned* st;
};

__device__ __forceinline__ XcdBarrier xcd_barrier_post(unsigned* bar, volatile LAS unsigned* st, int tid) {
    XcdBarrier b; b.bar = bar; b.x = xb_xcc_id(); b.st = st;
    if (tid == 0) (void)xb_add(&bar[XB_XCNT(b.x)], 1u);
    return b;
}
__device__ __forceinline__ void xcd_barrier_complete(unsigned* bar, unsigned x, unsigned& nloc, unsigned& nx) {
    const unsigned G = gridDim.x * gridDim.y * gridDim.z;
    unsigned sum, cnt, mine, sp = 0u;
    for (;;) {
        sum = 0u; cnt = 0u; mine = 0u;
#pragma unroll
        for (unsigned j = 0; j < 16; ++j) { const unsigned c = xb_ld(&bar[XB_XCNT(j)]); sum += c; cnt += (c > 0u) ? 1u : 0u; mine = (j == x) ? c : mine; }
        if (sum == G) break;
        __builtin_amdgcn_s_sleep(1);
        if ((++sp & 255u) == 0u) { if (xb_ld(&bar[XB_TMO])) break; if (sp > XB_SPIN_CAP) { atomicAdd(&bar[XB_TMO], 1u); break; } }
    }
    nloc = mine > 0u ? mine : 1u; nx = cnt > 0u ? cnt : 1u;
}

__device__ __forceinline__ void xcd_barrier(const XcdBarrier& b, int tid) {
    asm volatile("s_waitcnt vmcnt(0)" ::: "memory");
    __syncthreads();
    if (tid == 0) {
        unsigned* bar = b.bar;
        __builtin_amdgcn_s_waitcnt(0);
        unsigned nloc = b.st[0], nx = b.st[1];
        if (nloc == 0u) { xcd_barrier_complete(bar, b.x, nloc, nx); b.st[0] = nloc; b.st[1] = nx; }
        const unsigned old = xb_add(&bar[XB_XSUB(b.x)], 1u);
        const unsigned gen = old / nloc;
        if (old + 1u == (gen + 1u) * nloc) {
            __builtin_amdgcn_fence(__ATOMIC_RELEASE, "agent");
            asm volatile("s_waitcnt vmcnt(0)" ::: "memory");
            const unsigned og = xb_add(&bar[XB_TOP], 1u);
            const unsigned tg = og / nx;
            if (og + 1u == (tg + 1u) * nx) xb_add(&bar[XB_TOPGEN], 1u);
            else XB_SPIN(xb_ld(&bar[XB_TOPGEN]) == tg, bar);
            __builtin_amdgcn_fence(__ATOMIC_ACQUIRE, "agent");
            xb_add(&bar[XB_XGEN(b.x)], 1u);
            asm volatile("s_waitcnt vmcnt(0)" ::: "memory");
        } else {
            XB_SPIN(xb_ld(&bar[XB_XGEN(b.x)]) == gen, bar);
            __builtin_amdgcn_fence(__ATOMIC_ACQUIRE, "agent");
            asm volatile("s_waitcnt vmcnt(0)" ::: "memory");
        }
    }
    __syncthreads();
}

constexpr int MISC_OFF = 163072, CW_BAR = 4096;
__device__ __forceinline__ void grid_barrier(const Ctx& c0) {
    const Ctx c = refresh(c0);
    XcdBarrier b; b.bar = (unsigned*)(pt_get(c, 26) + WS_CTL) + CW_BAR; b.x = xb_xcc_id(); b.st = (volatile LAS unsigned*)(c.lds + MISC_OFF);
    xcd_barrier(b, c.tid);
}
__device__ __forceinline__ void ph_prep_x(const Ctx& c0, const float* x, const float* meta, bf16* XB, float* RSTD) { const Ctx c = refresh(c0);
    const int lane = c.lane;
    for (int w = c.gw; w < MP + 8; w += c.ngw) {
        const int t = w - 8; bf16* xb = XB + (ptrdiff_t)t * DM;
        if (t < 0 || t >= T) {
#pragma unroll
            for (int j = 0; j < 4; ++j) *(u32x4v*)(xb + 8 * lane + 512 * j) = (u32x4v){0u, 0u, 0u, 0u};
            if (t >= T && lane == 0) RSTD[t] = 0.f;
            continue;
        }
        const int b = t / L, p = t - b * L;
        const float* src = p < NMETA ? meta + (size_t)p * DM : x + ((size_t)b * SEQ + (p - NMETA)) * DM;
        float ss = 0.f;
#pragma unroll
        for (int j = 0; j < 4; ++j) {
            const f32x4v a = *(const f32x4v*)(src + 8 * lane + 512 * j), cc = *(const f32x4v*)(src + 8 * lane + 512 * j + 4);
            ss += a.x * a.x + a.y * a.y + a.z * a.z + a.w * a.w + cc.x * cc.x + cc.y * cc.y + cc.z * cc.z + cc.w * cc.w;
            *(u32x4v*)(xb + 8 * lane + 512 * j) = (u32x4v){pk2(a.x, a.y), pk2(a.z, a.w), pk2(cc.x, cc.y), pk2(cc.z, cc.w)};
        }
        ss = wave_sum(ss, lane);
        if (lane == 0) RSTD[t] = rsqrtf(ss * (1.f / DM) + EPSF);
    }
}

__device__ __forceinline__ void tp_tile(LAS float* tl, int lane, const float* src, int ld, const float* scale, float mul, bf16* dst, int Kd) {
    const int kk = lane >> 4, n4 = lane & 15;
    f32x4v v[16];
#pragma unroll
    for (int i = 0; i < 16; ++i) v[i] = *(const f32x4v*)(src + (size_t)(4 * i + kk) * ld + 4 * n4);
    if (scale) {
#pragma unroll
        for (int i = 0; i < 16; ++i) v[i] = v[i] * (scale[4 * i + kk] * mul); }
#pragma unroll
    for (int i = 0; i < 16; ++i)
#pragma unroll
        for (int e = 0; e < 4; ++e) tl[(4 * n4 + e) * 65 + 4 * i + kk] = v[i][e];
#pragma unroll
    for (int jj = 0; jj < 8; ++jj) { const int n = (lane >> 3) + 8 * jj, kc = (lane & 7) * 8; const LAS float* tp = tl + n * 65 + kc;
        *(u32x4v*)(dst + (size_t)n * Kd + kc) = (u32x4v){pk2(tp[0], tp[1]), pk2(tp[2], tp[3]), pk2(tp[4], tp[5]), pk2(tp[6], tp[7])}; }
}
template <class F, class M> __device__ __forceinline__ void transpose_tiles_map(const Ctx& c, bf16* dst, int Kd, int ntiles, const F& val, const M& map) {
    LAS float* tile = (LAS float*)c.lds + (c.tid >> 8) * (32 * 33);
    const int t2 = c.tid & 255, tx = t2 & 31, ty = t2 >> 5;
    for (int it = 2 * c.bid + (c.tid >> 8); it < ntiles; it += 2 * c.nb) {
        int k0, n0; map(it, k0, n0);
#pragma unroll
        for (int i = 0; i < 4; ++i) tile[(ty + 8 * i) * 33 + tx] = val(k0 + ty + 8 * i, n0 + tx);
        __syncthreads();
#pragma unroll
        for (int i = 0; i < 4; ++i) dst[(size_t)(n0 + ty + 8 * i) * Kd + k0 + tx] = f2bf(tile[tx * 33 + ty + 8 * i]);
        __syncthreads();
    }
}
__device__ __forceinline__ void ph_prep_w(const Ctx& c0, int ly, bf16* WIN, bf16* WOUT, bf16* WGU, bf16* WDN, bf16* WUKB, bf16* WUVT) { const Ctx c = refresh(c0);
    const float* w_in = INP(6) + (size_t)ly * DM * DIN; const float* g1 = INP(2) + (size_t)ly * DM; const float* w_uk = INP(17) + (size_t)ly * 8 * 128 * 64;
    const float* w_out = INP(19) + (size_t)ly * DM * DM; const float* ssd_norm = INP(12) + (size_t)ly * 512; const float* pool_w = INP(13) + (size_t)ly * 4 * 128 * 128;
    const float* pool_scale = INP(14) + (size_t)ly * 512; const float* w_uv = INP(18) + (size_t)ly * 8 * 128 * 64;
    const float* wg = INP(20) + (size_t)ly * DM * FF; const float* wu = INP(21) + (size_t)ly * DM * FF; const float* g3 = INP(4) + (size_t)ly * DM;
    const float* wd = INP(24) + (size_t)ly * FF * DM;
    {
        LAS float* tl = (LAS float*)c.lds + c.wave * (64 * 65);
        constexpr int N_WIN = 71 * 32, N_WGU = 176 * 32, N_WDN = 32 * 88, N_WOUT = 32 * 24, N_ALL = N_WIN + N_WGU + N_WDN + N_WOUT;
#pragma unroll 1
        for (int it0 = c.gw; it0 < N_ALL * REP_FAST; it0 += c.ngw) { const int it = it0 % N_ALL;
            int r = it; const float* src; const float* scl; bf16* dst; int ld, Kd; float mul = 1.f;
            if (r < N_WGU) { const int kt = r / 176, ct = r - kt * 176, pn = ct >> 2, up = (ct >> 1) & 1, hf = ct & 1;
                src = (up ? wu : wg) + (size_t)(64 * kt) * FF + 128 * pn + 64 * hf; ld = FF; scl = g3 + 64 * kt; dst = WGU + (size_t)(256 * pn + 128 * up + 64 * hf) * DM + 64 * kt; Kd = DM; }
            else if ((r -= N_WGU) < N_WDN) { const int kt = r >> 5, ct = r & 31;
                src = wd + (size_t)(64 * kt) * DM + 64 * ct; ld = DM; scl = nullptr; dst = WDN + (size_t)(64 * ct) * FF + 64 * kt; Kd = FF; }
            else if ((r -= N_WDN) < N_WIN) { const int kt = r / 71, ct = r - kt * 71;
                int dcol, scol;
                if (ct < 24) { dcol = 64 * ct; scol = dcol; }
                else if (ct < 32) { dcol = 64 * ct; scol = 1544 + 64 * (ct - 24); }
                else if (ct < 56) { dcol = 64 * ct; scol = 2056 + 64 * (ct - 32); if (ct < 40) mul = 0.18033688011112042f; }
                else if (ct < 64) { dcol = 64 * ct; scol = 3600 + 64 * (ct - 56); }
                else if (ct < 66) { dcol = C_DC + 64 * (ct - 64); scol = 4112 + 64 * (ct - 64); }
                else if (ct < 70) { dcol = C_QI + 64 * (ct - 66); scol = 4240 + 64 * (ct - 66); }
                else { dcol = C_KI; scol = 4496; }
                src = w_in + (size_t)(64 * kt) * DIN + scol; ld = DIN; scl = g1 + 64 * kt; dst = WIN + (size_t)dcol * DM + 64 * kt; Kd = DM; }
            else { r -= N_WIN; const int kq = r >> 5, nt = r & 31, k0 = kq < 8 ? 64 * kq : 1024 + 64 * (kq - 8);
                src = w_out + (size_t)k0 * DM + 64 * nt; ld = DM; scl = kq < 8 ? ssd_norm + k0 : nullptr; dst = WOUT + (size_t)(64 * nt) * KOUT + k0; Kd = KOUT; }
            tp_tile(tl, c.lane, src, ld, scl, mul, dst, Kd);
        }
    }
    __syncthreads();
    {   const int gt = c.bid * NTHR + c.tid, ngt = c.nb * NTHR;
        for (int it = gt; it < 8 * 128 * 64 / 2; it += ngt) { const float sc = 0.125f * 1.4426950408889634f; *(unsigned*)(WUKB + 2 * it) = pk2(w_uk[2 * it] * sc, w_uk[2 * it + 1] * sc); }
        for (int it = gt; it < 4 * 32 * 512; it += ngt) {
            const int nq = it & 511, cq = (it >> 9) & 31, gi = it >> 14, n0 = 4 * nq, c0_ = 4 * cq;
            float acc[4][4];
#pragma unroll
            for (int a = 0; a < 4; ++a)
#pragma unroll
                for (int b = 0; b < 4; ++b) acc[a][b] = 0.f;
            const float* ap = pool_w + ((size_t)gi * 128 + c0_) * 128; const float* sp = pool_scale + 128 * gi; const float* bp = w_out + (size_t)(512 + 128 * gi) * DM + n0;
#pragma unroll 2
            for (int d = 0; d < 128; d += 4) {
                f32x4v av[4], bv[4]; const f32x4v sv = *(const f32x4v*)(sp + d);
#pragma unroll
                for (int a = 0; a < 4; ++a) { av[a] = *(const f32x4v*)(ap + a * 128 + d) * sv; bv[a] = *(const f32x4v*)(bp + (size_t)(d + a) * DM); }
#pragma unroll
                for (int a = 0; a < 4; ++a)
#pragma unroll
                    for (int b = 0; b < 4; ++b) acc[a][b] += av[a][0] * bv[0][b] + av[a][1] * bv[1][b] + av[a][2] * bv[2][b] + av[a][3] * bv[3][b];
            }
#pragma unroll
            for (int b = 0; b < 4; ++b) *(u32x2v*)(WOUT + (size_t)(n0 + b) * KOUT + 512 + 128 * gi + c0_) = (u32x2v){pk2(acc[0][b], acc[1][b]), pk2(acc[2][b], acc[3][b])};
        }
        for (int it = gt; it < 8 * 64 * 128; it += ngt) { const int r = it & 127, d = (it >> 7) & 63, h = it >> 13; WUVT[it] = f2bf(w_uv[((size_t)h * 128 + r) * 64 + d]); }
    }
    transpose_tiles_map(c, WIN, DM, 2 * 64, [=](int k, int n) -> float {
            int src = -1;
            if (n < C_SM + 8) src = 1536 + (n - C_SM);
            else if (n < C_SM + 16) src = 3592 + (n - C_SM - 8);
            else if (n < C_SM + 20) src = 4560 + (n - C_SM - 16);
            return src >= 0 ? w_in[(size_t)k * DIN + src] * g1[k] : 0.f; },
        [=](int it, int& k0, int& n0) { k0 = 32 * (it & 63); n0 = C_SM + 32 * (it >> 6); });
}

__device__ __forceinline__ void ph_mixprep(const Ctx& c0, const bf16* U, const float* UF, const float* cw, const float* cb, const float* kvn, const float* dtb, bf16* XC, bf16* Y, bf16* CN, float* DT, bf16* KI) { const Ctx c = refresh(c0);
    const int gt = c.bid * NTHR + c.tid, ngt = c.nb * NTHR;
    for (int idx = gt; idx < (T / 4) * 128; idx += ngt) {
        const int t0 = (idx >> 7) * 4, c0 = (idx & 127) * 8, pos0 = t0 % L;
        u32x4v v[7];
#pragma unroll
        for (int i = 0; i < 7; ++i) v[i] = pos0 - 3 + i >= 0 ? *(const u32x4v*)(U + (size_t)(t0 - 3 + i) * NU + C_XBC + c0) : (u32x4v){0u, 0u, 0u, 0u};
        f32x4v wa[4], wb[4];
#pragma unroll
        for (int k = 0; k < 4; ++k) { wa[k] = *(const f32x4v*)(cw + k * 1024 + c0); wb[k] = *(const f32x4v*)(cw + k * 1024 + c0 + 4); }
        const f32x4v ba = *(const f32x4v*)(cb + c0), bb = *(const f32x4v*)(cb + c0 + 4);
        float x[7][8];
#pragma unroll
        for (int i = 0; i < 7; ++i) { const unsigned w_[4] = {v[i].x, v[i].y, v[i].z, v[i].w};
#pragma unroll
            for (int j = 0; j < 8; ++j) x[i][j] = bf2f((bf16)(w_[j >> 1] >> (16 * (j & 1)))); }
#pragma unroll
        for (int r = 0; r < 4; ++r) { float acc[8];
#pragma unroll
            for (int j = 0; j < 8; ++j) { acc[j] = j < 4 ? ba[j] : bb[j - 4];
#pragma unroll
                for (int k = 0; k < 4; ++k) acc[j] += (j < 4 ? wa[k][j] : wb[k][j - 4]) * x[r + k][j]; }
            *(u32x4v*)(XC + (size_t)(t0 + r) * 1024 + c0) = (u32x4v){pk2(siluf(acc[0]), siluf(acc[1])), pk2(siluf(acc[2]), siluf(acc[3])), pk2(siluf(acc[4]), siluf(acc[5])), pk2(siluf(acc[6]), siluf(acc[7]))}; }
    }
    for (int idx = gt; idx < (T / 4) * 64; idx += ngt) {
        const int t0 = (idx >> 6) * 4, c0 = (idx & 63) * 8, pos0 = t0 % L, gi = c0 >> 7;
        const bf16* up = U + (size_t)t0 * NU + C_POOL + c0;
#define POOL_BLK(W) { u32x4v v[W + 3]; _Pragma("unroll") for (int i = 0; i < W + 3; ++i) v[i] = pos0 - (W - 1) + i >= 0 ? *(const u32x4v*)(up + (ptrdiff_t)(i - (W - 1)) * NU) : (u32x4v){0u, 0u, 0u, 0u}; \
            _Pragma("unroll") for (int r = 0; r < 4; ++r) { float acc[8] = {0, 0, 0, 0, 0, 0, 0, 0}, self[8]; \
                _Pragma("unroll") for (int i = 0; i < W; ++i) { const u32x4v q_ = v[r + i]; const unsigned w_[4] = {q_.x, q_.y, q_.z, q_.w}; \
                    _Pragma("unroll") for (int j = 0; j < 8; ++j) { const float f = bf2f((bf16)(w_[j >> 1] >> (16 * (j & 1)))); acc[j] += f; if (i == W - 1) self[j] = f; } } \
                const float inv = 1.f / (float)min(pos0 + r + 1, W); \
                *(u32x4v*)(Y + (size_t)(t0 + r) * KOUT + 512 + c0) = (u32x4v){pk2(acc[0] * inv - self[0], acc[1] * inv - self[1]), pk2(acc[2] * inv - self[2], acc[3] * inv - self[3]), \
                    pk2(acc[4] * inv - self[4], acc[5] * inv - self[5]), pk2(acc[6] * inv - self[6], acc[7] * inv - self[7])}; } }
        if (gi == 0) POOL_BLK(2) else if (gi == 1) POOL_BLK(4) else if (gi == 2) POOL_BLK(8) else POOL_BLK(16)
    }
    for (int t = c.gw; t < T; t += c.ngw) {
        const int lane = c.lane;
        const unsigned v = *(const unsigned*)(U + (size_t)t * NU + C_DC + 2 * lane);
        const float a = bf2f((bf16)(v & 0xffff)), cc = bf2f((bf16)(v >> 16));
        const float rs = rsqrtf(wave_sum(a * a + cc * cc, lane) * (1.f / 128.f) + EPSF);
        *(unsigned*)(CN + (size_t)t * 128 + 2 * lane) = pk2(a * rs * kvn[2 * lane], cc * rs * kvn[2 * lane + 1]);
        if (lane < 8) DT[(size_t)t * 8 + lane] = softplusf(UF[(size_t)t * 32 + lane] + dtb[lane]);
        if (lane < 32) *(unsigned*)(KI + (size_t)t * 64 + 2 * lane) = *(const unsigned*)(U + (size_t)t * NU + C_KI + 2 * lane);
    }
}
__device__ __forceinline__ void ph_fcum(const Ctx& c0, const float* UF, const float* fb, float* FCUM) { const Ctx c = refresh(c0);
    const int lane = c.lane, w = c.wave;
    LAS float* tot = (LAS float*)c.lds;
    for (int bh = c.bid; bh < 64; bh += c.nb) {
        const int b = bh >> 3, h = bh & 7; const float bias = fb[h]; float v[9]; float carry = 0.f;
#pragma unroll
        for (int i = 0; i < 9; ++i) { const int p = 576 * w + 64 * i + lane; v[i] = p < L ? logsigmoidf(UF[(size_t)(b * L + p) * 32 + 8 + h] + bias) : 0.f; }
#pragma unroll
        for (int i = 0; i < 9; ++i) { float x = v[i];
#pragma unroll
            for (int o = 1; o < 64; o <<= 1) { const float n = lane_read(x, (lane - o) & 63); if (lane >= o) x += n; }
            x += carry; v[i] = x; carry = lane_read(x, 63); }
        if (lane == 0) tot[w] = carry;
        __syncthreads();
        float off = 0.f;
#pragma unroll
        for (int ww = 0; ww < NWAVE; ++ww) off += ww < w ? tot[ww] : 0.f;
#pragma unroll
        for (int i = 0; i < 9; ++i) { const int p = 576 * w + 64 * i + lane; if (p < L) FCUM[(size_t)bh * LKP + (p < 16 ? p : p + 48)] = -(v[i] + off) * 1.4426950408889634f; }
        if (w == 0 && lane >= 16) FCUM[(size_t)bh * LKP + lane] = -1e30f;
        __syncthreads();
    }
}
__device__ __forceinline__ unsigned fkey(float f) { const unsigned u = __float_as_uint(f); return (u & 0x80000000u) ? ~u : (u | 0x80000000u); }
__device__ __forceinline__ int crow(int r, int hi) { return (r & 3) + 8 * (r >> 2) + 4 * hi; }
typedef short bf16x8 __attribute__((ext_vector_type(8)));
typedef float f32x16 __attribute__((ext_vector_type(16)));
typedef float f32x2v __attribute__((ext_vector_type(2)));
typedef __bf16 bf16x2v __attribute__((ext_vector_type(2)));
#define MFMA32(a, b, c) __builtin_amdgcn_mfma_f32_32x32x16_bf16((a), (b), (c), 0, 0, 0)
#define WLANE64(lo, hi, m, sel) asm volatile("s_nop 1\n\tv_writelane_b32 %0, %2, %4\n\tv_writelane_b32 %1, %3, %4" : "+v"(lo), "+v"(hi) : "s"((unsigned)(m)), "s"((unsigned)((m) >> 32)), "n"(sel))
__device__ __forceinline__ float max3c(float a, float b, float c) { return __builtin_fmaxf(__builtin_fmaxf(a, b), c); }
__device__ __forceinline__ float max3f(float a, float b, float c) { float r; asm("v_max3_f32 %0, %1, %2, %3" : "=v"(r) : "v"(a), "v"(b), "v"(c)); return r; }
__device__ __forceinline__ unsigned cvtpk(float lo, float hi) { f32x2v v = {lo, hi}; bf16x2v b = __builtin_convertvector(v, bf16x2v); return __builtin_bit_cast(unsigned, b); }
__device__ __forceinline__ bf16x8 pack8(const f32x16& p, int s) {
    u32x4v r; r.x = cvtpk(p[8 * s], p[8 * s + 1]); r.y = cvtpk(p[8 * s + 2], p[8 * s + 3]); r.z = cvtpk(p[8 * s + 4], p[8 * s + 5]); r.w = cvtpk(p[8 * s + 6], p[8 * s + 7]);
    return __builtin_bit_cast(bf16x8, r);
}
constexpr int AT_KSTR = 72;
constexpr int AT_VSTR = 68;
constexpr int FOX_KB = 64 * AT_KSTR;
typedef short fx_s16x4 __attribute__((ext_vector_type(4)));
constexpr int FX_SLOTB = 8192, FX_LDS_K = 0, FX_LDS_V = 3 * FX_SLOTB, FX_LDS_B = 6 * FX_SLOTB;
#define FX_THR 8.f
#define FX_SBAR() __builtin_amdgcn_sched_barrier(0)
#define FX_PIN(x) asm volatile("" : "+v"(x))
#define FX_WAIT_BAR(N) asm volatile("s_waitcnt vmcnt(" #N ") lgkmcnt(0)\n\ts_barrier" ::: "memory")
__device__ __forceinline__ void fx_glds16(const void* g, unsigned lds_base) {
    unsigned sv; asm volatile("s_mov_b32 %0, m0\n\ts_mov_b32 m0, %2\n\ts_nop 0\n\tglobal_load_lds_dwordx4 %1, off\n\ts_mov_b32 m0, %0" : "=&s"(sv) : "v"(g), "s"(lds_base) : "memory"); }
__device__ __forceinline__ void fx_glds4(const void* g, unsigned lds_base) {
    unsigned sv; asm volatile("s_mov_b32 %0, m0\n\ts_mov_b32 m0, %2\n\ts_nop 0\n\tglobal_load_lds_dword %1, off\n\ts_mov_b32 m0, %0" : "=&s"(sv) : "v"(g), "s"(lds_base) : "memory"); }
__device__ __forceinline__ void fx_kload2(bf16x8* kf, const LAS char* kp, int d0) { kf[2 * d0] = *(const LAS bf16x8*)(kp + d0 * 2048); kf[2 * d0 + 1] = *(const LAS bf16x8*)(kp + d0 * 2048 + 512); }
__device__ __forceinline__ fx_s16x4 fx_vtr(const LAS char* p) { return __builtin_bit_cast(fx_s16x4, __builtin_amdgcn_ds_read_tr16_b64_v4i16((LAS fx_s16x4*)p)); }
__device__ __forceinline__ float fx_swapmax(float m) {
#if defined(__HIP_DEVICE_COMPILE__)
    const auto rr = __builtin_amdgcn_permlane32_swap(__float_as_uint(m), __float_as_uint(m), false, false); return max3f(__uint_as_float(rr[0]), __uint_as_float(rr[1]), __uint_as_float(rr[1]));
#else
    return m;
#endif
}
__device__ __forceinline__ float fx_swapsum(float m) {
#if defined(__HIP_DEVICE_COMPILE__)
    const auto rr = __builtin_amdgcn_permlane32_swap(__float_as_uint(m), __float_as_uint(m), false, false); return __uint_as_float(rr[0]) + __uint_as_float(rr[1]);
#else
    return m;
#endif
}
__device__ __forceinline__ float fx_rowmax(const f32x16& p0, const f32x16& p1) {
    float a = max3c(p0[0], p0[1], p1[0]), b = max3c(p0[2], p0[3], p1[1]); a = max3c(a, p1[2], p1[3]);
#pragma unroll
    for (int r = 4; r < 16; r += 4) { a = max3c(a, p0[r], p0[r + 1]); b = max3c(b, p0[r + 2], p0[r + 3]); a = max3c(a, p1[r], p1[r + 1]); b = max3c(b, p1[r + 2], p1[r + 3]); }
    return fx_swapmax(max3c(a, b, b)); }
__device__ __forceinline__ void fx_cmask(f32x16& p0, f32x16& p1, int jb, int qrel, int hi) {
    const int kb = 64 * jb + 4 * hi;
#pragma unroll
    for (int r = 0; r < 16; ++r) { const int kv = kb + (r & 3) + 8 * (r >> 2); if (kv > qrel) p0[r] = -__builtin_inff(); if (kv + 32 > qrel) p1[r] = -__builtin_inff(); } }

__device__ __forceinline__ void fox_unit(const Ctx& c, int b, int h, int j, const bf16* U, const float* BT, bf16* Y) {
    const int lane = c.lane, r32 = lane & 31, hi = lane >> 5, wid = c.wave;
    const int q0 = 16 + 256 * (j - 1), NT = 1 + 4 * j;
    const bf16* Ub = U + (size_t)(b * L) * NU;
    const unsigned lds0 = (unsigned)(size_t)c.lds;
    const bf16* ksrc = Ub + (size_t)lane * NU + C_FK + 64 * h + wid * 8;
    const bf16* vsrc = Ub + (size_t)(16 * (wid & 3) + (lane >> 2)) * NU + C_FV + 64 * h + (wid >> 2) * 32 + (lane & 3) * 8;
    const float* bsrc = BT + lane;
    const unsigned kdst = lds0 + FX_LDS_K + wid * 1024, vdst = lds0 + FX_LDS_V + wid * 1024, bdst = lds0 + FX_LDS_B + wid * 256;
#define FX_TROW(t) ((t) == 0 ? 0 : 64 * (t) - 48)
#define FX_DMA_K(t, slot) fx_glds16(ksrc + (size_t)FX_TROW(t) * NU, (unsigned)__builtin_amdgcn_readfirstlane(kdst + (slot)))
#define FX_DMA_V(t, slot) fx_glds16(vsrc + (size_t)FX_TROW(t) * NU, (unsigned)__builtin_amdgcn_readfirstlane(vdst + (slot)))
#define FX_DMA_B(t, slot) fx_glds4(bsrc + 64 * (t), (unsigned)__builtin_amdgcn_readfirstlane(bdst + ((slot) >> 2)))
    const LAS char* vp0 = (const LAS char*)c.lds + FX_LDS_V + ((lane >> 4) & 1) * 32 + (lane & 3) * 8 + (4 * hi + ((lane & 15) >> 2)) * 64;
    const LAS char* kp0 = (const LAS char*)c.lds + FX_LDS_K + hi * 1024 + r32 * 16;
    const LAS char* bp0 = (const LAS char*)c.lds + FX_LDS_B + wid * 256 + hi * 16;
    FX_DMA_K(0, 0); FX_DMA_B(0, 0); FX_DMA_V(0, 0); FX_DMA_K(1, FX_SLOTB); FX_DMA_B(1, FX_SLOTB);
    bf16x8 qr[4];
#pragma unroll
    for (int d0 = 0; d0 < 4; ++d0) qr[d0] = *(const bf16x8*)(Ub + (size_t)(q0 + 32 * wid + r32) * NU + C_FQ + 64 * h + 16 * d0 + 8 * hi);
    const float bq = BT[q0 + 32 * wid + r32 + 48];
    float mhat = 0.f, l_reg = 0.f, fsc = 1.f; f32x16 o[2];
#pragma unroll
    for (int r = 0; r < 16; ++r) { o[0][r] = 0.f; o[1][r] = 0.f; }
    const int qrel = wid * 32 + r32; bool resc = false;
    f32x16 pA0, pA1, pB0, pB1; bf16x8 kf[8]; fx_s16x4 vlo[8], vhi[8]; u32x4v pw0, pw1, pw2, pw3;
    int sl_prev = 0, sl_cur = 0, sl_next = FX_SLOTB;
#define FX_ROT() do { sl_prev = sl_cur; sl_cur = sl_next; sl_next = (sl_next == 2 * FX_SLOTB) ? 0 : sl_next + FX_SLOTB; } while (0)
#define FX_EX(v) __builtin_amdgcn_exp2f((v) + nmh)
#define FX_RESC() do { if (resc) { _Pragma("unroll") for (int d_ = 0; d_ < 2; ++d_) _Pragma("unroll") for (int r = 0; r < 16; ++r) o[d_][r] *= fsc; } } while (0)
#define FX_BIAS(X0, X1, bp, i4) do { const f32x4v f0_ = *(const LAS f32x4v*)((bp) + 32 * (i4)), f1_ = *(const LAS f32x4v*)((bp) + 128 + 32 * (i4)); \
        _Pragma("unroll") for (int e_ = 0; e_ < 4; ++e_) { X0[4 * (i4) + e_] = f0_[e_]; X1[4 * (i4) + e_] = f1_[e_]; } } while (0)
    FX_DMA_K(2, 2 * FX_SLOTB); FX_DMA_B(2, 2 * FX_SLOTB);
    FX_WAIT_BAR(4);
    _Pragma("unroll") for (int i4 = 0; i4 < 4; ++i4) FX_BIAS(pA0, pA1, bp0, i4);
    _Pragma("unroll") for (int d0 = 0; d0 < 4; ++d0) fx_kload2(kf, kp0, d0);
    pA0 = MFMA32(kf[0], qr[0], pA0); pA1 = MFMA32(kf[1], qr[0], pA1); pA0 = MFMA32(kf[2], qr[1], pA0); pA1 = MFMA32(kf[3], qr[1], pA1);
    pA0 = MFMA32(kf[4], qr[2], pA0); pA1 = MFMA32(kf[5], qr[2], pA1); pA0 = MFMA32(kf[6], qr[3], pA0); pA1 = MFMA32(kf[7], qr[3], pA1);
    { const float rm = fx_rowmax(pA0, pA1); mhat = fmaxf(rm, bq); const float nmh = -mhat;
#pragma unroll
      for (int r = 0; r < 16; ++r) { pA0[r] = FX_EX(pA0[r]); pA1[r] = FX_EX(pA1[r]); } }
    FX_WAIT_BAR(0);
    FX_DMA_K(3, 0); FX_DMA_B(3, 0); FX_DMA_V(1, FX_SLOTB); FX_ROT();
    _Pragma("unroll") for (int d0 = 0; d0 < 4; ++d0) fx_kload2(kf, kp0 + sl_cur, d0);
    _Pragma("unroll") for (int i4 = 0; i4 < 4; ++i4) FX_BIAS(pB0, pB1, bp0 + (sl_cur >> 2), i4);
    FX_WAIT_BAR(3);
#define FX_PKW(P, i) cvtpk(P[i], P[i + 1])
#define FX_PAF(k) __builtin_bit_cast(bf16x8, pw##k)
#define FX_VFR(i) (bf16x8){vlo[i][0], vlo[i][1], vlo[i][2], vlo[i][3], vhi[i][0], vhi[i][1], vhi[i][2], vhi[i][3]}
#define FX_VRD(i) do { vlo[i] = fx_vtr(vp_ + (((i) >> 2) * 4096 + ((i) & 3) * 1024)); vhi[i] = fx_vtr(vp_ + (((i) >> 2) * 4096 + ((i) & 3) * 1024 + 512)); } while (0)
#define FX_KRD(G, d0) do { if (G) { fx_kload2(kf, kp0 + sl_next, d0); FX_SBAR(); } } while (0)
#define FX_BRD(G, X0, X1, i4) do { if (G) { FX_BIAS(X0, X1, bp0 + (sl_next >> 2), i4); FX_SBAR(); } } while (0)
#define FX_GAPA(MF, a0, a1, a2, a3, W0, W1, PW) do { MF; sacc += a0; sacc += a1; sacc += a2; sacc += a3; W0; W1; FX_PIN(PW); FX_PIN(sacc); FX_SBAR(); } while (0)
#define FX_GAPB(MF, X, i) do { MF; X[i] = FX_EX(X[i]); X[i + 1] = FX_EX(X[i + 1]); X[i + 2] = FX_EX(X[i + 2]); X[i + 3] = FX_EX(X[i + 3]); FX_PIN(X); FX_SBAR(); } while (0)
#define FX_STEP(C0, C1, P0, P1, t, MASK, GK, GV, GL) do { FX_SBAR(); \
    const LAS char* vp_ = vp0 + sl_prev; \
    FX_VRD(0); FX_SBAR(); float sacc = P0[0] + P0[1]; \
                          FX_GAPA(C0 = MFMA32(kf[0], qr[0], C0), P0[2], P0[3], P0[4], P0[5],     pw0[0] = FX_PKW(P0, 0),  pw0[1] = FX_PKW(P0, 2),  pw0); \
    FX_VRD(4); FX_SBAR(); FX_GAPA(C1 = MFMA32(kf[1], qr[0], C1), P0[6], P0[7], P0[8], P0[9],     pw0[2] = FX_PKW(P0, 4),  pw0[3] = FX_PKW(P0, 6),  pw0); \
    FX_VRD(1); FX_SBAR(); FX_GAPA(C0 = MFMA32(kf[2], qr[1], C0), P0[10], P0[11], P0[12], P0[13], pw1[0] = FX_PKW(P0, 8),  pw1[1] = FX_PKW(P0, 10), pw1); \
    FX_VRD(5); FX_SBAR(); FX_GAPA(C1 = MFMA32(kf[3], qr[1], C1), P0[14], P0[15], P1[0], P1[1],   pw1[2] = FX_PKW(P0, 12), pw1[3] = FX_PKW(P0, 14), pw1); \
    FX_VRD(2); FX_SBAR(); FX_GAPA(C0 = MFMA32(kf[4], qr[2], C0), P1[2], P1[3], P1[4], P1[5],     pw2[0] = FX_PKW(P1, 0),  pw2[1] = FX_PKW(P1, 2),  pw2); \
    FX_VRD(6); FX_SBAR(); FX_GAPA(C1 = MFMA32(kf[5], qr[2], C1), P1[6], P1[7], P1[8], P1[9],     pw2[2] = FX_PKW(P1, 4),  pw2[3] = FX_PKW(P1, 6),  pw2); \
    FX_VRD(3); FX_SBAR(); FX_GAPA(C0 = MFMA32(kf[6], qr[3], C0), P1[10], P1[11], P1[12], P1[13], pw3[0] = FX_PKW(P1, 8),  pw3[1] = FX_PKW(P1, 10), pw3); \
    FX_VRD(7); FX_SBAR(); FX_GAPA(C1 = MFMA32(kf[7], qr[3], C1), P1[14], P1[15], 0.f, 0.f,       pw3[2] = FX_PKW(P1, 12), pw3[3] = FX_PKW(P1, 14), pw3); \
    l_reg += sacc; \
    if (GK) { FX_DMA_K((t) + 3, sl_cur); FX_DMA_B((t) + 3, sl_cur); } if (GV) FX_DMA_V((t) + 1, sl_next); \
    if (MASK) fx_cmask(C0, C1, (t) - (NT - 4), qrel, hi); \
    { const float rm = fx_rowmax(C0, C1) - mhat; resc = false; \
      if (__builtin_expect(__ballot(rm > FX_THR) != 0ull, 0)) { const float dl = fmaxf(rm, 0.f); mhat += dl; fsc = __builtin_amdgcn_exp2f(-dl); l_reg *= fsc; resc = true; } } \
    const float nmh = -mhat; FX_SBAR(); \
    FX_GAPB(o[0] = MFMA32(FX_VFR(0), FX_PAF(0), o[0]), C0, 0);                    FX_GAPB(o[1] = MFMA32(FX_VFR(4), FX_PAF(0), o[1]), C0, 4); \
    FX_KRD(GL, 0); FX_GAPB(o[0] = MFMA32(FX_VFR(1), FX_PAF(1), o[0]), C0, 8);     FX_KRD(GL, 1); FX_GAPB(o[1] = MFMA32(FX_VFR(5), FX_PAF(1), o[1]), C0, 12); \
    FX_KRD(GL, 2); FX_GAPB(o[0] = MFMA32(FX_VFR(2), FX_PAF(2), o[0]), C1, 0);     FX_KRD(GL, 3); FX_GAPB(o[1] = MFMA32(FX_VFR(6), FX_PAF(2), o[1]), C1, 4); \
    FX_BRD(GL, P0, P1, 0); FX_BRD(GL, P0, P1, 1); FX_GAPB(o[0] = MFMA32(FX_VFR(3), FX_PAF(3), o[0]), C1, 8); \
    FX_BRD(GL, P0, P1, 2); FX_BRD(GL, P0, P1, 3); FX_GAPB(o[1] = MFMA32(FX_VFR(7), FX_PAF(3), o[1]), C1, 12); \
    } while (0)
#define FX_ENDW(tt) do { if ((tt) + 3 < NT) { FX_WAIT_BAR(3); } else if ((tt) + 2 < NT) { FX_WAIT_BAR(1); } else { FX_WAIT_BAR(0); } } while (0)
    FX_STEP(pB0, pB1, pA0, pA1, 1, true, true, true, true); FX_ENDW(1); FX_RESC(); FX_ROT();
    int t = 2;
    for (; t + 5 < NT; t += 2) {
        FX_STEP(pA0, pA1, pB0, pB1, t, false, true, true, true);     FX_WAIT_BAR(3); FX_RESC(); FX_ROT();
        FX_STEP(pB0, pB1, pA0, pA1, t + 1, false, true, true, true); FX_WAIT_BAR(3); FX_RESC(); FX_ROT();
    }
    for (; t + 1 < NT; t += 2) {
        FX_STEP(pA0, pA1, pB0, pB1, t, true, (t + 3 < NT), (t + 1 < NT), (t + 1 < NT));         FX_ENDW(t);     FX_RESC(); FX_ROT();
        FX_STEP(pB0, pB1, pA0, pA1, t + 1, true, (t + 4 < NT), (t + 2 < NT), (t + 2 < NT));     FX_ENDW(t + 1); FX_RESC(); FX_ROT();
    }
    FX_STEP(pA0, pA1, pB0, pB1, NT - 1, true, false, false, false); FX_RESC();
    { float sacc = pA0[0] + pA0[1];
#pragma unroll
      for (int r = 2; r < 16; ++r) sacc += pA0[r];
#pragma unroll
      for (int r = 0; r < 16; ++r) sacc += pA1[r];
      l_reg += sacc;
      pw0 = (u32x4v){FX_PKW(pA0, 0), FX_PKW(pA0, 2), FX_PKW(pA0, 4), FX_PKW(pA0, 6)}; pw1 = (u32x4v){FX_PKW(pA0, 8), FX_PKW(pA0, 10), FX_PKW(pA0, 12), FX_PKW(pA0, 14)};
      pw2 = (u32x4v){FX_PKW(pA1, 0), FX_PKW(pA1, 2), FX_PKW(pA1, 4), FX_PKW(pA1, 6)}; pw3 = (u32x4v){FX_PKW(pA1, 8), FX_PKW(pA1, 10), FX_PKW(pA1, 12), FX_PKW(pA1, 14)};
      const LAS char* vp_ = vp0 + sl_cur; _Pragma("unroll") for (int i = 0; i < 8; ++i) FX_VRD(i);
      o[0] = MFMA32(FX_VFR(0), FX_PAF(0), o[0]); o[1] = MFMA32(FX_VFR(4), FX_PAF(0), o[1]); o[0] = MFMA32(FX_VFR(1), FX_PAF(1), o[0]); o[1] = MFMA32(FX_VFR(5), FX_PAF(1), o[1]);
      o[0] = MFMA32(FX_VFR(2), FX_PAF(2), o[0]); o[1] = MFMA32(FX_VFR(6), FX_PAF(2), o[1]); o[0] = MFMA32(FX_VFR(3), FX_PAF(3), o[0]); o[1] = MFMA32(FX_VFR(7), FX_PAF(3), o[1]); }
    l_reg = fx_swapsum(l_reg);
    {   const float inv = __builtin_amdgcn_rcpf(l_reg); bf16* yr = Y + (size_t)(b * L + q0 + 32 * wid + r32) * KOUT + 1024 + 64 * h;
#pragma unroll
        for (int i4 = 0; i4 < 4; ++i4) {
            *(u32x2v*)(yr + 8 * i4 + 4 * hi) = (u32x2v){cvtpk(o[0][4 * i4] * inv, o[0][4 * i4 + 1] * inv), cvtpk(o[0][4 * i4 + 2] * inv, o[0][4 * i4 + 3] * inv)};
            *(u32x2v*)(yr + 32 + 8 * i4 + 4 * hi) = (u32x2v){cvtpk(o[1][4 * i4] * inv, o[1][4 * i4 + 1] * inv), cvtpk(o[1][4 * i4 + 2] * inv, o[1][4 * i4 + 3] * inv)};
        }
    }
    asm volatile("s_waitcnt lgkmcnt(0)\n\ts_barrier" ::: "memory");
#undef FX_TROW
#undef FX_DMA_K
#undef FX_DMA_V
#undef FX_DMA_B
#undef FX_ROT
#undef FX_EX
#undef FX_RESC
#undef FX_BIAS
#undef FX_PKW
#undef FX_PAF
#undef FX_VFR
#undef FX_VRD
#undef FX_KRD
#undef FX_BRD
#undef FX_GAPA
#undef FX_GAPB
#undef FX_STEP
#undef FX_ENDW
}
__device__ __forceinline__ void ph_fox(const Ctx& c0, const bf16* U, const float* FCUM, bf16* Y) {
    const Ctx c = refresh(c0);
    LAS bf16* KS = (LAS bf16*)c.lds;
    LAS bf16* VT = KS + 2 * FOX_KB;
    LAS float* FB = (LAS float*)(c.lds + 4 * FOX_KB * 2);
    const int lane = c.lane, w = c.wave, r32 = lane & 31, hi = lane >> 5, tid = c.tid;
    const float LOG2E = 1.4426950408889634f;
    typedef short s16x4v __attribute__((ext_vector_type(4)));
    for (int it = c.bid; it < 64 * 17; it += c.nb) {
        const int rnd = it >> 8, cu = it & 255, k4 = cu >> 6, bh = cu & 63, b = bh >> 3, h = bh & 7;
        const int j = rnd == 0 ? 16 - k4 : rnd == 1 ? 9 + k4 : rnd == 2 ? 8 - k4 : rnd == 3 ? 1 + k4 : 0;
        if (j > 0) { fox_unit(c, b, h, j, U, FCUM + (size_t)bh * LKP, Y); continue; }
        const int q0 = j == 0 ? 0 : 16 + 256 * (j - 1), qrow = q0 + 32 * w + r32, ntiles = 1 + 4 * j, qmax = q0 + 32 * w + 31;
        const bool wave_on = (j > 0) || (w == 0), row_ok = (j > 0) || (r32 < 16);
        const bf16* Ub = U + (size_t)(b * L) * NU;
        bf16x8 qf[4];
#pragma unroll
        for (int s = 0; s < 4; ++s) qf[s] = (bf16x8){0, 0, 0, 0, 0, 0, 0, 0};
        if (wave_on && row_ok) {
#pragma unroll
            for (int s = 0; s < 4; ++s) qf[s] = *(const bf16x8*)(Ub + (size_t)qrow * NU + C_FQ + 64 * h + 16 * s + 8 * hi);
        }
        f32x16 o0, o1;
#pragma unroll
        for (int r = 0; r < 16; ++r) { o0[r] = 0.f; o1[r] = 0.f; }
        float m = -1e30f, l = 0.f;
        const float* fc = FCUM + (size_t)bh * LKP;
        const bf16* kg = Ub + (size_t)(tid >> 3) * NU + C_FK + 64 * h + 8 * (tid & 7);
        const bf16* vg = Ub + (size_t)lane * NU + C_FV + 64 * h + 8 * w;
#define FOX_KB0(t) ((t) == 0 ? 0 : 16 + 64 * ((t) - 1))
#define FOX_PUT_K(buf, kr, fr) do { *(LAS u32x4v*)(KS + (buf) * FOX_KB + (tid >> 3) * AT_KSTR + 8 * (tid & 7)) = kr; if (tid < 64) FB[(buf) * 64 + tid] = fr; } while (0)
#define FOX_PUT_V(buf, vr) do { const unsigned vv_[4] = {vr.x, vr.y, vr.z, vr.w}; \
            _Pragma("unroll") for (int e = 0; e < 8; ++e) VT[(buf) * FOX_KB + (8 * w + e) * AT_VSTR + lane] = (bf16)(vv_[e >> 1] >> (16 * (e & 1))); } while (0)
#define FOX_GET_K(t, kr, fr) do { const int kb_ = FOX_KB0(t); kr = *(const u32x4v*)(kg + (size_t)kb_ * NU); if (tid < 64) fr = fc[kb_ + tid]; } while (0)
#define FOX_GET_V(t, vr) do { vr = *(const u32x4v*)(vg + (size_t)FOX_KB0(t) * NU); } while (0)
#define FOX_QK(buf, P0, P1) do { const LAS float* fb_ = FB + (buf) * 64; \
            _Pragma("unroll") for (int i4 = 0; i4 < 4; ++i4) { const f32x4v f0 = *(const LAS f32x4v*)(fb_ + 8 * i4 + 4 * hi), f1 = *(const LAS f32x4v*)(fb_ + 32 + 8 * i4 + 4 * hi); \
                _Pragma("unroll") for (int e = 0; e < 4; ++e) { P0[4 * i4 + e] = f0[e]; P1[4 * i4 + e] = f1[e]; } } \
            _Pragma("unroll") for (int s = 0; s < 4; ++s) { \
                const bf16x8 a0 = *(const LAS bf16x8*)(KS + (buf) * FOX_KB + r32 * AT_KSTR + 16 * s + 8 * hi), a1 = *(const LAS bf16x8*)(KS + (buf) * FOX_KB + (32 + r32) * AT_KSTR + 16 * s + 8 * hi); \
                P0 = MFMA32(a0, qf[s], P0); P1 = MFMA32(a1, qf[s], P1); } } while (0)
        u32x4v kreg, vreg; float fbreg = 0.f;
        FOX_GET_K(0, kreg, fbreg); FOX_GET_V(0, vreg);
        FOX_PUT_K(0, kreg, fbreg); FOX_PUT_V(0, vreg);
        if (ntiles > 1) { FOX_GET_K(1, kreg, fbreg); FOX_GET_V(1, vreg); FOX_PUT_K(1, kreg, fbreg); }
        if (ntiles > 2) FOX_GET_K(2, kreg, fbreg);
        __syncthreads();
        f32x16 pc0, pc1, pn0, pn1;
#pragma unroll
        for (int r = 0; r < 16; ++r) { pc0[r] = 0.f; pc1[r] = 0.f; pn0[r] = 0.f; pn1[r] = 0.f; }
        if (wave_on) FOX_QK(0, pc0, pc1);
        __syncthreads();
        for (int i = 0; i < ntiles; ++i) {
            const int cur = i & 1, kb = FOX_KB0(i), kbn = FOX_KB0(i + 1);
            if (i + 2 < ntiles) FOX_PUT_K(cur, kreg, fbreg);
            if (i + 1 < ntiles) FOX_PUT_V(cur ^ 1, vreg);
            if (i + 3 < ntiles) FOX_GET_K(i + 3, kreg, fbreg);
            if (i + 2 < ntiles) FOX_GET_V(i + 2, vreg);
            const bool on_next = wave_on && (i + 1 < ntiles) && kbn <= qmax, on_cur = wave_on && kb <= qmax;
            if (on_next) FOX_QK(cur ^ 1, pn0, pn1);
            if (on_cur) {
                if (i == 0 || kb + 63 > q0 + 32 * w) {
                    const int klim = i == 0 ? 16 : 64;
#pragma unroll
                    for (int r = 0; r < 16; ++r) { const int k0 = crow(r, hi), k1 = 32 + k0;
                        if (!(k0 < klim && kb + k0 <= qrow)) pc0[r] = -1e30f;
                        if (!(k1 < klim && kb + k1 <= qrow)) pc1[r] = -1e30f; }
                }
                float mx = max3c(pc0[0], pc1[0], pc0[1]), mx2 = max3c(pc1[1], pc0[2], pc1[2]);
#pragma unroll
                for (int r = 3; r < 15; r += 2) { mx = max3c(mx, pc0[r], pc1[r]); mx2 = max3c(mx2, pc0[r + 1], pc1[r + 1]); }
                mx = max3c(mx, pc0[15], pc1[15]); mx = max3c(mx, mx2, mx2);
                const float mn = max3c(m, mx, lane_read(mx, lane ^ 32)), alpha = __builtin_amdgcn_exp2f(m - mn); const bool grew = __ballot(mn > m) != 0ull; m = mn;
                float sum = 0.f;
#pragma unroll
                for (int r = 0; r < 16; ++r) { pc0[r] = __builtin_amdgcn_exp2f(pc0[r] - mn); pc1[r] = __builtin_amdgcn_exp2f(pc1[r] - mn); sum += pc0[r] + pc1[r]; }
                l = l * alpha + sum;
                if (grew) {
#pragma unroll
                    for (int r = 0; r < 16; ++r) { o0[r] *= alpha; o1[r] *= alpha; } }
#pragma unroll
                for (int blk = 0; blk < 2; ++blk)
#pragma unroll
                    for (int s = 0; s < 2; ++s) {
                        const bf16x8 xs = pack8(blk == 0 ? pc0 : pc1, s);
                        const LAS bf16* vp = VT + cur * FOX_KB + r32 * AT_VSTR + 32 * blk + 16 * s + 4 * hi;
                        const s16x4v lo0 = *(const LAS s16x4v*)vp, hi0 = *(const LAS s16x4v*)(vp + 8);
                        const s16x4v lo1 = *(const LAS s16x4v*)(vp + 32 * AT_VSTR), hi1 = *(const LAS s16x4v*)(vp + 32 * AT_VSTR + 8);
                        const bf16x8 pa0 = __builtin_shufflevector(lo0, hi0, 0, 1, 2, 3, 4, 5, 6, 7), pa1 = __builtin_shufflevector(lo1, hi1, 0, 1, 2, 3, 4, 5, 6, 7);
                        o0 = MFMA32(pa0, xs, o0); o1 = MFMA32(pa1, xs, o1);
                    }
            }
            pc0 = pn0; pc1 = pn1;
            __syncthreads();
        }
        l += lane_read(l, lane ^ 32);
        if (wave_on && row_ok) {
            const float inv = 1.f / l; bf16* yr = Y + (size_t)(b * L + qrow) * KOUT + 1024 + 64 * h;
#pragma unroll
            for (int i4 = 0; i4 < 4; ++i4) {
                *(u32x2v*)(yr + 8 * i4 + 4 * hi) = (u32x2v){cvtpk(o0[4 * i4] * inv, o0[4 * i4 + 1] * inv), cvtpk(o0[4 * i4 + 2] * inv, o0[4 * i4 + 3] * inv)};
                *(u32x2v*)(yr + 32 + 8 * i4 + 4 * hi) = (u32x2v){cvtpk(o1[4 * i4] * inv, o1[4 * i4 + 1] * inv), cvtpk(o1[4 * i4 + 2] * inv, o1[4 * i4 + 3] * inv)};
            }
        }
    }
}
constexpr int DSA_LIST_OFF = 150016  , DSA_BUF_ELEMS = 17920  , DSA_SC_STR = 4160, DSA_MW_OFF = 8 * DSA_SC_STR * 4  , DSA_KSTR = 136, DSA_VT_OFF = 64 * DSA_KSTR * 2  , DSA_RING_OFF = 73728  ;
__device__ __forceinline__ void ph_dsa(const Ctx& c0, const bf16* U, const float* UF, const bf16* CN, const bf16* KI) {
    const Ctx c = refresh(c0);
    LAS unsigned* SC = (LAS unsigned*)c.lds;
    LAS u64* MW = (LAS u64*)(c.lds + DSA_MW_OFF);
    LAS bf16* KS = (LAS bf16*)c.lds;
    LAS bf16* VT = (LAS bf16*)(c.lds + DSA_VT_OFF);
    const int lane0 = c.lane, w0 = c.wave;
    const float LOG2E = 1.4426950408889634f;
    for (int it = c.bid; it < 1032; it += c.nb) {
        int w_tk = w0; asm volatile("" : "+s"(w_tk)); const int w = w_tk;
        int lane_tk = lane0; asm volatile("" : "+v"(lane_tk)); const int lane = lane_tk, r32 = lane & 31, hi = lane >> 5, tid = w * 64 + lane;
        const int rnd = it >> 8, cu = it & 255, g16 = cu >> 4, wi16 = cu & 15;
        const int ch = rnd == 0 ? 64 - g16 : rnd == 1 ? 33 + g16 : rnd == 2 ? 32 - g16 : rnd == 3 ? 1 + g16 : 0;
        const int b = rnd == 4 ? cu : (wi16 >> 1), half = rnd == 4 ? 0 : (wi16 & 1);
        const int p0q = ch == 0 ? 0 : 16 + 64 * (ch - 1) + 32 * half, nq = ch == 0 ? 16 : 32, nadm = ch == 0 ? 16 : 16 + 64 * ch, nw = ch + 1;
        const int t0 = b * L + p0q;
        const bf16* Ub = U + (size_t)(b * L) * NU;
        if (nadm <= TOPK) {
            for (int i = tid; i < 32 * 65; i += NTHR) { const int wd = i % 65; const int lo = 64 * wd; const int nb_ = nadm - lo;
                MW[i] = (wd < nw && nb_ > 0) ? (nb_ >= 64 ? ~0ull : ((1ull << nb_) - 1ull)) : 0ull; }
            __syncthreads();
        } else {
            const int nkb = 2 * nw;
#pragma unroll 1
            for (int sb = 0; sb < 4; ++sb) {
                const int tq = t0 + 8 * sb;
                for (int rs_ = 0; rs_ < REP_SCORE; ++rs_) {
                    bf16x8 aq[4]; float wq[4][4];
#pragma unroll
                    for (int s = 0; s < 4; ++s) aq[s] = *(const bf16x8*)(U + (size_t)(tq + (r32 >> 2)) * NU + C_QI + 64 * (r32 & 3) + 32 * hi + 8 * s);
#pragma unroll
                    for (int i4 = 0; i4 < 4; ++i4) { const f32x4v t4 = *(const f32x4v*)(UF + (size_t)(tq + 2 * i4 + hi) * 32 + 16); wq[i4][0] = t4[0]; wq[i4][1] = t4[1]; wq[i4][2] = t4[2]; wq[i4][3] = t4[3]; }
                    const bf16* kib = KI + (size_t)(b * L) * 64 + (size_t)r32 * 64 + 32 * hi;
                    bf16x8 bk[4], bn[4], bm[4];
#pragma unroll
                    for (int s = 0; s < 4; ++s) { bk[s] = *(const bf16x8*)(kib + (size_t)(32 * w) * 64 + 8 * s); bn[s] = bk[s]; bm[s] = bk[s]; }
                    if (w + NWAVE < nkb) {
#pragma unroll
                        for (int s = 0; s < 4; ++s) bn[s] = *(const bf16x8*)(kib + (size_t)(32 * (w + NWAVE)) * 64 + 8 * s); }
#pragma unroll 1
                    for (int kb = w; kb < nkb; kb += NWAVE) {
                        if (kb + 2 * NWAVE < nkb) {
#pragma unroll
                            for (int s = 0; s < 4; ++s) bm[s] = *(const bf16x8*)(kib + (size_t)(32 * (kb + 2 * NWAVE)) * 64 + 8 * s); }
                        const int key = 32 * kb + r32; f32x16 acc;
#pragma unroll
                        for (int r = 0; r < 16; ++r) acc[r] = 0.f;
#pragma unroll
                        for (int s = 0; s < 4; ++s) acc = MFMA32(aq[s], bk[s], acc);
#pragma unroll
                        for (int i4 = 0; i4 < 4; ++i4) {
                            float s = wq[i4][0] * fmaxf(acc[4 * i4], 0.f) + wq[i4][1] * fmaxf(acc[4 * i4 + 1], 0.f) + wq[i4][2] * fmaxf(acc[4 * i4 + 2], 0.f) + wq[i4][3] * fmaxf(acc[4 * i4 + 3], 0.f);
                            asm("v_add_f32 %0, 0, %0" : "+v"(s));
                            unsigned kv = fkey(s); if (32 * kb + 31 >= nadm) kv = key < nadm ? kv : 0u;
                            SC[(2 * i4 + hi) * DSA_SC_STR + key] = kv;
                        }
#pragma unroll
                        for (int s = 0; s < 4; ++s) { bk[s] = bn[s]; bn[s] = bm[s]; }
                    }
                }
                __syncthreads();
                for (int rs_ = 0; rs_ < REP_SEL; ++rs_) {
                    unsigned kk[65];
#pragma unroll
                    for (int j = 0; j < 65; ++j) kk[j] = 0u;
#define DSA_BUCKETS(F) { F(0, 16) if (nw > 16) { F(16, 32) } if (nw > 32) { F(32, 48) } if (nw > 48) { F(48, 64) } if (nw > 64) { F(64, 65) } }
#define DSA_LOAD(j0, j1) _Pragma("unroll") for (int j = j0; j < j1; ++j) kk[j] = SC[w * DSA_SC_STR + 64 * j + lane];
                    DSA_BUCKETS(DSA_LOAD)
#pragma unroll
                    for (int j = 0; j < 65; ++j) if (j >= 5) kk[j] = j < nw ? kk[j] : 0u;
#define DSA_C4(a, b, c_, d) asm volatile("v_cmp_ge_u32_e64 %1, %5, %9\n\tv_cmp_ge_u32_e64 %2, %6, %9\n\tv_cmp_ge_u32_e64 %3, %7, %9\n\tv_cmp_ge_u32_e64 %4, %8, %9\n\t" \
                        "v_addc_co_u32_e64 %0, vcc, 0, %0, %1\n\tv_addc_co_u32_e64 %0, vcc, 0, %0, %2\n\tv_addc_co_u32_e64 %0, vcc, 0, %0, %3\n\tv_addc_co_u32_e64 %0, vcc, 0, %0, %4" \
                        : "+v"(nl_), "=&s"(m0_), "=&s"(m1_), "=&s"(m2_), "=&s"(m3_) : "v"(a), "v"(b), "v"(c_), "v"(d), "v"(cand_) : "vcc");
#define DSA_CNT16(j0, j1) if (j1 - j0 == 16) { DSA_C4(kk[j0], kk[j0 + 1], kk[j0 + 2], kk[j0 + 3]) DSA_C4(kk[j0 + 4], kk[j0 + 5], kk[j0 + 6], kk[j0 + 7]) DSA_C4(kk[j0 + 8], kk[j0 + 9], kk[j0 + 10], kk[j0 + 11]) DSA_C4(kk[j0 + 12], kk[j0 + 13], kk[j0 + 14], kk[j0 + 15]) } \
                        else { nl_ += kk[64] >= cand_ ? 1 : 0; }
#define DSA_COUNT(CAND, N) { const unsigned cand_ = (CAND); int nl_ = 0; u64 m0_, m1_, m2_, m3_; DSA_BUCKETS(DSA_CNT16) N = 0; \
                        _Pragma("unroll") for (int k_ = 0; k_ < 7; ++k_) N += __popcll(__ballot((nl_ >> k_) & 1)) << k_; }
                    unsigned kmax = 0u;
#define DSA_MAX(j0, j1) _Pragma("unroll") for (int j = j0; j < j1; ++j) kmax = kk[j] > kmax ? kk[j] : kmax;
                    DSA_BUCKETS(DSA_MAX)
#pragma unroll
                    for (int o = 1; o < 64; o <<= 1) { const unsigned t_ = (unsigned)lane_readi((int)kmax, lane ^ o); kmax = t_ > kmax ? t_ : kmax; }
                    kmax = (unsigned)__builtin_amdgcn_readfirstlane((int)kmax);
                    unsigned lo = 0u, hi = (kmax >> 23) + 1u, tau = 0u; int nhi = 0, nlo = -1; bool exact = false;
                    {   unsigned step = 1u;
#pragma unroll 1
                        while (hi - lo > 1u) {
                            const unsigned e = step ? (hi - lo > step ? hi - step : lo + 1u) : lo + ((hi - lo) >> 1);
                            int n; DSA_COUNT(e << 23, n)
                            if (n == TOPK) { exact = true; tau = e << 23; break; }
                            if (n > TOPK) { lo = e; nlo = n; step = 0u; } else { hi = e; nhi = n; if (step) step <<= 1; }
                        }
                    }
                    int need = 0, ntau = -1, wb = 23;
                    if (!exact) {
                        tau = lo << 23; ntau = nlo;
#pragma unroll 1
                        for (int bit = 22; bit >= 20; --bit) {
                            if (ntau >= 0 && ntau - nhi <= 256) break;
                            const unsigned cand = tau | (1u << bit); int n; DSA_COUNT(cand, n)
                            if (n == TOPK) { exact = true; tau = cand; break; }
                            if (n > TOPK) { tau = cand; ntau = n; } else nhi = n;
                            wb = bit; }
                    }
                    if (!exact) {
                        int nin = ntau; if (nin < 0) { DSA_COUNT(tau, nin) }
                        const int nc = nin - nhi, needc = TOPK - nhi;
                        if (nc <= 256) {
                            LAS unsigned* lst = (LAS unsigned*)(c.lds + DSA_LIST_OFF) + w * 256; int base = 0;
#define DSA_COMPACT1(j) { const bool inb = (kk[j] - tau) < (1u << wb); const u64 be = __ballot(inb); \
                                if (be != 0ull) { if (inb) lst[base + __popcll(be & ((1ull << lane) - 1ull))] = kk[j]; base += __popcll(be); } }
#define DSA_COMPACT(j0, j1) if (j1 - j0 == 16) { _Pragma("unroll") for (int j = j0; j < j1; j += 4) { \
                                    const u64 any_ = __ballot((kk[j] - tau) < (1u << wb)) | __ballot((kk[j + 1] - tau) < (1u << wb)) | __ballot((kk[j + 2] - tau) < (1u << wb)) | __ballot((kk[j + 3] - tau) < (1u << wb)); \
                                    if (any_ != 0ull) { DSA_COMPACT1(j) DSA_COMPACT1(j + 1) DSA_COMPACT1(j + 2) DSA_COMPACT1(j + 3) } } }        \
                            else { DSA_COMPACT1(j0) }
                            DSA_BUCKETS(DSA_COMPACT)
                            const unsigned c0 = lane < nc ? lst[lane] : 0u, c1 = lane + 64 < nc ? lst[lane + 64] : 0u, c2 = lane + 128 < nc ? lst[lane + 128] : 0u, c3 = lane + 192 < nc ? lst[lane + 192] : 0u;
#pragma unroll 1
                            for (int bit = wb - 1; bit >= 0; --bit) { const unsigned cand = tau | (1u << bit);
                                const int n = (__popcll(__ballot(c0 >= cand)) + __popcll(__ballot(c1 >= cand))) + (__popcll(__ballot(c2 >= cand)) + __popcll(__ballot(c3 >= cand)));
                                if (n >= needc) tau = cand;
                                if (n == needc) { exact = true; break; } }
                            if (!exact) need = needc - ((__popcll(__ballot(c0 > tau)) + __popcll(__ballot(c1 > tau))) + (__popcll(__ballot(c2 > tau)) + __popcll(__ballot(c3 > tau))));
                        } else {
                            int n1; DSA_COUNT(tau + 1u, n1)
                            if (n1 < TOPK) need = TOPK - n1;
                            else {
#pragma unroll 1
                                for (int bit = wb - 1; bit >= 0; --bit) { const unsigned cand = tau | (1u << bit); int n; DSA_COUNT(cand, n)
                                    if (n >= TOPK) tau = cand;
                                    if (n == TOPK) { exact = true; break; } }
                                if (!exact) { int n; DSA_COUNT(tau + 1u, n) need = TOPK - n; }
                            }
                        }
                    }
                    int run = 0; unsigned mlo = 0u, mhi = 0u; u64 mine1 = 0ull; const unsigned tsel = exact ? tau : tau + 1u;
#define DSA_SEL(j0, j1) _Pragma("unroll") for (int j = j0; j < j1; ++j) { u64 bs = __ballot(kk[j] >= tsel); \
                        if (!exact) { const u64 be = __ballot(kk[j] == tau); \
                            if (be != 0ull) { const int take = need - run; if (take > 0) { const bool eq = kk[j] == tau; const int rank = __popcll(be & ((1ull << lane) - 1ull)); bs |= __ballot(eq && rank < take); } run += __popcll(be); } } \
                        if (j < 64) { WLANE64(mlo, mhi, bs, j); } else mine1 = bs; }
#define DSA_SELX(j0, j1) _Pragma("unroll") for (int j = j0; j < j1; ++j) { const u64 bs = __ballot(kk[j] >= tsel); if (j < 64) { WLANE64(mlo, mhi, bs, j); } else mine1 = bs; }
                    if (exact) { DSA_BUCKETS(DSA_SELX) } else { DSA_BUCKETS(DSA_SEL) }
                    const u64 mine0 = ((u64)mhi << 32) | mlo;
                    MW[(8 * sb + w) * 65 + lane] = lane < nw ? mine0 : 0ull;
                    if (lane == 0) MW[(8 * sb + w) * 65 + 64] = nw > 64 ? mine1 : 0ull;
                }
                __syncthreads();
            }
        }
        for (int ra_ = 0; ra_ < REP_ATT; ++ra_) {
        int w_at = w0; asm volatile("" : "+s"(w_at)); const int w = w_at;
        int lane_at = lane0; asm volatile("" : "+v"(lane_at)); const int lane = lane_at, r32 = lane & 31, hi = lane >> 5, tid = w * 64 + lane;
        const bf16* Cb = CN + (size_t)(b * L) * 128;
        const unsigned ring0 = (unsigned)(size_t)c.lds + DSA_RING_OFF;
#define DSA_SLOT(ti) ((((ti) & 3) == 3) ? (unsigned)(size_t)c.lds : ring0 + (unsigned)((ti) & 3) * 16384u)
#define DSA_DMA(ti) do { const unsigned d_ = (unsigned)__builtin_amdgcn_readfirstlane(DSA_SLOT(ti) + w * 2048); \
            int lq_ = lane0; asm volatile("" : "+v"(lq_)); const int rr0_ = 8 * w + (lq_ >> 4), rr1_ = rr0_ + 4;        \
            fx_glds16(Cb + (size_t)(64 * (ti) + rr0_) * 128 + 8 * ((lq_ & 15) ^ (((rr0_ & 3) << 2) | ((rr0_ >> 2) & 3))), d_); \
            fx_glds16(Cb + (size_t)(64 * (ti) + rr1_) * 128 + 8 * ((lq_ & 15) ^ (((rr1_ & 3) << 2) | ((rr1_ >> 2) & 3))), d_ + 1024); } while (0)
        DSA_DMA(0); if (nw > 1) DSA_DMA(1);
        bf16x8 qf[8];
        {   LAS bf16* QL = (LAS bf16*)c.lds + w * (32 * 136); const bf16* WUKB = (const bf16*)(pt_get(c, 26) + WS_FCUM + 1536 * 1024);
            bf16x8 qd[4];
#pragma unroll
            for (int s = 0; s < 4; ++s) qd[s] = *(const bf16x8*)(U + (size_t)(t0 + r32) * NU + C_DQ + 64 * w + 16 * s + 8 * hi);
#pragma unroll
            for (int rb = 0; rb < 4; ++rb) {
                f32x16 a_;
#pragma unroll
                for (int r = 0; r < 16; ++r) a_[r] = 0.f;
#pragma unroll
                for (int s = 0; s < 4; ++s) a_ = MFMA32(*(const bf16x8*)(WUKB + (size_t)(w * 128 + 32 * rb + r32) * 64 + 16 * s + 8 * hi), qd[s], a_);
#pragma unroll
                for (int i4 = 0; i4 < 4; ++i4) *(LAS u32x2v*)(QL + r32 * 136 + 32 * rb + 8 * i4 + 4 * hi) = (u32x2v){cvtpk(a_[4 * i4], a_[4 * i4 + 1]), cvtpk(a_[4 * i4 + 2], a_[4 * i4 + 3])};
            }
#pragma unroll
            for (int s = 0; s < 8; ++s) qf[s] = *(const LAS bf16x8*)(QL + r32 * 136 + 16 * s + 8 * hi);
            if (r32 >= nq) {
#pragma unroll
                for (int s = 0; s < 8; ++s) qf[s] = (bf16x8){0, 0, 0, 0, 0, 0, 0, 0}; }
        }
        f32x16 o[4];
#pragma unroll
        for (int db = 0; db < 4; ++db)
#pragma unroll
            for (int r = 0; r < 16; ++r) o[db][r] = 0.f;
        float m = -1e4f, l = 0.f;
        unsigned kb0, vb0[2];
        {   int lo_ = lane; asm volatile("" : "+v"(lo_));
            const int r32 = lo_ & 31, hi = lo_ >> 5, lane = lo_;
            const unsigned xr = ((r32 & 3) << 2) | ((r32 >> 2) & 3);
            kb0 = (256u * r32 + 16u * (hi ^ (xr & 1u))) | (16u * (xr & 14u));
            const unsigned blk_ = (lane >> 4) & 1, q_ = (lane & 15) >> 2, p_ = lane & 3;
#pragma unroll
            for (int t = 0; t < 2; ++t) vb0[t] = (256u * (4 * hi + 8 * t + q_) + 16u * ((2 * blk_ + (p_ >> 1)) ^ ((hi + 2 * t) & 3)) + 8u * (p_ & 1)) | (64u * q_);
        }
#define DSA_WAITBAR(t) do { if ((t) + 1 < nw) asm volatile("s_waitcnt vmcnt(2) lgkmcnt(0)\n\ts_barrier" ::: "memory"); else asm volatile("s_waitcnt vmcnt(0) lgkmcnt(0)\n\ts_barrier" ::: "memory"); } while (0)
#define DSA_KRD(dst, s) dst = *(const LAS bf16x8*)((const LAS char*)(size_t)(kbt ^ (32u * (s))))
#define DSA_VRD(lo_, hh_, k) do { lo_ = fx_vtr((const LAS char*)(size_t)(vpt0 ^ (64u * ((k) & 3))) + 4096 * ((k) >> 2)); hh_ = fx_vtr((const LAS char*)(size_t)(vpt1 ^ (64u * ((k) & 3))) + 4096 * ((k) >> 2)); } while (0)
#define DSA_VF(lo_, hh_) __builtin_shufflevector(lo_, hh_, 0, 1, 2, 3, 4, 5, 6, 7)
#define DSA_PVAL(P, i) (P)[i] = __builtin_amdgcn_exp2f((P)[i]); sacc += (P)[i]
#define DSA_INIT(C, r) do { const unsigned s0_ = (unsigned)__builtin_amdgcn_sbfe((int)msk_s, ((r) & 3) + 8 * ((r) >> 2), 1); \
            C[r] = __uint_as_float((negm_b & s0_) | (0xf149f2cau & ~s0_)); } while (0)
#define DSA_DECIDE(C) do { const float rm_ = max3c(mx, fx_swapmax(mx), mx); \
            if (__builtin_expect(__ballot(rm_ > FX_THR) != 0ull, 0)) { const float dl_ = fmaxf(rm_, 0.f), alpha_ = __builtin_amdgcn_exp2f(-dl_); m += dl_; l *= alpha_; \
                _Pragma("unroll") for (int r = 0; r < 16; ++r) C[r] -= dl_; \
                _Pragma("unroll") for (int db = 0; db < 4; ++db) _Pragma("unroll") for (int r = 0; r < 16; ++r) o[db][r] *= alpha_; } } while (0)
#define DSA_GA(C, P, s, f) { \
            C = MFMA32(f, qf[s], C); DSA_PVAL(P, 2 * (s)); DSA_PVAL(P, 2 * (s) + 1); \
            if ((s) < 4) { pwa[(s) & 3] = cvtpk((P)[2 * (s)], (P)[2 * (s) + 1]); FX_PIN(pwa); } else { pwb[(s) & 3] = cvtpk((P)[2 * (s)], (P)[2 * (s) + 1]); FX_PIN(pwb); } FX_PIN(sacc); FX_SBAR(); \
            if ((s) + 2 < 8) { DSA_KRD(f, (s) + 2); FX_SBAR(); } }
#define DSA_GB(C, k, f0, f1, n0, n1) { \
            if ((k) + 1 < 8) { DSA_VRD(n0, n1, 4 * ksb + (k) + 1); FX_SBAR(); } \
            o[(k) & 3] = MFMA32(DSA_VF(f0, f1), __builtin_bit_cast(bf16x8, (k) < 4 ? pwa : pwb), o[(k) & 3]); \
            mx = max3c(mx, C[2 * (k)], C[2 * (k) + 1]); FX_PIN(mx); FX_SBAR(); }
#define DSA_HSTEP(C, P, t, hf, tp) do { \
            const unsigned kbt = DSA_SLOT(t) + kb0 + 8192u * (hf), vpt0 = DSA_SLOT(tp) + vb0[0], vpt1 = DSA_SLOT(tp) + vb0[1]; constexpr int ksb = 2 * (1 - (hf)); \
            const u64 m64 = MW[r32 * 65 + (t)]; const unsigned msk_s = (unsigned)((hf) ? (m64 >> 32) : m64) >> (4 * hi); \
            bf16x8 ka, kc; float sacc = 0.f, mx = -1e30f; u32x4v pwa, pwb; fx_s16x4 va0, va1, vb0_, vb1_; \
            DSA_KRD(ka, 0); DSA_KRD(kc, 1); FX_SBAR(); \
            { const unsigned negm_b = __float_as_uint(-m); _Pragma("unroll") for (int r = 0; r < 16; ++r) DSA_INIT(C, r); } \
            DSA_GA(C, P, 0, ka) DSA_GA(C, P, 1, kc) DSA_GA(C, P, 2, ka) DSA_GA(C, P, 3, kc) DSA_GA(C, P, 4, ka) DSA_GA(C, P, 5, kc) DSA_GA(C, P, 6, ka) DSA_GA(C, P, 7, kc) \
            l += sacc; \
            DSA_VRD(va0, va1, 4 * ksb); FX_SBAR(); \
            DSA_GB(C, 0, va0, va1, vb0_, vb1_) DSA_GB(C, 1, vb0_, vb1_, va0, va1) DSA_GB(C, 2, va0, va1, vb0_, vb1_) DSA_GB(C, 3, vb0_, vb1_, va0, va1) \
            DSA_GB(C, 4, va0, va1, vb0_, vb1_) DSA_GB(C, 5, vb0_, vb1_, va0, va1) DSA_GB(C, 6, va0, va1, vb0_, vb1_) DSA_GB(C, 7, vb0_, vb1_, va0, va1) \
            DSA_DECIDE(C); } while (0)
        f32x16 pA, pB;
        DSA_WAITBAR(0); if (2 < nw) DSA_DMA(2);
        {   const unsigned kbt = DSA_SLOT(0) + kb0; const u64 m64 = MW[r32 * 65]; const unsigned msk_s = (unsigned)m64 >> (4 * hi), negm_b = 0u; float mx = -1e30f;
#pragma unroll
            for (int r = 0; r < 16; ++r) DSA_INIT(pA, r);
#pragma unroll
            for (int s = 0; s < 8; ++s) { bf16x8 kf_; DSA_KRD(kf_, s); pA = MFMA32(kf_, qf[s], pA); }
#pragma unroll
            for (int r = 0; r < 16; ++r) mx = max3c(mx, pA[r], pA[r]);
            m = max3c(mx, fx_swapmax(mx), -1e4f);
#pragma unroll
            for (int r = 0; r < 16; ++r) pA[r] -= m;
        }
        DSA_HSTEP(pB, pA, 0, 1, 0);
        for (int t = 1; t < nw; ++t) {
            DSA_WAITBAR(t); if (t + 2 < nw) DSA_DMA(t + 2);
            DSA_HSTEP(pA, pB, t, 0, t - 1);
            DSA_HSTEP(pB, pA, t, 1, t);
        }
        {   float sacc = 0.f;
#pragma unroll
            for (int r = 0; r < 16; ++r) { DSA_PVAL(pB, r); }
            l += sacc;
            const unsigned vpt0 = DSA_SLOT(nw - 1) + vb0[0], vpt1 = DSA_SLOT(nw - 1) + vb0[1];
#pragma unroll
            for (int s = 0; s < 2; ++s) { const bf16x8 x1 = pack8(pB, s);
#pragma unroll
                for (int db = 0; db < 4; ++db) { fx_s16x4 a_, b_; DSA_VRD(a_, b_, 4 * (2 + s) + db); o[db] = MFMA32(DSA_VF(a_, b_), x1, o[db]); } }
        }
        __syncthreads();
        l += lane_read(l, lane ^ 32);
        {
            const float inv = 1.f / l; f32x16 yd0, yd1; const bf16* WUVT = (const bf16*)(pt_get(c, 26) + WS_FCUM + 1792 * 1024);
#pragma unroll
            for (int r = 0; r < 16; ++r) { yd0[r] = 0.f; yd1[r] = 0.f; }
            typedef short s16x4v __attribute__((ext_vector_type(4)));
#pragma unroll
            for (int db = 0; db < 4; ++db) {
#pragma unroll
                for (int r = 0; r < 16; ++r) o[db][r] *= inv;
#pragma unroll
                for (int t = 0; t < 2; ++t) {
                    const bf16x8 xs = pack8(o[db], t);
                    const bf16* wp = WUVT + (size_t)(w * 64 + r32) * 128 + 32 * db + 16 * t + 4 * hi;
                    const s16x4v l0 = *(const s16x4v*)wp, h0 = *(const s16x4v*)(wp + 8), l1 = *(const s16x4v*)(wp + 32 * 128), h1 = *(const s16x4v*)(wp + 32 * 128 + 8);
                    yd0 = MFMA32(__builtin_shufflevector(l0, h0, 0, 1, 2, 3, 4, 5, 6, 7), xs, yd0); yd1 = MFMA32(__builtin_shufflevector(l1, h1, 0, 1, 2, 3, 4, 5, 6, 7), xs, yd1);
                }
            }
            if (r32 < nq) { bf16* yr = (bf16*)(pt_get(c, 26) + WS_Y) + (size_t)(t0 + r32) * KOUT + 1536 + 64 * w;
#pragma unroll
                for (int i4 = 0; i4 < 4; ++i4) {
                    *(u32x2v*)(yr + 8 * i4 + 4 * hi) = (u32x2v){cvtpk(yd0[4 * i4], yd0[4 * i4 + 1]), cvtpk(yd0[4 * i4 + 2], yd0[4 * i4 + 3])};
                    *(u32x2v*)(yr + 32 + 8 * i4 + 4 * hi) = (u32x2v){cvtpk(yd1[4 * i4], yd1[4 * i4 + 1]), cvtpk(yd1[4 * i4 + 2], yd1[4 * i4 + 3])}; }
            }
        }
        }
    }
}

__device__ __forceinline__ float wave_scan_incl(float v, int lane) {
#pragma unroll
    for (int o = 1; o < 64; o <<= 1) { const float n = lane_read(v, (lane - o) & 63); if (lane >= o) v += n; }
    return v;
}
__device__ __forceinline__ void ph_ssd_states(const Ctx& c0, const bf16* XC, const float* DT, const float* a_log, bf16* ST, float* CD) {
    const Ctx c = refresh(c0);
    const int lane = c.lane, w = c.wave, r32 = lane & 31, hi = lane >> 5, g = w >> 2;
    LAS bf16* XT = (LAS bf16*)c.lds + w * (64 * 72);
    LAS bf16* BT = (LAS bf16*)(c.lds + 73728);
    const float a_neg = -__expf(a_log[w]);
    for (int it = c.bid; it < NB * 65; it += c.nb) {
        const int b = it < 512 ? it >> 6 : it - 512, ch = it < 512 ? 1 + (it & 63) : 0, pseq = 64 * ch - 48 + lane;
        const bool valid = pseq >= 0; const size_t t = (size_t)(b * L + (valid ? pseq : 0));
        const float dtv = valid ? DT[t * 8 + w] : 0.f, acs = wave_scan_incl(dtv * a_neg, lane), tot = lane_read(acs, 63), scale = dtv * __expf(tot - acs);
        if (lane == 0) CD[(b * 65 + ch) * 8 + w] = __expf(tot);
        const bf16* xrow = XC + t * 1024 + 64 * w;
#pragma unroll
        for (int q = 0; q < 8; ++q) { u32x4v v = (u32x4v){0u, 0u, 0u, 0u}; if (valid) v = *(const u32x4v*)(xrow + 8 * q); const unsigned vv[4] = {v.x, v.y, v.z, v.w};
#pragma unroll
            for (int e = 0; e < 8; ++e) XT[(8 * q + e) * 72 + lane] = f2bf(bf2f((bf16)(vv[e >> 1] >> (16 * (e & 1)))) * scale); }
        const bf16* brow = XC + t * 1024 + 512 + 32 * w;
#pragma unroll
        for (int q = 0; q < 4; ++q) { u32x4v v = (u32x4v){0u, 0u, 0u, 0u}; if (valid) v = *(const u32x4v*)(brow + 8 * q); const unsigned vv[4] = {v.x, v.y, v.z, v.w};
#pragma unroll
            for (int e = 0; e < 8; ++e) BT[(32 * w + 8 * q + e) * 72 + lane] = (bf16)(vv[e >> 1] >> (16 * (e & 1))); }
        __syncthreads();
        bf16* st = ST + ((size_t)(b * 65 + ch) * 8 + w) * 8192;
#pragma unroll 1
        for (int pb = 0; pb < 2; ++pb)
#pragma unroll 1
            for (int nb = 0; nb < 4; ++nb) {
                f32x16 acc;
#pragma unroll
                for (int r = 0; r < 16; ++r) acc[r] = 0.f;
#pragma unroll
                for (int s = 0; s < 4; ++s) { const bf16x8 a = *(const LAS bf16x8*)(XT + (32 * pb + r32) * 72 + 16 * s + 8 * hi), bb = *(const LAS bf16x8*)(BT + (128 * g + 32 * nb + r32) * 72 + 16 * s + 8 * hi);
                    acc = MFMA32(a, bb, acc); }
#pragma unroll
                for (int r = 0; r < 16; ++r) st[(32 * pb + crow(r, hi)) * 128 + 32 * nb + r32] = f2bf(acc[r]);
            }
        __syncthreads();
    }
}
__device__ __forceinline__ void ph_ssd_scan(const Ctx& c0, bf16* ST, const float* CD) {
    const Ctx c = refresh(c0);
    for (int idx = c.bid * NTHR + c.tid; idx < NB * 8 * 64 * 32; idx += c.nb * NTHR) {
        const int n4 = idx & 31, p = (idx >> 5) & 63, h = (idx >> 11) & 7, b = idx >> 14;
        float h0 = 0.f, h1 = 0.f, h2 = 0.f, h3 = 0.f;
        bf16* base = ST + ((size_t)(b * 65) * 8 + h) * 8192 + p * 128 + 4 * n4; const float* cd = CD + (size_t)(b * 65) * 8 + h;
#pragma unroll 1
        for (int c5 = 0; c5 < 65; c5 += 5) {
            u32x2v v[5]; float d[5];
#pragma unroll
            for (int q = 0; q < 5; ++q) { v[q] = *(const u32x2v*)(base + (size_t)(c5 + q) * 8 * 8192); d[q] = cd[(c5 + q) * 8]; }
#pragma unroll
            for (int q = 0; q < 5; ++q) {
                *(u32x2v*)(base + (size_t)(c5 + q) * 8 * 8192) = (u32x2v){pk2(h0, h1), pk2(h2, h3)};
                h0 = d[q] * h0 + bf2f((bf16)(v[q].x & 0xffff)); h1 = d[q] * h1 + bf2f((bf16)(v[q].x >> 16)); h2 = d[q] * h2 + bf2f((bf16)(v[q].y & 0xffff)); h3 = d[q] * h3 + bf2f((bf16)(v[q].y >> 16)); }
        }
    }
}
__device__ __forceinline__ void ph_ssd_out(const Ctx& c0, const bf16* XC, const bf16* U, const float* DT, const float* a_log, const float* dsk, const bf16* ST, bf16* Y) {
    const Ctx c = refresh(c0);
    const int lane = c.lane, w = c.wave, r32 = lane & 31, hi = lane >> 5, g = w >> 2;
    LAS bf16* XT = (LAS bf16*)c.lds + w * (64 * 72);
    LAS float* ACS = (LAS float*)(c.lds + 73728) + w * 64;
    LAS float* SS = (LAS float*)(c.lds + 73728 + 2048);
    const float a_neg = -__expf(a_log[w]), Dk = dsk[w];
    typedef short s16x4v __attribute__((ext_vector_type(4)));
    for (int it = c.bid; it < NB * 65; it += c.nb) {
        const int b = it < 512 ? it >> 6 : it - 512, ch = it < 512 ? 1 + (it & 63) : 0, p0 = 64 * ch - 48, pseq = p0 + lane; const bool valid = pseq >= 0; const size_t t = (size_t)(b * L + (valid ? pseq : 0));
        const float dtv = valid ? DT[t * 8 + w] : 0.f, acs = wave_scan_incl(dtv * a_neg, lane);
        ACS[lane] = acs;
        {   const bf16* xrow = XC + t * 1024 + 64 * w;
#pragma unroll
            for (int q = 0; q < 8; ++q) { u32x4v v = (u32x4v){0u, 0u, 0u, 0u}; if (valid) v = *(const u32x4v*)(xrow + 8 * q); const unsigned vv[4] = {v.x, v.y, v.z, v.w};
#pragma unroll
                for (int e = 0; e < 8; ++e) XT[(8 * q + e) * 72 + lane] = f2bf(bf2f((bf16)(vv[e >> 1] >> (16 * (e & 1)))) * dtv); } }
        const bool vl0 = p0 + r32 >= 0, vl1 = p0 + 32 + r32 >= 0;
        const size_t tl0 = (size_t)(b * L + (vl0 ? p0 + r32 : 0)), tl1 = (size_t)(b * L + (vl1 ? p0 + 32 + r32 : 0));
        f32x16 acc[2][2];
#pragma unroll
        for (int pb = 0; pb < 2; ++pb)
#pragma unroll
            for (int lb = 0; lb < 2; ++lb)
#pragma unroll
                for (int r = 0; r < 16; ++r) acc[pb][lb][r] = 0.f;
        const bf16* hin = ST + ((size_t)(b * 65 + ch) * 8 + w) * 8192;
        if (ch != 0) {
#pragma unroll
        for (int k = 0; k < 8; ++k) {
            bf16x8 c0f = (bf16x8){0, 0, 0, 0, 0, 0, 0, 0}, c1f = c0f;
            if (vl0) c0f = *(const bf16x8*)(XC + tl0 * 1024 + 768 + 128 * g + 16 * k + 8 * hi);
            if (vl1) c1f = *(const bf16x8*)(XC + tl1 * 1024 + 768 + 128 * g + 16 * k + 8 * hi);
            const bf16x8 h0f = *(const bf16x8*)(hin + (size_t)r32 * 128 + 16 * k + 8 * hi), h1f = *(const bf16x8*)(hin + (size_t)(32 + r32) * 128 + 16 * k + 8 * hi);
            acc[0][0] = MFMA32(h0f, c0f, acc[0][0]); acc[0][1] = MFMA32(h0f, c1f, acc[0][1]); acc[1][0] = MFMA32(h1f, c0f, acc[1][0]); acc[1][1] = MFMA32(h1f, c1f, acc[1][1]);
        }
        }
        const float acl0 = ACS[r32], acl1 = ACS[32 + r32], e0 = __expf(acl0), e1 = __expf(acl1);
#pragma unroll
        for (int pb = 0; pb < 2; ++pb)
#pragma unroll
            for (int r = 0; r < 16; ++r) { acc[pb][0][r] *= e0; acc[pb][1][r] *= e1; }
#pragma unroll
        for (int sb = 0; sb < 2; ++sb)
#pragma unroll
            for (int lb = sb; lb < 2; ++lb) if (!(ch == 0 && sb == 0)) {
                f32x16 x;
#pragma unroll
                for (int r = 0; r < 16; ++r) x[r] = 0.f;
                const bool vs = p0 + 32 * sb + r32 >= 0; const size_t ts = (size_t)(b * L + (vs ? p0 + 32 * sb + r32 : 0));
                const bool vl = lb == 0 ? vl0 : vl1; const size_t tl = lb == 0 ? tl0 : tl1;
#pragma unroll
                for (int k = 0; k < 8; ++k) {
                    bf16x8 bf_ = (bf16x8){0, 0, 0, 0, 0, 0, 0, 0}, cf_ = bf_;
                    if (vs) bf_ = *(const bf16x8*)(XC + ts * 1024 + 512 + 128 * g + 16 * k + 8 * hi);
                    if (vl) cf_ = *(const bf16x8*)(XC + tl * 1024 + 768 + 128 * g + 16 * k + 8 * hi);
                    x = MFMA32(bf_, cf_, x);
                }
                const float acl = lb == 0 ? acl0 : acl1; const int lrow = 32 * lb + r32;
#pragma unroll
                for (int i4 = 0; i4 < 4; ++i4) { const f32x4v as = *(const LAS f32x4v*)(ACS + 32 * sb + 8 * i4 + 4 * hi);
#pragma unroll
                    for (int e = 0; e < 4; ++e) { const int srow = 32 * sb + 8 * i4 + 4 * hi + e; x[4 * i4 + e] = srow <= lrow ? x[4 * i4 + e] * __expf(fminf(acl - as[e], 0.f)) : 0.f; } }
#pragma unroll
                for (int ks = 0; ks < 2; ++ks) {
                    const bf16x8 xs = pack8(x, ks);
#pragma unroll
                    for (int pb = 0; pb < 2; ++pb) {
                        const LAS bf16* vp = XT + (32 * pb + r32) * 72 + 32 * sb + 16 * ks + 4 * hi;
                        const s16x4v lo = *(const LAS s16x4v*)vp, hh = *(const LAS s16x4v*)(vp + 8);
                        const bf16x8 pa = __builtin_shufflevector(lo, hh, 0, 1, 2, 3, 4, 5, 6, 7);
                        if (lb == 0) acc[pb][0] = MFMA32(pa, xs, acc[pb][0]); else acc[pb][1] = MFMA32(pa, xs, acc[pb][1]);
                    }
                }
            }
        float ssq0 = 0.f, ssq1 = 0.f;
#pragma unroll
        for (int lb = 0; lb < 2; ++lb) { const bool vl = lb == 0 ? vl0 : vl1; const size_t tl = lb == 0 ? tl0 : tl1;
#pragma unroll
            for (int pb = 0; pb < 2; ++pb)
#pragma unroll
                for (int i4 = 0; i4 < 4; ++i4) { const int pc = 64 * w + 32 * pb + 8 * i4 + 4 * hi;
                    u32x2v xv = (u32x2v){0u, 0u}, zv = xv;
                    if (vl) { xv = *(const u32x2v*)(XC + tl * 1024 + pc); zv = *(const u32x2v*)(U + tl * NU + C_Z + pc); }
                    const float xe[4] = {bf2f((bf16)(xv.x & 0xffff)), bf2f((bf16)(xv.x >> 16)), bf2f((bf16)(xv.y & 0xffff)), bf2f((bf16)(xv.y >> 16))};
                    const float ze[4] = {bf2f((bf16)(zv.x & 0xffff)), bf2f((bf16)(zv.x >> 16)), bf2f((bf16)(zv.y & 0xffff)), bf2f((bf16)(zv.y >> 16))};
#pragma unroll
                    for (int e = 0; e < 4; ++e) { const float y = acc[pb][lb][4 * i4 + e] + Dk * xe[e], gz = y * siluf(ze[e]); acc[pb][lb][4 * i4 + e] = gz; if (lb == 0) ssq0 += gz * gz; else ssq1 += gz * gz; } } }
        ssq0 += lane_read(ssq0, lane ^ 32); ssq1 += lane_read(ssq1, lane ^ 32);
        if (hi == 0) { SS[w * 64 + r32] = ssq0; SS[w * 64 + 32 + r32] = ssq1; }
        __syncthreads();
        const float tot0 = SS[(4 * g) * 64 + r32] + SS[(4 * g + 1) * 64 + r32] + SS[(4 * g + 2) * 64 + r32] + SS[(4 * g + 3) * 64 + r32];
        const float tot1 = SS[(4 * g) * 64 + 32 + r32] + SS[(4 * g + 1) * 64 + 32 + r32] + SS[(4 * g + 2) * 64 + 32 + r32] + SS[(4 * g + 3) * 64 + 32 + r32];
        const float rs0 = rsqrtf(tot0 * (1.f / 256.f) + EPSF), rs1 = rsqrtf(tot1 * (1.f / 256.f) + EPSF);
#pragma unroll
        for (int lb = 0; lb < 2; ++lb) { const bool vl = lb == 0 ? vl0 : vl1; const size_t tl = lb == 0 ? tl0 : tl1; const float rs = lb == 0 ? rs0 : rs1;
            if (vl) {
#pragma unroll
                for (int pb = 0; pb < 2; ++pb)
#pragma unroll
                    for (int i4 = 0; i4 < 4; ++i4)
                        *(u32x2v*)(Y + tl * KOUT + 64 * w + 32 * pb + 8 * i4 + 4 * hi) = (u32x2v){cvtpk(acc[pb][lb][4 * i4] * rs, acc[pb][lb][4 * i4 + 1] * rs), cvtpk(acc[pb][lb][4 * i4 + 2] * rs, acc[pb][lb][4 * i4 + 3] * rs)};
            } }
        __syncthreads();
    }
}

__device__ __forceinline__ void ph_resid(const Ctx& c0, const bf16* MIX, const float* g, bf16* XB, float* RSTD, float* dout, const float* SSslot = nullptr) { const Ctx c = refresh(c0);
    const int lane = c.lane;
    if (SSslot) {
        for (int idx = c.bid * NTHR + c.tid; idx < 128 * 256; idx += c.nb * NTHR) { const float* q = SSslot + (size_t)idx * 8; float sm = 0.f;
#pragma unroll
            for (int k = 0; k < 8; ++k) sm += q[k];
            RSTD[pg8::tile_row0(1, idx >> 8) + (idx & 255)] = rsqrtf(sm * (1.f / DM) + EPSF); } }
    const bool reord = c.ngw == 2048;
    for (int it = SSslot ? 16 : 0; it < (reord ? 17 : (T + c.ngw - 1) / c.ngw); ++it) {
        int t;
        if (reord) {
            if (it < 16) { const int q = 3 - (it >> 2), j = it & 3, i8 = c.gw >> 8; t = (2 * j + (i8 >> 2)) * L + 16 + 256 * (4 * q + (i8 & 3)) + (c.gw & 255); }
            else { if (c.gw >= 128) break; t = (c.gw >> 4) * L + (c.gw & 15); }
        } else { t = c.gw + it * c.ngw; if (t >= T) break; }
        float mv[32], xv[32]; float ss = 0.f;
#pragma unroll
        for (int j = 0; j < 4; ++j) { const u32x4v v = *(const u32x4v*)(MIX + (size_t)t * DM + 8 * lane + 512 * j), xx = *(const u32x4v*)(XB + (size_t)t * DM + 8 * lane + 512 * j);
            const unsigned w[4] = {v.x, v.y, v.z, v.w}, xw[4] = {xx.x, xx.y, xx.z, xx.w};
#pragma unroll
            for (int i = 0; i < 8; ++i) { const float f = bf2f((bf16)(w[i >> 1] >> (16 * (i & 1)))); mv[8 * j + i] = f; ss += f * f; xv[8 * j + i] = bf2f((bf16)(xw[i >> 1] >> (16 * (i & 1)))); } }
        const float rs = rsqrtf(wave_sum(ss, lane) * (1.f / DM) + EPSF);
        float s2 = 0.f;
        const int b = t / L, p = t - b * L; float* orow = (dout != nullptr && p >= NMETA) ? dout + ((size_t)b * SEQ + (p - NMETA)) * DM : nullptr;
#pragma unroll
        for (int j = 0; j < 4; ++j) { const int cc = 8 * lane + 512 * j;
            const f32x4v ga = *(const f32x4v*)(g + cc), gb = *(const f32x4v*)(g + cc + 4); float a[8];
#pragma unroll
            for (int i = 0; i < 4; ++i) { a[i] = xv[8 * j + i] + mv[8 * j + i] * rs * ga[i]; a[4 + i] = xv[8 * j + 4 + i] + mv[8 * j + 4 + i] * rs * gb[i]; }
#pragma unroll
            for (int i = 0; i < 8; ++i) s2 += a[i] * a[i];
            if (orow) { *(f32x4v*)(orow + cc) = (f32x4v){a[0], a[1], a[2], a[3]}; *(f32x4v*)(orow + cc + 4) = (f32x4v){a[4], a[5], a[6], a[7]}; }
            *(u32x4v*)(XB + (size_t)t * DM + cc) = (u32x4v){pk2(a[0], a[1]), pk2(a[2], a[3]), pk2(a[4], a[5]), pk2(a[6], a[7])}; }
        s2 = wave_sum(s2, lane);
        if (lane == 0) RSTD[t] = rsqrtf(s2 * (1.f / DM) + EPSF);
    }
}

__device__ __forceinline__ void gemm_meta_rows(const Ctx& c, const bf16* A, const bf16* Bt, bf16* O, int N, int K, int ldc, const float* rs, float* UF, float* O32 = nullptr) {
    const int lane = c.lane, r32 = lane & 31, hi = lane >> 5, w = c.wave;
    LAS float* red = (LAS float*)c.lds;
    for (int strip = c.bid; strip < N / 32; strip += c.nb) {
        const bf16* ap = A + (size_t)(r32 & 15) * K + 8 * hi; const bf16* bp = Bt + (size_t)(32 * strip + r32) * K + 8 * hi;
        f32x16 acc;
#pragma unroll
        for (int r = 0; r < 16; ++r) acc[r] = 0.f;
#pragma unroll 1
        for (int s0 = w; s0 < K / 16; s0 += 16 * NWAVE) {
            bf16x8 fa[16], fb[16];
#pragma unroll
            for (int u = 0; u < 16; ++u) { const int s = s0 + u * NWAVE; const bool ok = s < K / 16; const int sc = ok ? s : w;
                fa[u] = *(const bf16x8*)(ap + 16 * sc); fb[u] = *(const bf16x8*)(bp + 16 * sc); if (!ok) fa[u] = (bf16x8){0, 0, 0, 0, 0, 0, 0, 0}; }
#pragma unroll
            for (int u = 0; u < 16; ++u) acc = MFMA32(fa[u], fb[u], acc);
        }
#pragma unroll
        for (int r = 0; r < 8; ++r) red[(w * 8 + r) * 64 + lane] = acc[r];
        __syncthreads();
        if (w == 0) {
            float v8[8];
#pragma unroll
            for (int r = 0; r < 8; ++r) { float t = 0.f;
#pragma unroll
                for (int ww = 0; ww < NWAVE; ++ww) t += red[(ww * 8 + r) * 64 + lane];
                v8[r] = t * (rs ? rs[crow(r, hi)] : 1.f); }
            const int n = 32 * strip + r32; const bool sm = UF != nullptr && n >= C_SM && n < C_SM + 32;
            if (O32) {
#pragma unroll
                for (int r = 0; r < 8; ++r) O32[(size_t)crow(r, hi) * N + n] = v8[r];
            } else
#pragma unroll 1
            for (int b = 0; b < NB; ++b) {
                bf16* ob = O + (size_t)(b * L) * ldc + n; float* ub = UF + (size_t)(b * L) * 32 + (n - C_SM);
#pragma unroll
                for (int r = 0; r < 8; ++r) { const int p = crow(r, hi); ob[(size_t)p * ldc] = f2bf(v8[r]); if (sm) ub[(size_t)p * 32] = v8[r]; }
            }
        }
        __syncthreads();
    }
}
__device__ __forceinline__ void ph_gemm_plain(const Ctx& c0, const bf16* A, const bf16* Bt, bf16* O, int N, int K, int ldc, const float* rs, float* UF, int wgm) { const Ctx c = refresh(c0);
    gemm_meta_rows(c, A, Bt, O, N, K, ldc, rs, UF);
    pg8::StaticOrder S; S.init(128 * 256, N, c.nb, c.bid, wgm);
    pg8::Gemm g{A, Bt, 128 * 256, N, K, (size_t)256 * K * 2, 1};
    pg8::EpiBf16Plain E{O, ldc, rs, UF, C_SM, 1};
    pg8::gemm_phase<pg8::EpiBf16Plain, pg8::StaticOrder, true, true>(c.lds, g, S, E, c.tid);
}
__device__ __forceinline__ void ph_gemm_resid(const Ctx& c0, const bf16* A, const bf16* Bt, bf16* O, int K, bf16* XB, const float* g, float* dout, float* PS, float* SS, unsigned* cnt) { const Ctx c = refresh(c0);
    gemm_meta_rows(c, A, Bt, O, DM, K, DM, nullptr, nullptr);
    pg8::StaticOrder S; S.init(128 * 256, DM, c.nb, c.bid, 4);
    pg8::Gemm g_{A, Bt, 128 * 256, DM, K, (size_t)256 * K * 2, 1};
    pg8::EpiResid E{XB, g, dout, PS, SS, cnt, (LAS float*)(c.lds + HALO_OFF)};
    pg8::gemm_phase<pg8::EpiResid, pg8::StaticOrder, true, true>(c.lds, g_, S, E, c.tid);
}
__device__ __forceinline__ void ph_gemm_gateup(const Ctx& c0, const bf16* XB, const bf16* Bt, bf16* H, const float* rs, const float* cw, const float* cb, float* FXG, float* FXU, float* HB, float* GUM) { const Ctx c = refresh(c0);
    gemm_meta_rows(c, XB, Bt, nullptr, NGU, DM, 0, rs, nullptr, GUM);
    pg8::StaticOrder S; S.init(128 * 256, NGU, c.nb, c.bid, WGM_GU);
    pg8::Gemm g{XB, Bt, 128 * 256, NGU, DM, (size_t)256 * DM * 2, 1};
    pg8::EpiGateUp E{H, rs, cw, cb, (LAS float*)(c.lds + HALO_OFF), FXG, FXU, HB};
    pg8::gemm_phase<pg8::EpiGateUp, pg8::StaticOrder, true, true>(c.lds, g, S, E, c.tid);
}
__device__ __forceinline__ void ph_ffn_fixup(const Ctx& c0, bf16* H, const float* cw, const float* cb, const float* FXG, const float* FXU, const float* HB, const float* GUM) { const Ctx c = refresh(c0);
    const int gt = c.bid * NTHR + c.tid, ngt = c.nb * NTHR;
    for (int idx = gt; idx < 128 * (FF / 4); idx += ngt) {
        const int pm = idx / (FF / 4), ch = (idx - pm * (FF / 4)) * 4, pn = ch >> 7, cl = ch & 127;
        const f32x4v g0 = *(const f32x4v*)(FXG + ((size_t)pm * 2) * FF + ch), g1 = *(const f32x4v*)(FXG + ((size_t)pm * 2 + 1) * FF + ch);
        const f32x4v u0 = *(const f32x4v*)(FXU + ((size_t)pm * 2) * FF + ch), u1 = *(const f32x4v*)(FXU + ((size_t)pm * 2 + 1) * FF + ch);
        f32x4v hm2, hm1;
        if ((pm & 15) == 0) { hm2 = *(const f32x4v*)(GUM + (size_t)14 * NGU + 256 * pn + cl); hm1 = *(const f32x4v*)(GUM + (size_t)15 * NGU + 256 * pn + cl); }
        else { hm2 = *(const f32x4v*)(HB + ((size_t)(pm - 1) * 2) * FF + ch); hm1 = *(const f32x4v*)(HB + ((size_t)(pm - 1) * 2 + 1) * FF + ch); }
        const f32x4v w0 = *(const f32x4v*)(cw + ch), w1 = *(const f32x4v*)(cw + FF + ch), w2 = *(const f32x4v*)(cw + 2 * FF + ch), bb = *(const f32x4v*)(cb + ch);
        const f32x4v c0v = bb + w2 * g0 + w1 * hm1 + w0 * hm2, c1v = bb + w2 * g1 + w1 * g0 + w0 * hm1;
        const size_t row = (size_t)pg8::tile_row0(1, pm);
        *(u32x2v*)(H + row * FF + ch) = (u32x2v){pk2(siluf(c0v[0]) * u0[0], siluf(c0v[1]) * u0[1]), pk2(siluf(c0v[2]) * u0[2], siluf(c0v[3]) * u0[3])};
        *(u32x2v*)(H + (row + 1) * FF + ch) = (u32x2v){pk2(siluf(c1v[0]) * u1[0], siluf(c1v[1]) * u1[1]), pk2(siluf(c1v[2]) * u1[2], siluf(c1v[3]) * u1[3])};
    }
    for (int idx = gt; idx < 16 * (FF / 4); idx += ngt) {
        const int p = idx / (FF / 4), ch = (idx - p * (FF / 4)) * 4, pn = ch >> 7, cl = ch & 127;
        const float* gr = GUM + (size_t)p * NGU + 256 * pn + cl;
        const f32x4v g = *(const f32x4v*)gr, up = *(const f32x4v*)(gr + 128);
        f32x4v gm1 = (f32x4v){0.f, 0.f, 0.f, 0.f}, gm2 = gm1;
        if (p >= 1) gm1 = *(const f32x4v*)(gr - NGU);
        if (p >= 2) gm2 = *(const f32x4v*)(gr - 2 * NGU);
        const f32x4v w0 = *(const f32x4v*)(cw + ch), w1 = *(const f32x4v*)(cw + FF + ch), w2 = *(const f32x4v*)(cw + 2 * FF + ch), bb = *(const f32x4v*)(cb + ch);
        const f32x4v cv = bb + w2 * g + w1 * gm1 + w0 * gm2;
        const u32x2v o = (u32x2v){pk2(siluf(cv[0]) * up[0], siluf(cv[1]) * up[1]), pk2(siluf(cv[2]) * up[2], siluf(cv[3]) * up[3])};
#pragma unroll
        for (int b = 0; b < NB; ++b) *(u32x2v*)(H + (size_t)(b * L + p) * FF + ch) = o;
    }
}

constexpr int REP_PREPW = 1, REP_G1 = 1, REP_G2 = 1, REP_G3 = 1, REP_G4 = 1, REP_M1 = 1, REP_SSD = 1, REP_FOX = 1, REP_DSA = 1;
__global__ void __launch_bounds__(NTHR, 2) fwd_mega(Args A) {
    extern __shared__ __attribute__((aligned(16))) unsigned char lds_raw[];
    cg::grid_group grid = cg::this_grid();
    Ctx c; c.tid = threadIdx.x; c.lane = c.tid & 63; c.wave = __builtin_amdgcn_readfirstlane(c.tid >> 6); c.bid = blockIdx.x; c.nb = gridDim.x;
    c.gw = c.bid * NWAVE + c.wave; c.ngw = c.nb * NWAVE; c.lds = (LAS unsigned char*)lds_raw;
    if (c.tid == 0) { LAS unsigned long long* PT = (LAS unsigned long long*)(c.lds + PT_OFF);
#pragma unroll
        for (int i = 0; i < 25; ++i) PT[i] = (unsigned long long)A.in[i];
        PT[25] = (unsigned long long)A.out; PT[26] = (unsigned long long)A.ws; }
    if (c.tid < 2) ((LAS unsigned*)(c.lds + MISC_OFF))[c.tid] = 0u;
    __syncthreads();
    (void)xcd_barrier_post((unsigned*)(A.ws + WS_CTL) + CW_BAR, (volatile LAS unsigned*)(c.lds + MISC_OFF), c.tid);
#define WSP(off) (pt_get(c, 26) + (off))
#define DOUT ((float*)pt_get(c, 25))
#define P_WIN ((bf16*)WSP(WS_WIN))
#define P_WOUT ((bf16*)WSP(WS_WOUT))
#define P_WGU ((bf16*)WSP(WS_WGU))
#define P_WDN ((bf16*)WSP(WS_WDN))
#define P_METAX ((float*)WSP(WS_METAX))
#define P_RSTD ((float*)WSP(WS_RSTD))
#define P_UF ((float*)WSP(WS_UF))
#define P_DT ((float*)WSP(WS_DT))
#define P_FCUM ((float*)WSP(WS_FCUM))
#define P_CN ((bf16*)WSP(WS_CN))
#define P_MASK ((u64*)WSP(WS_MASK))
#define P_KI ((bf16*)WSP(WS_MASK))
#define P_XB ((bf16*)WSP(WS_XB) + (size_t)8 * DM)
#define P_Y ((bf16*)WSP(WS_Y))
#define P_U ((bf16*)WSP(WS_R1))
#define P_XC ((bf16*)WSP(WS_XC))
#define P_H ((bf16*)WSP(WS_R1))
#define P_MIX ((bf16*)WSP(WS_R1))
#define P_MIX2 ((bf16*)WSP(WS_Y))
#define P_ST ((bf16*)WSP(WS_YA))
#define P_CD ((float*)WSP(WS_DT + 1536 * 1024))
#define P_WUV ((bf16*)WSP(WS_FCUM + 1792 * 1024))
#define P_FXG ((float*)WSP(WS_FIX))
#define P_FXU ((float*)WSP(WS_FIX + 6 * MiB))
#define P_HB ((float*)WSP(WS_FIX + 12 * MiB))
#define P_GUM ((float*)WSP(WS_FIX + 18 * MiB))
#define P_PS ((float*)WSP(WS_FIX + 19 * MiB))
#define P_SS ((float*)WSP(WS_FIX + 20 * MiB))
#define P_CNT ((unsigned*)WSP(WS_CTL) + 8192)
#define P_WUK ((bf16*)WSP(WS_FCUM + 1536 * 1024))
    ph_prep_x(c, INP(0), INP(1), P_XB, P_RSTD);
    ph_prep_w(c, 0, P_WIN, P_WOUT, P_WGU, P_WDN, P_WUK, P_WUV);
    grid.sync();
#define LAYER_BODY(ly) do { \
        for (int rep = 0; rep < REP_G1; ++rep) ph_gemm_plain(c, P_XB, P_WIN, P_U, NU, DM, NU, P_RSTD, P_UF, WGM_IN); \
        grid_barrier(c); \
        for (int rep = 0; rep < REP_M1; ++rep) { \
        ph_mixprep(c, P_U, P_UF, INP(7) + (size_t)ly * 4 * 1024, INP(8) + (size_t)ly * 1024, INP(16) + (size_t)ly * 128, INP(9) + (size_t)ly * 8, P_XC, P_Y, P_CN, P_DT, P_KI); \
        ph_fcum(c, P_UF, INP(15) + (size_t)ly * 8, P_FCUM); } \
        grid_barrier(c); \
        for (int rep = 0; rep < REP_SSD; ++rep) ph_ssd_states(c, P_XC, P_DT, INP(10) + (size_t)ly * 8, P_ST, P_CD); \
        for (int rep = 0; rep < REP_FOX; ++rep) ph_fox(c, P_U, P_FCUM, P_Y); \
        grid_barrier(c); \
        ph_ssd_scan(c, P_ST, P_CD); \
        for (int rep = 0; rep < REP_DSA; ++rep) ph_dsa(c, P_U, P_UF, P_CN, P_KI); \
        grid_barrier(c); \
        for (int rep = 0; rep < REP_SSD; ++rep) ph_ssd_out(c, P_XC, P_U, P_DT, INP(10) + (size_t)ly * 8, INP(11) + (size_t)ly * 8, P_ST, P_Y); \
        grid_barrier(c); \
        if (fused) { ph_gemm_resid(c, P_Y, P_WOUT, P_MIX, KOUT, P_XB, INP(3) + (size_t)ly * DM, nullptr, P_PS, P_SS, P_CNT + (2 * (ly)) * 128); \
            grid_barrier(c); \
            ph_resid(c, P_MIX, INP(3) + (size_t)ly * DM, P_XB, P_RSTD, nullptr, P_SS); } \
        else { for (int rep = 0; rep < REP_G2; ++rep) ph_gemm_plain(c, P_Y, P_WOUT, P_MIX, DM, KOUT, DM, nullptr, nullptr, WGM_OUT); \
            grid_barrier(c); \
            ph_resid(c, P_MIX, INP(3) + (size_t)ly * DM, P_XB, P_RSTD, nullptr); } \
        grid_barrier(c); \
        for (int rep = 0; rep < REP_G3; ++rep) ph_gemm_gateup(c, P_XB, P_WGU, P_H, P_RSTD, INP(22) + (size_t)ly * 3 * FF, INP(23) + (size_t)ly * FF, P_FXG, P_FXU, P_HB, P_GUM); \
        grid_barrier(c); \
        ph_ffn_fixup(c, P_H, INP(22) + (size_t)ly * 3 * FF, INP(23) + (size_t)ly * FF, P_FXG, P_FXU, P_HB, P_GUM); \
        grid_barrier(c); \
        if (fused) { ph_gemm_resid(c, P_H, P_WDN, P_MIX2, FF, P_XB, INP(5) + (size_t)ly * DM, (ly) == DEPTH - 1 ? DOUT : nullptr, P_PS, P_SS, P_CNT + (2 * (ly) + 1) * 128); \
            if ((ly) + 1 < DEPTH) { grid_barrier(c); \
                ph_resid(c, P_MIX2, INP(5) + (size_t)ly * DM, P_XB, P_RSTD, nullptr, P_SS); } }        \
        else { for (int rep = 0; rep < REP_G4; ++rep) ph_gemm_plain(c, P_H, P_WDN, P_MIX2, DM, FF, DM, nullptr, nullptr, WGM_DN); \
            grid_barrier(c); \
            ph_resid(c, P_MIX2, INP(5) + (size_t)ly * DM, P_XB, P_RSTD, (ly) == DEPTH - 1 ? DOUT : nullptr); } \
        if ((ly) + 1 < DEPTH) { for (int rep = 0; rep < REP_PREPW; ++rep) ph_prep_w(c, (ly) + 1, P_WIN, P_WOUT, P_WGU, P_WDN, P_WUK, P_WUV);     \
            grid_barrier(c); } \
    } while (0)
    const bool fused = c.nb == 256;
    LAYER_BODY(0); LAYER_BODY(1); LAYER_BODY(2); LAYER_BODY(3);
}

extern "C" void kernel_launch(void* const* d_in, const int* in_sizes, int n_in, void* d_out, int out_size, void* d_ws, size_t ws_size, hipStream_t stream) {
    static int grid_blocks = 0;
    if (grid_blocks == 0) {
        if (n_in != 25 || in_sizes[0] != NB * SEQ * DM || out_size != NB * SEQ * DM || ws_size < WS_END) { fprintf(stderr, "kernel_launch: unexpected shapes (n_in %d in0 %d out %d ws %zu)\n", n_in, n_in > 0 ? in_sizes[0] : -1, out_size, ws_size); grid_blocks = -1; return; }
        int dev = 0, cus = 0, per_cu = 0;
        (void)hipGetDevice(&dev); (void)hipDeviceGetAttribute(&cus, hipDeviceAttributeMultiprocessorCount, dev);
        if (hipFuncSetAttribute((const void*)fwd_mega, hipFuncAttributeMaxDynamicSharedMemorySize, LDS_BYTES) != hipSuccess) { fprintf(stderr, "kernel_launch: hipFuncSetAttribute failed\n"); grid_blocks = -1; return; }
        if (hipOccupancyMaxActiveBlocksPerMultiprocessor(&per_cu, (const void*)fwd_mega, NTHR, LDS_BYTES) != hipSuccess || per_cu < 1) { fprintf(stderr, "kernel_launch: occupancy query says %d blocks/CU\n", per_cu); grid_blocks = -1; return; }
        grid_blocks = cus;
        fprintf(stderr, "kernel_launch: %d CUs, %d blocks/CU by the occupancy query, grid %d\n", cus, per_cu, grid_blocks);
    }
    if (grid_blocks < 0) return;
    if (hipMemsetAsync((char*)d_ws + WS_CTL, 0, 65536, stream) != hipSuccess) { fprintf(stderr, "kernel_launch: memset failed\n"); return; }
    Args a{};
    for (int i = 0; i < 25; ++i) a.in[i] = (const float*)d_in[i];
    a.out = (float*)d_out; a.ws = (unsigned char*)d_ws;
    void* args[] = {&a};
    hipError_t e = hipLaunchCooperativeKernel((const void*)fwd_mega, dim3(grid_blocks), dim3(NTHR), args, LDS_BYTES, stream);
    if (e != hipSuccess) fprintf(stderr, "kernel_launch: cooperative launch failed: %s (grid %d)\n", hipGetErrorString(e), grid_blocks);
}
```
